# Optimizing an MI355X kernel written in HIP

```python
import math
import jax, jax.numpy as jnp
from jax import lax
import numpy as np

D_MODEL = 1024
BATCH = 2
SEQ = 8192
DEPTH = 1

D_MIX = D_MODEL
D_POOL = D_MIX // 2
POOL_WINDOWS = (2, 4, 8, 16)
N_POOL_GROUPS = len(POOL_WINDOWS)
POOL_GROUP = D_POOL // N_POOL_GROUPS
D_SSM = D_MIX - D_POOL
SSM_GROUP = 16
N_SSM_GROUPS = D_SSM // SSM_GROUP
SSM_STATE = 64
N_DIR = 2
DT_MIN = 0.001
DT_MAX = 0.1
N_EXPERT_GROUPS = 4
EXPERTS_PER_GROUP = 8
TOP_K_IN_GROUP = 2
D_EXPERT = D_MODEL // 4
D_PLE = 256
RMS_EPS = 1e-6

kernel_name = 'hymba_pool_s5_hmoe_block'

F32 = jnp.float32


def rmsnorm(x, g):
    xf = x.astype(F32)
    y = xf * lax.rsqrt(jnp.mean(xf * xf, axis=-1, keepdims=True) + RMS_EPS)
    return (y * g.astype(F32)).astype(x.dtype)


def centred_window_mean(x, w):
    s = x.shape[1]
    xf = x.astype(F32)
    cs = jnp.concatenate([jnp.zeros_like(xf[:, :1]), jnp.cumsum(xf, axis=1)], axis=1)
    t = jnp.arange(s)
    lo = jnp.clip(t - w // 2, 0, s)
    hi = jnp.clip(t - w // 2 + w, 0, s)
    total = jnp.take(cs, hi, axis=1) - jnp.take(cs, lo, axis=1)
    return total / (hi - lo).astype(F32)[None, :, None]


def pool_mixer(u, pool_w, pool_scale):
    outs = []
    for gi, w in enumerate(POOL_WINDOWS):
        ug = u[..., gi * POOL_GROUP:(gi + 1) * POOL_GROUP]
        diff = (centred_window_mean(ug, w) - ug.astype(F32)).astype(u.dtype)
        outs.append(diff @ pool_w[gi])
    return jnp.concatenate(outs, axis=-1) * pool_scale


def ssm_scan_direction(u_c, lam_bar, b_bar, c):
    bu = jnp.einsum('bsgc,gnc->bsgn', u_c, b_bar)
    a = jnp.broadcast_to(lam_bar, bu.shape)

    def combine(left, right):
        a_l, b_l = left
        a_r, b_r = right
        return a_l * a_r, a_r * b_l + b_r

    _, states = lax.associative_scan(combine, (a, bu), axis=1)
    return jnp.einsum('bsgn,gcn->bsgc', states, c).real


def ssm_mixer(u, a_re, a_im, log_dt, b_re, b_im, c_re, c_im, d, glu_w, glu_b):
    bsz, s, _ = u.shape
    uf = u.astype(F32)
    u_c = uf.reshape(bsz, s, N_SSM_GROUPS, SSM_GROUP).astype(jnp.complex64)
    y = uf * d.astype(F32)
    for di in range(N_DIR):
        lam = lax.complex(a_re[di].astype(F32), a_im[di].astype(F32))
        dt = jnp.exp(log_dt[di].astype(F32))[:, None]
        lam_bar = jnp.exp(lam * dt)
        b_bar = ((lam_bar - 1.0) / lam)[..., None] * lax.complex(b_re[di].astype(F32), b_im[di].astype(F32))
        c = lax.complex(c_re[di].astype(F32), c_im[di].astype(F32))
        if di == 0:
            yd = ssm_scan_direction(u_c, lam_bar, b_bar, c)
        else:
            yd = jnp.flip(ssm_scan_direction(jnp.flip(u_c, axis=1), lam_bar, b_bar, c), axis=1)
        y = y + yd.reshape(bsz, s, D_SSM)
    z = jax.nn.gelu(y)
    gate = jax.nn.sigmoid(z @ glu_w.astype(F32) + glu_b.astype(F32))
    return (z * gate).astype(u.dtype)


def hierarchical_moe(v, grp_w, grp_b, exp_w, exp_b, w_gate, w_up, w_down):
    bsz, s, dm = v.shape
    t = v.reshape(-1, dm)
    tf = t.astype(F32)
    grp_prob = jax.nn.softmax(tf @ grp_w.astype(F32) + grp_b.astype(F32), axis=-1)
    grp_p, grp_idx = lax.top_k(grp_prob, 1)
    exp_logits = jnp.einsum('td,gde->tge', tf, exp_w.astype(F32)) + exp_b.astype(F32)
    sel_logits = jnp.take_along_axis(exp_logits, grp_idx[:, :, None], axis=1)[:, 0]
    exp_prob = jax.nn.softmax(sel_logits, axis=-1)
    top_w, top_idx = lax.top_k(exp_prob, TOP_K_IN_GROUP)
    top_w = top_w / jnp.sum(top_w, axis=-1, keepdims=True)
    exp_comb = jnp.sum(jax.nn.one_hot(top_idx, EXPERTS_PER_GROUP, dtype=F32) * top_w[..., None], axis=1)
    combine = jax.nn.one_hot(grp_idx[:, 0], N_EXPERT_GROUPS, dtype=F32)[:, :, None] * (grp_p * exp_comb)[:, None, :]
    out = jnp.zeros((t.shape[0], dm), F32)
    for g in range(N_EXPERT_GROUPS):
        hg = jax.nn.silu(jnp.einsum('td,edf->tef', t, w_gate[g])) * jnp.einsum('td,edf->tef', t, w_up[g])
        hg = hg * combine[:, g, :, None].astype(hg.dtype)
        out = out + jnp.einsum('tef,efd->td', hg, w_down[g]).astype(F32)
    return out.astype(v.dtype).reshape(bsz, s, dm)


def setup_inputs(seed: int = 0) -> dict:
    key = jax.random.key(seed)
    ks = jax.random.split(key, 32)
    L = DEPTH
    G, N, C = N_SSM_GROUPS, SSM_STATE, SSM_GROUP
    GE, E, F = N_EXPERT_GROUPS, EXPERTS_PER_GROUP, D_EXPERT
    nrm = lambda k, shape, scale: jax.random.normal(k, shape, F32) * scale
    a_im_base = jnp.pi * jnp.arange(N, dtype=F32)
    return {
        'x': jax.random.normal(ks[0], (BATCH, SEQ, D_MODEL), F32),
        'p': jax.random.normal(ks[1], (DEPTH, BATCH, SEQ, D_PLE), F32),
        'g_mix': 1.0 + nrm(ks[2], (L, D_MODEL), 0.05),
        'w_in': nrm(ks[3], (L, D_MODEL, D_MIX), D_MODEL ** -0.5),
        'pool_w': nrm(ks[4], (L, N_POOL_GROUPS, POOL_GROUP, POOL_GROUP), POOL_GROUP ** -0.5),
        'pool_scale': 1.0 + nrm(ks[5], (L, D_POOL), 0.05),
        'ssm_a_re': -0.5 + nrm(ks[6], (L, N_DIR, G, N), 0.01),
        'ssm_a_im': a_im_base + nrm(ks[7], (L, N_DIR, G, N), 0.01),
        'ssm_log_dt': jax.random.uniform(ks[8], (L, N_DIR, G), F32, math.log(DT_MIN), math.log(DT_MAX)),
        'ssm_b_re': nrm(ks[9], (L, N_DIR, G, N, C), (2 * C) ** -0.5),
        'ssm_b_im': nrm(ks[10], (L, N_DIR, G, N, C), (2 * C) ** -0.5),
        'ssm_c_re': nrm(ks[11], (L, N_DIR, G, C, N), 0.5),
        'ssm_c_im': nrm(ks[12], (L, N_DIR, G, C, N), 0.5),
        'ssm_d': nrm(ks[13], (L, D_SSM), 1.0),
        'glu_w': nrm(ks[14], (L, D_SSM, D_SSM), D_SSM ** -0.5),
        'glu_b': nrm(ks[15], (L, D_SSM), 0.02),
        'w_out': nrm(ks[16], (L, D_MIX, D_MODEL), D_MIX ** -0.5),
        'g_ffn': 1.0 + nrm(ks[17], (L, D_MODEL), 0.05),
        'router_grp_w': nrm(ks[18], (L, D_MODEL, GE), D_MODEL ** -0.5),
        'router_grp_b': nrm(ks[19], (L, GE), 0.01),
        'router_exp_w': nrm(ks[20], (L, GE, D_MODEL, E), D_MODEL ** -0.5),
        'router_exp_b': nrm(ks[21], (L, GE, E), 0.01),
        'exp_w_gate': nrm(ks[22], (L, GE, E, D_MODEL, F), D_MODEL ** -0.5),
        'exp_w_up': nrm(ks[23], (L, GE, E, D_MODEL, F), D_MODEL ** -0.5),
        'exp_w_down': nrm(ks[24], (L, GE, E, F, D_MODEL), F ** -0.5),
        'g_ple': 1.0 + nrm(ks[25], (L, D_MODEL), 0.05),
        'ple_gate_w': nrm(ks[26], (L, D_MODEL, D_MODEL), D_MODEL ** -0.5),
        'ple_gate_b': nrm(ks[27], (L, D_MODEL), 0.02),
        'ple_proj_w': nrm(ks[28], (L, D_PLE, D_MODEL), D_PLE ** -0.5),
        'g_final': 1.0 + nrm(ks[29], (D_MODEL,), 0.05),
    }


def reference(x, p, g_mix, w_in, pool_w, pool_scale, ssm_a_re, ssm_a_im, ssm_log_dt,
              ssm_b_re, ssm_b_im, ssm_c_re, ssm_c_im, ssm_d, glu_w, glu_b, w_out,
              g_ffn, router_grp_w, router_grp_b, router_exp_w, router_exp_b,
              exp_w_gate, exp_w_up, exp_w_down, g_ple, ple_gate_w, ple_gate_b,
              ple_proj_w, g_final):
    h = x
    for i in range(DEPTH):
        u = rmsnorm(h, g_mix[i])
        z = u @ w_in[i]
        a = pool_mixer(z[..., :D_POOL], pool_w[i], pool_scale[i])
        s = ssm_mixer(z[..., D_POOL:], ssm_a_re[i], ssm_a_im[i], ssm_log_dt[i],
                      ssm_b_re[i], ssm_b_im[i], ssm_c_re[i], ssm_c_im[i], ssm_d[i],
                      glu_w[i], glu_b[i])
        h = h + jnp.concatenate([a, s], axis=-1) @ w_out[i]
        h = h + hierarchical_moe(rmsnorm(h, g_ffn[i]), router_grp_w[i], router_grp_b[i],
                                 router_exp_w[i], router_exp_b[i], exp_w_gate[i],
                                 exp_w_up[i], exp_w_down[i])
        gate = jax.nn.sigmoid(rmsnorm(h, g_ple[i]) @ ple_gate_w[i] + ple_gate_b[i])
        h = h + gate * (p[i] @ ple_proj_w[i])
    return rmsnorm(h, g_final)
```

```cpp
#include <hip/hip_runtime.h>
#include <cstdio>
#include <cstdint>
namespace pg8 {
#define PG8_LAS __attribute__((address_space(3)))
typedef unsigned short bf16_t;
typedef short bf16x8 __attribute__((ext_vector_type(8)));
typedef float f32x4 __attribute__((ext_vector_type(4)));
typedef unsigned u32x4 __attribute__((ext_vector_type(4)));
constexpr int BM = 256, BK = 64, HALF = 128, HTB = HALF * BK * 2  , STAGE_BYTES = 8 * HTB, NXCD = 8, WGM = 8;

__host__ __device__ __forceinline__ int lds_byte(int r, int c) { const int st = (r >> 4) * 2 + (c >> 5), rr = r & 15, cc = c & 31, ob = rr * 64 + cc * 2; return st * 1024 + (ob ^ (((ob >> 9) & 1) << 5)); }
__host__ __device__ __forceinline__ void stage_rc(int b, int& R, int& C) { const int st = b / 1024, sb = b % 1024, swz = sb ^ (((sb >> 9) & 1) << 5); R = (st >> 1) * 16 + swz / 64; C = (st & 1) * 32 + (swz % 64) / 2; }
__host__ __device__ __forceinline__ int perm32(int rho) { const int n = rho >> 4, i = rho & 15; return 8 * (i >> 2) + 4 * n + (i & 3); }

struct Unit { int pm, pn; };
struct Gemm { const bf16_t* A; const bf16_t* Bt; int K, lda, ldb; };

struct StaticOrder {
    int nM, nN, nwg, G, c;
    __host__ __device__ void init(int M, int N, int G_, int c_) { nM = M / BM; nN = N / BM; nwg = nM * nN; G = G_; c = c_; }
    __host__ __device__ bool next(int i, Unit& u) const {
        const long L = (long)i * G + c; if (L >= nwg) return false;
        int wgid = (int)L; { const int q = nwg / NXCD, r = nwg % NXCD, xcd = wgid % NXCD, off = wgid / NXCD; wgid = (xcd < r ? xcd * (q + 1) : r * (q + 1) + (xcd - r) * q) + off; }
        const int nig = WGM * nN, gid = wgid / nig, fm = gid * WGM, gsz = (nM - fm) < WGM ? (nM - fm) : WGM;
        u.pm = fm + ((wgid % nig) % gsz); u.pn = (wgid % nig) / gsz; return true;
    }
    __device__ __forceinline__ void a_ready(const Unit&) const {}
    __device__ __forceinline__ void done(const Unit&) const {}
};

template <class Epi, class Sched, bool ALIGN_EPI = false, bool SP2 = false>
__device__ __forceinline__ void gemm_phase(PG8_LAS unsigned char* lds, const Gemm g, const Sched& S, const Epi& E) {
    int tid_ = threadIdx.x; asm volatile("" : "+v"(tid_));
    const int tid = tid_, wid = __builtin_amdgcn_readfirstlane(tid >> 6), lane = tid & 63, wr = wid >> 2, wc = wid & 3, fr = lane & 15, fq = lane >> 4;
    const int K = g.K, nt = K / BK;
    unsigned voffA[2], voffB[2];
#pragma unroll
    for (int i = 0; i < 2; ++i) { int R, C; stage_rc(tid * 16 + i * 8192, R, C); const int Rb = Epi::PERM ? ((R & ~31) + perm32(R & 31)) : R;
        voffA[i] = (unsigned)(R * g.lda + C) * 2u; voffB[i] = (unsigned)(Rb * g.ldb + C) * 2u; }
    const size_t kstep = (size_t)(BK * 2);
    const size_t hstepA = (size_t)HALF * g.lda * 2, hstepB = (size_t)HALF * g.ldb * 2;
    const size_t tstepA = 2 * hstepA, tstepB = 2 * hstepB;
    const unsigned ldsw = (unsigned)wid * 1024u;
    const int aoff = lds_byte(wr * 64 + fr, fq * 8), boff = lds_byte(wc * 32 + fr, fq * 8);
#define PG8_SA(b, h) (((b) * 2 + (h)) * HTB)
#define PG8_SB(b, h) ((4 + (b) * 2 + (h)) * HTB)
#define PG8_STAGE(bufoff, gbase, voff) do { _Pragma("unroll") for (int _i = 0; _i < 2; ++_i) \
        __builtin_amdgcn_global_load_lds((const unsigned*)((const char*)(gbase) + (voff)[_i]), (PG8_LAS unsigned*)(lds + (bufoff) + ldsw + _i * 8192), 16, 0, 0); } while (0)
#define PG8_LDA(dst, b, h) do { _Pragma("unroll") for (int m = 0; m < 4; ++m) _Pragma("unroll") for (int k = 0; k < 2; ++k) dst[m][k] = *(const PG8_LAS bf16x8*)(lds + PG8_SA(b, h) + aoff + m * 2048 + k * 1024); } while (0)
#define PG8_LDB(dst, b, h) do { _Pragma("unroll") for (int n = 0; n < 2; ++n) _Pragma("unroll") for (int k = 0; k < 2; ++k) dst[n][k] = *(const PG8_LAS bf16x8*)(lds + PG8_SB(b, h) + boff + n * 2048 + k * 1024); } while (0)
#define PG8_MMA(ai, bj, At, Bt) do { __builtin_amdgcn_s_setprio(1); _Pragma("unroll") for (int m = 0; m < 4; ++m) _Pragma("unroll") for (int n = 0; n < 2; ++n) _Pragma("unroll") for (int k = 0; k < 2; ++k) \
        acc[ai][bj][m][n] = __builtin_amdgcn_mfma_f32_16x16x32_bf16(Bt[n][k], At[m][k], acc[ai][bj][m][n], 0, 0, 0); __builtin_amdgcn_s_setprio(0); } while (0)
#define PG8_WAIT_V(n) asm volatile("s_waitcnt vmcnt(" #n ")" ::: "memory")
#define PG8_WAIT_L(n) asm volatile("s_waitcnt lgkmcnt(" #n ")" ::: "memory")
#define PG8_BAR __builtin_amdgcn_s_barrier()
#define PG8_SCHED __builtin_amdgcn_sched_barrier(0)
    Unit cur, nxt; int ui = 0;
    if (!S.next(0, cur)) return;
    f32x4 acc[2][2][4][2];
#pragma unroll
    for (int a = 0; a < 2; ++a)
#pragma unroll
        for (int b = 0; b < 2; ++b)
#pragma unroll
            for (int m = 0; m < 4; ++m)
#pragma unroll
                for (int n = 0; n < 2; ++n) acc[a][b][m][n] = (f32x4){0.f, 0.f, 0.f, 0.f};
    bf16x8 At[4][2], B0[2][2], B1[2][2];
    const char* cA = (const char*)g.A + (size_t)cur.pm * tstepA; const char* cB = (const char*)g.Bt + (size_t)cur.pn * tstepB;
    S.a_ready(cur);
    if constexpr (SP2) {
        PG8_STAGE(PG8_SB(0, 0), cB, voffB); PG8_STAGE(PG8_SB(0, 1), cB + hstepB, voffB); PG8_STAGE(PG8_SA(0, 0), cA, voffA); PG8_STAGE(PG8_SA(0, 1), cA + hstepA, voffA);
        if (wr == 1) PG8_BAR;
        PG8_WAIT_V(2); PG8_BAR;
        PG8_STAGE(PG8_SB(1, 0), cB + kstep, voffB); PG8_STAGE(PG8_SA(1, 0), cA + kstep, voffA); PG8_STAGE(PG8_SB(1, 1), cB + hstepB + kstep, voffB);
        PG8_WAIT_V(6); PG8_BAR;
    } else {
        PG8_STAGE(PG8_SB(0, 0), cB, voffB); PG8_STAGE(PG8_SA(0, 0), cA, voffA); PG8_STAGE(PG8_SB(0, 1), cB + hstepB, voffB); PG8_STAGE(PG8_SA(0, 1), cA + hstepA, voffA);
        if (wr == 1) PG8_BAR;
        PG8_WAIT_V(4); PG8_BAR;
        PG8_STAGE(PG8_SB(1, 0), cB + kstep, voffB); PG8_STAGE(PG8_SA(1, 0), cA + kstep, voffA); PG8_STAGE(PG8_SB(1, 1), cB + hstepB + kstep, voffB);
        PG8_WAIT_V(6); PG8_BAR;
    }
    for (;;) {
        const bool has_next = S.next(ui + 1, nxt);
        const char* nA = has_next ? (const char*)g.A + (size_t)nxt.pm * tstepA : cA; const char* nB = has_next ? (const char*)g.Bt + (size_t)nxt.pn * tstepB : cB;
        for (int t = 0; t < nt; t += 2) {
            const bool last = (t == nt - 2);
            const char* a1 = cA + (size_t)(t + 1) * kstep;
            const char* a2 = last ? nA : cA + (size_t)(t + 2) * kstep; const char* b2 = last ? nB : cB + (size_t)(t + 2) * kstep;
            const char* a3 = a2 + kstep; const char* b3 = b2 + kstep;
            if (last && has_next) S.a_ready(nxt);
            if constexpr (SP2) {
            PG8_LDB(B0, 0, 0); PG8_LDB(B1, 0, 1); PG8_SCHED; PG8_LDA(At, 0, 0); PG8_STAGE(PG8_SA(1, 1), a1 + hstepA, voffA);
            PG8_WAIT_V(8); PG8_WAIT_L(0); PG8_BAR; PG8_MMA(0, 0, At, B0); PG8_MMA(0, 1, At, B1); PG8_BAR; PG8_SCHED;
            PG8_LDA(At, 0, 1); PG8_STAGE(PG8_SB(0, 0), b2, voffB); PG8_STAGE(PG8_SB(0, 1), b2 + hstepB, voffB); PG8_STAGE(PG8_SA(0, 0), a2, voffA);
            PG8_WAIT_V(8); PG8_WAIT_L(0); PG8_BAR; PG8_MMA(1, 0, At, B0); PG8_MMA(1, 1, At, B1); PG8_BAR; PG8_SCHED;
            PG8_LDB(B0, 1, 0); PG8_LDB(B1, 1, 1); PG8_SCHED; PG8_LDA(At, 1, 0); PG8_STAGE(PG8_SA(0, 1), a2 + hstepA, voffA);
            PG8_WAIT_V(8); PG8_WAIT_L(0); PG8_BAR; PG8_MMA(0, 0, At, B0); PG8_MMA(0, 1, At, B1); PG8_BAR; PG8_SCHED;
            PG8_LDA(At, 1, 1); PG8_STAGE(PG8_SB(1, 0), b3, voffB); PG8_STAGE(PG8_SB(1, 1), b3 + hstepB, voffB); PG8_STAGE(PG8_SA(1, 0), a3, voffA);
            PG8_WAIT_V(8); PG8_WAIT_L(0); PG8_BAR; PG8_MMA(1, 0, At, B0); PG8_MMA(1, 1, At, B1); PG8_BAR; PG8_SCHED;
            } else {
            PG8_LDB(B0, 0, 0); PG8_SCHED; PG8_LDA(At, 0, 0); PG8_STAGE(PG8_SA(1, 1), a1 + hstepA, voffA);
            PG8_WAIT_L(8); PG8_BAR; PG8_WAIT_L(0); PG8_MMA(0, 0, At, B0); PG8_BAR; PG8_SCHED;
            PG8_LDB(B1, 0, 1); PG8_STAGE(PG8_SB(0, 0), b2, voffB);
            PG8_BAR; PG8_WAIT_L(0); PG8_MMA(0, 1, At, B1); PG8_BAR;
            PG8_LDA(At, 0, 1); PG8_STAGE(PG8_SA(0, 0), a2, voffA);
            PG8_BAR; PG8_WAIT_L(0); PG8_MMA(1, 0, At, B0); PG8_BAR; PG8_SCHED;
            PG8_STAGE(PG8_SB(0, 1), b2 + hstepB, voffB);
            PG8_WAIT_V(6); PG8_BAR; PG8_MMA(1, 1, At, B1); PG8_BAR;
            PG8_LDB(B0, 1, 0); PG8_SCHED; PG8_LDA(At, 1, 0); PG8_STAGE(PG8_SA(0, 1), a2 + hstepA, voffA);
            PG8_WAIT_L(8); PG8_BAR; PG8_WAIT_L(0); PG8_MMA(0, 0, At, B0); PG8_BAR; PG8_SCHED;
            PG8_LDB(B1, 1, 1); PG8_STAGE(PG8_SB(1, 0), b3, voffB);
            PG8_BAR; PG8_WAIT_L(0); PG8_MMA(0, 1, At, B1); PG8_BAR;
            PG8_LDA(At, 1, 1); PG8_STAGE(PG8_SA(1, 0), a3, voffA);
            PG8_BAR; PG8_WAIT_L(0); PG8_MMA(1, 0, At, B0); PG8_BAR; PG8_SCHED;
            PG8_STAGE(PG8_SB(1, 1), b3 + hstepB, voffB);
            PG8_WAIT_V(6); PG8_BAR; PG8_MMA(1, 1, At, B1); PG8_BAR;
            }
        }
        if constexpr (ALIGN_EPI) { if (wr == 0) PG8_BAR; }
        if constexpr (!Epi::AFTER_DRAIN) { E(acc, cur, wr, wc, fr, fq); S.done(cur); }
        if (!has_next) break;
#pragma unroll
        for (int a = 0; a < 2; ++a)
#pragma unroll
            for (int b = 0; b < 2; ++b)
#pragma unroll
                for (int m = 0; m < 4; ++m)
#pragma unroll
                    for (int n = 0; n < 2; ++n) acc[a][b][m][n] = (f32x4){0.f, 0.f, 0.f, 0.f};
        cur = nxt; cA = nA; cB = nB; ++ui;
        if constexpr (ALIGN_EPI) { if (wr == 1) PG8_BAR; }
    }
    PG8_WAIT_V(0);
    if constexpr (!ALIGN_EPI) { if (wr == 0) PG8_BAR; }
    PG8_BAR;
    if constexpr (Epi::AFTER_DRAIN) { E.fused(acc, cur, wr, wc, fr, fq, lds, wid, lane); S.done(cur); }
#undef PG8_SA
#undef PG8_SB
#undef PG8_STAGE
#undef PG8_LDA
#undef PG8_LDB
#undef PG8_MMA
#undef PG8_WAIT_V
#undef PG8_WAIT_L
#undef PG8_BAR
#undef PG8_SCHED
}
}

#ifndef MK_STAGE
#define MK_STAGE 4
#endif
constexpr int NWAVES = 8;
constexpr int M = 16384, D = 1024, SEQ = 8192, DP = 512, NG = 32, NST = 64, GC = 16, CL = 16  ;
constexpr int NCH = M / CL;
constexpr int NEXP = 32, DF = 256, DPLE = 256;
constexpr int VP_ROWS = 2 * M + NEXP * 256;
constexpr float RMS_EPS = 1e-6f;

constexpr size_t MiB = 1u << 20;
constexpr size_t WS_CTL = 0, CTL_ZERO_BYTES = 1 * MiB;
constexpr size_t WS_WR = 1 * MiB;
constexpr size_t WS_LAMT = 1 * MiB + 256 * 1024;
constexpr size_t WS_ROUTE = 1 * MiB + 512 * 1024;
constexpr size_t WS_WIN = 2 * MiB, WS_GLU = 4 * MiB, WS_WCAT = 5 * MiB, WS_WG = 7 * MiB, WS_WPLE = 9 * MiB;
constexpr size_t WS_ROWINFO = 9 * MiB + 512 * 1024, WS_ROWW = 9 * MiB + 768 * 1024;
constexpr size_t WS_WGU = 10 * MiB, WS_WD = 42 * MiB;
constexpr size_t WS_MS = 58 * MiB, WS_WS3 = 62 * MiB;
constexpr size_t WS_ZZ = 70 * MiB;
constexpr size_t WS_PE = 58 * MiB;
constexpr size_t WS_XN = 90 * MiB;
constexpr size_t WS_ZP = 122 * MiB, WS_AS = 138 * MiB, WS_SLOC = 170 * MiB, WS_CAT = 202 * MiB, WS_PB = 234 * MiB;
constexpr size_t WS_VP = 122 * MiB, WS_ACT = 202 * MiB, WS_MO0 = 122 * MiB, WS_MO1 = 154 * MiB;
constexpr size_t WS_END = 256 * MiB;
static_assert(WS_VP + (size_t)VP_ROWS * 2048 <= WS_ACT && WS_ACT + (size_t)VP_ROWS * 512 <= WS_PB && WS_PB + (size_t)M * 512 <= WS_END, "ws map");
constexpr int CW_CNT = 1024;
constexpr int CW_FILL = 2048;
constexpr int CW_BAR = 4096;
constexpr int RING_OFF = 0, RING_BYTES = 131072, LDSCTL_OFF = RING_BYTES, MISC_OFF = LDSCTL_OFF + 320, LDS_BYTES = 147456;

#define GAS __attribute__((address_space(1)))
#define LAS __attribute__((address_space(3)))
typedef unsigned short bf16;
typedef unsigned v4u __attribute__((ext_vector_type(4)));
typedef unsigned v2u __attribute__((ext_vector_type(2)));
typedef float f32x4 __attribute__((ext_vector_type(4)));
typedef GAS unsigned gu32;
#define RLX_AGENT __ATOMIC_RELAXED, __HIP_MEMORY_SCOPE_AGENT
#define LDS_WAIT() asm volatile("s_waitcnt lgkmcnt(0)" ::: "memory")
#define VM_WAIT() asm volatile("s_waitcnt vmcnt(0)" ::: "memory")
__device__ __forceinline__ unsigned f2bf(float f) { unsigned u = __builtin_bit_cast(unsigned, f); return (u + 0x7fffu + ((u >> 16) & 1u)) >> 16; }
__device__ __forceinline__ unsigned pk2(float lo, float hi) { return f2bf(lo) | (f2bf(hi) << 16); }
__device__ __forceinline__ float bflo(unsigned w) { return __builtin_bit_cast(float, w << 16); }
__device__ __forceinline__ float bfhi(unsigned w) { return __builtin_bit_cast(float, w & 0xffff0000u); }
__device__ __forceinline__ float sigmoidf_(float x) { return 1.0f / (1.0f + __expf(-x)); }
__device__ __forceinline__ float gelu_tanh(float y) { const float t = 1.5957691216f * (y + 0.044715f * y * y * y); return y / (1.0f + __expf(-t)); }

#define XB_TMO      128
#define XB_XCNT(j)  (256  + 64 * (j))
#define XB_XSUB(j)  (1280 + 64 * (j))
#define XB_XGEN(j)  (2304 + 64 * (j))
#define XB_TOP      3328
#define XB_TOPGEN   3392
#define XCD_BAR_WORDS 3456
#define XB_SPIN_CAP (1u << 18)
__device__ __forceinline__ unsigned xb_ld(unsigned* p)              { return __hip_atomic_load(p, __ATOMIC_RELAXED, __HIP_MEMORY_SCOPE_AGENT); }
__device__ __forceinline__ unsigned xb_add(unsigned* p, unsigned v) { return __hip_atomic_fetch_add(p, v, __ATOMIC_RELAXED, __HIP_MEMORY_SCOPE_AGENT); }
__device__ __forceinline__ unsigned xb_xcc_id() { return (unsigned)__builtin_amdgcn_s_getreg((3 << 11) | 20) & 0xFu; }
#define XB_SPIN(cond, bar) do { unsigned _sp = 0; while (cond) { __builtin_amdgcn_s_sleep(1); \
    if ((++_sp & 255u) == 0u) { if (xb_ld(&(bar)[XB_TMO])) break; if (_sp > XB_SPIN_CAP) { atomicAdd(&(bar)[XB_TMO], 1u); break; } } } } while (0)
struct XcdBarrier { unsigned* bar; unsigned x; volatile LAS unsigned* st; };
__device__ __forceinline__ XcdBarrier xcd_barrier_post(unsigned* bar, volatile LAS unsigned* st) {
    XcdBarrier b; b.bar = bar; b.x = xb_xcc_id(); b.st = st;
    if (threadIdx.x == 0) (void)xb_add(&bar[XB_XCNT(b.x)], 1u);
    return b;
}
__device__ __forceinline__ void xcd_barrier_complete(unsigned* bar, unsigned x, unsigned& nloc, unsigned& nx) {
    const unsigned G = gridDim.x * gridDim.y * gridDim.z;
    unsigned sum, cnt, mine, sp = 0u;
    for (;;) {
        sum = 0u; cnt = 0u; mine = 0u;
#pragma unroll
        for (unsigned j = 0; j < 16; ++j) { const unsigned c = xb_ld(&bar[XB_XCNT(j)]); sum += c; cnt += (c > 0u) ? 1u : 0u; mine = (j == x) ? c : mine; }
        if (sum == G) break;
        __builtin_amdgcn_s_sleep(1);
        if ((++sp & 255u) == 0u) { if (xb_ld(&bar[XB_TMO])) break; if (sp > XB_SPIN_CAP) { atomicAdd(&bar[XB_TMO], 1u); break; } }
    }
    nloc = mine > 0u ? mine : 1u; nx = cnt > 0u ? cnt : 1u;
}
__device__ __forceinline__ void xcd_barrier(const XcdBarrier& b) {
    asm volatile("s_waitcnt vmcnt(0)" ::: "memory");
    __syncthreads();
    if (threadIdx.x == 0) {
        unsigned* bar = b.bar;
        __builtin_amdgcn_s_waitcnt(0);
        unsigned nloc = b.st[0], nx = b.st[1];
        if (nloc == 0u) { xcd_barrier_complete(bar, b.x, nloc, nx); b.st[0] = nloc; b.st[1] = nx; }
        const unsigned old = xb_add(&bar[XB_XSUB(b.x)], 1u);
        const unsigned gen = old / nloc;
        if (old + 1u == (gen + 1u) * nloc) {
            __builtin_amdgcn_fence(__ATOMIC_RELEASE, "agent");
            asm volatile("s_waitcnt vmcnt(0)" ::: "memory");
            const unsigned og = xb_add(&bar[XB_TOP], 1u);
            const unsigned tg = og / nx;
            if (og + 1u == (tg + 1u) * nx) xb_add(&bar[XB_TOPGEN], 1u);
            else XB_SPIN(xb_ld(&bar[XB_TOPGEN]) == tg, bar);
            __builtin_amdgcn_fence(__ATOMIC_ACQUIRE, "agent");
            xb_add(&bar[XB_XGEN(b.x)], 1u);
            asm volatile("s_waitcnt vmcnt(0)" ::: "memory");
        } else {
            XB_SPIN(xb_ld(&bar[XB_XGEN(b.x)]) == gen, bar);
            __builtin_amdgcn_fence(__ATOMIC_ACQUIRE, "agent");
            asm volatile("s_waitcnt vmcnt(0)" ::: "memory");
        }
    }
    __syncthreads();
}

struct Args { const float* in[30]; float* out; unsigned char* ws; };
struct Frame {
    LAS unsigned char* lds;
    volatile LAS unsigned* MISC;
    gu32* ctl;
    int tid, lane, wave, G, gw, ngw;
    float* out;
    unsigned char* ws;
};
__device__ __forceinline__ int opq(int v) { asm volatile("" : "+v"(v)); return v; }
__device__ __forceinline__ float wave_sum(float v) {
#pragma unroll
    for (int o = 1; o < 64; o <<= 1) v += __shfl_xor(v, o);
    return v;
}

__device__ __forceinline__ void transpose_item(const float* src, int ld_src, bf16* dst, int ld_dst, LAS float* scr, int lane) {
#pragma unroll 8
    for (int i = 0; i < 32; ++i) { const int kk = 2 * i + (lane >> 5); scr[kk * 33 + (lane & 31)] = src[(size_t)kk * ld_src + (lane & 31)]; }
    LDS_WAIT(); asm volatile("" ::: "memory");
    const int c = lane & 7;
#pragma unroll
    for (int j = 0; j < 4; ++j) { const int n = (lane >> 3) + 8 * j; const LAS float* s = scr + (8 * c) * 33 + n;
        v4u o; o.x = pk2(s[0 * 33], s[1 * 33]); o.y = pk2(s[2 * 33], s[3 * 33]); o.z = pk2(s[4 * 33], s[5 * 33]); o.w = pk2(s[6 * 33], s[7 * 33]);
        *(GAS v4u*)(dst + (size_t)n * ld_dst + 8 * c) = o; }
    LDS_WAIT(); asm volatile("" ::: "memory");
}
__device__ __forceinline__ void rms_row_to_bf16(const float* xrow, const float* g, bf16* orow, int lane) {
    const GAS f32x4* xr = (const GAS f32x4*)xrow + lane; const GAS f32x4* gr = (const GAS f32x4*)g + lane;
    f32x4 v[4]; float s = 0.f;
#pragma unroll
    for (int j = 0; j < 4; ++j) { v[j] = xr[64 * j]; s += (v[j].x * v[j].x + v[j].y * v[j].y) + (v[j].z * v[j].z + v[j].w * v[j].w); }
    const float rstd = 1.f / sqrtf(wave_sum(s) * (1.f / D) + RMS_EPS);
    GAS unsigned long long* o8 = (GAS unsigned long long*)orow + lane;
#pragma unroll
    for (int j = 0; j < 4; ++j) { const f32x4 gg = gr[64 * j];
        o8[64 * j] = (unsigned long long)pk2(v[j].x * rstd * gg.x, v[j].y * rstd * gg.y) | ((unsigned long long)pk2(v[j].z * rstd * gg.z, v[j].w * rstd * gg.w) << 32); }
}
__device__ __forceinline__ void sincos_d(double x, double& sn, double& cs) {
    const double k = __builtin_rint(x * 0.63661977236758134308);
    const double r = (x - k * 1.57079632679489655800e+00) - k * 6.12323399573676603587e-17;
    const double r2 = r * r;
    const double s = r * (1.0 + r2 * (-1.0 / 6.0 + r2 * (1.0 / 120.0 + r2 * (-1.0 / 5040.0 + r2 * (1.0 / 362880.0 + r2 * (-1.0 / 39916800.0 + r2 * (1.0 / 6227020800.0)))))));
    const double c = 1.0 + r2 * (-0.5 + r2 * (1.0 / 24.0 + r2 * (-1.0 / 720.0 + r2 * (1.0 / 40320.0 + r2 * (-1.0 / 3628800.0 + r2 * (1.0 / 479001600.0 + r2 * (-1.0 / 87178291200.0)))))));
    const int q = ((int)k) & 3;
    sn = (q == 0) ? s : (q == 1) ? c : (q == 2) ? -s : -c;
    cs = (q == 0) ? c : (q == 1) ? -s : (q == 2) ? -c : s;
}
__device__ __forceinline__ void ssm_gen(Frame& F, const Args& A, int g) {
    LAS float* lamP = (LAS float*)(F.lds + RING_OFF);
    LAS float* Bb = lamP + 2 * 17 * 64 * 2;
    LAS float* Cc = Bb + 2 * 64 * 16 * 2;
    LAS float* KT = Cc + 2 * 16 * 64 * 2;
    LAS float* dv = KT + 2 * 16 * 256;
    LAS float* bfac = dv + 16;
    const float* a_re = A.in[6]; const float* a_im = A.in[7]; const float* log_dt = A.in[8];
    const float* b_re = A.in[9]; const float* b_im = A.in[10]; const float* c_re = A.in[11]; const float* c_im = A.in[12]; const float* ssm_d = A.in[13];
    const int t = opq(F.tid);
    __syncthreads();
    if (t < 128) {
        const int d = t >> 6, n = t & 63;
        const double are = (double)a_re[(d * NG + g) * NST + n], aim = (double)a_im[(d * NG + g) * NST + n], dt = exp((double)log_dt[d * NG + g]);
        const double mag = exp(are * dt); double sn, cs; sincos_d(aim * dt, sn, cs);
        const double lr = mag * cs, li = mag * sn;
        const double nr = lr - 1.0, ni = li, den = are * are + aim * aim;
        bfac[(d * 64 + n) * 2] = (float)((nr * are + ni * aim) / den); bfac[(d * 64 + n) * 2 + 1] = (float)((ni * are - nr * aim) / den);
        double pr = 1.0, pi = 0.0;
        for (int k = 0; k <= 16; ++k) { lamP[((d * 17 + k) * 64 + n) * 2] = (float)pr; lamP[((d * 17 + k) * 64 + n) * 2 + 1] = (float)pi;
            if (k < 16) { const double tr = pr * lr - pi * li, ti = pr * li + pi * lr; pr = tr; pi = ti; } }
        float* lt = (float*)(F.ws + WS_LAMT) + ((g * 2 + d) * 64 + n) * 4;
        lt[0] = (float)pr; lt[1] = (float)pi;
        for (int k = 0; k < 6; ++k) { const double tr = pr * pr - pi * pi, ti = 2.0 * pr * pi; pr = tr; pi = ti; }
        lt[2] = (float)pr; lt[3] = (float)pi;
    }
    if (t < 16) dv[t] = ssm_d[g * GC + t];
    __syncthreads();
    for (int idx = t; idx < 2048; idx += NWAVES * 64) {
        { const int d = idx >> 10, n = (idx >> 4) & 63, ci = idx & 15; const size_t si = ((size_t)(d * NG + g) * NST + n) * GC + ci;
          const float br = b_re[si], bi = b_im[si], fr = bfac[(d * 64 + n) * 2], fi = bfac[(d * 64 + n) * 2 + 1];
          Bb[idx * 2] = fr * br - fi * bi; Bb[idx * 2 + 1] = fr * bi + fi * br; }
        { const int d = idx >> 10, co = (idx >> 6) & 15, n = idx & 63; const size_t si = ((size_t)(d * NG + g) * GC + co) * NST + n;
          Cc[idx * 2] = c_re[si]; Cc[idx * 2 + 1] = c_im[si]; }
    }
    __syncthreads();
    {
        const int d = t >> 8, k = (t >> 4) & 15, ci = t & 15;
        float acc[16];
#pragma unroll
        for (int co = 0; co < 16; ++co) acc[co] = 0.f;
        for (int n = 0; n < 64; ++n) {
            const float pr = lamP[((d * 17 + k) * 64 + n) * 2], pi = lamP[((d * 17 + k) * 64 + n) * 2 + 1];
            const float br = Bb[((d * 64 + n) * 16 + ci) * 2], bi = Bb[((d * 64 + n) * 16 + ci) * 2 + 1];
            const float qr = pr * br - pi * bi, qi = pr * bi + pi * br;
#pragma unroll
            for (int co = 0; co < 16; ++co) acc[co] += Cc[((d * 16 + co) * 64 + n) * 2] * qr - Cc[((d * 16 + co) * 64 + n) * 2 + 1] * qi;
        }
#pragma unroll
        for (int co = 0; co < 16; ++co) KT[((d * 16 + k) * 16 + co) * 16 + ci] = acc[co];
    }
    __syncthreads();
    bf16* WS3 = (bf16*)(F.ws + WS_WS3) + (size_t)g * 256 * 512;
    for (int p = t; p < 256 * 64; p += NWAVES * 64) {
        const int row = p >> 6, kc = (p & 63) * 8, j = row >> 4, co = row & 15;
        float v[8];
        if (kc < 256) {
            const int s = kc >> 4, ci0 = kc & 15;
#pragma unroll
            for (int i = 0; i < 8; ++i) { const int ci = ci0 + i;
                if (j > s) v[i] = KT[((0 * 16 + (j - s)) * 16 + co) * 16 + ci];
                else if (j < s) v[i] = KT[((1 * 16 + (s - j)) * 16 + co) * 16 + ci];
                else v[i] = KT[(0 * 16 + co) * 16 + ci] + KT[((1 * 16 + 0) * 16 + co) * 16 + ci] + (co == ci ? dv[co] : 0.f); }
        } else {
            const int q = (kc - 256) >> 6, n0 = (kc - 256) & 63, d = q >> 1, e = (d == 0) ? (j + 1) : (16 - j);
#pragma unroll
            for (int i = 0; i < 8; ++i) { const int n = n0 + i;
                const float cr = Cc[((d * 16 + co) * 64 + n) * 2], cim = Cc[((d * 16 + co) * 64 + n) * 2 + 1];
                const float pr = lamP[((d * 17 + e) * 64 + n) * 2], pi = lamP[((d * 17 + e) * 64 + n) * 2 + 1];
                v[i] = (q & 1) ? -(cr * pi + cim * pr) : (cr * pr - cim * pi); }
        }
        v4u o; o.x = pk2(v[0], v[1]); o.y = pk2(v[2], v[3]); o.z = pk2(v[4], v[5]); o.w = pk2(v[6], v[7]);
        *(GAS v4u*)(WS3 + (size_t)row * 512 + kc) = o;
    }
    bf16* MS = (bf16*)(F.ws + WS_MS) + (size_t)g * 256 * 256;
    for (int p = t; p < 256 * 32; p += NWAVES * 64) {
        const int row = p >> 5, kc = (p & 31) * 8, q = row >> 6, n = row & 63, d = q >> 1, j = kc >> 4, ci0 = kc & 15, e = (d == 0) ? (15 - j) : j;
        const float pr = lamP[((d * 17 + e) * 64 + n) * 2], pi = lamP[((d * 17 + e) * 64 + n) * 2 + 1];
        float v[8];
#pragma unroll
        for (int i = 0; i < 8; ++i) { const float br = Bb[((d * 64 + n) * 16 + ci0 + i) * 2], bi = Bb[((d * 64 + n) * 16 + ci0 + i) * 2 + 1];
            v[i] = (q & 1) ? (pr * bi + pi * br) : (pr * br - pi * bi); }
        v4u o; o.x = pk2(v[0], v[1]); o.y = pk2(v[2], v[3]); o.z = pk2(v[4], v[5]); o.w = pk2(v[6], v[7]);
        *(GAS v4u*)(MS + (size_t)row * 256 + kc) = o;
    }
    __syncthreads();
}

__device__ __forceinline__ void weff_item(Frame& F, const Args& A, int item) {
    const int gi = item >> 6, nb = (item >> 2) & 15, cb = item & 3, n = nb * 64 + opq(F.lane);
    const float* pool_w = A.in[4] + ((size_t)gi * 128 + cb * 32) * 128; const float* pool_scale = A.in[5] + gi * 128; const float* w_out = A.in[16] + (size_t)gi * 128 * D + n;
    float acc[32];
#pragma unroll
    for (int i = 0; i < 32; ++i) acc[i] = 0.f;
    for (int co = 0; co < 128; ++co) {
        const float w = w_out[(size_t)co * D] * pool_scale[co];
#pragma unroll
        for (int i = 0; i < 32; ++i) acc[i] += pool_w[i * 128 + co] * w;
    }
    bf16* dst = (bf16*)(F.ws + WS_WCAT) + (size_t)n * D + gi * 128 + cb * 32;
#pragma unroll
    for (int i = 0; i < 4; ++i) { v4u o; o.x = pk2(acc[8 * i], acc[8 * i + 1]); o.y = pk2(acc[8 * i + 2], acc[8 * i + 3]); o.z = pk2(acc[8 * i + 4], acc[8 * i + 5]); o.w = pk2(acc[8 * i + 6], acc[8 * i + 7]);
        *(GAS v4u*)(dst + 8 * i) = o; }
}

__device__ __forceinline__ void p0_prologue(Frame& F, const Args& A) {
    for (int g = blockIdx.x; g < NG; g += F.G) ssm_gen(F, A, g);
    __syncthreads();
    LAS float* scr = (LAS float*)(F.lds + RING_OFF + F.wave * 16384);
    constexpr int I_WIN = 16 * 32, I_GLU = 8 * 16, I_WOB = 8 * 32, I_GU = NEXP * 16 * 8, I_DN = NEXP * 4 * 32, I_WG = 16 * 32, I_WPLE = 4 * 32;
    constexpr int I_WEFF = 256, I_WR = 36, I_RI = VP_ROWS / 256, I_ROWS = M / 8;
    constexpr int NITEMS = I_GU + I_GU + I_DN + I_WIN + I_GLU + I_WOB + I_WG + I_WPLE + I_WEFF + I_WR + I_RI + I_ROWS;
    for (int it = F.gw; it < NITEMS; it += F.ngw) {
        int r = it; const int lane = opq(F.lane);
        if (r < 2 * I_GU) {
            const int up = r >= I_GU; if (up) r -= I_GU;
            const int e = r >> 7, kb = (r >> 3) & 15, nb = r & 7, k0 = kb * 64, n0 = nb * 32;
            const float* src = A.in[up ? 23 : 22] + ((size_t)e * D + k0) * DF + n0;
            bf16* dst = (bf16*)(F.ws + WS_WGU) + ((size_t)e * 512 + (n0 >> 7) * 256 + (up ? 128 : 0) + (n0 & 127)) * D + k0;
            transpose_item(src, DF, dst, D, scr, lane); continue; }
        r -= 2 * I_GU;
        if (r < I_DN) {
            const int e = r >> 7, kb = (r >> 5) & 3, nb = r & 31, k0 = kb * 64, n0 = nb * 32;
            transpose_item(A.in[24] + ((size_t)e * DF + k0) * D + n0, D, (bf16*)(F.ws + WS_WD) + ((size_t)e * D + n0) * DF + k0, DF, scr, lane); continue; }
        r -= I_DN;
        if (r < I_WIN) { const int kb = r >> 5, nb = r & 31; transpose_item(A.in[3] + (size_t)kb * 64 * D + nb * 32, D, (bf16*)(F.ws + WS_WIN) + (size_t)nb * 32 * D + kb * 64, D, scr, lane); continue; }
        r -= I_WIN;
        if (r < I_GLU) { const int kb = r >> 4, nb = r & 15; transpose_item(A.in[14] + (size_t)kb * 64 * DP + nb * 32, DP, (bf16*)(F.ws + WS_GLU) + (size_t)nb * 32 * DP + kb * 64, DP, scr, lane); continue; }
        r -= I_GLU;
        if (r < I_WOB) { const int kb = r >> 5, nb = r & 31;
            transpose_item(A.in[16] + (size_t)(DP + kb * 64) * D + nb * 32, D, (bf16*)(F.ws + WS_WCAT) + (size_t)nb * 32 * D + DP + kb * 64, D, scr, lane); continue; }
        r -= I_WOB;
        if (r < I_WG) { const int kb = r >> 5, nb = r & 31; transpose_item(A.in[26] + (size_t)kb * 64 * D + nb * 32, D, (bf16*)(F.ws + WS_WG) + (size_t)nb * 32 * D + kb * 64, D, scr, lane); continue; }
        r -= I_WG;
        if (r < I_WPLE) { const int kb = r >> 5, nb = r & 31; transpose_item(A.in[28] + (size_t)kb * 64 * D + nb * 32, D, (bf16*)(F.ws + WS_WPLE) + (size_t)nb * 32 * DPLE + kb * 64, DPLE, scr, lane); continue; }
        r -= I_WPLE;
        if (r < I_WEFF) { weff_item(F, A, r); continue; }
        r -= I_WEFF;
        if (r < I_WR) {
            float* dst = (float*)(F.ws + WS_WR) + (size_t)r * D;
            if (r < 4) { for (int dd = lane; dd < D; dd += 64) dst[dd] = A.in[18][dd * 4 + r]; }
            else { const int gq = (r - 4) >> 3, e = (r - 4) & 7; for (int dd = lane; dd < D; dd += 64) dst[dd] = A.in[20][((size_t)gq * D + dd) * 8 + e]; }
            continue; }
        r -= I_WR;
        if (r < I_RI) { int* ri = (int*)(F.ws + WS_ROWINFO) + r * 256;
#pragma unroll
            for (int i = 0; i < 4; ++i) ri[lane + 64 * i] = -1;
            continue; }
        r -= I_RI;
        {
            for (int i = 0; i < 8; ++i) { const int m = r * 8 + i;
                rms_row_to_bf16(A.in[0] + (size_t)m * D, A.in[2], (bf16*)(F.ws + WS_XN) + (size_t)m * D, lane);
                const f32x4 pv = *((const GAS f32x4*)(A.in[1] + (size_t)m * DPLE) + lane);
                v2u o; o.x = pk2(pv.x, pv.y); o.y = pk2(pv.z, pv.w);
                *((GAS v2u*)((bf16*)(F.ws + WS_PB) + (size_t)m * DPLE) + lane) = o; }
        }
    }
}

using pg8::Unit; using pg8::bf16_t; typedef unsigned u32x4 __attribute__((ext_vector_type(4)));
__device__ __forceinline__ u32x4 pack8(const f32x4& a, const f32x4& b) { u32x4 w; w.x = pk2(a[0], a[1]); w.y = pk2(a[2], a[3]); w.z = pk2(b[0], b[1]); w.w = pk2(b[2], b[3]); return w; }
struct EpiZ { static constexpr bool PERM = true, AFTER_DRAIN = false; bf16_t* ZP; bf16_t* AS;
    __device__ __forceinline__ void operator()(const f32x4 (&acc)[2][2][4][2], const Unit& u, int wr, int wc, int fr, int fq) const {
        const int row0 = u.pm * 256 + wr * 64 + fr;
#pragma unroll
        for (int ai = 0; ai < 2; ++ai)
#pragma unroll
            for (int m = 0; m < 4; ++m) { const int r = row0 + ai * 128 + m * 16;
#pragma unroll
                for (int bj = 0; bj < 2; ++bj) { const int col = u.pn * 256 + bj * 128 + wc * 32 + 8 * fq; const u32x4 w = pack8(acc[ai][bj][m][0], acc[ai][bj][m][1]);
                    if (u.pn < 2) *(u32x4*)(ZP + (size_t)r * DP + col) = w;
                    else { const int sc = col - DP, g = sc >> 4, ch0 = sc & 15; *(u32x4*)(AS + ((size_t)(g * NCH + (r >> 4)) * 512 + (r & 15) * 16 + ch0)) = w; } } }
    } };
struct EpiSloc { static constexpr bool PERM = false, AFTER_DRAIN = false; float* C;
    __device__ __forceinline__ void operator()(const f32x4 (&acc)[2][2][4][2], const Unit& u, int wr, int wc, int fr, int fq) const {
        const int row0 = u.pm * 256 + wr * 64 + fr, col0 = wc * 32 + 4 * fq;
#pragma unroll
        for (int ai = 0; ai < 2; ++ai)
#pragma unroll
            for (int m = 0; m < 4; ++m) { float* rowp = C + (size_t)(row0 + ai * 128 + m * 16) * 256 + col0;
#pragma unroll
                for (int bj = 0; bj < 2; ++bj)
#pragma unroll
                    for (int n = 0; n < 2; ++n) *(f32x4*)(rowp + bj * 128 + n * 16) = acc[ai][bj][m][n]; }
    } };
struct EpiY { static constexpr bool PERM = true, AFTER_DRAIN = false; bf16_t* ZZ;
    __device__ __forceinline__ void operator()(const f32x4 (&acc)[2][2][4][2], const Unit& u, int wr, int wc, int fr, int fq) const {
        const int g = u.pn, row0 = (u.pm & 3) * 256 + wr * 64 + fr;
#pragma unroll
        for (int ai = 0; ai < 2; ++ai)
#pragma unroll
            for (int m = 0; m < 4; ++m) { const int c = row0 + ai * 128 + m * 16;
#pragma unroll
                for (int bj = 0; bj < 2; ++bj) { const int col = bj * 128 + wc * 32 + 8 * fq, j = col >> 4, co0 = col & 15;
                    f32x4 a = acc[ai][bj][m][0], b = acc[ai][bj][m][1];
#pragma unroll
                    for (int i = 0; i < 4; ++i) { a[i] = gelu_tanh(a[i]); b[i] = gelu_tanh(b[i]); }
                    *(u32x4*)(ZZ + (size_t)(c * CL + j) * DP + g * GC + co0) = pack8(a, b); asm volatile("" ::: "memory"); } }
    } };
struct EpiGlu { static constexpr bool PERM = true, AFTER_DRAIN = false; const bf16_t* ZZ; const float* bias; bf16_t* CAT;
    __device__ __forceinline__ void operator()(const f32x4 (&acc)[2][2][4][2], const Unit& u, int wr, int wc, int fr, int fq) const {
        const int row0 = u.pm * 256 + wr * 64 + fr;
#pragma unroll
        for (int bj = 0; bj < 2; ++bj) { const int col = u.pn * 256 + bj * 128 + wc * 32 + 8 * fq;
            const f32x4 b0 = *(const f32x4*)(bias + col), b1 = *(const f32x4*)(bias + col + 4);
#pragma unroll
            for (int ai = 0; ai < 2; ++ai)
#pragma unroll
                for (int m = 0; m < 4; ++m) { const int r = row0 + ai * 128 + m * 16;
                    const u32x4 z = *(const u32x4*)(ZZ + (size_t)r * DP + col);
                    f32x4 a = acc[ai][bj][m][0] + b0, b = acc[ai][bj][m][1] + b1;
                    a[0] = bflo(z.x) * sigmoidf_(a[0]); a[1] = bfhi(z.x) * sigmoidf_(a[1]); a[2] = bflo(z.y) * sigmoidf_(a[2]); a[3] = bfhi(z.y) * sigmoidf_(a[3]);
                    b[0] = bflo(z.z) * sigmoidf_(b[0]); b[1] = bfhi(z.z) * sigmoidf_(b[1]); b[2] = bflo(z.w) * sigmoidf_(b[2]); b[3] = bfhi(z.w) * sigmoidf_(b[3]);
                    *(u32x4*)(CAT + (size_t)r * D + DP + col) = pack8(a, b); asm volatile("" ::: "memory"); } }
    } };
struct EpiRes { static constexpr bool PERM = false, AFTER_DRAIN = false; const float* X; float* H;
    __device__ __forceinline__ void operator()(const f32x4 (&acc)[2][2][4][2], const Unit& u, int wr, int wc, int fr, int fq) const {
        const int row0 = u.pm * 256 + wr * 64 + fr, col0 = u.pn * 256 + wc * 32 + 4 * fq;
#pragma unroll
        for (int ai = 0; ai < 2; ++ai)
#pragma unroll
            for (int m = 0; m < 4; ++m) { const size_t off = (size_t)(row0 + ai * 128 + m * 16) * D + col0;
#pragma unroll
                for (int bj = 0; bj < 2; ++bj)
#pragma unroll
                    for (int n = 0; n < 2; ++n) *(f32x4*)(H + off + bj * 128 + n * 16) = *(const f32x4*)(X + off + bj * 128 + n * 16) + acc[ai][bj][m][n]; }
    } };
struct EpiAct { static constexpr bool PERM = true, AFTER_DRAIN = false; const float* ROWW; bf16_t* ACT;
    __device__ __forceinline__ void operator()(const f32x4 (&acc)[2][2][4][2], const Unit& u, int wr, int wc, int fr, int fq) const {
        const int row0 = u.pm * 256 + wr * 64 + fr, col = (u.pn & 1) * 128 + wc * 32 + 8 * fq;
#pragma unroll
        for (int ai = 0; ai < 2; ++ai)
#pragma unroll
            for (int m = 0; m < 4; ++m) { const int r = row0 + ai * 128 + m * 16; const float w = ROWW[r];
                f32x4 a, b;
#pragma unroll
                for (int i = 0; i < 4; ++i) { const float g0 = acc[ai][0][m][0][i], g1 = acc[ai][0][m][1][i];
                    a[i] = g0 * sigmoidf_(g0) * acc[ai][1][m][0][i] * w; b[i] = g1 * sigmoidf_(g1) * acc[ai][1][m][1][i] * w; }
                *(u32x4*)(ACT + (size_t)r * DF + col) = pack8(a, b); }
    } };
struct EpiDown { static constexpr bool PERM = true, AFTER_DRAIN = false; const int* ROWINFO; bf16_t* MO0; bf16_t* MO1;
    __device__ __forceinline__ void operator()(const f32x4 (&acc)[2][2][4][2], const Unit& u, int wr, int wc, int fr, int fq) const {
        const int row0 = u.pm * 256 + wr * 64 + fr, col0 = (u.pn & 3) * 256 + wc * 32 + 8 * fq;
#pragma unroll
        for (int ai = 0; ai < 2; ++ai)
#pragma unroll
            for (int m = 0; m < 4; ++m) { const int r = row0 + ai * 128 + m * 16; const int info = ROWINFO[r];
                if (info >= 0) { bf16_t* dst = ((info & 1) ? MO1 : MO0) + (size_t)(info >> 1) * D + col0;
#pragma unroll
                    for (int bj = 0; bj < 2; ++bj) *(u32x4*)(dst + bj * 128) = pack8(acc[ai][bj][m][0], acc[ai][bj][m][1]); } }
    } };
struct EpiPe { static constexpr bool PERM = true, AFTER_DRAIN = false; bf16_t* O;
    __device__ __forceinline__ void operator()(const f32x4 (&acc)[2][2][4][2], const Unit& u, int wr, int wc, int fr, int fq) const {
        const int row0 = u.pm * 256 + wr * 64 + fr, col0 = u.pn * 256 + wc * 32 + 8 * fq;
#pragma unroll
        for (int ai = 0; ai < 2; ++ai)
#pragma unroll
            for (int m = 0; m < 4; ++m) { bf16_t* rowp = O + (size_t)(row0 + ai * 128 + m * 16) * D + col0;
#pragma unroll
                for (int bj = 0; bj < 2; ++bj) *(u32x4*)(rowp + bj * 128) = pack8(acc[ai][bj][m][0], acc[ai][bj][m][1]); }
    } };
struct EpiPle { static constexpr bool PERM = false, AFTER_DRAIN = false; float* H; const float* bias; const bf16_t* PE;
    __device__ __forceinline__ void operator()(const f32x4 (&acc)[2][2][4][2], const Unit& u, int wr, int wc, int fr, int fq) const {
        const int row0 = u.pm * 256 + wr * 64 + fr, col0 = u.pn * 256 + wc * 32 + 4 * fq;
#pragma unroll
        for (int bj = 0; bj < 2; ++bj)
#pragma unroll
            for (int n = 0; n < 2; ++n) { const f32x4 bv = *(const f32x4*)(bias + col0 + bj * 128 + n * 16);
#pragma unroll
                for (int ai = 0; ai < 2; ++ai)
#pragma unroll
                    for (int m = 0; m < 4; ++m) { const size_t off = (size_t)(row0 + ai * 128 + m * 16) * D + col0 + bj * 128 + n * 16;
                        const v2u pe = *(const v2u*)(PE + off); const f32x4 a = acc[ai][bj][m][n] + bv; f32x4 h = *(const f32x4*)(H + off);
                        h[0] += sigmoidf_(a[0]) * bflo(pe.x); h[1] += sigmoidf_(a[1]) * bfhi(pe.x); h[2] += sigmoidf_(a[2]) * bflo(pe.y); h[3] += sigmoidf_(a[3]) * bfhi(pe.y);
                        *(f32x4*)(H + off) = h; if (m & 1) asm volatile("" ::: "memory"); } }
    } };

struct GroupOrder { int G, c;
    __device__ __forceinline__ bool next(int i, Unit& u) const { const int L = i * G + c; if (L >= NG * 4) return false; u.pm = L; u.pn = L >> 2; return true; }
    __device__ __forceinline__ void a_ready(const Unit&) const {}
    __device__ __forceinline__ void done(const Unit&) const {} };
template <int NSUB> struct ExpertOrder { int G, c; const volatile LAS unsigned* tstart;
    __device__ __forceinline__ bool next(int i, Unit& u) const {
        const int L = i * G + c, tau = L / NSUB, sub = L % NSUB; if (tau >= (int)tstart[NEXP]) return false;
        int e = 0;
        for (int k = 1; k < NEXP; ++k) e += ((int)tstart[k] <= tau) ? 1 : 0;
        u.pm = tau; u.pn = e * NSUB + sub; return true; }
    __device__ __forceinline__ void a_ready(const Unit&) const {}
    __device__ __forceinline__ void done(const Unit&) const {} };

__device__ __forceinline__ void carry_unit(Frame& F, int unit) {
    const int d = unit & 1, g = (unit >> 1) & 31, b = unit >> 6, n = opq(F.lane), s = F.wave;
    const float* lt = (const float*)(F.ws + WS_LAMT) + ((g * 2 + d) * 64 + n) * 4;
    const float l16r = lt[0], l16i = lt[1], lkr = lt[2], lki = lt[3];
    const float* SL = (const float*)(F.ws + WS_SLOC) + (size_t)(g * NCH + b * 512) * 256 + d * 128 + n;
    bf16* AS = (bf16*)(F.ws + WS_AS) + (size_t)(g * NCH + b * 512) * 512 + 256 + d * 128 + n;
    LAS float* segE = (LAS float*)(F.lds + RING_OFF);
    float er = 0.f, ei = 0.f;
    for (int i0 = 0; i0 < 64; i0 += 16) {
        float sr[16], si[16];
#pragma unroll
        for (int ii = 0; ii < 16; ++ii) { const int i = s * 64 + i0 + ii, c = d ? (511 - i) : i; sr[ii] = SL[(size_t)c * 256]; si[ii] = SL[(size_t)c * 256 + 64]; }
#pragma unroll
        for (int ii = 0; ii < 16; ++ii) { const float tr = l16r * er - l16i * ei + sr[ii], ti = l16r * ei + l16i * er + si[ii]; er = tr; ei = ti; }
    }
    __syncthreads();
    segE[(s * 64 + n) * 2] = er; segE[(s * 64 + n) * 2 + 1] = ei;
    __syncthreads();
    float xr = 0.f, xi = 0.f;
    for (int sp = 0; sp < s; ++sp) { const float pr = segE[(sp * 64 + n) * 2], pi = segE[(sp * 64 + n) * 2 + 1];
        const float tr = lkr * xr - lki * xi + pr, ti = lkr * xi + lki * xr + pi; xr = tr; xi = ti; }
    for (int i0 = 0; i0 < 64; i0 += 16) {
        float sr[16], si[16];
#pragma unroll
        for (int ii = 0; ii < 16; ++ii) { const int i = s * 64 + i0 + ii, c = d ? (511 - i) : i; sr[ii] = SL[(size_t)c * 256]; si[ii] = SL[(size_t)c * 256 + 64]; }
#pragma unroll
        for (int ii = 0; ii < 16; ++ii) { const int i = s * 64 + i0 + ii, c = d ? (511 - i) : i;
            AS[(size_t)c * 512] = (bf16)f2bf(xr); AS[(size_t)c * 512 + 64] = (bf16)f2bf(xi);
            const float tr = l16r * xr - l16i * xi + sr[ii], ti = l16r * xi + l16i * xr + si[ii]; xr = tr; xi = ti; }
    }
    __syncthreads();
}
__device__ __forceinline__ void diff_row(Frame& F, int m) {
    const int t = m & (SEQ - 1), lane = opq(F.lane), h = 1 << (lane >> 4), lo = max(t - h, 0), hi = min(t + h, SEQ);
    const bf16* ZP = (const bf16*)(F.ws + WS_ZP) + (size_t)(m - t) * DP + lane * 8;
    float acc[8];
#pragma unroll
    for (int i = 0; i < 8; ++i) acc[i] = 0.f;
    v4u zt = (v4u){0u, 0u, 0u, 0u};
#pragma unroll
    for (int k = 0; k < 16; ++k) { const int s = t - 8 + k;
        if (s >= lo && s < hi) { const v4u z = *(const GAS v4u*)(ZP + (size_t)s * DP);
            acc[0] += bflo(z.x); acc[1] += bfhi(z.x); acc[2] += bflo(z.y); acc[3] += bfhi(z.y); acc[4] += bflo(z.z); acc[5] += bfhi(z.z); acc[6] += bflo(z.w); acc[7] += bfhi(z.w);
            if (k == 8) zt = z; } }
    const float inv = 1.0f / (float)(hi - lo);
    v4u o; o.x = pk2(acc[0] * inv - bflo(zt.x), acc[1] * inv - bfhi(zt.x)); o.y = pk2(acc[2] * inv - bflo(zt.y), acc[3] * inv - bfhi(zt.y));
    o.z = pk2(acc[4] * inv - bflo(zt.z), acc[5] * inv - bfhi(zt.z)); o.w = pk2(acc[6] * inv - bflo(zt.w), acc[7] * inv - bfhi(zt.w));
    *(GAS v4u*)((bf16*)(F.ws + WS_CAT) + (size_t)m * D + lane * 8) = o;
#if MK_STAGE == 1
    *(GAS v4u*)((bf16*)(F.ws + WS_CAT) + (size_t)m * D + DP + lane * 8) = (v4u){0u, 0u, 0u, 0u};
#endif
}
__device__ __forceinline__ float dot16(const f32x4 (&v)[4], const float* w, int lane) {
    const GAS f32x4* wr = (const GAS f32x4*)w + lane; float s = 0.f;
#pragma unroll
    for (int j = 0; j < 4; ++j) { const f32x4 ww = wr[64 * j]; s += (v[j].x * ww.x + v[j].y * ww.y) + (v[j].z * ww.z + v[j].w * ww.w); }
    return wave_sum(s);
}
__device__ __forceinline__ void route_row(Frame& F, const Args& A, int m) {
    const int lane = opq(F.lane);
    const GAS f32x4* hr = (const GAS f32x4*)(F.out + (size_t)m * D) + lane; const GAS f32x4* gr = (const GAS f32x4*)A.in[17] + lane;
    f32x4 v[4]; float s = 0.f;
#pragma unroll
    for (int j = 0; j < 4; ++j) { v[j] = hr[64 * j]; s += (v[j].x * v[j].x + v[j].y * v[j].y) + (v[j].z * v[j].z + v[j].w * v[j].w); }
    const float rstd = 1.f / sqrtf(wave_sum(s) * (1.f / D) + RMS_EPS);
    GAS unsigned long long* o8 = (GAS unsigned long long*)((bf16*)(F.ws + WS_XN) + (size_t)m * D) + lane;
#pragma unroll
    for (int j = 0; j < 4; ++j) { const f32x4 gg = gr[64 * j]; v[j] = v[j] * rstd * gg;
        o8[64 * j] = (unsigned long long)pk2(v[j].x, v[j].y) | ((unsigned long long)pk2(v[j].z, v[j].w) << 32); }
    const float* WR = (const float*)(F.ws + WS_WR);
    float gl[4];
#pragma unroll
    for (int k = 0; k < 4; ++k) gl[k] = dot16(v, WR + (size_t)k * D, lane) + A.in[19][k];
    int gsel = 0; float gmax = gl[0];
#pragma unroll
    for (int k = 1; k < 4; ++k) if (gl[k] > gmax) { gmax = gl[k]; gsel = k; }
    float gden = 0.f;
#pragma unroll
    for (int k = 0; k < 4; ++k) gden += __expf(gl[k] - gmax);
    const float grp_p = 1.0f / gden;
    gsel = __builtin_amdgcn_readfirstlane(gsel);
    float el[8];
#pragma unroll
    for (int e = 0; e < 8; ++e) el[e] = dot16(v, WR + (size_t)(4 + gsel * 8 + e) * D, lane) + A.in[21][gsel * 8 + e];
    int i1 = 0; float m1 = el[0];
#pragma unroll
    for (int e = 1; e < 8; ++e) if (el[e] > m1) { m1 = el[e]; i1 = e; }
    int i2 = -1; float m2 = -3.0e38f;
#pragma unroll
    for (int e = 0; e < 8; ++e) if (e != i1 && el[e] > m2) { m2 = el[e]; i2 = e; }
    const float r = __expf(m2 - m1), w1 = grp_p / (1.0f + r), w2 = grp_p * r / (1.0f + r);
    if (lane == 0) {
        const int e1 = gsel * 8 + i1, e2 = gsel * 8 + i2;
        int* rt = (int*)(F.ws + WS_ROUTE) + (size_t)m * 4; rt[0] = e1; rt[1] = e2; ((float*)rt)[2] = w1; ((float*)rt)[3] = w2;
        __hip_atomic_fetch_add((unsigned*)(F.ctl + CW_CNT) + e1, 1u, RLX_AGENT); __hip_atomic_fetch_add((unsigned*)(F.ctl + CW_CNT) + e2, 1u, RLX_AGENT);
    }
}
__device__ __forceinline__ void build_tstart(Frame& F) {
    if (F.tid == 0) { unsigned acc = 0u;
        for (int e = 0; e < NEXP; ++e) { F.MISC[16 + e] = acc; acc += (__hip_atomic_load((unsigned*)(F.ctl + CW_CNT) + e, RLX_AGENT) + 255u) >> 8; }
        F.MISC[16 + NEXP] = acc; }
    __syncthreads();
}
__device__ __forceinline__ void permute_row(Frame& F, int m) {
    const int lane = opq(F.lane);
    const int* rt = (const int*)(F.ws + WS_ROUTE) + (size_t)m * 4;
    const int e1 = rt[0], e2 = rt[1]; const float w1 = ((const float*)rt)[2], w2 = ((const float*)rt)[3];
    const GAS v4u* src = (const GAS v4u*)((const bf16*)(F.ws + WS_XN) + (size_t)m * D) + lane;
    const v4u a = src[0], b = src[64];
#pragma unroll
    for (int k = 0; k < 2; ++k) { const int e = k ? e2 : e1;
        unsigned pos = 0u;
        if (lane == 0) pos = F.MISC[16 + e] * 256u + __hip_atomic_fetch_add((unsigned*)(F.ctl + CW_FILL) + e, 1u, RLX_AGENT);
        pos = __builtin_amdgcn_readfirstlane(pos);
        GAS v4u* dst = (GAS v4u*)((bf16*)(F.ws + WS_VP) + (size_t)pos * D) + lane; dst[0] = a; dst[64] = b;
        if (lane == 0) { ((int*)(F.ws + WS_ROWINFO))[pos] = 2 * m + k; ((float*)(F.ws + WS_ROWW))[pos] = k ? w2 : w1; } }
}
__device__ __forceinline__ void moe_combine_row(Frame& F, const Args& A, int m) {
    const int lane = opq(F.lane);
    GAS f32x4* hr = (GAS f32x4*)(F.out + (size_t)m * D) + lane; const GAS f32x4* gr = (const GAS f32x4*)A.in[25] + lane;
    const GAS v2u* m0 = (const GAS v2u*)((const bf16*)(F.ws + WS_MO0) + (size_t)m * D) + lane; const GAS v2u* m1 = (const GAS v2u*)((const bf16*)(F.ws + WS_MO1) + (size_t)m * D) + lane;
    f32x4 v[4]; float s = 0.f;
#pragma unroll
    for (int j = 0; j < 4; ++j) { v[j] = hr[64 * j]; const v2u a = m0[64 * j], b = m1[64 * j];
        v[j].x += bflo(a.x) + bflo(b.x); v[j].y += bfhi(a.x) + bfhi(b.x); v[j].z += bflo(a.y) + bflo(b.y); v[j].w += bfhi(a.y) + bfhi(b.y);
        hr[64 * j] = v[j]; s += (v[j].x * v[j].x + v[j].y * v[j].y) + (v[j].z * v[j].z + v[j].w * v[j].w); }
    const float rstd = 1.f / sqrtf(wave_sum(s) * (1.f / D) + RMS_EPS);
    GAS unsigned long long* o8 = (GAS unsigned long long*)((bf16*)(F.ws + WS_XN) + (size_t)m * D) + lane;
#pragma unroll
    for (int j = 0; j < 4; ++j) { const f32x4 gg = gr[64 * j];
        o8[64 * j] = (unsigned long long)pk2(v[j].x * rstd * gg.x, v[j].y * rstd * gg.y) | ((unsigned long long)pk2(v[j].z * rstd * gg.z, v[j].w * rstd * gg.w) << 32); }
}
__device__ __forceinline__ void final_row(Frame& F, const Args& A, int m) {
    const int lane = opq(F.lane);
    GAS f32x4* hr = (GAS f32x4*)(F.out + (size_t)m * D) + lane; const GAS f32x4* gr = (const GAS f32x4*)A.in[29] + lane;
    f32x4 v[4]; float s = 0.f;
#pragma unroll
    for (int j = 0; j < 4; ++j) { v[j] = hr[64 * j]; s += (v[j].x * v[j].x + v[j].y * v[j].y) + (v[j].z * v[j].z + v[j].w * v[j].w); }
    const float rstd = 1.f / sqrtf(wave_sum(s) * (1.f / D) + RMS_EPS);
#pragma unroll
    for (int j = 0; j < 4; ++j) hr[64 * j] = v[j] * rstd * gr[64 * j];
}

__global__ void __launch_bounds__(NWAVES * 64, 2) mk_fwd(Args args) {
    extern __shared__ __attribute__((aligned(16))) unsigned char lds[];
    Frame F;
    F.lds = (LAS unsigned char*)lds;
    F.MISC = (volatile LAS unsigned*)(F.lds + MISC_OFF);
    F.tid = threadIdx.x; F.lane = F.tid & 63; F.wave = __builtin_amdgcn_readfirstlane(F.tid >> 6);
    F.G = gridDim.x; F.gw = blockIdx.x * NWAVES + F.wave; F.ngw = F.G * NWAVES;
    F.out = args.out; F.ws = args.ws; F.ctl = (gu32*)(args.ws + WS_CTL);
    for (int u = F.tid; u < (LDS_BYTES - LDSCTL_OFF) / 4; u += NWAVES * 64) ((LAS unsigned*)(F.lds + LDSCTL_OFF))[u] = 0u;
    __syncthreads();
    XcdBarrier bar = xcd_barrier_post((unsigned*)(F.ctl + CW_BAR), F.MISC + 8);
#define GRID_BAR() xcd_barrier(bar)
    bf16* const WIN = (bf16*)(F.ws + WS_WIN); bf16* const GLU = (bf16*)(F.ws + WS_GLU); bf16* const WCAT = (bf16*)(F.ws + WS_WCAT); bf16* const WG = (bf16*)(F.ws + WS_WG); bf16* const WPLE = (bf16*)(F.ws + WS_WPLE);
    bf16* const WGU = (bf16*)(F.ws + WS_WGU); bf16* const WD = (bf16*)(F.ws + WS_WD); bf16* const MS = (bf16*)(F.ws + WS_MS); bf16* const WS3 = (bf16*)(F.ws + WS_WS3);
    bf16* const XN = (bf16*)(F.ws + WS_XN); bf16* const ZP = (bf16*)(F.ws + WS_ZP); bf16* const AS = (bf16*)(F.ws + WS_AS); float* const SLOC = (float*)(F.ws + WS_SLOC);
    bf16* const CAT = (bf16*)(F.ws + WS_CAT); bf16* const ZZ = (bf16*)(F.ws + WS_ZZ); bf16* const PB = (bf16*)(F.ws + WS_PB); bf16* const PE = (bf16*)(F.ws + WS_PE);
    bf16* const VP = (bf16*)(F.ws + WS_VP); bf16* const ACT = (bf16*)(F.ws + WS_ACT); bf16* const MO0 = (bf16*)(F.ws + WS_MO0); bf16* const MO1 = (bf16*)(F.ws + WS_MO1);
    const int cid = (int)blockIdx.x;

    p0_prologue(F, args);
    GRID_BAR();
    { pg8::Gemm g{XN, WIN, D, D, D}; pg8::StaticOrder S; S.init(M, D, F.G, cid); EpiZ E{ZP, AS};
      pg8::gemm_phase<EpiZ, pg8::StaticOrder, true, true>(F.lds + RING_OFF, g, S, E); }
    GRID_BAR();
#if MK_STAGE >= 2
    { pg8::Gemm g{AS, MS, 256, 512, 256}; GroupOrder S{F.G, cid}; EpiSloc E{SLOC};
      pg8::gemm_phase<EpiSloc, GroupOrder, true, true>(F.lds + RING_OFF, g, S, E); }
    GRID_BAR();
#endif
    {
#if MK_STAGE >= 2
        if (F.G >= 256) { if (cid < 128) carry_unit(F, cid); else for (int m = (cid - 128) * NWAVES + F.wave; m < M; m += (F.G - 128) * NWAVES) diff_row(F, m); }
        else { for (int u = cid; u < 128; u += F.G) carry_unit(F, u); for (int m = F.gw; m < M; m += F.ngw) diff_row(F, m); }
#else
        for (int m = F.gw; m < M; m += F.ngw) diff_row(F, m);
#endif
    }
    GRID_BAR();
#if MK_STAGE >= 2
    { pg8::Gemm g{AS, WS3, 512, 512, 512}; GroupOrder S{F.G, cid}; EpiY E{ZZ};
      pg8::gemm_phase<EpiY, GroupOrder, true, true>(F.lds + RING_OFF, g, S, E); }
    GRID_BAR();
    { pg8::Gemm g{ZZ, GLU, DP, DP, DP}; pg8::StaticOrder S; S.init(M, DP, F.G, cid); EpiGlu E{ZZ, args.in[15], CAT};
      pg8::gemm_phase<EpiGlu, pg8::StaticOrder, true, true>(F.lds + RING_OFF, g, S, E); }
    GRID_BAR();
#endif
    { pg8::Gemm g{CAT, WCAT, D, D, D}; pg8::StaticOrder S; S.init(M, D, F.G, cid); EpiRes E{args.in[0], F.out};
      pg8::gemm_phase<EpiRes, pg8::StaticOrder, true, true>(F.lds + RING_OFF, g, S, E); }
    GRID_BAR();
#if MK_STAGE >= 3
    for (int m = F.gw; m < M; m += F.ngw) route_row(F, args, m);
    GRID_BAR();
    build_tstart(F);
    for (int m = F.gw; m < M; m += F.ngw) permute_row(F, m);
    GRID_BAR();
    { pg8::Gemm g{VP, WGU, D, D, D}; ExpertOrder<2> S{F.G, cid, F.MISC + 16}; EpiAct E{(const float*)(F.ws + WS_ROWW), ACT};
      pg8::gemm_phase<EpiAct, ExpertOrder<2>, true, true>(F.lds + RING_OFF, g, S, E); }
    GRID_BAR();
    { pg8::Gemm g{ACT, WD, DF, DF, DF}; ExpertOrder<4> S{F.G, cid, F.MISC + 16}; EpiDown E{(const int*)(F.ws + WS_ROWINFO), MO0, MO1};
      pg8::gemm_phase<EpiDown, ExpertOrder<4>, true, true>(F.lds + RING_OFF, g, S, E); }
    GRID_BAR();
    for (int m = F.gw; m < M; m += F.ngw) moe_combine_row(F, args, m);
    GRID_BAR();
#endif
#if MK_STAGE >= 4
    { pg8::Gemm g{PB, WPLE, DPLE, DPLE, DPLE}; pg8::StaticOrder S; S.init(M, D, F.G, cid); EpiPe E{PE};
      pg8::gemm_phase<EpiPe, pg8::StaticOrder, true, true>(F.lds + RING_OFF, g, S, E); }
    GRID_BAR();
    { pg8::Gemm g{XN, WG, D, D, D}; pg8::StaticOrder S; S.init(M, D, F.G, cid); EpiPle E{F.out, args.in[27], PE};
      pg8::gemm_phase<EpiPle, pg8::StaticOrder, true, true>(F.lds + RING_OFF, g, S, E); }
    GRID_BAR();
#endif
    for (int m = F.gw; m < M; m += F.ngw) final_row(F, args, m);
}

extern "C" void kernel_launch(void* const* d_in, const int* in_sizes, int n_in, void* d_out, int out_size, void* d_ws, size_t ws_size, hipStream_t stream) {
    static int grid = 0;
    if (grid == 0) {
        if (n_in != 30 || in_sizes[0] != M * D || out_size != M * D || ws_size < WS_END) { fprintf(stderr, "kernel_launch: unexpected shapes (n_in %d, in0 %d, out %d, ws %zu)\n", n_in, n_in > 0 ? in_sizes[0] : -1, out_size, ws_size); grid = -1; return; }
        int dev = 0, cus = 0, per_cu = 0;
        if (hipGetDevice(&dev) != hipSuccess || hipDeviceGetAttribute(&cus, hipDeviceAttributeMultiprocessorCount, dev) != hipSuccess) { grid = -1; return; }
        if (hipFuncSetAttribute((const void*)mk_fwd, hipFuncAttributeMaxDynamicSharedMemorySize, LDS_BYTES) != hipSuccess) { fprintf(stderr, "kernel_launch: hipFuncSetAttribute failed\n"); grid = -1; return; }
        if (hipOccupancyMaxActiveBlocksPerMultiprocessor(&per_cu, (const void*)mk_fwd, NWAVES * 64, LDS_BYTES) != hipSuccess || per_cu < 1) { fprintf(stderr, "kernel_launch: occupancy query reports %d blocks per CU\n", per_cu); }
        (void)hipGetLastError();
        grid = cus;
    }
    if (grid < 0) return;
    (void)hipMemsetAsync((char*)d_ws + WS_CTL, 0, CTL_ZERO_BYTES, stream);
    Args a{};
    for (int i = 0; i < 30; ++i) a.in[i] = (const float*)d_in[i];
    a.out = (float*)d_out; a.ws = (unsigned char*)d_ws;
    hipLaunchKernelGGL(mk_fwd, dim3(grid), dim3(NWAVES * 64), LDS_BYTES, stream, a);
}
```

```cpp
#include <hip/hip_runtime.h>
#include <cstdio>
#include <cstdint>
__device__ __forceinline__ int hw_lane() { int l; asm volatile("v_mbcnt_lo_u32_b32 %0, -1, 0\n\tv_mbcnt_hi_u32_b32 %0, -1, %0" : "=v"(l)); return l; }
namespace pg8 {
#define PG8_LAS __attribute__((address_space(3)))
typedef unsigned short bf16_t;
typedef short bf16x8 __attribute__((ext_vector_type(8)));
typedef float f32x4 __attribute__((ext_vector_type(4)));
typedef unsigned u32x4 __attribute__((ext_vector_type(4)));
constexpr int BM = 256, BK = 64, HALF = 128, HTB = HALF * BK * 2  , STAGE_BYTES = 8 * HTB, NXCD = 8, WGM = 8;

__host__ __device__ __forceinline__ int lds_byte(int r, int c) { const int st = (r >> 4) * 2 + (c >> 5), rr = r & 15, cc = c & 31, ob = rr * 64 + cc * 2; return st * 1024 + (ob ^ (((ob >> 9) & 1) << 5)); }
__host__ __device__ __forceinline__ void stage_rc(int b, int& R, int& C) { const int st = b / 1024, sb = b % 1024, swz = sb ^ (((sb >> 9) & 1) << 5); R = (st >> 1) * 16 + swz / 64; C = (st & 1) * 32 + (swz % 64) / 2; }
__host__ __device__ __forceinline__ int perm32(int rho) { const int n = rho >> 4, i = rho & 15; return 8 * (i >> 2) + 4 * n + (i & 3); }

struct Unit { int pm, pn; };
struct Gemm { const bf16_t* A; const bf16_t* Bt; int K, lda, ldb; };

struct StaticOrder {
    int nM, nN, nwg, G, c;
    __host__ __device__ void init(int M, int N, int G_, int c_) { nM = M / BM; nN = N / BM; nwg = nM * nN; G = G_; c = c_; }
    __host__ __device__ bool next(int i, Unit& u) const {
        const long L = (long)i * G + c; if (L >= nwg) return false;
        int wgid = (int)L; { const int q = nwg / NXCD, r = nwg % NXCD, xcd = wgid % NXCD, off = wgid / NXCD; wgid = (xcd < r ? xcd * (q + 1) : r * (q + 1) + (xcd - r) * q) + off; }
        const int nig = WGM * nN, gid = wgid / nig, fm = gid * WGM, gsz = (nM - fm) < WGM ? (nM - fm) : WGM;
        u.pm = fm + ((wgid % nig) % gsz); u.pn = (wgid % nig) / gsz; return true;
    }
    __device__ __forceinline__ void a_ready(const Unit&) const {}
    __device__ __forceinline__ void done(const Unit&) const {}
};

template <class Epi, class Sched, bool ALIGN_EPI = false, bool SP2 = false>
__device__ __forceinline__ void gemm_phase(PG8_LAS unsigned char* lds, const Gemm g, const Sched& S, const Epi& E, const int wid  ) {
    int lane_ = hw_lane(); asm volatile("" : "+v"(lane_));
    const int lane = lane_, tid = wid * 64 + lane, wr = wid >> 2, wc = wid & 3, fr = lane & 15, fq = lane >> 4;
    const int K = g.K, nt = K / BK;
    unsigned voffA[2], voffB[2];
#pragma unroll
    for (int i = 0; i < 2; ++i) { int R, C; stage_rc(tid * 16 + i * 8192, R, C); const int Rb = Epi::PERM ? ((R & ~31) + perm32(R & 31)) : R;
        voffA[i] = (unsigned)(R * g.lda + C) * 2u; voffB[i] = (unsigned)(Rb * g.ldb + C) * 2u; }
    const size_t kstep = (size_t)(BK * 2);
    const size_t hstepA = (size_t)HALF * g.lda * 2, hstepB = (size_t)HALF * g.ldb * 2;
    const size_t tstepA = 2 * hstepA, tstepB = 2 * hstepB;
    const unsigned ldsw = (unsigned)wid * 1024u;
    const int aoff = lds_byte(wr * 64 + fr, fq * 8), boff = lds_byte(wc * 32 + fr, fq * 8);
#define PG8_SA(b, h) (((b) * 2 + (h)) * HTB)
#define PG8_SB(b, h) ((4 + (b) * 2 + (h)) * HTB)
#define PG8_STAGE(bufoff, gbase, voff) do { _Pragma("unroll") for (int _i = 0; _i < 2; ++_i) \
        __builtin_amdgcn_global_load_lds((const unsigned*)((const char*)(gbase) + (voff)[_i]), (PG8_LAS unsigned*)(lds + (bufoff) + ldsw + _i * 8192), 16, 0, 0); } while (0)
#define PG8_LDA(dst, b, h) do { _Pragma("unroll") for (int m = 0; m < 4; ++m) _Pragma("unroll") for (int k = 0; k < 2; ++k) dst[m][k] = *(const PG8_LAS bf16x8*)(lds + PG8_SA(b, h) + aoff + m * 2048 + k * 1024); } while (0)
#define PG8_LDB(dst, b, h) do { _Pragma("unroll") for (int n = 0; n < 2; ++n) _Pragma("unroll") for (int k = 0; k < 2; ++k) dst[n][k] = *(const PG8_LAS bf16x8*)(lds + PG8_SB(b, h) + boff + n * 2048 + k * 1024); } while (0)
#define PG8_MMA(ai, bj, At, Bt) do { __builtin_amdgcn_s_setprio(1); _Pragma("unroll") for (int m = 0; m < 4; ++m) _Pragma("unroll") for (int n = 0; n < 2; ++n) _Pragma("unroll") for (int k = 0; k < 2; ++k) \
        acc[ai][bj][m][n] = __builtin_amdgcn_mfma_f32_16x16x32_bf16(Bt[n][k], At[m][k], acc[ai][bj][m][n], 0, 0, 0); __builtin_amdgcn_s_setprio(0); } while (0)
#define PG8_WAIT_V(n) asm volatile("s_waitcnt vmcnt(" #n ")" ::: "memory")
#define PG8_WAIT_L(n) asm volatile("s_waitcnt lgkmcnt(" #n ")" ::: "memory")
#define PG8_BAR __builtin_amdgcn_s_barrier()
#define PG8_SCHED __builtin_amdgcn_sched_barrier(0)
    Unit cur, nxt; int ui = 0;
    if (!S.next(0, cur)) return;
    f32x4 acc[2][2][4][2];
#pragma unroll
    for (int a = 0; a < 2; ++a)
#pragma unroll
        for (int b = 0; b < 2; ++b)
#pragma unroll
            for (int m = 0; m < 4; ++m)
#pragma unroll
                for (int n = 0; n < 2; ++n) acc[a][b][m][n] = (f32x4){0.f, 0.f, 0.f, 0.f};
    bf16x8 At[4][2], B0[2][2], B1[2][2];
    const char* cA = (const char*)g.A + (size_t)cur.pm * tstepA; const char* cB = (const char*)g.Bt + (size_t)cur.pn * tstepB;
    S.a_ready(cur);
    if constexpr (SP2) {
        PG8_STAGE(PG8_SB(0, 0), cB, voffB); PG8_STAGE(PG8_SB(0, 1), cB + hstepB, voffB); PG8_STAGE(PG8_SA(0, 0), cA, voffA); PG8_STAGE(PG8_SA(0, 1), cA + hstepA, voffA);
        if (wr == 1) PG8_BAR;
        PG8_WAIT_V(2); PG8_BAR;
        PG8_STAGE(PG8_SB(1, 0), cB + kstep, voffB); PG8_STAGE(PG8_SA(1, 0), cA + kstep, voffA); PG8_STAGE(PG8_SB(1, 1), cB + hstepB + kstep, voffB);
        PG8_WAIT_V(6); PG8_BAR;
    } else {
        PG8_STAGE(PG8_SB(0, 0), cB, voffB); PG8_STAGE(PG8_SA(0, 0), cA, voffA); PG8_STAGE(PG8_SB(0, 1), cB + hstepB, voffB); PG8_STAGE(PG8_SA(0, 1), cA + hstepA, voffA);
        if (wr == 1) PG8_BAR;
        PG8_WAIT_V(4); PG8_BAR;
        PG8_STAGE(PG8_SB(1, 0), cB + kstep, voffB); PG8_STAGE(PG8_SA(1, 0), cA + kstep, voffA); PG8_STAGE(PG8_SB(1, 1), cB + hstepB + kstep, voffB);
        PG8_WAIT_V(6); PG8_BAR;
    }
    for (;;) {
        const bool has_next = S.next(ui + 1, nxt);
        const char* nA = has_next ? (const char*)g.A + (size_t)nxt.pm * tstepA : cA; const char* nB = has_next ? (const char*)g.Bt + (size_t)nxt.pn * tstepB : cB;
        for (int t = 0; t < nt; t += 2) {
            const bool last = (t == nt - 2);
            const char* a1 = cA + (size_t)(t + 1) * kstep;
            const char* a2 = last ? nA : cA + (size_t)(t + 2) * kstep; const char* b2 = last ? nB : cB + (size_t)(t + 2) * kstep;
            const char* a3 = a2 + kstep; const char* b3 = b2 + kstep;
            if (last && has_next) S.a_ready(nxt);
            if constexpr (SP2) {
            PG8_LDB(B0, 0, 0); PG8_LDB(B1, 0, 1); PG8_SCHED; PG8_LDA(At, 0, 0); PG8_STAGE(PG8_SA(1, 1), a1 + hstepA, voffA);
            PG8_WAIT_V(8); PG8_WAIT_L(0); PG8_BAR; PG8_MMA(0, 0, At, B0); PG8_MMA(0, 1, At, B1); PG8_BAR; PG8_SCHED;
            PG8_LDA(At, 0, 1); PG8_STAGE(PG8_SB(0, 0), b2, voffB); PG8_STAGE(PG8_SB(0, 1), b2 + hstepB, voffB); PG8_STAGE(PG8_SA(0, 0), a2, voffA);
            PG8_WAIT_V(8); PG8_WAIT_L(0); PG8_BAR; PG8_MMA(1, 0, At, B0); PG8_MMA(1, 1, At, B1); PG8_BAR; PG8_SCHED;
            PG8_LDB(B0, 1, 0); PG8_LDB(B1, 1, 1); PG8_SCHED; PG8_LDA(At, 1, 0); PG8_STAGE(PG8_SA(0, 1), a2 + hstepA, voffA);
            PG8_WAIT_V(8); PG8_WAIT_L(0); PG8_BAR; PG8_MMA(0, 0, At, B0); PG8_MMA(0, 1, At, B1); PG8_BAR; PG8_SCHED;
            PG8_LDA(At, 1, 1); PG8_STAGE(PG8_SB(1, 0), b3, voffB); PG8_STAGE(PG8_SB(1, 1), b3 + hstepB, voffB); PG8_STAGE(PG8_SA(1, 0), a3, voffA);
            PG8_WAIT_V(8); PG8_WAIT_L(0); PG8_BAR; PG8_MMA(1, 0, At, B0); PG8_MMA(1, 1, At, B1); PG8_BAR; PG8_SCHED;
            } else {
            PG8_LDB(B0, 0, 0); PG8_SCHED; PG8_LDA(At, 0, 0); PG8_STAGE(PG8_SA(1, 1), a1 + hstepA, voffA);
            PG8_WAIT_L(8); PG8_BAR; PG8_WAIT_L(0); PG8_MMA(0, 0, At, B0); PG8_BAR; PG8_SCHED;
            PG8_LDB(B1, 0, 1); PG8_STAGE(PG8_SB(0, 0), b2, voffB);
            PG8_BAR; PG8_WAIT_L(0); PG8_MMA(0, 1, At, B1); PG8_BAR;
            PG8_LDA(At, 0, 1); PG8_STAGE(PG8_SA(0, 0), a2, voffA);
            PG8_BAR; PG8_WAIT_L(0); PG8_MMA(1, 0, At, B0); PG8_BAR; PG8_SCHED;
            PG8_STAGE(PG8_SB(0, 1), b2 + hstepB, voffB);
            PG8_WAIT_V(6); PG8_BAR; PG8_MMA(1, 1, At, B1); PG8_BAR;
            PG8_LDB(B0, 1, 0); PG8_SCHED; PG8_LDA(At, 1, 0); PG8_STAGE(PG8_SA(0, 1), a2 + hstepA, voffA);
            PG8_WAIT_L(8); PG8_BAR; PG8_WAIT_L(0); PG8_MMA(0, 0, At, B0); PG8_BAR; PG8_SCHED;
            PG8_LDB(B1, 1, 1); PG8_STAGE(PG8_SB(1, 0), b3, voffB);
            PG8_BAR; PG8_WAIT_L(0); PG8_MMA(0, 1, At, B1); PG8_BAR;
            PG8_LDA(At, 1, 1); PG8_STAGE(PG8_SA(1, 0), a3, voffA);
            PG8_BAR; PG8_WAIT_L(0); PG8_MMA(1, 0, At, B0); PG8_BAR; PG8_SCHED;
            PG8_STAGE(PG8_SB(1, 1), b3 + hstepB, voffB);
            PG8_WAIT_V(6); PG8_BAR; PG8_MMA(1, 1, At, B1); PG8_BAR;
            }
        }
        if constexpr (ALIGN_EPI) { if (wr == 0) PG8_BAR; }
        if constexpr (!Epi::AFTER_DRAIN) { E(acc, cur, wr, wc, fr, fq); S.done(cur); }
        if (!has_next) break;
#pragma unroll
        for (int a = 0; a < 2; ++a)
#pragma unroll
            for (int b = 0; b < 2; ++b)
#pragma unroll
                for (int m = 0; m < 4; ++m)
#pragma unroll
                    for (int n = 0; n < 2; ++n) acc[a][b][m][n] = (f32x4){0.f, 0.f, 0.f, 0.f};
        cur = nxt; cA = nA; cB = nB; ++ui;
        if constexpr (ALIGN_EPI) { if (wr == 1) PG8_BAR; }
    }
    PG8_WAIT_V(0);
    if constexpr (!ALIGN_EPI) { if (wr == 0) PG8_BAR; }
    PG8_BAR;
    if constexpr (Epi::AFTER_DRAIN) { E.fused(acc, cur, wr, wc, fr, fq, lds, wid, lane); S.done(cur); }
#undef PG8_SA
#undef PG8_SB
#undef PG8_STAGE
#undef PG8_LDA
#undef PG8_LDB
#undef PG8_MMA
#undef PG8_WAIT_V
#undef PG8_WAIT_L
#undef PG8_BAR
#undef PG8_SCHED
}
}

#ifndef MK_STAGE
#define MK_STAGE 4
#endif
constexpr int NWAVES = 8;
constexpr int M = 16384, D = 1024, SEQ = 8192, DP = 512, NG = 32, NST = 64, GC = 16, CL = 16  ;
constexpr int NCH = M / CL;
constexpr int NEXP = 32, DF = 256, DPLE = 256;
constexpr int VP_ROWS = 2 * M + NEXP * 256;
constexpr float RMS_EPS = 1e-6f;

constexpr size_t MiB = 1u << 20;
constexpr size_t WS_CTL = 0, CTL_ZERO_BYTES = 1 * MiB;
constexpr size_t WS_WR = 1 * MiB;
constexpr size_t WS_LAMT = 1 * MiB + 256 * 1024;
constexpr size_t WS_ROUTE = 1 * MiB + 512 * 1024;
constexpr size_t WS_WIN = 2 * MiB, WS_GLU = 4 * MiB, WS_WCAT = 5 * MiB, WS_WG = 7 * MiB, WS_WPLE = 9 * MiB;
constexpr size_t WS_ROWINFO = 9 * MiB + 512 * 1024, WS_ROWW = 9 * MiB + 768 * 1024;
constexpr size_t WS_WGU = 10 * MiB, WS_WD = 42 * MiB;
constexpr size_t WS_MS = 58 * MiB, WS_WS3 = 62 * MiB;
constexpr size_t WS_ZZ = 70 * MiB;
constexpr size_t WS_PE = 58 * MiB;
constexpr size_t WS_XN = 90 * MiB;
constexpr size_t WS_ZP = 122 * MiB, WS_AS = 138 * MiB, WS_SLOC = 170 * MiB, WS_CAT = 202 * MiB, WS_PB = 234 * MiB;
constexpr size_t WS_VP = 122 * MiB, WS_ACT = 202 * MiB, WS_MO0 = 122 * MiB, WS_MO1 = 154 * MiB;
constexpr size_t WS_END = 256 * MiB;
static_assert(WS_VP + (size_t)VP_ROWS * 2048 <= WS_ACT && WS_ACT + (size_t)VP_ROWS * 512 <= WS_PB && WS_PB + (size_t)M * 512 <= WS_END, "ws map");
constexpr int CW_CNT = 8192;
constexpr int CW_FILL = 10240;
constexpr int CW_BAR = 4096;
constexpr int RING_OFF = 0, RING_BYTES = 131072, P0_SCR = 64 * 65 * 4  , LDSCTL_OFF = 139264, MISC_OFF = LDSCTL_OFF + 320, LDS_BYTES = 147456;
static_assert(NWAVES * P0_SCR <= LDSCTL_OFF && MISC_OFF + 4 * 64 <= LDS_BYTES, "LDS map");

#define GAS __attribute__((address_space(1)))
#define LAS __attribute__((address_space(3)))
typedef unsigned short bf16;
typedef unsigned v4u __attribute__((ext_vector_type(4)));
typedef unsigned v2u __attribute__((ext_vector_type(2)));
typedef float f32x4 __attribute__((ext_vector_type(4)));
typedef GAS unsigned gu32;
#define RLX_AGENT __ATOMIC_RELAXED, __HIP_MEMORY_SCOPE_AGENT
#define LDS_WAIT() asm volatile("s_waitcnt lgkmcnt(0)" ::: "memory")
#define VM_WAIT() asm volatile("s_waitcnt vmcnt(0)" ::: "memory")
__device__ __forceinline__ unsigned f2bf(float f) { unsigned u = __builtin_bit_cast(unsigned, f); return (u + 0x7fffu + ((u >> 16) & 1u)) >> 16; }
__device__ __forceinline__ unsigned pk2(float lo, float hi) { return f2bf(lo) | (f2bf(hi) << 16); }
__device__ __forceinline__ float bflo(unsigned w) { return __builtin_bit_cast(float, w << 16); }
__device__ __forceinline__ float bfhi(unsigned w) { return __builtin_bit_cast(float, w & 0xffff0000u); }
__device__ __forceinline__ float sigmoidf_(float x) { return 1.0f / (1.0f + __expf(-x)); }
__device__ __forceinline__ float gelu_tanh(float y) { const float t = 1.5957691216f * (y + 0.044715f * y * y * y); return y / (1.0f + __expf(-t)); }

#define XB_TMO      128
#define XB_XCNT(j)  (256  + 64 * (j))
#define XB_XSUB(j)  (1280 + 64 * (j))
#define XB_XGEN(j)  (2304 + 64 * (j))
#define XB_TOP      3328
#define XB_TOPGEN   3392
#define XCD_BAR_WORDS 3456
#define XB_SPIN_CAP (1u << 18)
__device__ __forceinline__ unsigned xb_ld(unsigned* p)              { return __hip_atomic_load(p, __ATOMIC_RELAXED, __HIP_MEMORY_SCOPE_AGENT); }
__device__ __forceinline__ unsigned xb_add(unsigned* p, unsigned v) { return __hip_atomic_fetch_add(p, v, __ATOMIC_RELAXED, __HIP_MEMORY_SCOPE_AGENT); }
__device__ __forceinline__ unsigned xb_xcc_id() { return (unsigned)__builtin_amdgcn_s_getreg((3 << 11) | 20) & 0xFu; }
#define XB_SPIN(cond, bar) do { unsigned _sp = 0; while (cond) { __builtin_amdgcn_s_sleep(1); \
    if ((++_sp & 255u) == 0u) { if (xb_ld(&(bar)[XB_TMO])) break; if (_sp > XB_SPIN_CAP) { atomicAdd(&(bar)[XB_TMO], 1u); break; } } } } while (0)
struct XcdBarrier { unsigned* bar; unsigned x; volatile LAS unsigned* st; int wave; };
__device__ __forceinline__ XcdBarrier xcd_barrier_post(unsigned* bar, volatile LAS unsigned* st) {
    XcdBarrier b; b.bar = bar; b.x = xb_xcc_id(); b.st = st; b.wave = 0;
    if (threadIdx.x == 0) (void)xb_add(&bar[XB_XCNT(b.x)], 1u);
    return b;
}
__device__ __forceinline__ void xcd_barrier_complete(unsigned* bar, unsigned x, unsigned& nloc, unsigned& nx) {
    const unsigned G = gridDim.x * gridDim.y * gridDim.z;
    unsigned sum, cnt, mine, sp = 0u;
    for (;;) {
        sum = 0u; cnt = 0u; mine = 0u;
#pragma unroll
        for (unsigned j = 0; j < 16; ++j) { const unsigned c = xb_ld(&bar[XB_XCNT(j)]); sum += c; cnt += (c > 0u) ? 1u : 0u; mine = (j == x) ? c : mine; }
        if (sum == G) break;
        __builtin_amdgcn_s_sleep(1);
        if ((++sp & 255u) == 0u) { if (xb_ld(&bar[XB_TMO])) break; if (sp > XB_SPIN_CAP) { atomicAdd(&bar[XB_TMO], 1u); break; } }
    }
    nloc = mine > 0u ? mine : 1u; nx = cnt > 0u ? cnt : 1u;
}
__device__ __forceinline__ void xcd_barrier(const XcdBarrier& b) {
    asm volatile("s_waitcnt vmcnt(0)" ::: "memory");
    __syncthreads();
    if (b.wave == 0 && hw_lane() == 0) {
        unsigned* bar = b.bar;
        __builtin_amdgcn_s_waitcnt(0);
        unsigned nloc = b.st[0], nx = b.st[1];
        if (nloc == 0u) { xcd_barrier_complete(bar, b.x, nloc, nx); b.st[0] = nloc; b.st[1] = nx; }
        const unsigned old = xb_add(&bar[XB_XSUB(b.x)], 1u);
        const unsigned gen = old / nloc;
        if (old + 1u == (gen + 1u) * nloc) {
            __builtin_amdgcn_fence(__ATOMIC_RELEASE, "agent");
            asm volatile("s_waitcnt vmcnt(0)" ::: "memory");
            const unsigned og = xb_add(&bar[XB_TOP], 1u);
            const unsigned tg = og / nx;
            if (og + 1u == (tg + 1u) * nx) xb_add(&bar[XB_TOPGEN], 1u);
            else XB_SPIN(xb_ld(&bar[XB_TOPGEN]) == tg, bar);
            __builtin_amdgcn_fence(__ATOMIC_ACQUIRE, "agent");
            xb_add(&bar[XB_XGEN(b.x)], 1u);
            asm volatile("s_waitcnt vmcnt(0)" ::: "memory");
        } else {
            XB_SPIN(xb_ld(&bar[XB_XGEN(b.x)]) == gen, bar);
            __builtin_amdgcn_fence(__ATOMIC_ACQUIRE, "agent");
            asm volatile("s_waitcnt vmcnt(0)" ::: "memory");
        }
    }
    __syncthreads();
}

struct Args { const float* in[30]; float* out; unsigned char* ws; };
struct Frame {
    LAS unsigned char* lds;
    volatile LAS unsigned* MISC;
    gu32* ctl;
    int wave, G, gw, ngw;
    float* out;
    unsigned char* ws;
};
__device__ __forceinline__ int opq(int v) { asm volatile("" : "+v"(v)); return v; }
template <int CTRL> __device__ __forceinline__ float dpp_f(float v) { return __builtin_bit_cast(float, __builtin_amdgcn_update_dpp(0, __builtin_bit_cast(int, v), CTRL, 0xf, 0xf, true)); }
__device__ __forceinline__ float wave_sum(float v) {
    v += dpp_f<0xB1>(v);
    v += dpp_f<0x4E>(v);
    v += dpp_f<0x141>(v);
    v += dpp_f<0x140>(v);
    const float r0 = __builtin_bit_cast(float, __builtin_amdgcn_readlane(__builtin_bit_cast(int, v), 0)), r1 = __builtin_bit_cast(float, __builtin_amdgcn_readlane(__builtin_bit_cast(int, v), 16));
    const float r2 = __builtin_bit_cast(float, __builtin_amdgcn_readlane(__builtin_bit_cast(int, v), 32)), r3 = __builtin_bit_cast(float, __builtin_amdgcn_readlane(__builtin_bit_cast(int, v), 48));
    return (r0 + r1) + (r2 + r3);
}

__device__ __forceinline__ void transpose_item64(const float* src, int ld_src, bf16* dst, int ld_dst, LAS float* scr, int lane) {
    f32x4 v[16];
    const int kq = lane >> 4, n4 = (lane & 15) * 4;
#pragma unroll
    for (int i = 0; i < 16; ++i) v[i] = *(const GAS f32x4*)(src + (size_t)(4 * i + kq) * ld_src + n4);
#pragma unroll
    for (int i = 0; i < 16; ++i) { LAS float* p = scr + (4 * i + kq) * 65 + n4; p[0] = v[i].x; p[1] = v[i].y; p[2] = v[i].z; p[3] = v[i].w; }
    LDS_WAIT(); asm volatile("" ::: "memory");
    const int c = lane & 7;
#pragma unroll
    for (int j = 0; j < 8; ++j) { const int n = (lane >> 3) + 8 * j; const LAS float* q = scr + (8 * c) * 65 + n;
        v4u o; o.x = pk2(q[0 * 65], q[1 * 65]); o.y = pk2(q[2 * 65], q[3 * 65]); o.z = pk2(q[4 * 65], q[5 * 65]); o.w = pk2(q[6 * 65], q[7 * 65]);
        *(GAS v4u*)(dst + (size_t)n * ld_dst + 8 * c) = o; }
    LDS_WAIT(); asm volatile("" ::: "memory");
}
__device__ __forceinline__ void rms_row_to_bf16(const float* xrow, const float* g, bf16* orow, int lane) {
    const GAS f32x4* xr = (const GAS f32x4*)xrow + lane; const GAS f32x4* gr = (const GAS f32x4*)g + lane;
    f32x4 v[4]; float s = 0.f;
#pragma unroll
    for (int j = 0; j < 4; ++j) { v[j] = xr[64 * j]; s += (v[j].x * v[j].x + v[j].y * v[j].y) + (v[j].z * v[j].z + v[j].w * v[j].w); }
    const float rstd = 1.f / sqrtf(wave_sum(s) * (1.f / D) + RMS_EPS);
    GAS unsigned long long* o8 = (GAS unsigned long long*)orow + lane;
#pragma unroll
    for (int j = 0; j < 4; ++j) { const f32x4 gg = gr[64 * j];
        o8[64 * j] = (unsigned long long)pk2(v[j].x * rstd * gg.x, v[j].y * rstd * gg.y) | ((unsigned long long)pk2(v[j].z * rstd * gg.z, v[j].w * rstd * gg.w) << 32); }
}
__device__ __forceinline__ void sincos_d(double x, double& sn, double& cs) {
    const double k = __builtin_rint(x * 0.63661977236758134308);
    const double r = (x - k * 1.57079632679489655800e+00) - k * 6.12323399573676603587e-17;
    const double r2 = r * r;
    const double s = r * (1.0 + r2 * (-1.0 / 6.0 + r2 * (1.0 / 120.0 + r2 * (-1.0 / 5040.0 + r2 * (1.0 / 362880.0 + r2 * (-1.0 / 39916800.0 + r2 * (1.0 / 6227020800.0)))))));
    const double c = 1.0 + r2 * (-0.5 + r2 * (1.0 / 24.0 + r2 * (-1.0 / 720.0 + r2 * (1.0 / 40320.0 + r2 * (-1.0 / 3628800.0 + r2 * (1.0 / 479001600.0 + r2 * (-1.0 / 87178291200.0)))))));
    const int q = ((int)k) & 3;
    sn = (q == 0) ? s : (q == 1) ? c : (q == 2) ? -s : -c;
    cs = (q == 0) ? c : (q == 1) ? -s : (q == 2) ? -c : s;
}
__device__ __forceinline__ void ssm_gen(Frame& F, const Args& A, int g) {
    LAS float* lamP = (LAS float*)(F.lds + RING_OFF);
    LAS float* Bb = lamP + 2 * 17 * 64 * 2;
    LAS float* Cc = Bb + 2 * 64 * 16 * 2;
    LAS float* KT = Cc + 2 * 16 * 64 * 2;
    LAS float* dv = KT + 2 * 16 * 256;
    LAS float* bfac = dv + 16;
    const float* a_re = A.in[6]; const float* a_im = A.in[7]; const float* log_dt = A.in[8];
    const float* b_re = A.in[9]; const float* b_im = A.in[10]; const float* c_re = A.in[11]; const float* c_im = A.in[12]; const float* ssm_d = A.in[13];
    const int t = opq(F.wave * 64 + hw_lane());
    __syncthreads();
    if (t < 128) {
        const int d = t >> 6, n = t & 63;
        const double are = (double)a_re[(d * NG + g) * NST + n], aim = (double)a_im[(d * NG + g) * NST + n], dt = exp((double)log_dt[d * NG + g]);
        const double mag = exp(are * dt); double sn, cs; sincos_d(aim * dt, sn, cs);
        const double lr = mag * cs, li = mag * sn;
        const double nr = lr - 1.0, ni = li, den = are * are + aim * aim;
        bfac[(d * 64 + n) * 2] = (float)((nr * are + ni * aim) / den); bfac[(d * 64 + n) * 2 + 1] = (float)((ni * are - nr * aim) / den);
        double pr = 1.0, pi = 0.0;
        for (int k = 0; k <= 16; ++k) { lamP[((d * 17 + k) * 64 + n) * 2] = (float)pr; lamP[((d * 17 + k) * 64 + n) * 2 + 1] = (float)pi;
            if (k < 16) { const double tr = pr * lr - pi * li, ti = pr * li + pi * lr; pr = tr; pi = ti; } }
        float* lt = (float*)(F.ws + WS_LAMT) + ((g * 2 + d) * 64 + n) * 4;
        lt[0] = (float)pr; lt[1] = (float)pi;
        for (int k = 0; k < 6; ++k) { const double tr = pr * pr - pi * pi, ti = 2.0 * pr * pi; pr = tr; pi = ti; }
        lt[2] = (float)pr; lt[3] = (float)pi;
    }
    if (t < 16) dv[t] = ssm_d[g * GC + t];
    __syncthreads();
    for (int idx = t; idx < 2048; idx += NWAVES * 64) {
        { const int d = idx >> 10, n = (idx >> 4) & 63, ci = idx & 15; const size_t si = ((size_t)(d * NG + g) * NST + n) * GC + ci;
          const float br = b_re[si], bi = b_im[si], fr = bfac[(d * 64 + n) * 2], fi = bfac[(d * 64 + n) * 2 + 1];
          Bb[idx * 2] = fr * br - fi * bi; Bb[idx * 2 + 1] = fr * bi + fi * br; }
        { const int d = idx >> 10, co = (idx >> 6) & 15, n = idx & 63; const size_t si = ((size_t)(d * NG + g) * GC + co) * NST + n;
          Cc[idx * 2] = c_re[si]; Cc[idx * 2 + 1] = c_im[si]; }
    }
    __syncthreads();
    {
        const int d = t >> 8, k = (t >> 4) & 15, ci = t & 15;
        float acc[16];
#pragma unroll
        for (int co = 0; co < 16; ++co) acc[co] = 0.f;
        for (int n = 0; n < 64; ++n) {
            const float pr = lamP[((d * 17 + k) * 64 + n) * 2], pi = lamP[((d * 17 + k) * 64 + n) * 2 + 1];
            const float br = Bb[((d * 64 + n) * 16 + ci) * 2], bi = Bb[((d * 64 + n) * 16 + ci) * 2 + 1];
            const float qr = pr * br - pi * bi, qi = pr * bi + pi * br;
#pragma unroll
            for (int co = 0; co < 16; ++co) acc[co] += Cc[((d * 16 + co) * 64 + n) * 2] * qr - Cc[((d * 16 + co) * 64 + n) * 2 + 1] * qi;
        }
#pragma unroll
        for (int co = 0; co < 16; ++co) KT[((d * 16 + k) * 16 + co) * 16 + ci] = acc[co];
    }
    __syncthreads();
    bf16* WS3 = (bf16*)(F.ws + WS_WS3) + (size_t)g * 256 * 512;
    for (int p = t; p < 256 * 64; p += NWAVES * 64) {
        const int row = p >> 6, kc = (p & 63) * 8, j = row >> 4, co = row & 15;
        float v[8];
        if (kc < 256) {
            const int s = kc >> 4, ci0 = kc & 15;
#pragma unroll
            for (int i = 0; i < 8; ++i) { const int ci = ci0 + i;
                if (j > s) v[i] = KT[((0 * 16 + (j - s)) * 16 + co) * 16 + ci];
                else if (j < s) v[i] = KT[((1 * 16 + (s - j)) * 16 + co) * 16 + ci];
                else v[i] = KT[(0 * 16 + co) * 16 + ci] + KT[((1 * 16 + 0) * 16 + co) * 16 + ci] + (co == ci ? dv[co] : 0.f); }
        } else {
            const int q = (kc - 256) >> 6, n0 = (kc - 256) & 63, d = q >> 1, e = (d == 0) ? (j + 1) : (16 - j);
#pragma unroll
            for (int i = 0; i < 8; ++i) { const int n = n0 + i;
                const float cr = Cc[((d * 16 + co) * 64 + n) * 2], cim = Cc[((d * 16 + co) * 64 + n) * 2 + 1];
                const float pr = lamP[((d * 17 + e) * 64 + n) * 2], pi = lamP[((d * 17 + e) * 64 + n) * 2 + 1];
                v[i] = (q & 1) ? -(cr * pi + cim * pr) : (cr * pr - cim * pi); }
        }
        v4u o; o.x = pk2(v[0], v[1]); o.y = pk2(v[2], v[3]); o.z = pk2(v[4], v[5]); o.w = pk2(v[6], v[7]);
        *(GAS v4u*)(WS3 + (size_t)row * 512 + kc) = o;
    }
    bf16* MS = (bf16*)(F.ws + WS_MS) + (size_t)g * 256 * 256;
    for (int p = t; p < 256 * 32; p += NWAVES * 64) {
        const int row = p >> 5, kc = (p & 31) * 8, q = row >> 6, n = row & 63, d = q >> 1, j = kc >> 4, ci0 = kc & 15, e = (d == 0) ? (15 - j) : j;
        const float pr = lamP[((d * 17 + e) * 64 + n) * 2], pi = lamP[((d * 17 + e) * 64 + n) * 2 + 1];
        float v[8];
#pragma unroll
        for (int i = 0; i < 8; ++i) { const float br = Bb[((d * 64 + n) * 16 + ci0 + i) * 2], bi = Bb[((d * 64 + n) * 16 + ci0 + i) * 2 + 1];
            v[i] = (q & 1) ? (pr * bi + pi * br) : (pr * br - pi * bi); }
        v4u o; o.x = pk2(v[0], v[1]); o.y = pk2(v[2], v[3]); o.z = pk2(v[4], v[5]); o.w = pk2(v[6], v[7]);
        *(GAS v4u*)(MS + (size_t)row * 256 + kc) = o;
    }
    __syncthreads();
}

__device__ __forceinline__ void weff_item(Frame& F, const Args& A, int item) {
    const int gi = item >> 6, nb = (item >> 2) & 15, cb = item & 3, n = nb * 64 + opq(hw_lane());
    const float* pool_w = A.in[4] + ((size_t)gi * 128 + cb * 32) * 128; const float* pool_scale = A.in[5] + gi * 128; const float* w_out = A.in[16] + (size_t)gi * 128 * D + n;
    float acc[32];
#pragma unroll
    for (int i = 0; i < 32; ++i) acc[i] = 0.f;
    for (int co = 0; co < 128; ++co) {
        const float w = w_out[(size_t)co * D] * pool_scale[co];
#pragma unroll
        for (int i = 0; i < 32; ++i) acc[i] += pool_w[i * 128 + co] * w;
    }
    bf16* dst = (bf16*)(F.ws + WS_WCAT) + (size_t)n * D + gi * 128 + cb * 32;
#pragma unroll
    for (int i = 0; i < 4; ++i) { v4u o; o.x = pk2(acc[8 * i], acc[8 * i + 1]); o.y = pk2(acc[8 * i + 2], acc[8 * i + 3]); o.z = pk2(acc[8 * i + 4], acc[8 * i + 5]); o.w = pk2(acc[8 * i + 6], acc[8 * i + 7]);
        *(GAS v4u*)(dst + 8 * i) = o; }
}

__device__ __forceinline__ void p0_prologue(Frame& F, const Args& A) {
    for (int g = blockIdx.x; g < NG; g += F.G) ssm_gen(F, A, g);
    __syncthreads();
    LAS float* scr = (LAS float*)(F.lds + RING_OFF + F.wave * P0_SCR);
    constexpr int I_WIN = 16 * 16, I_GLU = 8 * 8, I_WOB = 8 * 16, I_GU = NEXP * 16 * 4, I_DN = NEXP * 4 * 16, I_WG = 16 * 16, I_WPLE = 4 * 16;
    constexpr int I_WEFF = 256, I_WR = 36, I_RI = VP_ROWS / 256, I_ROWS = M / 8;
    constexpr int NITEMS = I_GU + I_GU + I_DN + I_WIN + I_GLU + I_WOB + I_WG + I_WPLE + I_WEFF + I_WR + I_RI + I_ROWS;
    for (int it = F.gw; it < NITEMS; it += F.ngw) {
        int r = it; const int lane = opq(hw_lane());
        if (r < 2 * I_GU) {
            const int up = r >= I_GU; if (up) r -= I_GU;
            const int e = r >> 6, kb = (r >> 2) & 15, nb = r & 3, k0 = kb * 64, n0 = nb * 64;
            const float* src = A.in[up ? 23 : 22] + ((size_t)e * D + k0) * DF + n0;
            bf16* dst = (bf16*)(F.ws + WS_WGU) + ((size_t)e * 512 + (n0 >> 7) * 256 + (up ? 128 : 0) + (n0 & 127)) * D + k0;
            transpose_item64(src, DF, dst, D, scr, lane); continue; }
        r -= 2 * I_GU;
        if (r < I_DN) {
            const int e = r >> 6, kb = (r >> 4) & 3, nb = r & 15, k0 = kb * 64, n0 = nb * 64;
            transpose_item64(A.in[24] + ((size_t)e * DF + k0) * D + n0, D, (bf16*)(F.ws + WS_WD) + ((size_t)e * D + n0) * DF + k0, DF, scr, lane); continue; }
        r -= I_DN;
        if (r < I_WIN) { const int kb = r >> 4, nb = r & 15; transpose_item64(A.in[3] + (size_t)kb * 64 * D + nb * 64, D, (bf16*)(F.ws + WS_WIN) + (size_t)nb * 64 * D + kb * 64, D, scr, lane); continue; }
        r -= I_WIN;
        if (r < I_GLU) { const int kb = r >> 3, nb = r & 7; transpose_item64(A.in[14] + (size_t)kb * 64 * DP + nb * 64, DP, (bf16*)(F.ws + WS_GLU) + (size_t)nb * 64 * DP + kb * 64, DP, scr, lane); continue; }
        r -= I_GLU;
        if (r < I_WOB) { const int kb = r >> 4, nb = r & 15;
            transpose_item64(A.in[16] + (size_t)(DP + kb * 64) * D + nb * 64, D, (bf16*)(F.ws + WS_WCAT) + (size_t)nb * 64 * D + DP + kb * 64, D, scr, lane); continue; }
        r -= I_WOB;
        if (r < I_WG) { const int kb = r >> 4, nb = r & 15; transpose_item64(A.in[26] + (size_t)kb * 64 * D + nb * 64, D, (bf16*)(F.ws + WS_WG) + (size_t)nb * 64 * D + kb * 64, D, scr, lane); continue; }
        r -= I_WG;
        if (r < I_WPLE) { const int kb = r >> 4, nb = r & 15; transpose_item64(A.in[28] + (size_t)kb * 64 * D + nb * 64, D, (bf16*)(F.ws + WS_WPLE) + (size_t)nb * 64 * DPLE + kb * 64, DPLE, scr, lane); continue; }
        r -= I_WPLE;
        if (r < I_WEFF) { weff_item(F, A, r); continue; }
        r -= I_WEFF;
        if (r < I_WR) {
            float* dst = (float*)(F.ws + WS_WR) + (size_t)r * D;
            if (r < 4) { for (int dd = lane; dd < D; dd += 64) dst[dd] = A.in[18][dd * 4 + r]; }
            else { const int gq = (r - 4) >> 3, e = (r - 4) & 7; for (int dd = lane; dd < D; dd += 64) dst[dd] = A.in[20][((size_t)gq * D + dd) * 8 + e]; }
            continue; }
        r -= I_WR;
        if (r < I_RI) { int* ri = (int*)(F.ws + WS_ROWINFO) + r * 256;
#pragma unroll
            for (int i = 0; i < 4; ++i) ri[lane + 64 * i] = -1;
            continue; }
        r -= I_RI;
        {
            for (int i = 0; i < 8; ++i) { const int m = r * 8 + i;
                rms_row_to_bf16(A.in[0] + (size_t)m * D, A.in[2], (bf16*)(F.ws + WS_XN) + (size_t)m * D, lane);
                const f32x4 pv = *((const GAS f32x4*)(A.in[1] + (size_t)m * DPLE) + lane);
                v2u o; o.x = pk2(pv.x, pv.y); o.y = pk2(pv.z, pv.w);
                *((GAS v2u*)((bf16*)(F.ws + WS_PB) + (size_t)m * DPLE) + lane) = o; }
        }
    }
}

using pg8::Unit; using pg8::bf16_t; typedef unsigned u32x4 __attribute__((ext_vector_type(4)));
__device__ __forceinline__ u32x4 pack8(const f32x4& a, const f32x4& b) { u32x4 w; w.x = pk2(a[0], a[1]); w.y = pk2(a[2], a[3]); w.z = pk2(b[0], b[1]); w.w = pk2(b[2], b[3]); return w; }
struct EpiZ { static constexpr bool PERM = true, AFTER_DRAIN = false; bf16_t* ZP; bf16_t* AS;
    __device__ __forceinline__ void operator()(const f32x4 (&acc)[2][2][4][2], const Unit& u, int wr, int wc, int fr, int fq) const {
        const int row0 = u.pm * 256 + wr * 64 + fr;
#pragma unroll
        for (int ai = 0; ai < 2; ++ai)
#pragma unroll
            for (int m = 0; m < 4; ++m) { const int r = row0 + ai * 128 + m * 16;
#pragma unroll
                for (int bj = 0; bj < 2; ++bj) { const int col = u.pn * 256 + bj * 128 + wc * 32 + 8 * fq; const u32x4 w = pack8(acc[ai][bj][m][0], acc[ai][bj][m][1]);
                    if (u.pn < 2) *(u32x4*)(ZP + (size_t)r * DP + col) = w;
                    else { const int sc = col - DP, g = sc >> 4, ch0 = sc & 15; *(u32x4*)(AS + ((size_t)(g * NCH + (r >> 4)) * 512 + (r & 15) * 16 + ch0)) = w; } } }
    } };
struct EpiSloc { static constexpr bool PERM = false, AFTER_DRAIN = false; float* C;
    __device__ __forceinline__ void operator()(const f32x4 (&acc)[2][2][4][2], const Unit& u, int wr, int wc, int fr, int fq) const {
        const int row0 = u.pm * 256 + wr * 64 + fr, col0 = wc * 32 + 4 * fq;
#pragma unroll
        for (int ai = 0; ai < 2; ++ai)
#pragma unroll
            for (int m = 0; m < 4; ++m) { float* rowp = C + (size_t)(row0 + ai * 128 + m * 16) * 256 + col0;
#pragma unroll
                for (int bj = 0; bj < 2; ++bj)
#pragma unroll
                    for (int n = 0; n < 2; ++n) *(f32x4*)(rowp + bj * 128 + n * 16) = acc[ai][bj][m][n]; }
    } };
struct EpiY { static constexpr bool PERM = true, AFTER_DRAIN = false; bf16_t* ZZ;
    __device__ __forceinline__ void operator()(const f32x4 (&acc)[2][2][4][2], const Unit& u, int wr, int wc, int fr, int fq) const {
        const int g = u.pn, row0 = (u.pm & 3) * 256 + wr * 64 + fr;
#pragma unroll
        for (int ai = 0; ai < 2; ++ai)
#pragma unroll
            for (int m = 0; m < 4; ++m) { const int c = row0 + ai * 128 + m * 16;
#pragma unroll
                for (int bj = 0; bj < 2; ++bj) { const int col = bj * 128 + wc * 32 + 8 * fq, j = col >> 4, co0 = col & 15;
                    f32x4 a = acc[ai][bj][m][0], b = acc[ai][bj][m][1];
#pragma unroll
                    for (int i = 0; i < 4; ++i) { a[i] = gelu_tanh(a[i]); b[i] = gelu_tanh(b[i]); }
                    *(u32x4*)(ZZ + (size_t)(c * CL + j) * DP + g * GC + co0) = pack8(a, b); asm volatile("" ::: "memory"); } }
    } };
struct EpiGlu { static constexpr bool PERM = true, AFTER_DRAIN = false; const bf16_t* ZZ; const float* bias; bf16_t* CAT;
    __device__ __forceinline__ void operator()(const f32x4 (&acc)[2][2][4][2], const Unit& u, int wr, int wc, int fr, int fq) const {
        const int row0 = u.pm * 256 + wr * 64 + fr;
#pragma unroll
        for (int bj = 0; bj < 2; ++bj) { const int col = u.pn * 256 + bj * 128 + wc * 32 + 8 * fq;
            const f32x4 b0 = *(const f32x4*)(bias + col), b1 = *(const f32x4*)(bias + col + 4);
#pragma unroll
            for (int ai = 0; ai < 2; ++ai)
#pragma unroll
                for (int m = 0; m < 4; ++m) { const int r = row0 + ai * 128 + m * 16;
                    const u32x4 z = *(const u32x4*)(ZZ + (size_t)r * DP + col);
                    f32x4 a = acc[ai][bj][m][0] + b0, b = acc[ai][bj][m][1] + b1;
                    a[0] = bflo(z.x) * sigmoidf_(a[0]); a[1] = bfhi(z.x) * sigmoidf_(a[1]); a[2] = bflo(z.y) * sigmoidf_(a[2]); a[3] = bfhi(z.y) * sigmoidf_(a[3]);
                    b[0] = bflo(z.z) * sigmoidf_(b[0]); b[1] = bfhi(z.z) * sigmoidf_(b[1]); b[2] = bflo(z.w) * sigmoidf_(b[2]); b[3] = bfhi(z.w) * sigmoidf_(b[3]);
                    *(u32x4*)(CAT + (size_t)r * D + DP + col) = pack8(a, b); asm volatile("" ::: "memory"); } }
    } };
struct EpiRes { static constexpr bool PERM = false, AFTER_DRAIN = false; const float* X; float* H;
    __device__ __forceinline__ void operator()(const f32x4 (&acc)[2][2][4][2], const Unit& u, int wr, int wc, int fr, int fq) const {
        const int row0 = u.pm * 256 + wr * 64 + fr, col0 = u.pn * 256 + wc * 32 + 4 * fq;
#pragma unroll
        for (int ai = 0; ai < 2; ++ai)
#pragma unroll
            for (int m = 0; m < 4; ++m) { const size_t off = (size_t)(row0 + ai * 128 + m * 16) * D + col0;
#pragma unroll
                for (int bj = 0; bj < 2; ++bj)
#pragma unroll
                    for (int n = 0; n < 2; ++n) *(f32x4*)(H + off + bj * 128 + n * 16) = *(const f32x4*)(X + off + bj * 128 + n * 16) + acc[ai][bj][m][n]; }
    } };
struct EpiAct { static constexpr bool PERM = true, AFTER_DRAIN = false; const float* ROWW; bf16_t* ACT;
    __device__ __forceinline__ void operator()(const f32x4 (&acc)[2][2][4][2], const Unit& u, int wr, int wc, int fr, int fq) const {
        const int row0 = u.pm * 256 + wr * 64 + fr, col = (u.pn & 1) * 128 + wc * 32 + 8 * fq;
#pragma unroll
        for (int ai = 0; ai < 2; ++ai)
#pragma unroll
            for (int m = 0; m < 4; ++m) { const int r = row0 + ai * 128 + m * 16; const float w = ROWW[r];
                f32x4 a, b;
#pragma unroll
                for (int i = 0; i < 4; ++i) { const float g0 = acc[ai][0][m][0][i], g1 = acc[ai][0][m][1][i];
                    a[i] = g0 * sigmoidf_(g0) * acc[ai][1][m][0][i] * w; b[i] = g1 * sigmoidf_(g1) * acc[ai][1][m][1][i] * w; }
                *(u32x4*)(ACT + (size_t)r * DF + col) = pack8(a, b); }
    } };
struct EpiDown { static constexpr bool PERM = true, AFTER_DRAIN = false; const int* ROWINFO; bf16_t* MO0; bf16_t* MO1;
    __device__ __forceinline__ void operator()(const f32x4 (&acc)[2][2][4][2], const Unit& u, int wr, int wc, int fr, int fq) const {
        const int row0 = u.pm * 256 + wr * 64 + fr, col0 = (u.pn & 3) * 256 + wc * 32 + 8 * fq;
#pragma unroll
        for (int ai = 0; ai < 2; ++ai)
#pragma unroll
            for (int m = 0; m < 4; ++m) { const int r = row0 + ai * 128 + m * 16; const int info = ROWINFO[r];
                if (info >= 0) { bf16_t* dst = ((info & 1) ? MO1 : MO0) + (size_t)(info >> 1) * D + col0;
#pragma unroll
                    for (int bj = 0; bj < 2; ++bj) *(u32x4*)(dst + bj * 128) = pack8(acc[ai][bj][m][0], acc[ai][bj][m][1]); } }
    } };
struct EpiPe { static constexpr bool PERM = true, AFTER_DRAIN = false; bf16_t* O;
    __device__ __forceinline__ void operator()(const f32x4 (&acc)[2][2][4][2], const Unit& u, int wr, int wc, int fr, int fq) const {
        const int row0 = u.pm * 256 + wr * 64 + fr, col0 = u.pn * 256 + wc * 32 + 8 * fq;
#pragma unroll
        for (int ai = 0; ai < 2; ++ai)
#pragma unroll
            for (int m = 0; m < 4; ++m) { bf16_t* rowp = O + (size_t)(row0 + ai * 128 + m * 16) * D + col0;
#pragma unroll
                for (int bj = 0; bj < 2; ++bj) *(u32x4*)(rowp + bj * 128) = pack8(acc[ai][bj][m][0], acc[ai][bj][m][1]); }
    } };
struct EpiPle { static constexpr bool PERM = false, AFTER_DRAIN = false; float* H; const float* bias; const bf16_t* PE;
    __device__ __forceinline__ void operator()(const f32x4 (&acc)[2][2][4][2], const Unit& u, int wr, int wc, int fr, int fq) const {
        const int row0 = u.pm * 256 + wr * 64 + fr, col0 = u.pn * 256 + wc * 32 + 4 * fq;
#pragma unroll
        for (int bj = 0; bj < 2; ++bj)
#pragma unroll
            for (int n = 0; n < 2; ++n) { const f32x4 bv = *(const f32x4*)(bias + col0 + bj * 128 + n * 16);
#pragma unroll
                for (int ai = 0; ai < 2; ++ai)
#pragma unroll
                    for (int m = 0; m < 4; ++m) { const size_t off = (size_t)(row0 + ai * 128 + m * 16) * D + col0 + bj * 128 + n * 16;
                        const v2u pe = *(const v2u*)(PE + off); const f32x4 a = acc[ai][bj][m][n] + bv; f32x4 h = *(const f32x4*)(H + off);
                        h[0] += sigmoidf_(a[0]) * bflo(pe.x); h[1] += sigmoidf_(a[1]) * bfhi(pe.x); h[2] += sigmoidf_(a[2]) * bflo(pe.y); h[3] += sigmoidf_(a[3]) * bfhi(pe.y);
                        *(f32x4*)(H + off) = h; if (m & 1) asm volatile("" ::: "memory"); } }
    } };

struct GroupOrder { int G, c;
    __device__ __forceinline__ bool next(int i, Unit& u) const { const int L = i * G + c; if (L >= NG * 4) return false; u.pm = L; u.pn = L >> 2; return true; }
    __device__ __forceinline__ void a_ready(const Unit&) const {}
    __device__ __forceinline__ void done(const Unit&) const {} };
template <int NSUB> struct ExpertOrder { int G, c; const volatile LAS unsigned* tstart;
    __device__ __forceinline__ bool next(int i, Unit& u) const {
        const int L = i * G + c, tau = L / NSUB, sub = L % NSUB; if (tau >= (int)tstart[NEXP]) return false;
        int e = 0;
        for (int k = 1; k < NEXP; ++k) e += ((int)tstart[k] <= tau) ? 1 : 0;
        u.pm = tau; u.pn = e * NSUB + sub; return true; }
    __device__ __forceinline__ void a_ready(const Unit&) const {}
    __device__ __forceinline__ void done(const Unit&) const {} };

__device__ __forceinline__ void carry_unit(Frame& F, int unit) {
    const int d = unit & 1, g = (unit >> 1) & 31, b = unit >> 6, n = opq(hw_lane()), s = F.wave;
    const float* lt = (const float*)(F.ws + WS_LAMT) + ((g * 2 + d) * 64 + n) * 4;
    const float l16r = lt[0], l16i = lt[1], lkr = lt[2], lki = lt[3];
    const float* SL = (const float*)(F.ws + WS_SLOC) + (size_t)(g * NCH + b * 512) * 256 + d * 128 + n;
    bf16* AS = (bf16*)(F.ws + WS_AS) + (size_t)(g * NCH + b * 512) * 512 + 256 + d * 128 + n;
    LAS float* segE = (LAS float*)(F.lds + RING_OFF);
    float er = 0.f, ei = 0.f;
    for (int i0 = 0; i0 < 64; i0 += 16) {
        float sr[16], si[16];
#pragma unroll
        for (int ii = 0; ii < 16; ++ii) { const int i = s * 64 + i0 + ii, c = d ? (511 - i) : i; sr[ii] = SL[(size_t)c * 256]; si[ii] = SL[(size_t)c * 256 + 64]; }
#pragma unroll
        for (int ii = 0; ii < 16; ++ii) { const float tr = l16r * er - l16i * ei + sr[ii], ti = l16r * ei + l16i * er + si[ii]; er = tr; ei = ti; }
    }
    __syncthreads();
    segE[(s * 64 + n) * 2] = er; segE[(s * 64 + n) * 2 + 1] = ei;
    __syncthreads();
    float xr = 0.f, xi = 0.f;
    for (int sp = 0; sp < s; ++sp) { const float pr = segE[(sp * 64 + n) * 2], pi = segE[(sp * 64 + n) * 2 + 1];
        const float tr = lkr * xr - lki * xi + pr, ti = lkr * xi + lki * xr + pi; xr = tr; xi = ti; }
    for (int i0 = 0; i0 < 64; i0 += 16) {
        float sr[16], si[16];
#pragma unroll
        for (int ii = 0; ii < 16; ++ii) { const int i = s * 64 + i0 + ii, c = d ? (511 - i) : i; sr[ii] = SL[(size_t)c * 256]; si[ii] = SL[(size_t)c * 256 + 64]; }
#pragma unroll
        for (int ii = 0; ii < 16; ++ii) { const int i = s * 64 + i0 + ii, c = d ? (511 - i) : i;
            AS[(size_t)c * 512] = (bf16)f2bf(xr); AS[(size_t)c * 512 + 64] = (bf16)f2bf(xi);
            const float tr = l16r * xr - l16i * xi + sr[ii], ti = l16r * xi + l16i * xr + si[ii]; xr = tr; xi = ti; }
    }
    __syncthreads();
}
__device__ __forceinline__ void diff_row(Frame& F, int m) {
    const int t = m & (SEQ - 1), lane = opq(hw_lane()), h = 1 << (lane >> 4), lo = max(t - h, 0), hi = min(t + h, SEQ);
    const bf16* ZP = (const bf16*)(F.ws + WS_ZP) + (size_t)(m - t) * DP + lane * 8;
    float acc[8];
#pragma unroll
    for (int i = 0; i < 8; ++i) acc[i] = 0.f;
    v4u zt = (v4u){0u, 0u, 0u, 0u};
    v4u zz[16];
#pragma unroll
    for (int k = 0; k < 16; ++k) { const int s = t - 8 + k, sc = (s >= lo && s < hi) ? s : t; zz[k] = *(const GAS v4u*)(ZP + (size_t)sc * DP); }
#pragma unroll
    for (int k = 0; k < 16; ++k) { const int s = t - 8 + k; const float f = (s >= lo && s < hi) ? 1.f : 0.f; const v4u z = zz[k];
        acc[0] += f * bflo(z.x); acc[1] += f * bfhi(z.x); acc[2] += f * bflo(z.y); acc[3] += f * bfhi(z.y); acc[4] += f * bflo(z.z); acc[5] += f * bfhi(z.z); acc[6] += f * bflo(z.w); acc[7] += f * bfhi(z.w);
        if (k == 8) zt = z; }
    const float inv = 1.0f / (float)(hi - lo);
    v4u o; o.x = pk2(acc[0] * inv - bflo(zt.x), acc[1] * inv - bfhi(zt.x)); o.y = pk2(acc[2] * inv - bflo(zt.y), acc[3] * inv - bfhi(zt.y));
    o.z = pk2(acc[4] * inv - bflo(zt.z), acc[5] * inv - bfhi(zt.z)); o.w = pk2(acc[6] * inv - bflo(zt.w), acc[7] * inv - bfhi(zt.w));
    *(GAS v4u*)((bf16*)(F.ws + WS_CAT) + (size_t)m * D + lane * 8) = o;
#if MK_STAGE == 1
    *(GAS v4u*)((bf16*)(F.ws + WS_CAT) + (size_t)m * D + DP + lane * 8) = (v4u){0u, 0u, 0u, 0u};
#endif
}
__device__ __forceinline__ float dot16(const f32x4 (&v)[4], const float* w, int lane) {
    const GAS f32x4* wr = (const GAS f32x4*)w + lane; float s = 0.f;
#pragma unroll
    for (int j = 0; j < 4; ++j) { const f32x4 ww = wr[64 * j]; s += (v[j].x * ww.x + v[j].y * ww.y) + (v[j].z * ww.z + v[j].w * ww.w); }
    return wave_sum(s);
}
__device__ __forceinline__ void route_row(Frame& F, const Args& A, int m) {
    const int lane = opq(hw_lane());
    const GAS f32x4* hr = (const GAS f32x4*)(F.out + (size_t)m * D) + lane; const GAS f32x4* gr = (const GAS f32x4*)A.in[17] + lane;
    f32x4 v[4]; float s = 0.f;
#pragma unroll
    for (int j = 0; j < 4; ++j) { v[j] = hr[64 * j]; s += (v[j].x * v[j].x + v[j].y * v[j].y) + (v[j].z * v[j].z + v[j].w * v[j].w); }
    const float rstd = 1.f / sqrtf(wave_sum(s) * (1.f / D) + RMS_EPS);
    GAS unsigned long long* o8 = (GAS unsigned long long*)((bf16*)(F.ws + WS_XN) + (size_t)m * D) + lane;
#pragma unroll
    for (int j = 0; j < 4; ++j) { const f32x4 gg = gr[64 * j]; v[j] = v[j] * rstd * gg;
        o8[64 * j] = (unsigned long long)pk2(v[j].x, v[j].y) | ((unsigned long long)pk2(v[j].z, v[j].w) << 32); }
    const float* WR = (const float*)(F.ws + WS_WR);
    float gl[4];
#pragma unroll
    for (int k = 0; k < 4; ++k) gl[k] = dot16(v, WR + (size_t)k * D, lane) + A.in[19][k];
    int gsel = 0; float gmax = gl[0];
#pragma unroll
    for (int k = 1; k < 4; ++k) if (gl[k] > gmax) { gmax = gl[k]; gsel = k; }
    float gden = 0.f;
#pragma unroll
    for (int k = 0; k < 4; ++k) gden += __expf(gl[k] - gmax);
    const float grp_p = 1.0f / gden;
    gsel = __builtin_amdgcn_readfirstlane(gsel);
    float el[8];
#pragma unroll
    for (int e = 0; e < 8; ++e) el[e] = dot16(v, WR + (size_t)(4 + gsel * 8 + e) * D, lane) + A.in[21][gsel * 8 + e];
    int i1 = 0; float m1 = el[0];
#pragma unroll
    for (int e = 1; e < 8; ++e) if (el[e] > m1) { m1 = el[e]; i1 = e; }
    int i2 = -1; float m2 = -3.0e38f;
#pragma unroll
    for (int e = 0; e < 8; ++e) if (e != i1 && el[e] > m2) { m2 = el[e]; i2 = e; }
    const float r = __expf(m2 - m1), w1 = grp_p / (1.0f + r), w2 = grp_p * r / (1.0f + r);
    if (lane == 0) {
        const int e1 = gsel * 8 + i1, e2 = gsel * 8 + i2;
        int* rt = (int*)(F.ws + WS_ROUTE) + (size_t)m * 4; rt[0] = e1; rt[1] = e2; ((float*)rt)[2] = w1; ((float*)rt)[3] = w2;
        __hip_atomic_fetch_add((unsigned*)(F.ctl + CW_CNT) + 64 * e1, 1u, RLX_AGENT); __hip_atomic_fetch_add((unsigned*)(F.ctl + CW_CNT) + 64 * e2, 1u, RLX_AGENT);
    }
}
__device__ __forceinline__ void build_tstart(Frame& F) {
    if (F.wave == 0 && hw_lane() == 0) { unsigned acc = 0u;
        for (int e = 0; e < NEXP; ++e) { F.MISC[16 + e] = acc; acc += (__hip_atomic_load((unsigned*)(F.ctl + CW_CNT) + 64 * e, RLX_AGENT) + 255u) >> 8; }
        F.MISC[16 + NEXP] = acc; }
    __syncthreads();
}
__device__ __forceinline__ void permute_row(Frame& F, int m) {
    const int lane = opq(hw_lane());
    const int* rt = (const int*)(F.ws + WS_ROUTE) + (size_t)m * 4;
    const int e1 = rt[0], e2 = rt[1]; const float w1 = ((const float*)rt)[2], w2 = ((const float*)rt)[3];
    const GAS v4u* src = (const GAS v4u*)((const bf16*)(F.ws + WS_XN) + (size_t)m * D) + lane;
    const v4u a = src[0], b = src[64];
#pragma unroll
    for (int k = 0; k < 2; ++k) { const int e = k ? e2 : e1;
        unsigned pos = 0u;
        if (lane == 0) pos = F.MISC[16 + e] * 256u + __hip_atomic_fetch_add((unsigned*)(F.ctl + CW_FILL) + 64 * e, 1u, RLX_AGENT);
        pos = __builtin_amdgcn_readfirstlane(pos);
        GAS v4u* dst = (GAS v4u*)((bf16*)(F.ws + WS_VP) + (size_t)pos * D) + lane; dst[0] = a; dst[64] = b;
        if (lane == 0) { ((int*)(F.ws + WS_ROWINFO))[pos] = 2 * m + k; ((float*)(F.ws + WS_ROWW))[pos] = k ? w2 : w1; } }
}
template <int R> __device__ __forceinline__ void moe_combine_rows(Frame& F, const Args& A, int m) {
    const int lane = opq(hw_lane());
    GAS f32x4* hr = (GAS f32x4*)(F.out + (size_t)m * D) + lane; const GAS f32x4* gr = (const GAS f32x4*)A.in[25] + lane;
    const GAS v2u* m0 = (const GAS v2u*)((const bf16*)(F.ws + WS_MO0) + (size_t)m * D) + lane; const GAS v2u* m1 = (const GAS v2u*)((const bf16*)(F.ws + WS_MO1) + (size_t)m * D) + lane;
    f32x4 v[R][4]; v2u a[R][4], b[R][4];
#pragma unroll
    for (int r = 0; r < R; ++r)
#pragma unroll
        for (int j = 0; j < 4; ++j) { v[r][j] = hr[r * 256 + 64 * j]; a[r][j] = m0[r * 256 + 64 * j]; b[r][j] = m1[r * 256 + 64 * j]; }
    GAS unsigned long long* o8 = (GAS unsigned long long*)((bf16*)(F.ws + WS_XN) + (size_t)m * D) + lane;
#pragma unroll
    for (int r = 0; r < R; ++r) { float s = 0.f;
#pragma unroll
        for (int j = 0; j < 4; ++j) { f32x4& x = v[r][j];
            x.x += bflo(a[r][j].x) + bflo(b[r][j].x); x.y += bfhi(a[r][j].x) + bfhi(b[r][j].x); x.z += bflo(a[r][j].y) + bflo(b[r][j].y); x.w += bfhi(a[r][j].y) + bfhi(b[r][j].y);
            hr[r * 256 + 64 * j] = x; s += (x.x * x.x + x.y * x.y) + (x.z * x.z + x.w * x.w); }
        const float rstd = 1.f / sqrtf(wave_sum(s) * (1.f / D) + RMS_EPS);
#pragma unroll
        for (int j = 0; j < 4; ++j) { const f32x4 gg = gr[64 * j], x = v[r][j];
            o8[r * 256 + 64 * j] = (unsigned long long)pk2(x.x * rstd * gg.x, x.y * rstd * gg.y) | ((unsigned long long)pk2(x.z * rstd * gg.z, x.w * rstd * gg.w) << 32); } }
}
template <int R> __device__ __forceinline__ void final_rows(Frame& F, const Args& A, int m) {
    const int lane = opq(hw_lane());
    GAS f32x4* hr = (GAS f32x4*)(F.out + (size_t)m * D) + lane; const GAS f32x4* gr = (const GAS f32x4*)A.in[29] + lane;
    f32x4 v[R][4];
#pragma unroll
    for (int r = 0; r < R; ++r)
#pragma unroll
        for (int j = 0; j < 4; ++j) v[r][j] = hr[r * 256 + 64 * j];
#pragma unroll
    for (int r = 0; r < R; ++r) { float s = 0.f;
#pragma unroll
        for (int j = 0; j < 4; ++j) s += (v[r][j].x * v[r][j].x + v[r][j].y * v[r][j].y) + (v[r][j].z * v[r][j].z + v[r][j].w * v[r][j].w);
        const float rstd = 1.f / sqrtf(wave_sum(s) * (1.f / D) + RMS_EPS);
#pragma unroll
        for (int j = 0; j < 4; ++j) hr[r * 256 + 64 * j] = v[r][j] * rstd * gr[64 * j]; }
}

__global__ void __launch_bounds__(NWAVES * 64, 2) mk_fwd(Args args) {
    extern __shared__ __attribute__((aligned(16))) unsigned char lds[];
    Frame F;
    F.lds = (LAS unsigned char*)lds;
    F.MISC = (volatile LAS unsigned*)(F.lds + MISC_OFF);
    F.wave = __builtin_amdgcn_readfirstlane(threadIdx.x >> 6);
    F.G = gridDim.x; F.gw = blockIdx.x * NWAVES + F.wave; F.ngw = F.G * NWAVES;
    F.out = args.out; F.ws = args.ws; F.ctl = (gu32*)(args.ws + WS_CTL);
    for (int u = threadIdx.x; u < (LDS_BYTES - LDSCTL_OFF) / 4; u += NWAVES * 64) ((LAS unsigned*)(F.lds + LDSCTL_OFF))[u] = 0u;
    __syncthreads();
    XcdBarrier bar = xcd_barrier_post((unsigned*)(F.ctl + CW_BAR), F.MISC + 8); bar.wave = F.wave;
#define GRID_BAR() xcd_barrier(bar)
    bf16* const WIN = (bf16*)(F.ws + WS_WIN); bf16* const GLU = (bf16*)(F.ws + WS_GLU); bf16* const WCAT = (bf16*)(F.ws + WS_WCAT); bf16* const WG = (bf16*)(F.ws + WS_WG); bf16* const WPLE = (bf16*)(F.ws + WS_WPLE);
    bf16* const WGU = (bf16*)(F.ws + WS_WGU); bf16* const WD = (bf16*)(F.ws + WS_WD); bf16* const MS = (bf16*)(F.ws + WS_MS); bf16* const WS3 = (bf16*)(F.ws + WS_WS3);
    bf16* const XN = (bf16*)(F.ws + WS_XN); bf16* const ZP = (bf16*)(F.ws + WS_ZP); bf16* const AS = (bf16*)(F.ws + WS_AS); float* const SLOC = (float*)(F.ws + WS_SLOC);
    bf16* const CAT = (bf16*)(F.ws + WS_CAT); bf16* const ZZ = (bf16*)(F.ws + WS_ZZ); bf16* const PB = (bf16*)(F.ws + WS_PB); bf16* const PE = (bf16*)(F.ws + WS_PE);
    bf16* const VP = (bf16*)(F.ws + WS_VP); bf16* const ACT = (bf16*)(F.ws + WS_ACT); bf16* const MO0 = (bf16*)(F.ws + WS_MO0); bf16* const MO1 = (bf16*)(F.ws + WS_MO1);
    const int cid = (int)blockIdx.x;

#ifndef MK_REP
#define MK_REP -1
#endif
#define REP(k) for (int rep_ = 0; rep_ < ((MK_REP == (k)) ? 2 : 1); ++rep_)
    REP(0) { p0_prologue(F, args);
    GRID_BAR(); }
    REP(1) { pg8::Gemm g{XN, WIN, D, D, D}; pg8::StaticOrder S; S.init(M, D, F.G, cid); EpiZ E{ZP, AS};
      pg8::gemm_phase<EpiZ, pg8::StaticOrder, true, true>(F.lds + RING_OFF, g, S, E, F.wave);
    GRID_BAR(); }
#if MK_STAGE >= 2
    { pg8::Gemm g{AS, MS, 256, 512, 256}; GroupOrder S{F.G, cid}; EpiSloc E{SLOC};
      pg8::gemm_phase<EpiSloc, GroupOrder, true, true>(F.lds + RING_OFF, g, S, E, F.wave); }
    GRID_BAR();
#endif
    REP(3) {
#if MK_STAGE >= 2
        if (F.G >= 256) { if (cid < 128) { carry_unit(F, cid); for (int m = 12288 + cid * NWAVES + F.wave; m < M; m += 128 * NWAVES) diff_row(F, m); }
                          else for (int m = (cid - 128) * NWAVES + F.wave; m < 12288; m += (F.G - 128) * NWAVES) diff_row(F, m); }
        else { for (int u = cid; u < 128; u += F.G) carry_unit(F, u); for (int m = F.gw; m < M; m += F.ngw) diff_row(F, m); }
#else
        for (int m = F.gw; m < M; m += F.ngw) diff_row(F, m);
#endif
    GRID_BAR(); }
#if MK_STAGE >= 2
    { pg8::Gemm g{AS, WS3, 512, 512, 512}; GroupOrder S{F.G, cid}; EpiY E{ZZ};
      pg8::gemm_phase<EpiY, GroupOrder, true, true>(F.lds + RING_OFF, g, S, E, F.wave); }
    GRID_BAR();
    { pg8::Gemm g{ZZ, GLU, DP, DP, DP}; pg8::StaticOrder S; S.init(M, DP, F.G, cid); EpiGlu E{ZZ, args.in[15], CAT};
      pg8::gemm_phase<EpiGlu, pg8::StaticOrder, true, true>(F.lds + RING_OFF, g, S, E, F.wave); }
    GRID_BAR();
#endif
    { pg8::Gemm g{CAT, WCAT, D, D, D}; pg8::StaticOrder S; S.init(M, D, F.G, cid); EpiRes E{args.in[0], F.out};
      pg8::gemm_phase<EpiRes, pg8::StaticOrder, true, true>(F.lds + RING_OFF, g, S, E, F.wave); }
    GRID_BAR();
#if MK_STAGE >= 3
    for (int m = F.gw; m < M; m += F.ngw) route_row(F, args, m);
    GRID_BAR();
    build_tstart(F);
    for (int m = F.gw; m < M; m += F.ngw) permute_row(F, m);
    GRID_BAR();
    REP(90) {
    { pg8::Gemm g{VP, WGU, D, D, D}; ExpertOrder<2> S{F.G, cid, F.MISC + 16}; EpiAct E{(const float*)(F.ws + WS_ROWW), ACT};
      pg8::gemm_phase<EpiAct, ExpertOrder<2>, true, true>(F.lds + RING_OFF, g, S, E, F.wave); }
    GRID_BAR(); }
    REP(91) {
    { pg8::Gemm g{ACT, WD, DF, DF, DF}; ExpertOrder<4> S{F.G, cid, F.MISC + 16}; EpiDown E{(const int*)(F.ws + WS_ROWINFO), MO0, MO1};
      pg8::gemm_phase<EpiDown, ExpertOrder<4>, true, true>(F.lds + RING_OFF, g, S, E, F.wave); }
    GRID_BAR(); }
    for (int m = F.gw * 2; m < M; m += F.ngw * 2) moe_combine_rows<2>(F, args, m);
    GRID_BAR();
#endif
#if MK_STAGE >= 4
    { pg8::Gemm g{PB, WPLE, DPLE, DPLE, DPLE}; pg8::StaticOrder S; S.init(M, D, F.G, cid); EpiPe E{PE};
      pg8::gemm_phase<EpiPe, pg8::StaticOrder, true, true>(F.lds + RING_OFF, g, S, E, F.wave); }
    GRID_BAR();
    { pg8::Gemm g{XN, WG, D, D, D}; pg8::StaticOrder S; S.init(M, D, F.G, cid); EpiPle E{F.out, args.in[27], PE};
      pg8::gemm_phase<EpiPle, pg8::StaticOrder, true, true>(F.lds + RING_OFF, g, S, E, F.wave); }
    GRID_BAR();
#endif
    for (int m = F.gw * 4; m < M; m += F.ngw * 4) final_rows<4>(F, args, m);
}

extern "C" void kernel_launch(void* const* d_in, const int* in_sizes, int n_in, void* d_out, int out_size, void* d_ws, size_t ws_size, hipStream_t stream) {
    static int grid = 0;
    if (grid == 0) {
        if (n_in != 30 || in_sizes[0] != M * D || out_size != M * D || ws_size < WS_END) { fprintf(stderr, "kernel_launch: unexpected shapes (n_in %d, in0 %d, out %d, ws %zu)\n", n_in, n_in > 0 ? in_sizes[0] : -1, out_size, ws_size); grid = -1; return; }
        int dev = 0, cus = 0, per_cu = 0;
        if (hipGetDevice(&dev) != hipSuccess || hipDeviceGetAttribute(&cus, hipDeviceAttributeMultiprocessorCount, dev) != hipSuccess) { grid = -1; return; }
        if (hipFuncSetAttribute((const void*)mk_fwd, hipFuncAttributeMaxDynamicSharedMemorySize, LDS_BYTES) != hipSuccess) { fprintf(stderr, "kernel_launch: hipFuncSetAttribute failed\n"); grid = -1; return; }
        if (hipOccupancyMaxActiveBlocksPerMultiprocessor(&per_cu, (const void*)mk_fwd, NWAVES * 64, LDS_BYTES) != hipSuccess || per_cu < 1) { fprintf(stderr, "kernel_launch: occupancy query reports %d blocks per CU\n", per_cu); }
        (void)hipGetLastError();
        grid = cus;
    }
    if (grid < 0) return;
    (void)hipMemsetAsync((char*)d_ws + WS_CTL, 0, CTL_ZERO_BYTES, stream);
    Args a{};
    for (int i = 0; i < 30; ++i) a.in[i] = (const float*)d_in[i];
    a.out = (float*)d_out; a.ws = (unsigned char*)d_ws;
    hipLaunchKernelGGL(mk_fwd, dim3(grid), dim3(NWAVES * 64), LDS_BYTES, stream, a);
}
```

```cpp
#include <hip/hip_runtime.h>
#include <cstdio>
#include <cstdint>
__device__ __forceinline__ int hw_lane() { int l; asm volatile("v_mbcnt_lo_u32_b32 %0, -1, 0\n\tv_mbcnt_hi_u32_b32 %0, -1, %0" : "=v"(l)); return l; }
namespace pg8 {
#define PG8_LAS __attribute__((address_space(3)))
typedef unsigned short bf16_t;
typedef short bf16x8 __attribute__((ext_vector_type(8)));
typedef float f32x4 __attribute__((ext_vector_type(4)));
typedef unsigned u32x4 __attribute__((ext_vector_type(4)));
constexpr int BM = 256, BK = 64, HALF = 128, HTB = HALF * BK * 2  , STAGE_BYTES = 8 * HTB, NXCD = 8, WGM = 8;

__host__ __device__ __forceinline__ int lds_byte(int r, int c) { const int st = (r >> 4) * 2 + (c >> 5), rr = r & 15, cc = c & 31, ob = rr * 64 + cc * 2; return st * 1024 + (ob ^ (((ob >> 9) & 1) << 5)); }
__host__ __device__ __forceinline__ void stage_rc(int b, int& R, int& C) { const int st = b / 1024, sb = b % 1024, swz = sb ^ (((sb >> 9) & 1) << 5); R = (st >> 1) * 16 + swz / 64; C = (st & 1) * 32 + (swz % 64) / 2; }
__host__ __device__ __forceinline__ int perm32(int rho) { const int n = rho >> 4, i = rho & 15; return 8 * (i >> 2) + 4 * n + (i & 3); }

struct Unit { int pm, pn; };
struct Gemm { const bf16_t* A; const bf16_t* Bt; int K, lda, ldb; };

struct StaticOrder {
    int nM, nN, nwg, G, c;
    __host__ __device__ void init(int M, int N, int G_, int c_) { nM = M / BM; nN = N / BM; nwg = nM * nN; G = G_; c = c_; }
    __host__ __device__ bool next(int i, Unit& u) const {
        const long L = (long)i * G + c; if (L >= nwg) return false;
        int wgid = (int)L; { const int q = nwg / NXCD, r = nwg % NXCD, xcd = wgid % NXCD, off = wgid / NXCD; wgid = (xcd < r ? xcd * (q + 1) : r * (q + 1) + (xcd - r) * q) + off; }
        const int nig = WGM * nN, gid = wgid / nig, fm = gid * WGM, gsz = (nM - fm) < WGM ? (nM - fm) : WGM;
        u.pm = fm + ((wgid % nig) % gsz); u.pn = (wgid % nig) / gsz; return true;
    }
    __device__ __forceinline__ void a_ready(const Unit&) const {}
    __device__ __forceinline__ void done(const Unit&) const {}
};

template <class Epi, class Sched, bool ALIGN_EPI = false, bool SP2 = false>
__device__ __forceinline__ void gemm_phase(PG8_LAS unsigned char* lds, const Gemm g, const Sched& S, const Epi& E, const int wid  ) {
    int lane_ = hw_lane(); asm volatile("" : "+v"(lane_));
    const int lane = lane_, tid = wid * 64 + lane, wr = wid >> 2, wc = wid & 3, fr = lane & 15, fq = lane >> 4;
    const int K = g.K, nt = K / BK;
    unsigned voffA[2], voffB[2];
#pragma unroll
    for (int i = 0; i < 2; ++i) { int R, C; stage_rc(tid * 16 + i * 8192, R, C); const int Rb = Epi::PERM ? ((R & ~31) + perm32(R & 31)) : R;
        voffA[i] = (unsigned)(R * g.lda + C) * 2u; voffB[i] = (unsigned)(Rb * g.ldb + C) * 2u; }
    const size_t kstep = (size_t)(BK * 2);
    const size_t hstepA = (size_t)HALF * g.lda * 2, hstepB = (size_t)HALF * g.ldb * 2;
    const size_t tstepA = 2 * hstepA, tstepB = 2 * hstepB;
    const unsigned ldsw = (unsigned)wid * 1024u;
    const int aoff = lds_byte(wr * 64 + fr, fq * 8), boff = lds_byte(wc * 32 + fr, fq * 8);
#define PG8_SA(b, h) (((b) * 2 + (h)) * HTB)
#define PG8_SB(b, h) ((4 + (b) * 2 + (h)) * HTB)
#define PG8_STAGE(bufoff, gbase, voff) do { _Pragma("unroll") for (int _i = 0; _i < 2; ++_i) \
        __builtin_amdgcn_global_load_lds((const unsigned*)((const char*)(gbase) + (voff)[_i]), (PG8_LAS unsigned*)(lds + (bufoff) + ldsw + _i * 8192), 16, 0, 0); } while (0)
#define PG8_LDA(dst, b, h) do { _Pragma("unroll") for (int m = 0; m < 4; ++m) _Pragma("unroll") for (int k = 0; k < 2; ++k) dst[m][k] = *(const PG8_LAS bf16x8*)(lds + PG8_SA(b, h) + aoff + m * 2048 + k * 1024); } while (0)
#define PG8_LDB(dst, b, h) do { _Pragma("unroll") for (int n = 0; n < 2; ++n) _Pragma("unroll") for (int k = 0; k < 2; ++k) dst[n][k] = *(const PG8_LAS bf16x8*)(lds + PG8_SB(b, h) + boff + n * 2048 + k * 1024); } while (0)
#define PG8_MMA(ai, bj, At, Bt) do { __builtin_amdgcn_s_setprio(1); _Pragma("unroll") for (int m = 0; m < 4; ++m) _Pragma("unroll") for (int n = 0; n < 2; ++n) _Pragma("unroll") for (int k = 0; k < 2; ++k) \
        acc[ai][bj][m][n] = __builtin_amdgcn_mfma_f32_16x16x32_bf16(Bt[n][k], At[m][k], acc[ai][bj][m][n], 0, 0, 0); __builtin_amdgcn_s_setprio(0); } while (0)
#define PG8_WAIT_V(n) asm volatile("s_waitcnt vmcnt(" #n ")" ::: "memory")
#define PG8_WAIT_L(n) asm volatile("s_waitcnt lgkmcnt(" #n ")" ::: "memory")
#define PG8_BAR __builtin_amdgcn_s_barrier()
#define PG8_SCHED __builtin_amdgcn_sched_barrier(0)
    Unit cur, nxt; int ui = 0;
    if (!S.next(0, cur)) return;
    f32x4 acc[2][2][4][2];
#pragma unroll
    for (int a = 0; a < 2; ++a)
#pragma unroll
        for (int b = 0; b < 2; ++b)
#pragma unroll
            for (int m = 0; m < 4; ++m)
#pragma unroll
                for (int n = 0; n < 2; ++n) acc[a][b][m][n] = (f32x4){0.f, 0.f, 0.f, 0.f};
    bf16x8 At[4][2], B0[2][2], B1[2][2];
    const char* cA = (const char*)g.A + (size_t)cur.pm * tstepA; const char* cB = (const char*)g.Bt + (size_t)cur.pn * tstepB;
    S.a_ready(cur);
    if constexpr (SP2) {
        PG8_STAGE(PG8_SB(0, 0), cB, voffB); PG8_STAGE(PG8_SB(0, 1), cB + hstepB, voffB); PG8_STAGE(PG8_SA(0, 0), cA, voffA); PG8_STAGE(PG8_SA(0, 1), cA + hstepA, voffA);
        if (wr == 1) PG8_BAR;
        PG8_WAIT_V(2); PG8_BAR;
        PG8_STAGE(PG8_SB(1, 0), cB + kstep, voffB); PG8_STAGE(PG8_SA(1, 0), cA + kstep, voffA); PG8_STAGE(PG8_SB(1, 1), cB + hstepB + kstep, voffB);
        PG8_WAIT_V(6); PG8_BAR;
    } else {
        PG8_STAGE(PG8_SB(0, 0), cB, voffB); PG8_STAGE(PG8_SA(0, 0), cA, voffA); PG8_STAGE(PG8_SB(0, 1), cB + hstepB, voffB); PG8_STAGE(PG8_SA(0, 1), cA + hstepA, voffA);
        if (wr == 1) PG8_BAR;
        PG8_WAIT_V(4); PG8_BAR;
        PG8_STAGE(PG8_SB(1, 0), cB + kstep, voffB); PG8_STAGE(PG8_SA(1, 0), cA + kstep, voffA); PG8_STAGE(PG8_SB(1, 1), cB + hstepB + kstep, voffB);
        PG8_WAIT_V(6); PG8_BAR;
    }
    for (;;) {
        const bool has_next = S.next(ui + 1, nxt);
        const char* nA = has_next ? (const char*)g.A + (size_t)nxt.pm * tstepA : cA; const char* nB = has_next ? (const char*)g.Bt + (size_t)nxt.pn * tstepB : cB;
        for (int t = 0; t < nt; t += 2) {
            const bool last = (t == nt - 2);
            const char* a1 = cA + (size_t)(t + 1) * kstep;
            const char* a2 = last ? nA : cA + (size_t)(t + 2) * kstep; const char* b2 = last ? nB : cB + (size_t)(t + 2) * kstep;
            const char* a3 = a2 + kstep; const char* b3 = b2 + kstep;
            if (last && has_next) S.a_ready(nxt);
            if constexpr (SP2) {
            PG8_LDB(B0, 0, 0); PG8_LDB(B1, 0, 1); PG8_SCHED; PG8_LDA(At, 0, 0); PG8_STAGE(PG8_SA(1, 1), a1 + hstepA, voffA);
            PG8_WAIT_V(8); PG8_WAIT_L(0); PG8_BAR; PG8_MMA(0, 0, At, B0); PG8_MMA(0, 1, At, B1); PG8_BAR; PG8_SCHED;
            PG8_LDA(At, 0, 1); PG8_STAGE(PG8_SB(0, 0), b2, voffB); PG8_STAGE(PG8_SB(0, 1), b2 + hstepB, voffB); PG8_STAGE(PG8_SA(0, 0), a2, voffA);
            PG8_WAIT_V(8); PG8_WAIT_L(0); PG8_BAR; PG8_MMA(1, 0, At, B0); PG8_MMA(1, 1, At, B1); PG8_BAR; PG8_SCHED;
            PG8_LDB(B0, 1, 0); PG8_LDB(B1, 1, 1); PG8_SCHED; PG8_LDA(At, 1, 0); PG8_STAGE(PG8_SA(0, 1), a2 + hstepA, voffA);
            PG8_WAIT_V(8); PG8_WAIT_L(0); PG8_BAR; PG8_MMA(0, 0, At, B0); PG8_MMA(0, 1, At, B1); PG8_BAR; PG8_SCHED;
            PG8_LDA(At, 1, 1); PG8_STAGE(PG8_SB(1, 0), b3, voffB); PG8_STAGE(PG8_SB(1, 1), b3 + hstepB, voffB); PG8_STAGE(PG8_SA(1, 0), a3, voffA);
            PG8_WAIT_V(8); PG8_WAIT_L(0); PG8_BAR; PG8_MMA(1, 0, At, B0); PG8_MMA(1, 1, At, B1); PG8_BAR; PG8_SCHED;
            } else {
            PG8_LDB(B0, 0, 0); PG8_SCHED; PG8_LDA(At, 0, 0); PG8_STAGE(PG8_SA(1, 1), a1 + hstepA, voffA);
            PG8_WAIT_L(8); PG8_BAR; PG8_WAIT_L(0); PG8_MMA(0, 0, At, B0); PG8_BAR; PG8_SCHED;
            PG8_LDB(B1, 0, 1); PG8_STAGE(PG8_SB(0, 0), b2, voffB);
            PG8_BAR; PG8_WAIT_L(0); PG8_MMA(0, 1, At, B1); PG8_BAR;
            PG8_LDA(At, 0, 1); PG8_STAGE(PG8_SA(0, 0), a2, voffA);
            PG8_BAR; PG8_WAIT_L(0); PG8_MMA(1, 0, At, B0); PG8_BAR; PG8_SCHED;
            PG8_STAGE(PG8_SB(0, 1), b2 + hstepB, voffB);
            PG8_WAIT_V(6); PG8_BAR; PG8_MMA(1, 1, At, B1); PG8_BAR;
            PG8_LDB(B0, 1, 0); PG8_SCHED; PG8_LDA(At, 1, 0); PG8_STAGE(PG8_SA(0, 1), a2 + hstepA, voffA);
            PG8_WAIT_L(8); PG8_BAR; PG8_WAIT_L(0); PG8_MMA(0, 0, At, B0); PG8_BAR; PG8_SCHED;
            PG8_LDB(B1, 1, 1); PG8_STAGE(PG8_SB(1, 0), b3, voffB);
            PG8_BAR; PG8_WAIT_L(0); PG8_MMA(0, 1, At, B1); PG8_BAR;
            PG8_LDA(At, 1, 1); PG8_STAGE(PG8_SA(1, 0), a3, voffA);
            PG8_BAR; PG8_WAIT_L(0); PG8_MMA(1, 0, At, B0); PG8_BAR; PG8_SCHED;
            PG8_STAGE(PG8_SB(1, 1), b3 + hstepB, voffB);
            PG8_WAIT_V(6); PG8_BAR; PG8_MMA(1, 1, At, B1); PG8_BAR;
            }
        }
        if constexpr (ALIGN_EPI) { if (wr == 0) PG8_BAR; }
        if constexpr (!Epi::AFTER_DRAIN) { E(acc, cur, wr, wc, fr, fq); S.done(cur); }
        if (!has_next) break;
#pragma unroll
        for (int a = 0; a < 2; ++a)
#pragma unroll
            for (int b = 0; b < 2; ++b)
#pragma unroll
                for (int m = 0; m < 4; ++m)
#pragma unroll
                    for (int n = 0; n < 2; ++n) acc[a][b][m][n] = (f32x4){0.f, 0.f, 0.f, 0.f};
        cur = nxt; cA = nA; cB = nB; ++ui;
        if constexpr (ALIGN_EPI) { if (wr == 1) PG8_BAR; }
    }
    PG8_WAIT_V(0);
    if constexpr (!ALIGN_EPI) { if (wr == 0) PG8_BAR; }
    PG8_BAR;
    if constexpr (Epi::AFTER_DRAIN) { E.fused(acc, cur, wr, wc, fr, fq, lds, wid, lane); S.done(cur); }
#undef PG8_SA
#undef PG8_SB
#undef PG8_STAGE
#undef PG8_LDA
#undef PG8_LDB
#undef PG8_MMA
#undef PG8_WAIT_V
#undef PG8_WAIT_L
#undef PG8_BAR
#undef PG8_SCHED
}
}

#ifndef MK_STAGE
#define MK_STAGE 4
#endif
constexpr int NWAVES = 8;
constexpr int M = 16384, D = 1024, SEQ = 8192, DP = 512, NG = 32, NST = 64, GC = 16, CL = 16  ;
constexpr int NCH = M / CL;
constexpr int NEXP = 32, DF = 256, DPLE = 256;
constexpr int VP_ROWS = 2 * M + NEXP * 256;
constexpr float RMS_EPS = 1e-6f;

constexpr size_t MiB = 1u << 20;
constexpr size_t WS_CTL = 0, CTL_ZERO_BYTES = 1 * MiB;
constexpr size_t WS_WR = 1 * MiB;
constexpr size_t WS_LAMT = 1 * MiB + 256 * 1024;
constexpr size_t WS_ROUTE = 1 * MiB + 512 * 1024;
constexpr size_t WS_WIN = 2 * MiB, WS_GLU = 4 * MiB, WS_WCAT = 5 * MiB, WS_WG = 7 * MiB, WS_WPLE = 9 * MiB;
constexpr size_t WS_ROWINFO = 9 * MiB + 512 * 1024, WS_ROWW = 9 * MiB + 768 * 1024;
constexpr size_t WS_WGU = 10 * MiB, WS_WD = 42 * MiB;
constexpr size_t WS_MS = 58 * MiB, WS_WS3 = 62 * MiB;
constexpr size_t WS_ZZ = 70 * MiB;
constexpr size_t WS_PE = 58 * MiB;
constexpr size_t WS_XN = 90 * MiB;
constexpr size_t WS_ZP = 122 * MiB, WS_AS = 138 * MiB, WS_SLOC = 170 * MiB, WS_CAT = 202 * MiB, WS_PB = 234 * MiB;
constexpr size_t WS_VP = 122 * MiB, WS_ACT = 202 * MiB, WS_MO0 = 122 * MiB, WS_MO1 = 154 * MiB;
constexpr size_t WS_WOS = 242 * MiB, WS_BD = 243 * MiB;
constexpr size_t WS_END = 256 * MiB;
static_assert(WS_VP + (size_t)VP_ROWS * 2048 <= WS_ACT && WS_ACT + (size_t)VP_ROWS * 512 <= WS_PB && WS_PB + (size_t)M * 512 <= WS_END, "ws map");
constexpr int CW_CNT = 8192;
constexpr int CW_FILL = 10240;
constexpr int CW_BAR = 4096;
constexpr int RING_OFF = 0, RING_BYTES = 131072, P0_SCR = 64 * 65 * 4  , LDSCTL_OFF = 139264, MISC_OFF = LDSCTL_OFF + 320, LDS_BYTES = 147456;
static_assert(NWAVES * P0_SCR <= LDSCTL_OFF && MISC_OFF + 4 * 64 <= LDS_BYTES, "LDS map");

#define GAS __attribute__((address_space(1)))
#define LAS __attribute__((address_space(3)))
typedef unsigned short bf16;
typedef unsigned v4u __attribute__((ext_vector_type(4)));
typedef unsigned v2u __attribute__((ext_vector_type(2)));
typedef float f32x4 __attribute__((ext_vector_type(4)));
typedef GAS unsigned gu32;
#define RLX_AGENT __ATOMIC_RELAXED, __HIP_MEMORY_SCOPE_AGENT
#define LDS_WAIT() asm volatile("s_waitcnt lgkmcnt(0)" ::: "memory")
#define VM_WAIT() asm volatile("s_waitcnt vmcnt(0)" ::: "memory")
__device__ __forceinline__ unsigned f2bf(float f) { unsigned u = __builtin_bit_cast(unsigned, f); return (u + 0x7fffu + ((u >> 16) & 1u)) >> 16; }
__device__ __forceinline__ unsigned pk2(float lo, float hi) { return f2bf(lo) | (f2bf(hi) << 16); }
__device__ __forceinline__ float bflo(unsigned w) { return __builtin_bit_cast(float, w << 16); }
__device__ __forceinline__ float bfhi(unsigned w) { return __builtin_bit_cast(float, w & 0xffff0000u); }
__device__ __forceinline__ float sigmoidf_(float x) { return 1.0f / (1.0f + __expf(-x)); }
__device__ __forceinline__ float gelu_tanh(float y) { const float t = 1.5957691216f * (y + 0.044715f * y * y * y); return y / (1.0f + __expf(-t)); }

#define XB_TMO      128
#define XB_XCNT(j)  (256  + 64 * (j))
#define XB_XSUB(j)  (1280 + 64 * (j))
#define XB_XGEN(j)  (2304 + 64 * (j))
#define XB_TOP      3328
#define XB_TOPGEN   3392
#define XCD_BAR_WORDS 3456
#define XB_SPIN_CAP (1u << 18)
__device__ __forceinline__ unsigned xb_ld(unsigned* p)              { return __hip_atomic_load(p, __ATOMIC_RELAXED, __HIP_MEMORY_SCOPE_AGENT); }
__device__ __forceinline__ unsigned xb_add(unsigned* p, unsigned v) { return __hip_atomic_fetch_add(p, v, __ATOMIC_RELAXED, __HIP_MEMORY_SCOPE_AGENT); }
__device__ __forceinline__ unsigned xb_xcc_id() { return (unsigned)__builtin_amdgcn_s_getreg((3 << 11) | 20) & 0xFu; }
#define XB_SPIN(cond, bar) do { unsigned _sp = 0; while (cond) { __builtin_amdgcn_s_sleep(1); \
    if ((++_sp & 255u) == 0u) { if (xb_ld(&(bar)[XB_TMO])) break; if (_sp > XB_SPIN_CAP) { atomicAdd(&(bar)[XB_TMO], 1u); break; } } } } while (0)
struct XcdBarrier { unsigned* bar; unsigned x; volatile LAS unsigned* st; int wave; };
__device__ __forceinline__ XcdBarrier xcd_barrier_post(unsigned* bar, volatile LAS unsigned* st) {
    XcdBarrier b; b.bar = bar; b.x = xb_xcc_id(); b.st = st; b.wave = 0;
    if (threadIdx.x == 0) (void)xb_add(&bar[XB_XCNT(b.x)], 1u);
    return b;
}
__device__ __forceinline__ void xcd_barrier_complete(unsigned* bar, unsigned x, unsigned& nloc, unsigned& nx) {
    const unsigned G = gridDim.x * gridDim.y * gridDim.z;
    unsigned sum, cnt, mine, sp = 0u;
    for (;;) {
        sum = 0u; cnt = 0u; mine = 0u;
#pragma unroll
        for (unsigned j = 0; j < 16; ++j) { const unsigned c = xb_ld(&bar[XB_XCNT(j)]); sum += c; cnt += (c > 0u) ? 1u : 0u; mine = (j == x) ? c : mine; }
        if (sum == G) break;
        __builtin_amdgcn_s_sleep(1);
        if ((++sp & 255u) == 0u) { if (xb_ld(&bar[XB_TMO])) break; if (sp > XB_SPIN_CAP) { atomicAdd(&bar[XB_TMO], 1u); break; } }
    }
    nloc = mine > 0u ? mine : 1u; nx = cnt > 0u ? cnt : 1u;
}
__device__ __forceinline__ void xcd_barrier(const XcdBarrier& b) {
    asm volatile("s_waitcnt vmcnt(0)" ::: "memory");
    __syncthreads();
    if (b.wave == 0 && hw_lane() == 0) {
        unsigned* bar = b.bar;
        __builtin_amdgcn_s_waitcnt(0);
        unsigned nloc = b.st[0], nx = b.st[1];
        if (nloc == 0u) { xcd_barrier_complete(bar, b.x, nloc, nx); b.st[0] = nloc; b.st[1] = nx; }
        const unsigned old = xb_add(&bar[XB_XSUB(b.x)], 1u);
        const unsigned gen = old / nloc;
        if (old + 1u == (gen + 1u) * nloc) {
            __builtin_amdgcn_fence(__ATOMIC_RELEASE, "agent");
            asm volatile("s_waitcnt vmcnt(0)" ::: "memory");
            const unsigned og = xb_add(&bar[XB_TOP], 1u);
            const unsigned tg = og / nx;
            if (og + 1u == (tg + 1u) * nx) xb_add(&bar[XB_TOPGEN], 1u);
            else XB_SPIN(xb_ld(&bar[XB_TOPGEN]) == tg, bar);
            __builtin_amdgcn_fence(__ATOMIC_ACQUIRE, "agent");
            xb_add(&bar[XB_XGEN(b.x)], 1u);
            asm volatile("s_waitcnt vmcnt(0)" ::: "memory");
        } else {
            XB_SPIN(xb_ld(&bar[XB_XGEN(b.x)]) == gen, bar);
            __builtin_amdgcn_fence(__ATOMIC_ACQUIRE, "agent");
            asm volatile("s_waitcnt vmcnt(0)" ::: "memory");
        }
    }
    __syncthreads();
}

struct Args { const float* in[30]; float* out; unsigned char* ws; };
struct Frame {
    LAS unsigned char* lds;
    volatile LAS unsigned* MISC;
    gu32* ctl;
    int wave, G, gw, ngw;
    float* out;
    unsigned char* ws;
};
__device__ __forceinline__ int opq(int v) { asm volatile("" : "+v"(v)); return v; }
template <int CTRL> __device__ __forceinline__ float dpp_f(float v) { return __builtin_bit_cast(float, __builtin_amdgcn_update_dpp(0, __builtin_bit_cast(int, v), CTRL, 0xf, 0xf, true)); }
__device__ __forceinline__ float wave_sum(float v) {
    v += dpp_f<0xB1>(v);
    v += dpp_f<0x4E>(v);
    v += dpp_f<0x141>(v);
    v += dpp_f<0x140>(v);
    const float r0 = __builtin_bit_cast(float, __builtin_amdgcn_readlane(__builtin_bit_cast(int, v), 0)), r1 = __builtin_bit_cast(float, __builtin_amdgcn_readlane(__builtin_bit_cast(int, v), 16));
    const float r2 = __builtin_bit_cast(float, __builtin_amdgcn_readlane(__builtin_bit_cast(int, v), 32)), r3 = __builtin_bit_cast(float, __builtin_amdgcn_readlane(__builtin_bit_cast(int, v), 48));
    return (r0 + r1) + (r2 + r3);
}

__device__ __forceinline__ void transpose_item64(const float* src, int ld_src, bf16* dst, int ld_dst, LAS float* scr, int lane, const float* kscale = nullptr) {
    f32x4 v[16];
    const int kq = lane >> 4, n4 = (lane & 15) * 4;
#pragma unroll
    for (int i = 0; i < 16; ++i) v[i] = *(const GAS f32x4*)(src + (size_t)(4 * i + kq) * ld_src + n4);
    if (kscale) {
#pragma unroll
        for (int i = 0; i < 16; ++i) v[i] = v[i] * kscale[4 * i + kq]; }
#pragma unroll
    for (int i = 0; i < 16; ++i) { LAS float* p = scr + (4 * i + kq) * 65 + n4; p[0] = v[i].x; p[1] = v[i].y; p[2] = v[i].z; p[3] = v[i].w; }
    LDS_WAIT(); asm volatile("" ::: "memory");
    const int c = lane & 7;
#pragma unroll
    for (int j = 0; j < 8; ++j) { const int n = (lane >> 3) + 8 * j; const LAS float* q = scr + (8 * c) * 65 + n;
        v4u o; o.x = pk2(q[0 * 65], q[1 * 65]); o.y = pk2(q[2 * 65], q[3 * 65]); o.z = pk2(q[4 * 65], q[5 * 65]); o.w = pk2(q[6 * 65], q[7 * 65]);
        *(GAS v4u*)(dst + (size_t)n * ld_dst + 8 * c) = o; }
    LDS_WAIT(); asm volatile("" ::: "memory");
}
__device__ __forceinline__ void rms_row_to_bf16(const float* xrow, const float* g, bf16* orow, int lane) {
    const GAS f32x4* xr = (const GAS f32x4*)xrow + lane; const GAS f32x4* gr = (const GAS f32x4*)g + lane;
    f32x4 v[4]; float s = 0.f;
#pragma unroll
    for (int j = 0; j < 4; ++j) { v[j] = xr[64 * j]; s += (v[j].x * v[j].x + v[j].y * v[j].y) + (v[j].z * v[j].z + v[j].w * v[j].w); }
    const float rstd = 1.f / sqrtf(wave_sum(s) * (1.f / D) + RMS_EPS);
    GAS unsigned long long* o8 = (GAS unsigned long long*)orow + lane;
#pragma unroll
    for (int j = 0; j < 4; ++j) { const f32x4 gg = gr[64 * j];
        o8[64 * j] = (unsigned long long)pk2(v[j].x * rstd * gg.x, v[j].y * rstd * gg.y) | ((unsigned long long)pk2(v[j].z * rstd * gg.z, v[j].w * rstd * gg.w) << 32); }
}
__device__ __forceinline__ void sincos_d(double x, double& sn, double& cs) {
    const double k = __builtin_rint(x * 0.63661977236758134308);
    const double r = (x - k * 1.57079632679489655800e+00) - k * 6.12323399573676603587e-17;
    const double r2 = r * r;
    const double s = r * (1.0 + r2 * (-1.0 / 6.0 + r2 * (1.0 / 120.0 + r2 * (-1.0 / 5040.0 + r2 * (1.0 / 362880.0 + r2 * (-1.0 / 39916800.0 + r2 * (1.0 / 6227020800.0)))))));
    const double c = 1.0 + r2 * (-0.5 + r2 * (1.0 / 24.0 + r2 * (-1.0 / 720.0 + r2 * (1.0 / 40320.0 + r2 * (-1.0 / 3628800.0 + r2 * (1.0 / 479001600.0 + r2 * (-1.0 / 87178291200.0)))))));
    const int q = ((int)k) & 3;
    sn = (q == 0) ? s : (q == 1) ? c : (q == 2) ? -s : -c;
    cs = (q == 0) ? c : (q == 1) ? -s : (q == 2) ? -c : s;
}
__device__ __forceinline__ void ssm_gen(Frame& F, const Args& A, int g, int sl) {
    LAS float* lamP = (LAS float*)(F.lds + RING_OFF);
    LAS float* Bb = lamP + 2 * 17 * 64 * 2;
    LAS float* Cc = Bb + 2 * 64 * 16 * 2;
    LAS float* KT = Cc + 2 * 16 * 64 * 2;
    LAS float* dv = KT + 32 * 260;
    LAS float* bfac = dv + 16;
    const float* a_re = A.in[6]; const float* a_im = A.in[7]; const float* log_dt = A.in[8];
    const float* b_re = A.in[9]; const float* b_im = A.in[10]; const float* c_re = A.in[11]; const float* c_im = A.in[12]; const float* ssm_d = A.in[13];
    const int t = opq(F.wave * 64 + hw_lane());
    __syncthreads();
    if (t < 128) {
        const int d = t >> 6, n = t & 63;
        const double are = (double)a_re[(d * NG + g) * NST + n], aim = (double)a_im[(d * NG + g) * NST + n], dt = exp((double)log_dt[d * NG + g]);
        const double mag = exp(are * dt); double sn, cs; sincos_d(aim * dt, sn, cs);
        const double lr = mag * cs, li = mag * sn;
        const double nr = lr - 1.0, ni = li, den = are * are + aim * aim;
        bfac[(d * 64 + n) * 2] = (float)((nr * are + ni * aim) / den); bfac[(d * 64 + n) * 2 + 1] = (float)((ni * are - nr * aim) / den);
        double pr = 1.0, pi = 0.0;
        for (int k = 0; k <= 16; ++k) { lamP[((d * 17 + k) * 64 + n) * 2] = (float)pr; lamP[((d * 17 + k) * 64 + n) * 2 + 1] = (float)pi;
            if (k < 16) { const double tr = pr * lr - pi * li, ti = pr * li + pi * lr; pr = tr; pi = ti; } }
        if (sl == 0) {
            float* lt = (float*)(F.ws + WS_LAMT) + ((g * 2 + d) * 64 + n) * 4;
            lt[0] = (float)pr; lt[1] = (float)pi;
            for (int k = 0; k < 6; ++k) { const double tr = pr * pr - pi * pi, ti = 2.0 * pr * pi; pr = tr; pi = ti; }
            lt[2] = (float)pr; lt[3] = (float)pi; }
    }
    if (t < 16) dv[t] = ssm_d[g * GC + t];
    __syncthreads();
    for (int idx = t; idx < 2048; idx += NWAVES * 64) {
        { const int d = idx >> 10, n = (idx >> 4) & 63; const size_t si = (size_t)(d * NG + g) * NST * GC + (idx & 1023);
          const float br = b_re[si], bi = b_im[si], fr = bfac[(d * 64 + n) * 2], fi = bfac[(d * 64 + n) * 2 + 1];
          Bb[idx * 2] = fr * br - fi * bi; Bb[idx * 2 + 1] = fr * bi + fi * br; }
        { const int d = idx >> 10; const size_t si = (size_t)(d * NG + g) * GC * NST + (idx & 1023);
          Cc[idx * 2] = c_re[si]; Cc[idx * 2 + 1] = c_im[si]; }
    }
    __syncthreads();
    {
        const int d = t >> 8, co = (t >> 4) & 15, ci = t & 15;
        float acc[16];
#pragma unroll
        for (int k = 0; k < 16; ++k) acc[k] = 0.f;
        for (int n = 0; n < 64; ++n) {
            const float cr = Cc[((d * 16 + co) * 64 + n) * 2], cim = Cc[((d * 16 + co) * 64 + n) * 2 + 1];
            const float br = Bb[((d * 64 + n) * 16 + ci) * 2], bi = Bb[((d * 64 + n) * 16 + ci) * 2 + 1];
            const float lr = lamP[((d * 17 + 1) * 64 + n) * 2], li = lamP[((d * 17 + 1) * 64 + n) * 2 + 1];
            float qr = cr * br - cim * bi, qi = cr * bi + cim * br;
#pragma unroll
            for (int k = 0; k < 16; ++k) { acc[k] += qr; const float tr = qr * lr - qi * li; qi = qr * li + qi * lr; qr = tr; }
        }
#pragma unroll
        for (int k = 0; k < 16; ++k) KT[(d * 16 + k) * 260 + co * 16 + ci] = acc[k];
    }
    __syncthreads();
    bf16* WS3 = (bf16*)(F.ws + WS_WS3) + ((size_t)g * 256 + sl * 32) * 512;
    {
        const int rowl = t >> 4, sq = t & 15, row = sl * 32 + rowl, j = row >> 4, co = row & 15;
        float v[16];
        if (j != sq) { const LAS float* src = KT + ((j > sq) ? (j - sq) : (16 + sq - j)) * 260 + co * 16;
#pragma unroll
            for (int i = 0; i < 16; ++i) v[i] = src[i]; }
        else {
#pragma unroll
            for (int i = 0; i < 16; ++i) v[i] = KT[co * 16 + i] + KT[16 * 260 + co * 16 + i] + (co == i ? dv[co] : 0.f); }
        v4u o0, o1; o0.x = pk2(v[0], v[1]); o0.y = pk2(v[2], v[3]); o0.z = pk2(v[4], v[5]); o0.w = pk2(v[6], v[7]); o1.x = pk2(v[8], v[9]); o1.y = pk2(v[10], v[11]); o1.z = pk2(v[12], v[13]); o1.w = pk2(v[14], v[15]);
        GAS v4u* dst = (GAS v4u*)(WS3 + (size_t)rowl * 512 + sq * 16); dst[0] = o0; dst[1] = o1;
    }
#pragma unroll
    for (int i2 = 0; i2 < 2; ++i2) {
        const int idx = t + 512 * i2, rowl = idx >> 5, q = (idx >> 3) & 3, n0 = (idx & 7) * 8, row = sl * 32 + rowl, j = row >> 4, co = row & 15, d = q >> 1, e = (d == 0) ? (j + 1) : (16 - j);
        float v[8];
#pragma unroll
        for (int i = 0; i < 8; ++i) { const int n = n0 + i;
            const float cr = Cc[((d * 16 + co) * 64 + n) * 2], cim = Cc[((d * 16 + co) * 64 + n) * 2 + 1];
            const float pr = lamP[((d * 17 + e) * 64 + n) * 2], pi = lamP[((d * 17 + e) * 64 + n) * 2 + 1];
            v[i] = (q & 1) ? -(cr * pi + cim * pr) : (cr * pr - cim * pi); }
        v4u o; o.x = pk2(v[0], v[1]); o.y = pk2(v[2], v[3]); o.z = pk2(v[4], v[5]); o.w = pk2(v[6], v[7]);
        *(GAS v4u*)(WS3 + (size_t)rowl * 512 + 256 + q * 64 + n0) = o;
    }
    bf16* MS = (bf16*)(F.ws + WS_MS) + ((size_t)g * 256 + sl * 32) * 256;
#pragma unroll
    for (int i2 = 0; i2 < 2; ++i2) {
        const int idx = t + 512 * i2, rowl = idx >> 5, kc = (idx & 31) * 8, row = sl * 32 + rowl, q = row >> 6, n = row & 63, d = q >> 1, j = kc >> 4, ci0 = kc & 15, e = (d == 0) ? (15 - j) : j;
        const float pr = lamP[((d * 17 + e) * 64 + n) * 2], pi = lamP[((d * 17 + e) * 64 + n) * 2 + 1];
        float v[8];
#pragma unroll
        for (int i = 0; i < 8; ++i) { const float br = Bb[((d * 64 + n) * 16 + ci0 + i) * 2], bi = Bb[((d * 64 + n) * 16 + ci0 + i) * 2 + 1];
            v[i] = (q & 1) ? (pr * bi + pi * br) : (pr * br - pi * bi); }
        v4u o; o.x = pk2(v[0], v[1]); o.y = pk2(v[2], v[3]); o.z = pk2(v[4], v[5]); o.w = pk2(v[6], v[7]);
        *(GAS v4u*)(MS + (size_t)rowl * 256 + kc) = o;
    }
    __syncthreads();
}
constexpr int BG_GU = NEXP * 16 * 4, BG_DN = NEXP * 4 * 16, BG_WOB = 8 * 16, BG_WG = 16 * 16, BG_WPLE = 4 * 16;
constexpr int BG_TOTAL = 2 * BG_GU + BG_DN + BG_WOB + BG_WG + BG_WPLE;
__device__ __forceinline__ void bg_item(Frame& F, const Args& A, int r, LAS float* scr, int lane) {
    if (r < 2 * BG_GU) {
        const int up = r >= BG_GU; if (up) r -= BG_GU;
        const int e = r >> 6, kb = (r >> 2) & 15, nb = r & 3, k0 = kb * 64, n0 = nb * 64;
        const float* src = A.in[up ? 23 : 22] + ((size_t)e * D + k0) * DF + n0;
        bf16* dst = (bf16*)(F.ws + WS_WGU) + ((size_t)e * 512 + (n0 >> 7) * 256 + (up ? 128 : 0) + (n0 & 127)) * D + k0;
        transpose_item64(src, DF, dst, D, scr, lane); return; }
    r -= 2 * BG_GU;
    if (r < BG_DN) {
        const int e = r >> 6, kb = (r >> 4) & 3, nb = r & 15, k0 = kb * 64, n0 = nb * 64;
        transpose_item64(A.in[24] + ((size_t)e * DF + k0) * D + n0, D, (bf16*)(F.ws + WS_WD) + ((size_t)e * D + n0) * DF + k0, DF, scr, lane); return; }
    r -= BG_DN;
    if (r < BG_WOB) { const int kb = r >> 4, nb = r & 15;
        transpose_item64(A.in[16] + (size_t)(DP + kb * 64) * D + nb * 64, D, (bf16*)(F.ws + WS_WCAT) + (size_t)nb * 64 * D + DP + kb * 64, D, scr, lane); return; }
    r -= BG_WOB;
    if (r < BG_WG) { const int kb = r >> 4, nb = r & 15; transpose_item64(A.in[26] + (size_t)kb * 64 * D + nb * 64, D, (bf16*)(F.ws + WS_WG) + (size_t)nb * 64 * D + kb * 64, D, scr, lane); return; }
    r -= BG_WG;
    { const int kb = r >> 4, nb = r & 15; transpose_item64(A.in[28] + (size_t)kb * 64 * D + nb * 64, D, (bf16*)(F.ws + WS_WPLE) + (size_t)nb * 64 * DPLE + kb * 64, DPLE, scr, lane); }
}
__device__ __forceinline__ void bg_range(Frame& F, const Args& A, int lo, int hi) {
    int widx, nw;
    if (F.G >= 256) { if ((int)blockIdx.x < 128) return; widx = ((int)blockIdx.x - 128) * NWAVES + F.wave; nw = (F.G - 128) * NWAVES; } else { widx = F.gw; nw = F.ngw; }
    LAS float* scr = (LAS float*)(F.lds + RING_OFF + F.wave * P0_SCR);
    for (int it = lo + widx; it < hi; it += nw) bg_item(F, A, it, scr, opq(hw_lane()));
}
template <int R> __device__ __forceinline__ void xn_rows(Frame& F, const Args& A, int m0, int stride, int lane) {
    const GAS f32x4* gr = (const GAS f32x4*)A.in[2] + lane;
    f32x4 v[R][4], pv[R];
#pragma unroll
    for (int r = 0; r < R; ++r) { const size_t m = (size_t)(m0 + r * stride);
#pragma unroll
        for (int j = 0; j < 4; ++j) v[r][j] = *((const GAS f32x4*)(A.in[0] + m * D) + lane + 64 * j);
        pv[r] = *((const GAS f32x4*)(A.in[1] + m * DPLE) + lane); }
#pragma unroll
    for (int r = 0; r < R; ++r) { const size_t m = (size_t)(m0 + r * stride); float s = 0.f;
#pragma unroll
        for (int j = 0; j < 4; ++j) s += (v[r][j].x * v[r][j].x + v[r][j].y * v[r][j].y) + (v[r][j].z * v[r][j].z + v[r][j].w * v[r][j].w);
        const float rstd = 1.f / sqrtf(wave_sum(s) * (1.f / D) + RMS_EPS);
        GAS unsigned long long* o8 = (GAS unsigned long long*)((bf16*)(F.ws + WS_XN) + m * D) + lane;
#pragma unroll
        for (int j = 0; j < 4; ++j) { const f32x4 gg = gr[64 * j], x = v[r][j];
            o8[64 * j] = (unsigned long long)pk2(x.x * rstd * gg.x, x.y * rstd * gg.y) | ((unsigned long long)pk2(x.z * rstd * gg.z, x.w * rstd * gg.w) << 32); }
        v2u o; o.x = pk2(pv[r].x, pv[r].y); o.y = pk2(pv[r].z, pv[r].w);
        *((GAS v2u*)((bf16*)(F.ws + WS_PB) + m * DPLE) + lane) = o; }
}
__device__ __forceinline__ void p0_prologue(Frame& F, const Args& A) {
    for (int u = blockIdx.x; u < NG * 8; u += F.G) ssm_gen(F, A, u >> 3, u & 7);
    __syncthreads();
    const int widx = F.gw, nw = F.ngw;
    LAS float* scr = (LAS float*)(F.lds + RING_OFF + F.wave * P0_SCR);
    constexpr int I_WIN = 16 * 16, I_GLU = 8 * 8, I_WOS = 8 * 16, I_BD = 256, I_WR = 36, I_RI = VP_ROWS / 256, I_ROWS = M / 4;
    constexpr int NITEMS = I_WIN + I_GLU + I_WOS + I_BD + I_WR + I_RI + I_ROWS;
    for (int it = widx; it < NITEMS; it += nw) {
        int r = it; const int lane = opq(hw_lane());
        if (r < I_WIN) { const int kb = r >> 4, nb = r & 15; transpose_item64(A.in[3] + (size_t)kb * 64 * D + nb * 64, D, (bf16*)(F.ws + WS_WIN) + (size_t)nb * 64 * D + kb * 64, D, scr, lane); continue; }
        r -= I_WIN;
        if (r < I_GLU) { const int kb = r >> 3, nb = r & 7; transpose_item64(A.in[14] + (size_t)kb * 64 * DP + nb * 64, DP, (bf16*)(F.ws + WS_GLU) + (size_t)nb * 64 * DP + kb * 64, DP, scr, lane); continue; }
        r -= I_GLU;
        if (r < I_WOS) {
            const int kb = r >> 4, nb = r & 15, k0 = kb * 64;
            transpose_item64(A.in[16] + (size_t)k0 * D + nb * 64, D, (bf16*)(F.ws + WS_WOS) + ((size_t)(k0 >> 8) * D + nb * 64) * 256 + (k0 & 255), 256, scr, lane, A.in[5] + k0); continue; }
        r -= I_WOS;
        if (r < I_BD) {
            const int row = r * 2 + (lane >> 5), c0 = (lane & 31) * 8, gi = row >> 7;
            v4u o = (v4u){0u, 0u, 0u, 0u};
            if ((c0 >> 7) == (gi & 1)) { const f32x4 a = *(const GAS f32x4*)(A.in[4] + (size_t)row * 128 + (c0 & 127)), b = *(const GAS f32x4*)(A.in[4] + (size_t)row * 128 + (c0 & 127) + 4);
                o.x = pk2(a.x, a.y); o.y = pk2(a.z, a.w); o.z = pk2(b.x, b.y); o.w = pk2(b.z, b.w); }
            *(GAS v4u*)((bf16*)(F.ws + WS_BD) + (size_t)row * 256 + c0) = o; continue; }
        r -= I_BD;
        if (r < I_WR) {
            float* dst = (float*)(F.ws + WS_WR) + (size_t)r * D;
            if (r < 4) { for (int dd = lane; dd < D; dd += 64) dst[dd] = A.in[18][dd * 4 + r]; }
            else { const int gq = (r - 4) >> 3, e = (r - 4) & 7; for (int dd = lane; dd < D; dd += 64) dst[dd] = A.in[20][((size_t)gq * D + dd) * 8 + e]; }
            continue; }
        r -= I_WR;
        if (r < I_RI) { int* ri = (int*)(F.ws + WS_ROWINFO) + r * 256;
#pragma unroll
            for (int i = 0; i < 4; ++i) ri[lane + 64 * i] = -1;
            continue; }
        r -= I_RI;
        xn_rows<4>(F, A, r, I_ROWS, lane);
    }
}

using pg8::Unit; using pg8::bf16_t; typedef unsigned u32x4 __attribute__((ext_vector_type(4)));
__device__ __forceinline__ u32x4 pack8(const f32x4& a, const f32x4& b) { u32x4 w; w.x = pk2(a[0], a[1]); w.y = pk2(a[2], a[3]); w.z = pk2(b[0], b[1]); w.w = pk2(b[2], b[3]); return w; }
struct EpiZ { static constexpr bool PERM = true, AFTER_DRAIN = false; bf16_t* ZP; bf16_t* AS;
    __device__ __forceinline__ void operator()(const f32x4 (&acc)[2][2][4][2], const Unit& u, int wr, int wc, int fr, int fq) const {
        const int row0 = u.pm * 256 + wr * 64 + fr;
#pragma unroll
        for (int ai = 0; ai < 2; ++ai)
#pragma unroll
            for (int m = 0; m < 4; ++m) { const int r = row0 + ai * 128 + m * 16;
#pragma unroll
                for (int bj = 0; bj < 2; ++bj) { const int col = u.pn * 256 + bj * 128 + wc * 32 + 8 * fq; const u32x4 w = pack8(acc[ai][bj][m][0], acc[ai][bj][m][1]);
                    if (u.pn < 2) *(u32x4*)(ZP + (size_t)r * DP + col) = w;
                    else { const int sc = col - DP, g = sc >> 4, ch0 = sc & 15; *(u32x4*)(AS + ((size_t)(g * NCH + (r >> 4)) * 512 + (r & 15) * 16 + ch0)) = w; } } }
    } };
struct EpiSloc { static constexpr bool PERM = false, AFTER_DRAIN = false; float* C;
    __device__ __forceinline__ void operator()(const f32x4 (&acc)[2][2][4][2], const Unit& u, int wr, int wc, int fr, int fq) const {
        const int row0 = u.pm * 256 + wr * 64 + fr, col0 = wc * 32 + 4 * fq;
#pragma unroll
        for (int ai = 0; ai < 2; ++ai)
#pragma unroll
            for (int m = 0; m < 4; ++m) { float* rowp = C + (size_t)(row0 + ai * 128 + m * 16) * 256 + col0;
#pragma unroll
                for (int bj = 0; bj < 2; ++bj)
#pragma unroll
                    for (int n = 0; n < 2; ++n) *(f32x4*)(rowp + bj * 128 + n * 16) = acc[ai][bj][m][n]; }
    } };
struct EpiY { static constexpr bool PERM = true, AFTER_DRAIN = false; bf16_t* ZZ;
    __device__ __forceinline__ void operator()(const f32x4 (&acc)[2][2][4][2], const Unit& u, int wr, int wc, int fr, int fq) const {
        const int g = u.pn, row0 = (u.pm & 3) * 256 + wr * 64 + fr;
#pragma unroll
        for (int ai = 0; ai < 2; ++ai)
#pragma unroll
            for (int m = 0; m < 4; ++m) { const int c = row0 + ai * 128 + m * 16;
#pragma unroll
                for (int bj = 0; bj < 2; ++bj) { const int col = bj * 128 + wc * 32 + 8 * fq, j = col >> 4, co0 = col & 15;
                    f32x4 a = acc[ai][bj][m][0], b = acc[ai][bj][m][1];
#pragma unroll
                    for (int i = 0; i < 4; ++i) { a[i] = gelu_tanh(a[i]); b[i] = gelu_tanh(b[i]); }
                    *(u32x4*)(ZZ + (size_t)(c * CL + j) * DP + g * GC + co0) = pack8(a, b); asm volatile("" ::: "memory"); } }
    } };
struct EpiGlu { static constexpr bool PERM = true, AFTER_DRAIN = false; const bf16_t* ZZ; const float* bias; bf16_t* CAT;
    __device__ __forceinline__ void operator()(const f32x4 (&acc)[2][2][4][2], const Unit& u, int wr, int wc, int fr, int fq) const {
        const int row0 = u.pm * 256 + wr * 64 + fr;
#pragma unroll
        for (int bj = 0; bj < 2; ++bj) { const int col = u.pn * 256 + bj * 128 + wc * 32 + 8 * fq;
            const f32x4 b0 = *(const f32x4*)(bias + col), b1 = *(const f32x4*)(bias + col + 4);
#pragma unroll
            for (int ai = 0; ai < 2; ++ai)
#pragma unroll
                for (int m = 0; m < 4; ++m) { const int r = row0 + ai * 128 + m * 16;
                    const u32x4 z = *(const u32x4*)(ZZ + (size_t)r * DP + col);
                    f32x4 a = acc[ai][bj][m][0] + b0, b = acc[ai][bj][m][1] + b1;
                    a[0] = bflo(z.x) * sigmoidf_(a[0]); a[1] = bfhi(z.x) * sigmoidf_(a[1]); a[2] = bflo(z.y) * sigmoidf_(a[2]); a[3] = bfhi(z.y) * sigmoidf_(a[3]);
                    b[0] = bflo(z.z) * sigmoidf_(b[0]); b[1] = bfhi(z.z) * sigmoidf_(b[1]); b[2] = bflo(z.w) * sigmoidf_(b[2]); b[3] = bfhi(z.w) * sigmoidf_(b[3]);
                    *(u32x4*)(CAT + (size_t)r * D + DP + col) = pack8(a, b); asm volatile("" ::: "memory"); } }
    } };
struct EpiRes { static constexpr bool PERM = false, AFTER_DRAIN = false; const float* X; float* H;
    __device__ __forceinline__ void operator()(const f32x4 (&acc)[2][2][4][2], const Unit& u, int wr, int wc, int fr, int fq) const {
        const int row0 = u.pm * 256 + wr * 64 + fr, col0 = u.pn * 256 + wc * 32 + 4 * fq;
#pragma unroll
        for (int ai = 0; ai < 2; ++ai)
#pragma unroll
            for (int m = 0; m < 4; ++m) { const size_t off = (size_t)(row0 + ai * 128 + m * 16) * D + col0;
#pragma unroll
                for (int bj = 0; bj < 2; ++bj)
#pragma unroll
                    for (int n = 0; n < 2; ++n) *(f32x4*)(H + off + bj * 128 + n * 16) = *(const f32x4*)(X + off + bj * 128 + n * 16) + acc[ai][bj][m][n]; }
    } };
struct EpiAct { static constexpr bool PERM = true, AFTER_DRAIN = false; const float* ROWW; bf16_t* ACT;
    __device__ __forceinline__ void operator()(const f32x4 (&acc)[2][2][4][2], const Unit& u, int wr, int wc, int fr, int fq) const {
        const int row0 = u.pm * 256 + wr * 64 + fr, col = (u.pn & 1) * 128 + wc * 32 + 8 * fq;
#pragma unroll
        for (int ai = 0; ai < 2; ++ai)
#pragma unroll
            for (int m = 0; m < 4; ++m) { const int r = row0 + ai * 128 + m * 16; const float w = ROWW[r];
                f32x4 a, b;
#pragma unroll
                for (int i = 0; i < 4; ++i) { const float g0 = acc[ai][0][m][0][i], g1 = acc[ai][0][m][1][i];
                    a[i] = g0 * sigmoidf_(g0) * acc[ai][1][m][0][i] * w; b[i] = g1 * sigmoidf_(g1) * acc[ai][1][m][1][i] * w; }
                *(u32x4*)(ACT + (size_t)r * DF + col) = pack8(a, b); }
    } };
struct EpiDown { static constexpr bool PERM = true, AFTER_DRAIN = false; const int* ROWINFO; bf16_t* MO0; bf16_t* MO1;
    __device__ __forceinline__ void operator()(const f32x4 (&acc)[2][2][4][2], const Unit& u, int wr, int wc, int fr, int fq) const {
        const int row0 = u.pm * 256 + wr * 64 + fr, col0 = (u.pn & 3) * 256 + wc * 32 + 8 * fq;
#pragma unroll
        for (int ai = 0; ai < 2; ++ai)
#pragma unroll
            for (int m = 0; m < 4; ++m) { const int r = row0 + ai * 128 + m * 16; const int info = ROWINFO[r];
                if (info >= 0) { bf16_t* dst = ((info & 1) ? MO1 : MO0) + (size_t)(info >> 1) * D + col0;
#pragma unroll
                    for (int bj = 0; bj < 2; ++bj) *(u32x4*)(dst + bj * 128) = pack8(acc[ai][bj][m][0], acc[ai][bj][m][1]); } }
    } };
struct EpiPe { static constexpr bool PERM = true, AFTER_DRAIN = false; bf16_t* O;
    __device__ __forceinline__ void operator()(const f32x4 (&acc)[2][2][4][2], const Unit& u, int wr, int wc, int fr, int fq) const {
        const int row0 = u.pm * 256 + wr * 64 + fr, col0 = u.pn * 256 + wc * 32 + 8 * fq;
#pragma unroll
        for (int ai = 0; ai < 2; ++ai)
#pragma unroll
            for (int m = 0; m < 4; ++m) { bf16_t* rowp = O + (size_t)(row0 + ai * 128 + m * 16) * D + col0;
#pragma unroll
                for (int bj = 0; bj < 2; ++bj) *(u32x4*)(rowp + bj * 128) = pack8(acc[ai][bj][m][0], acc[ai][bj][m][1]); }
    } };
struct EpiGate { static constexpr bool PERM = true, AFTER_DRAIN = false; const float* bias; bf16_t* PE;
    __device__ __forceinline__ void operator()(const f32x4 (&acc)[2][2][4][2], const Unit& u, int wr, int wc, int fr, int fq) const {
        const int row0 = u.pm * 256 + wr * 64 + fr, col0 = u.pn * 256 + wc * 32 + 8 * fq;
        u32x4 pe[2][4][2];
#pragma unroll
        for (int ai = 0; ai < 2; ++ai)
#pragma unroll
            for (int m = 0; m < 4; ++m)
#pragma unroll
                for (int bj = 0; bj < 2; ++bj) pe[ai][m][bj] = *(const u32x4*)(PE + (size_t)(row0 + ai * 128 + m * 16) * D + col0 + bj * 128);
#pragma unroll
        for (int bj = 0; bj < 2; ++bj) { const f32x4 b0 = *(const f32x4*)(bias + col0 + bj * 128), b1 = *(const f32x4*)(bias + col0 + bj * 128 + 4);
#pragma unroll
            for (int ai = 0; ai < 2; ++ai)
#pragma unroll
                for (int m = 0; m < 4; ++m) { const u32x4 z = pe[ai][m][bj]; f32x4 a = acc[ai][bj][m][0] + b0, b = acc[ai][bj][m][1] + b1;
                    a[0] = bflo(z.x) * sigmoidf_(a[0]); a[1] = bfhi(z.x) * sigmoidf_(a[1]); a[2] = bflo(z.y) * sigmoidf_(a[2]); a[3] = bfhi(z.y) * sigmoidf_(a[3]);
                    b[0] = bflo(z.z) * sigmoidf_(b[0]); b[1] = bfhi(z.z) * sigmoidf_(b[1]); b[2] = bflo(z.w) * sigmoidf_(b[2]); b[3] = bfhi(z.w) * sigmoidf_(b[3]);
                    *(u32x4*)(PE + (size_t)(row0 + ai * 128 + m * 16) * D + col0 + bj * 128) = pack8(a, b); } }
    } };

struct GroupOrder { int G, c;
    __device__ __forceinline__ bool next(int i, Unit& u) const { const int L = i * G + c; if (L >= NG * 4) return false; u.pm = L; u.pn = L >> 2; return true; }
    __device__ __forceinline__ void a_ready(const Unit&) const {}
    __device__ __forceinline__ void done(const Unit&) const {} };
struct WeffOrder { int G, c;
    __device__ __forceinline__ bool next(int i, Unit& u) const { const int L = (G >= 256) ? ((i == 0) ? c - 128 : -1) : i * G + c; if (L < 0 || L >= 8) return false; u.pm = L; u.pn = L >> 2; return true; }
    __device__ __forceinline__ void a_ready(const Unit&) const {}
    __device__ __forceinline__ void done(const Unit&) const {} };
struct EpiWeff { static constexpr bool PERM = true, AFTER_DRAIN = false; bf16_t* O;
    __device__ __forceinline__ void operator()(const f32x4 (&acc)[2][2][4][2], const Unit& u, int wr, int wc, int fr, int fq) const {
        const int row0 = (u.pm & 3) * 256 + wr * 64 + fr, col0 = u.pn * 256 + wc * 32 + 8 * fq;
#pragma unroll
        for (int ai = 0; ai < 2; ++ai)
#pragma unroll
            for (int m = 0; m < 4; ++m) { bf16_t* rowp = O + (size_t)(row0 + ai * 128 + m * 16) * D + col0;
#pragma unroll
                for (int bj = 0; bj < 2; ++bj) *(u32x4*)(rowp + bj * 128) = pack8(acc[ai][bj][m][0], acc[ai][bj][m][1]); }
    } };
template <int NSUB> struct ExpertOrder { int G, c; const volatile LAS unsigned* tstart;
    __device__ __forceinline__ bool next(int i, Unit& u) const {
        const int L = i * G + c, tau = L / NSUB, sub = L % NSUB; if (tau >= (int)tstart[NEXP]) return false;
        int e = 0;
        for (int k = 1; k < NEXP; ++k) e += ((int)tstart[k] <= tau) ? 1 : 0;
        u.pm = tau; u.pn = e * NSUB + sub; return true; }
    __device__ __forceinline__ void a_ready(const Unit&) const {}
    __device__ __forceinline__ void done(const Unit&) const {} };

__device__ __forceinline__ void carry_unit(Frame& F, int unit) {
    const int d = unit & 1, g = (unit >> 1) & 31, b = unit >> 6, n = opq(hw_lane()), s = F.wave;
    const float* lt = (const float*)(F.ws + WS_LAMT) + ((g * 2 + d) * 64 + n) * 4;
    const float l16r = lt[0], l16i = lt[1], lkr = lt[2], lki = lt[3];
    const float* SL = (const float*)(F.ws + WS_SLOC) + (size_t)(g * NCH + b * 512) * 256 + d * 128 + n;
    bf16* AS = (bf16*)(F.ws + WS_AS) + (size_t)(g * NCH + b * 512) * 512 + 256 + d * 128 + n;
    LAS float* segE = (LAS float*)(F.lds + RING_OFF);
    float er = 0.f, ei = 0.f;
    for (int i0 = 0; i0 < 64; i0 += 16) {
        float sr[16], si[16];
#pragma unroll
        for (int ii = 0; ii < 16; ++ii) { const int i = s * 64 + i0 + ii, c = d ? (511 - i) : i; sr[ii] = SL[(size_t)c * 256]; si[ii] = SL[(size_t)c * 256 + 64]; }
#pragma unroll
        for (int ii = 0; ii < 16; ++ii) { const float tr = l16r * er - l16i * ei + sr[ii], ti = l16r * ei + l16i * er + si[ii]; er = tr; ei = ti; }
    }
    __syncthreads();
    segE[(s * 64 + n) * 2] = er; segE[(s * 64 + n) * 2 + 1] = ei;
    __syncthreads();
    float xr = 0.f, xi = 0.f;
    for (int sp = 0; sp < s; ++sp) { const float pr = segE[(sp * 64 + n) * 2], pi = segE[(sp * 64 + n) * 2 + 1];
        const float tr = lkr * xr - lki * xi + pr, ti = lkr * xi + lki * xr + pi; xr = tr; xi = ti; }
    for (int i0 = 0; i0 < 64; i0 += 16) {
        float sr[16], si[16];
#pragma unroll
        for (int ii = 0; ii < 16; ++ii) { const int i = s * 64 + i0 + ii, c = d ? (511 - i) : i; sr[ii] = SL[(size_t)c * 256]; si[ii] = SL[(size_t)c * 256 + 64]; }
#pragma unroll
        for (int ii = 0; ii < 16; ++ii) { const int i = s * 64 + i0 + ii, c = d ? (511 - i) : i;
            AS[(size_t)c * 512] = (bf16)f2bf(xr); AS[(size_t)c * 512 + 64] = (bf16)f2bf(xi);
            const float tr = l16r * xr - l16i * xi + sr[ii], ti = l16r * xi + l16i * xr + si[ii]; xr = tr; xi = ti; }
    }
    __syncthreads();
}
__device__ __forceinline__ void diff_row(Frame& F, int m) {
    const int t = m & (SEQ - 1), lane = opq(hw_lane()), h = 1 << (lane >> 4), lo = max(t - h, 0), hi = min(t + h, SEQ);
    const bf16* ZP = (const bf16*)(F.ws + WS_ZP) + (size_t)(m - t) * DP + lane * 8;
    float acc[8];
#pragma unroll
    for (int i = 0; i < 8; ++i) acc[i] = 0.f;
    v4u zt = (v4u){0u, 0u, 0u, 0u};
    v4u zz[16];
#pragma unroll
    for (int k = 0; k < 16; ++k) { const int s = t - 8 + k, sc = (s >= lo && s < hi) ? s : t; zz[k] = *(const GAS v4u*)(ZP + (size_t)sc * DP); }
#pragma unroll
    for (int k = 0; k < 16; ++k) { const int s = t - 8 + k; const float f = (s >= lo && s < hi) ? 1.f : 0.f; const v4u z = zz[k];
        acc[0] += f * bflo(z.x); acc[1] += f * bfhi(z.x); acc[2] += f * bflo(z.y); acc[3] += f * bfhi(z.y); acc[4] += f * bflo(z.z); acc[5] += f * bfhi(z.z); acc[6] += f * bflo(z.w); acc[7] += f * bfhi(z.w);
        if (k == 8) zt = z; }
    const float inv = 1.0f / (float)(hi - lo);
    v4u o; o.x = pk2(acc[0] * inv - bflo(zt.x), acc[1] * inv - bfhi(zt.x)); o.y = pk2(acc[2] * inv - bflo(zt.y), acc[3] * inv - bfhi(zt.y));
    o.z = pk2(acc[4] * inv - bflo(zt.z), acc[5] * inv - bfhi(zt.z)); o.w = pk2(acc[6] * inv - bflo(zt.w), acc[7] * inv - bfhi(zt.w));
    *(GAS v4u*)((bf16*)(F.ws + WS_CAT) + (size_t)m * D + lane * 8) = o;
#if MK_STAGE == 1
    *(GAS v4u*)((bf16*)(F.ws + WS_CAT) + (size_t)m * D + DP + lane * 8) = (v4u){0u, 0u, 0u, 0u};
#endif
}
__device__ __forceinline__ float dot16(const f32x4 (&v)[4], const float* w, int lane) {
    const GAS f32x4* wr = (const GAS f32x4*)w + lane; float s = 0.f;
#pragma unroll
    for (int j = 0; j < 4; ++j) { const f32x4 ww = wr[64 * j]; s += (v[j].x * ww.x + v[j].y * ww.y) + (v[j].z * ww.z + v[j].w * ww.w); }
    return wave_sum(s);
}
__device__ __forceinline__ void route_row(Frame& F, const Args& A, int m) {
    const int lane = opq(hw_lane());
    const GAS f32x4* hr = (const GAS f32x4*)(F.out + (size_t)m * D) + lane; const GAS f32x4* gr = (const GAS f32x4*)A.in[17] + lane;
    f32x4 v[4]; float s = 0.f;
#pragma unroll
    for (int j = 0; j < 4; ++j) { v[j] = hr[64 * j]; s += (v[j].x * v[j].x + v[j].y * v[j].y) + (v[j].z * v[j].z + v[j].w * v[j].w); }
    const float rstd = 1.f / sqrtf(wave_sum(s) * (1.f / D) + RMS_EPS);
    GAS unsigned long long* o8 = (GAS unsigned long long*)((bf16*)(F.ws + WS_XN) + (size_t)m * D) + lane;
#pragma unroll
    for (int j = 0; j < 4; ++j) { const f32x4 gg = gr[64 * j]; v[j] = v[j] * rstd * gg;
        o8[64 * j] = (unsigned long long)pk2(v[j].x, v[j].y) | ((unsigned long long)pk2(v[j].z, v[j].w) << 32); }
    const float* WR = (const float*)(F.ws + WS_WR);
    float gl[4];
#pragma unroll
    for (int k = 0; k < 4; ++k) gl[k] = dot16(v, WR + (size_t)k * D, lane) + A.in[19][k];
    int gsel = 0; float gmax = gl[0];
#pragma unroll
    for (int k = 1; k < 4; ++k) if (gl[k] > gmax) { gmax = gl[k]; gsel = k; }
    float gden = 0.f;
#pragma unroll
    for (int k = 0; k < 4; ++k) gden += __expf(gl[k] - gmax);
    const float grp_p = 1.0f / gden;
    gsel = __builtin_amdgcn_readfirstlane(gsel);
    float el[8];
#pragma unroll
    for (int e = 0; e < 8; ++e) el[e] = dot16(v, WR + (size_t)(4 + gsel * 8 + e) * D, lane) + A.in[21][gsel * 8 + e];
    int i1 = 0; float m1 = el[0];
#pragma unroll
    for (int e = 1; e < 8; ++e) if (el[e] > m1) { m1 = el[e]; i1 = e; }
    int i2 = -1; float m2 = -3.0e38f;
#pragma unroll
    for (int e = 0; e < 8; ++e) if (e != i1 && el[e] > m2) { m2 = el[e]; i2 = e; }
    const float r = __expf(m2 - m1), w1 = grp_p / (1.0f + r), w2 = grp_p * r / (1.0f + r);
    if (lane == 0) {
        const int e1 = gsel * 8 + i1, e2 = gsel * 8 + i2;
        int* rt = (int*)(F.ws + WS_ROUTE) + (size_t)m * 4; rt[0] = e1; rt[1] = e2; ((float*)rt)[2] = w1; ((float*)rt)[3] = w2;
        __hip_atomic_fetch_add((unsigned*)(F.ctl + CW_CNT) + 64 * e1, 1u, RLX_AGENT); __hip_atomic_fetch_add((unsigned*)(F.ctl + CW_CNT) + 64 * e2, 1u, RLX_AGENT);
    }
}
__device__ __forceinline__ void build_tstart(Frame& F) {
    if (F.wave == 0 && hw_lane() == 0) { unsigned acc = 0u;
        for (int e = 0; e < NEXP; ++e) { F.MISC[16 + e] = acc; acc += (__hip_atomic_load((unsigned*)(F.ctl + CW_CNT) + 64 * e, RLX_AGENT) + 255u) >> 8; }
        F.MISC[16 + NEXP] = acc; }
    __syncthreads();
}
__device__ __forceinline__ void permute_row(Frame& F, int m) {
    const int lane = opq(hw_lane());
    const int* rt = (const int*)(F.ws + WS_ROUTE) + (size_t)m * 4;
    const int e1 = rt[0], e2 = rt[1]; const float w1 = ((const float*)rt)[2], w2 = ((const float*)rt)[3];
    const GAS v4u* src = (const GAS v4u*)((const bf16*)(F.ws + WS_XN) + (size_t)m * D) + lane;
    const v4u a = src[0], b = src[64];
#pragma unroll
    for (int k = 0; k < 2; ++k) { const int e = k ? e2 : e1;
        unsigned pos = 0u;
        if (lane == 0) pos = F.MISC[16 + e] * 256u + __hip_atomic_fetch_add((unsigned*)(F.ctl + CW_FILL) + 64 * e, 1u, RLX_AGENT);
        pos = __builtin_amdgcn_readfirstlane(pos);
        GAS v4u* dst = (GAS v4u*)((bf16*)(F.ws + WS_VP) + (size_t)pos * D) + lane; dst[0] = a; dst[64] = b;
        if (lane == 0) { ((int*)(F.ws + WS_ROWINFO))[pos] = 2 * m + k; ((float*)(F.ws + WS_ROWW))[pos] = k ? w2 : w1; } }
}
template <int R> __device__ __forceinline__ void moe_combine_rows(Frame& F, const Args& A, int m0, int stride) {
    const int lane = opq(hw_lane());
    const GAS f32x4* gr = (const GAS f32x4*)A.in[25] + lane;
    f32x4 v[R][4]; v2u a[R][4], b[R][4];
#pragma unroll
    for (int r = 0; r < R; ++r) { const size_t m = (size_t)(m0 + r * stride);
#pragma unroll
        for (int j = 0; j < 4; ++j) { v[r][j] = *((const GAS f32x4*)(F.out + m * D) + lane + 64 * j);
            a[r][j] = *((const GAS v2u*)((const bf16*)(F.ws + WS_MO0) + m * D) + lane + 64 * j); b[r][j] = *((const GAS v2u*)((const bf16*)(F.ws + WS_MO1) + m * D) + lane + 64 * j); } }
#pragma unroll
    for (int r = 0; r < R; ++r) { const size_t m = (size_t)(m0 + r * stride); float s = 0.f;
        GAS f32x4* hr = (GAS f32x4*)(F.out + m * D) + lane; GAS unsigned long long* o8 = (GAS unsigned long long*)((bf16*)(F.ws + WS_XN) + m * D) + lane;
#pragma unroll
        for (int j = 0; j < 4; ++j) { f32x4& x = v[r][j];
            x.x += bflo(a[r][j].x) + bflo(b[r][j].x); x.y += bfhi(a[r][j].x) + bfhi(b[r][j].x); x.z += bflo(a[r][j].y) + bflo(b[r][j].y); x.w += bfhi(a[r][j].y) + bfhi(b[r][j].y);
            hr[64 * j] = x; s += (x.x * x.x + x.y * x.y) + (x.z * x.z + x.w * x.w); }
        const float rstd = 1.f / sqrtf(wave_sum(s) * (1.f / D) + RMS_EPS);
#pragma unroll
        for (int j = 0; j < 4; ++j) { const f32x4 gg = gr[64 * j], x = v[r][j];
            o8[64 * j] = (unsigned long long)pk2(x.x * rstd * gg.x, x.y * rstd * gg.y) | ((unsigned long long)pk2(x.z * rstd * gg.z, x.w * rstd * gg.w) << 32); } }
}
template <int R, bool ADDG> __device__ __forceinline__ void final_rows(Frame& F, const Args& A, int m0, int stride) {
    const int lane = opq(hw_lane());
    const GAS f32x4* gr = (const GAS f32x4*)A.in[29] + lane;
    f32x4 v[R][4]; v2u gg[R][4];
#pragma unroll
    for (int r = 0; r < R; ++r) { const size_t m = (size_t)(m0 + r * stride);
#pragma unroll
        for (int j = 0; j < 4; ++j) { v[r][j] = *((const GAS f32x4*)(F.out + m * D) + lane + 64 * j);
            if (ADDG) gg[r][j] = *((const GAS v2u*)((const bf16*)(F.ws + WS_PE) + m * D) + lane + 64 * j); } }
#pragma unroll
    for (int r = 0; r < R; ++r) { const size_t m = (size_t)(m0 + r * stride); float s = 0.f;
        GAS f32x4* hr = (GAS f32x4*)(F.out + m * D) + lane;
#pragma unroll
        for (int j = 0; j < 4; ++j) { f32x4& x = v[r][j];
            if (ADDG) { x.x += bflo(gg[r][j].x); x.y += bfhi(gg[r][j].x); x.z += bflo(gg[r][j].y); x.w += bfhi(gg[r][j].y); }
            s += (x.x * x.x + x.y * x.y) + (x.z * x.z + x.w * x.w); }
        const float rstd = 1.f / sqrtf(wave_sum(s) * (1.f / D) + RMS_EPS);
#pragma unroll
        for (int j = 0; j < 4; ++j) hr[64 * j] = v[r][j] * rstd * gr[64 * j]; }
}

__global__ void __launch_bounds__(NWAVES * 64, 2) mk_fwd(Args args) {
    extern __shared__ __attribute__((aligned(16))) unsigned char lds[];
    Frame F;
    F.lds = (LAS unsigned char*)lds;
    F.MISC = (volatile LAS unsigned*)(F.lds + MISC_OFF);
    F.wave = __builtin_amdgcn_readfirstlane(threadIdx.x >> 6);
    F.G = gridDim.x; F.gw = blockIdx.x * NWAVES + F.wave; F.ngw = F.G * NWAVES;
    F.out = args.out; F.ws = args.ws; F.ctl = (gu32*)(args.ws + WS_CTL);
    for (int u = threadIdx.x; u < (LDS_BYTES - LDSCTL_OFF) / 4; u += NWAVES * 64) ((LAS unsigned*)(F.lds + LDSCTL_OFF))[u] = 0u;
    __syncthreads();
    XcdBarrier bar = xcd_barrier_post((unsigned*)(F.ctl + CW_BAR), F.MISC + 8); bar.wave = F.wave;
#define GRID_BAR() xcd_barrier(bar)
    bf16* const WIN = (bf16*)(F.ws + WS_WIN); bf16* const GLU = (bf16*)(F.ws + WS_GLU); bf16* const WCAT = (bf16*)(F.ws + WS_WCAT); bf16* const WG = (bf16*)(F.ws + WS_WG); bf16* const WPLE = (bf16*)(F.ws + WS_WPLE);
    bf16* const WGU = (bf16*)(F.ws + WS_WGU); bf16* const WD = (bf16*)(F.ws + WS_WD); bf16* const MS = (bf16*)(F.ws + WS_MS); bf16* const WS3 = (bf16*)(F.ws + WS_WS3);
    bf16* const XN = (bf16*)(F.ws + WS_XN); bf16* const ZP = (bf16*)(F.ws + WS_ZP); bf16* const AS = (bf16*)(F.ws + WS_AS); float* const SLOC = (float*)(F.ws + WS_SLOC);
    bf16* const CAT = (bf16*)(F.ws + WS_CAT); bf16* const ZZ = (bf16*)(F.ws + WS_ZZ); bf16* const PB = (bf16*)(F.ws + WS_PB); bf16* const PE = (bf16*)(F.ws + WS_PE);
    bf16* const VP = (bf16*)(F.ws + WS_VP); bf16* const ACT = (bf16*)(F.ws + WS_ACT); bf16* const MO0 = (bf16*)(F.ws + WS_MO0); bf16* const MO1 = (bf16*)(F.ws + WS_MO1);
    const int cid = (int)blockIdx.x;

#ifndef MK_REP
#define MK_REP -1
#endif
#define REP(k) for (int rep_ = 0; rep_ < ((MK_REP == (k)) ? 2 : 1); ++rep_)
    REP(0) { p0_prologue(F, args);
    GRID_BAR(); }
    REP(1) { pg8::Gemm g{XN, WIN, D, D, D}; pg8::StaticOrder S; S.init(M, D, F.G, cid); EpiZ E{ZP, AS};
      pg8::gemm_phase<EpiZ, pg8::StaticOrder, true, true>(F.lds + RING_OFF, g, S, E, F.wave);
    GRID_BAR(); }
#if MK_STAGE >= 2
    { pg8::Gemm g{AS, MS, 256, 512, 256}; GroupOrder S{F.G, cid}; EpiSloc E{SLOC};
      pg8::gemm_phase<EpiSloc, GroupOrder, true, true>(F.lds + RING_OFF, g, S, E, F.wave); }
    { pg8::Gemm g{(const bf16*)(F.ws + WS_WOS), (const bf16*)(F.ws + WS_BD), 256, 256, 256}; WeffOrder S{F.G, cid}; EpiWeff E{WCAT};
      pg8::gemm_phase<EpiWeff, WeffOrder, true, true>(F.lds + RING_OFF, g, S, E, F.wave); }
    bg_range(F, args, 0, 1200);
    GRID_BAR();
#endif
    REP(3) {
#if MK_STAGE >= 2
        if (F.G >= 256) { if (cid < 128) { carry_unit(F, cid); for (int m = 12288 + cid * NWAVES + F.wave; m < M; m += 128 * NWAVES) diff_row(F, m); }
                          else for (int m = (cid - 128) * NWAVES + F.wave; m < 12288; m += (F.G - 128) * NWAVES) diff_row(F, m); }
        else { for (int u = cid; u < 128; u += F.G) carry_unit(F, u); for (int m = F.gw; m < M; m += F.ngw) diff_row(F, m); }
#else
        for (int m = F.gw; m < M; m += F.ngw) diff_row(F, m);
#endif
    GRID_BAR(); }
#if MK_STAGE >= 2
    { pg8::Gemm g{AS, WS3, 512, 512, 512}; GroupOrder S{F.G, cid}; EpiY E{ZZ};
      pg8::gemm_phase<EpiY, GroupOrder, true, true>(F.lds + RING_OFF, g, S, E, F.wave); }
    bg_range(F, args, 1200, 4600);
    GRID_BAR();
    { pg8::Gemm g{ZZ, GLU, DP, DP, DP}; pg8::StaticOrder S; S.init(M, DP, F.G, cid); EpiGlu E{ZZ, args.in[15], CAT};
      pg8::gemm_phase<EpiGlu, pg8::StaticOrder, true, true>(F.lds + RING_OFF, g, S, E, F.wave); }
    bg_range(F, args, 4600, BG_TOTAL);
    GRID_BAR();
#endif
    { pg8::Gemm g{CAT, WCAT, D, D, D}; pg8::StaticOrder S; S.init(M, D, F.G, cid); EpiRes E{args.in[0], F.out};
      pg8::gemm_phase<EpiRes, pg8::StaticOrder, true, true>(F.lds + RING_OFF, g, S, E, F.wave); }
    GRID_BAR();
#if MK_STAGE >= 3
    for (int m = F.gw; m < M; m += F.ngw) route_row(F, args, m);
    GRID_BAR();
    build_tstart(F);
    for (int m = F.gw; m < M; m += F.ngw) permute_row(F, m);
    GRID_BAR();
    REP(90) {
    { pg8::Gemm g{VP, WGU, D, D, D}; ExpertOrder<2> S{F.G, cid, F.MISC + 16}; EpiAct E{(const float*)(F.ws + WS_ROWW), ACT};
      pg8::gemm_phase<EpiAct, ExpertOrder<2>, true, true>(F.lds + RING_OFF, g, S, E, F.wave); }
    GRID_BAR(); }
    REP(91) {
    { pg8::Gemm g{ACT, WD, DF, DF, DF}; ExpertOrder<4> S{F.G, cid, F.MISC + 16}; EpiDown E{(const int*)(F.ws + WS_ROWINFO), MO0, MO1};
      pg8::gemm_phase<EpiDown, ExpertOrder<4>, true, true>(F.lds + RING_OFF, g, S, E, F.wave); }
    GRID_BAR(); }
    for (int m = F.gw; m + F.ngw < M; m += 2 * F.ngw) moe_combine_rows<2>(F, args, m, F.ngw);
    GRID_BAR();
#endif
#if MK_STAGE >= 4
    { pg8::Gemm g{PB, WPLE, DPLE, DPLE, DPLE}; pg8::StaticOrder S; S.init(M, D, F.G, cid); EpiPe E{PE};
      pg8::gemm_phase<EpiPe, pg8::StaticOrder, true, true>(F.lds + RING_OFF, g, S, E, F.wave); }
    GRID_BAR();
    { pg8::Gemm g{XN, WG, D, D, D}; pg8::StaticOrder S; S.init(M, D, F.G, cid); EpiGate E{args.in[27], PE};
      pg8::gemm_phase<EpiGate, pg8::StaticOrder, true, true>(F.lds + RING_OFF, g, S, E, F.wave); }
    GRID_BAR();
#endif
    for (int m = F.gw; m + 3 * F.ngw < M; m += 4 * F.ngw) final_rows<4, (MK_STAGE >= 4)>(F, args, m, F.ngw);
}

extern "C" void kernel_launch(void* const* d_in, const int* in_sizes, int n_in, void* d_out, int out_size, void* d_ws, size_t ws_size, hipStream_t stream) {
    static int grid = 0;
    if (grid == 0) {
        if (n_in != 30 || in_sizes[0] != M * D || out_size != M * D || ws_size < WS_END) { fprintf(stderr, "kernel_launch: unexpected shapes (n_in %d, in0 %d, out %d, ws %zu)\n", n_in, n_in > 0 ? in_sizes[0] : -1, out_size, ws_size); grid = -1; return; }
        int dev = 0, cus = 0, per_cu = 0;
        if (hipGetDevice(&dev) != hipSuccess || hipDeviceGetAttribute(&cus, hipDeviceAttributeMultiprocessorCount, dev) != hipSuccess) { grid = -1; return; }
        if (hipFuncSetAttribute((const void*)mk_fwd, hipFuncAttributeMaxDynamicSharedMemorySize, LDS_BYTES) != hipSuccess) { fprintf(stderr, "kernel_launch: hipFuncSetAttribute failed\n"); grid = -1; return; }
        if (hipOccupancyMaxActiveBlocksPerMultiprocessor(&per_cu, (const void*)mk_fwd, NWAVES * 64, LDS_BYTES) != hipSuccess || per_cu < 1) { fprintf(stderr, "kernel_launch: occupancy query reports %d blocks per CU\n", per_cu); }
        (void)hipGetLastError();
        grid = cus;
    }
    if (grid < 0) return;
    (void)hipMemsetAsync((char*)d_ws + WS_CTL, 0, CTL_ZERO_BYTES, stream);
    Args a{};
    for (int i = 0; i < 30; ++i) a.in[i] = (const float*)d_in[i];
    a.out = (float*)d_out; a.ws = (unsigned char*)d_ws;
    hipLaunchKernelGGL(mk_fwd, dim3(grid), dim3(NWAVES * 64), LDS_BYTES, stream, a);
}
```

```cpp
#include <hip/hip_runtime.h>
#include <cstdio>
#include <cstdint>
__device__ __forceinline__ int hw_lane() { int l; asm volatile("v_mbcnt_lo_u32_b32 %0, -1, 0\n\tv_mbcnt_hi_u32_b32 %0, -1, %0" : "=v"(l)); return l; }
namespace pg8 {
#define PG8_LAS __attribute__((address_space(3)))
typedef unsigned short bf16_t;
typedef short bf16x8 __attribute__((ext_vector_type(8)));
typedef float f32x4 __attribute__((ext_vector_type(4)));
typedef unsigned u32x4 __attribute__((ext_vector_type(4)));
constexpr int BM = 256, BK = 64, HALF = 128, HTB = HALF * BK * 2  , STAGE_BYTES = 8 * HTB, NXCD = 8, WGM = 8;

__host__ __device__ __forceinline__ int lds_byte(int r, int c) { const int st = (r >> 4) * 2 + (c >> 5), rr = r & 15, cc = c & 31, ob = rr * 64 + cc * 2; return st * 1024 + (ob ^ (((ob >> 9) & 1) << 5)); }
__host__ __device__ __forceinline__ void stage_rc(int b, int& R, int& C) { const int st = b / 1024, sb = b % 1024, swz = sb ^ (((sb >> 9) & 1) << 5); R = (st >> 1) * 16 + swz / 64; C = (st & 1) * 32 + (swz % 64) / 2; }
__host__ __device__ __forceinline__ int perm32(int rho) { const int n = rho >> 4, i = rho & 15; return 8 * (i >> 2) + 4 * n + (i & 3); }

struct Unit { int pm, pn; };
struct Gemm { const bf16_t* A; const bf16_t* Bt; int K, lda, ldb; };

struct StaticOrder {
    int nM, nN, nwg, G, c;
    __host__ __device__ void init(int M, int N, int G_, int c_) { nM = M / BM; nN = N / BM; nwg = nM * nN; G = G_; c = c_; }
    __host__ __device__ bool next(int i, Unit& u) const {
        const long L = (long)i * G + c; if (L >= nwg) return false;
        int wgid = (int)L; { const int q = nwg / NXCD, r = nwg % NXCD, xcd = wgid % NXCD, off = wgid / NXCD; wgid = (xcd < r ? xcd * (q + 1) : r * (q + 1) + (xcd - r) * q) + off; }
        const int nig = WGM * nN, gid = wgid / nig, fm = gid * WGM, gsz = (nM - fm) < WGM ? (nM - fm) : WGM;
        u.pm = fm + ((wgid % nig) % gsz); u.pn = (wgid % nig) / gsz; return true;
    }
    __device__ __forceinline__ void a_ready(const Unit&) const {}
    __device__ __forceinline__ void done(const Unit&) const {}
};

template <class Epi, class Sched, bool ALIGN_EPI = false, bool SP2 = false, bool GATHER = false>
__device__ __forceinline__ void gemm_phase(PG8_LAS unsigned char* lds, const Gemm g, const Sched& S, const Epi& E, const int wid  , const PG8_LAS unsigned* rowoff = nullptr) {
    static_assert(!GATHER || SP2, "GATHER is written for the SP2 loop");
    int lane_ = hw_lane(); asm volatile("" : "+v"(lane_));
    const int lane = lane_, tid = wid * 64 + lane, wr = wid >> 2, wc = wid & 3, fr = lane & 15, fq = lane >> 4;
    const int K = g.K, nt = K / BK;
    unsigned voffA[2], voffB[2];
#pragma unroll
    for (int i = 0; i < 2; ++i) { int R, C; stage_rc(tid * 16 + i * 8192, R, C); const int Rb = Epi::PERM ? ((R & ~31) + perm32(R & 31)) : R;
        voffA[i] = (unsigned)(R * g.lda + C) * 2u; voffB[i] = (unsigned)(Rb * g.ldb + C) * 2u; }
    const size_t kstep = (size_t)(BK * 2);
    const size_t hstepA = GATHER ? (size_t)0 : (size_t)HALF * g.lda * 2, hstepB = (size_t)HALF * g.ldb * 2;
    const size_t tstepA = 2 * hstepA, tstepB = 2 * hstepB;
    const unsigned ldsw = (unsigned)wid * 1024u;
    const int aoff = lds_byte(wr * 64 + fr, fq * 8), boff = lds_byte(wc * 32 + fr, fq * 8);
    unsigned cvo[2][2], nvo[2][2];
#define PG8_LOADVO(dst, u_) do { _Pragma("unroll") for (int _h = 0; _h < 2; ++_h) _Pragma("unroll") for (int _i = 0; _i < 2; ++_i) { int R_, C_; stage_rc(tid * 16 + _i * 8192, R_, C_); \
        dst[_h][_i] = rowoff[(u_) * 256 + _h * 128 + R_] + (unsigned)C_ * 2u; } } while (0)
#define PG8_VA(h) (GATHER ? cvo[h] : voffA)
#define PG8_SA(b, h) (((b) * 2 + (h)) * HTB)
#define PG8_SB(b, h) ((4 + (b) * 2 + (h)) * HTB)
#define PG8_STAGE(bufoff, gbase, voff) do { _Pragma("unroll") for (int _i = 0; _i < 2; ++_i) \
        __builtin_amdgcn_global_load_lds((const unsigned*)((const char*)(gbase) + (voff)[_i]), (PG8_LAS unsigned*)(lds + (bufoff) + ldsw + _i * 8192), 16, 0, 0); } while (0)
#define PG8_LDA(dst, b, h) do { _Pragma("unroll") for (int m = 0; m < 4; ++m) _Pragma("unroll") for (int k = 0; k < 2; ++k) dst[m][k] = *(const PG8_LAS bf16x8*)(lds + PG8_SA(b, h) + aoff + m * 2048 + k * 1024); } while (0)
#define PG8_LDB(dst, b, h) do { _Pragma("unroll") for (int n = 0; n < 2; ++n) _Pragma("unroll") for (int k = 0; k < 2; ++k) dst[n][k] = *(const PG8_LAS bf16x8*)(lds + PG8_SB(b, h) + boff + n * 2048 + k * 1024); } while (0)
#define PG8_MMA(ai, bj, At, Bt) do { __builtin_amdgcn_s_setprio(1); _Pragma("unroll") for (int m = 0; m < 4; ++m) _Pragma("unroll") for (int n = 0; n < 2; ++n) _Pragma("unroll") for (int k = 0; k < 2; ++k) \
        acc[ai][bj][m][n] = __builtin_amdgcn_mfma_f32_16x16x32_bf16(Bt[n][k], At[m][k], acc[ai][bj][m][n], 0, 0, 0); __builtin_amdgcn_s_setprio(0); } while (0)
#define PG8_WAIT_V(n) asm volatile("s_waitcnt vmcnt(" #n ")" ::: "memory")
#define PG8_WAIT_L(n) asm volatile("s_waitcnt lgkmcnt(" #n ")" ::: "memory")
#define PG8_BAR __builtin_amdgcn_s_barrier()
#define PG8_SCHED __builtin_amdgcn_sched_barrier(0)
    Unit cur, nxt; int ui = 0;
    if (!S.next(0, cur)) return;
    f32x4 acc[2][2][4][2];
#pragma unroll
    for (int a = 0; a < 2; ++a)
#pragma unroll
        for (int b = 0; b < 2; ++b)
#pragma unroll
            for (int m = 0; m < 4; ++m)
#pragma unroll
                for (int n = 0; n < 2; ++n) acc[a][b][m][n] = (f32x4){0.f, 0.f, 0.f, 0.f};
    bf16x8 At[4][2], B0[2][2], B1[2][2];
    const char* cA = (const char*)g.A + (size_t)cur.pm * tstepA; const char* cB = (const char*)g.Bt + (size_t)cur.pn * tstepB;
    S.a_ready(cur);
    if constexpr (GATHER) PG8_LOADVO(cvo, 0);
    if constexpr (SP2) {
        PG8_STAGE(PG8_SB(0, 0), cB, voffB); PG8_STAGE(PG8_SB(0, 1), cB + hstepB, voffB); PG8_STAGE(PG8_SA(0, 0), cA, PG8_VA(0)); PG8_STAGE(PG8_SA(0, 1), cA + hstepA, PG8_VA(1));
        if (wr == 1) PG8_BAR;
        PG8_WAIT_V(2); PG8_BAR;
        PG8_STAGE(PG8_SB(1, 0), cB + kstep, voffB); PG8_STAGE(PG8_SA(1, 0), cA + kstep, PG8_VA(0)); PG8_STAGE(PG8_SB(1, 1), cB + hstepB + kstep, voffB);
        PG8_WAIT_V(6); PG8_BAR;
    } else {
        PG8_STAGE(PG8_SB(0, 0), cB, voffB); PG8_STAGE(PG8_SA(0, 0), cA, voffA); PG8_STAGE(PG8_SB(0, 1), cB + hstepB, voffB); PG8_STAGE(PG8_SA(0, 1), cA + hstepA, voffA);
        if (wr == 1) PG8_BAR;
        PG8_WAIT_V(4); PG8_BAR;
        PG8_STAGE(PG8_SB(1, 0), cB + kstep, voffB); PG8_STAGE(PG8_SA(1, 0), cA + kstep, voffA); PG8_STAGE(PG8_SB(1, 1), cB + hstepB + kstep, voffB);
        PG8_WAIT_V(6); PG8_BAR;
    }
    for (;;) {
        const bool has_next = S.next(ui + 1, nxt);
        const char* nA = has_next ? (const char*)g.A + (size_t)nxt.pm * tstepA : cA; const char* nB = has_next ? (const char*)g.Bt + (size_t)nxt.pn * tstepB : cB;
        for (int t = 0; t < nt; t += 2) {
            const bool last = (t == nt - 2);
            const char* a1 = cA + (size_t)(t + 1) * kstep;
            const char* a2 = last ? nA : cA + (size_t)(t + 2) * kstep; const char* b2 = last ? nB : cB + (size_t)(t + 2) * kstep;
            const char* a3 = a2 + kstep; const char* b3 = b2 + kstep;
            if (last && has_next) S.a_ready(nxt);
            if constexpr (SP2) {
            if constexpr (GATHER) { if (last && has_next) PG8_LOADVO(nvo, ui + 1); }
            PG8_LDB(B0, 0, 0); PG8_LDB(B1, 0, 1); PG8_SCHED; PG8_LDA(At, 0, 0); PG8_STAGE(PG8_SA(1, 1), a1 + hstepA, PG8_VA(1));
            if constexpr (GATHER) { if (last && has_next) { cvo[0][0] = nvo[0][0]; cvo[0][1] = nvo[0][1]; cvo[1][0] = nvo[1][0]; cvo[1][1] = nvo[1][1]; } }
            PG8_WAIT_V(8); PG8_WAIT_L(0); PG8_BAR; PG8_MMA(0, 0, At, B0); PG8_MMA(0, 1, At, B1); PG8_BAR; PG8_SCHED;
            PG8_LDA(At, 0, 1); PG8_STAGE(PG8_SB(0, 0), b2, voffB); PG8_STAGE(PG8_SB(0, 1), b2 + hstepB, voffB); PG8_STAGE(PG8_SA(0, 0), a2, PG8_VA(0));
            PG8_WAIT_V(8); PG8_WAIT_L(0); PG8_BAR; PG8_MMA(1, 0, At, B0); PG8_MMA(1, 1, At, B1); PG8_BAR; PG8_SCHED;
            PG8_LDB(B0, 1, 0); PG8_LDB(B1, 1, 1); PG8_SCHED; PG8_LDA(At, 1, 0); PG8_STAGE(PG8_SA(0, 1), a2 + hstepA, PG8_VA(1));
            PG8_WAIT_V(8); PG8_WAIT_L(0); PG8_BAR; PG8_MMA(0, 0, At, B0); PG8_MMA(0, 1, At, B1); PG8_BAR; PG8_SCHED;
            PG8_LDA(At, 1, 1); PG8_STAGE(PG8_SB(1, 0), b3, voffB); PG8_STAGE(PG8_SB(1, 1), b3 + hstepB, voffB); PG8_STAGE(PG8_SA(1, 0), a3, PG8_VA(0));
            PG8_WAIT_V(8); PG8_WAIT_L(0); PG8_BAR; PG8_MMA(1, 0, At, B0); PG8_MMA(1, 1, At, B1); PG8_BAR; PG8_SCHED;
            } else {
            PG8_LDB(B0, 0, 0); PG8_SCHED; PG8_LDA(At, 0, 0); PG8_STAGE(PG8_SA(1, 1), a1 + hstepA, voffA);
            PG8_WAIT_L(8); PG8_BAR; PG8_WAIT_L(0); PG8_MMA(0, 0, At, B0); PG8_BAR; PG8_SCHED;
            PG8_LDB(B1, 0, 1); PG8_STAGE(PG8_SB(0, 0), b2, voffB);
            PG8_BAR; PG8_WAIT_L(0); PG8_MMA(0, 1, At, B1); PG8_BAR;
            PG8_LDA(At, 0, 1); PG8_STAGE(PG8_SA(0, 0), a2, voffA);
            PG8_BAR; PG8_WAIT_L(0); PG8_MMA(1, 0, At, B0); PG8_BAR; PG8_SCHED;
            PG8_STAGE(PG8_SB(0, 1), b2 + hstepB, voffB);
            PG8_WAIT_V(6); PG8_BAR; PG8_MMA(1, 1, At, B1); PG8_BAR;
            PG8_LDB(B0, 1, 0); PG8_SCHED; PG8_LDA(At, 1, 0); PG8_STAGE(PG8_SA(0, 1), a2 + hstepA, voffA);
            PG8_WAIT_L(8); PG8_BAR; PG8_WAIT_L(0); PG8_MMA(0, 0, At, B0); PG8_BAR; PG8_SCHED;
            PG8_LDB(B1, 1, 1); PG8_STAGE(PG8_SB(1, 0), b3, voffB);
            PG8_BAR; PG8_WAIT_L(0); PG8_MMA(0, 1, At, B1); PG8_BAR;
            PG8_LDA(At, 1, 1); PG8_STAGE(PG8_SA(1, 0), a3, voffA);
            PG8_BAR; PG8_WAIT_L(0); PG8_MMA(1, 0, At, B0); PG8_BAR; PG8_SCHED;
            PG8_STAGE(PG8_SB(1, 1), b3 + hstepB, voffB);
            PG8_WAIT_V(6); PG8_BAR; PG8_MMA(1, 1, At, B1); PG8_BAR;
            }
        }
        if constexpr (ALIGN_EPI) { if (wr == 0) PG8_BAR; }
        if constexpr (!Epi::AFTER_DRAIN) { E(acc, cur, wr, wc, fr, fq); S.done(cur); }
        if (!has_next) break;
#pragma unroll
        for (int a = 0; a < 2; ++a)
#pragma unroll
            for (int b = 0; b < 2; ++b)
#pragma unroll
                for (int m = 0; m < 4; ++m)
#pragma unroll
                    for (int n = 0; n < 2; ++n) acc[a][b][m][n] = (f32x4){0.f, 0.f, 0.f, 0.f};
        cur = nxt; cA = nA; cB = nB; ++ui;
        if constexpr (ALIGN_EPI) { if (wr == 1) PG8_BAR; }
    }
    PG8_WAIT_V(0);
    if constexpr (!ALIGN_EPI) { if (wr == 0) PG8_BAR; }
    PG8_BAR;
    if constexpr (Epi::AFTER_DRAIN) { E.fused(acc, cur, wr, wc, fr, fq, lds, wid, lane); S.done(cur); }
#undef PG8_SA
#undef PG8_LOADVO
#undef PG8_VA
#undef PG8_SB
#undef PG8_STAGE
#undef PG8_LDA
#undef PG8_LDB
#undef PG8_MMA
#undef PG8_WAIT_V
#undef PG8_WAIT_L
#undef PG8_BAR
#undef PG8_SCHED
}
}

#ifndef MK_STAGE
#define MK_STAGE 4
#endif
constexpr int NWAVES = 8;
constexpr int M = 16384, D = 1024, SEQ = 8192, DP = 512, NG = 32, NST = 64, GC = 16, CL = 16  ;
constexpr int NCH = M / CL;
constexpr int NEXP = 32, DF = 256, DPLE = 256;
constexpr int VP_ROWS = 2 * M + NEXP * 256;
constexpr float RMS_EPS = 1e-6f;

constexpr size_t MiB = 1u << 20;
constexpr size_t WS_CTL = 0, CTL_ZERO_BYTES = 1 * MiB;
constexpr size_t WS_WR = 1 * MiB;
constexpr size_t WS_LAMT = 1 * MiB + 256 * 1024;
constexpr size_t WS_ROUTE = 1 * MiB + 512 * 1024;
constexpr size_t WS_WIN = 2 * MiB, WS_GLU = 4 * MiB, WS_WCAT = 5 * MiB, WS_WG = 7 * MiB, WS_WPLE = 9 * MiB;
constexpr size_t WS_ROWINFO = 9 * MiB + 512 * 1024, WS_ROWW = 9 * MiB + 768 * 1024;
constexpr size_t WS_WGU = 10 * MiB, WS_WD = 42 * MiB;
constexpr size_t WS_MS = 58 * MiB, WS_WS3 = 62 * MiB;
constexpr size_t WS_ZZ = 70 * MiB;
constexpr size_t WS_PE = 58 * MiB;
constexpr size_t WS_XN = 90 * MiB;
constexpr size_t WS_ZP = 122 * MiB, WS_AS = 138 * MiB, WS_SLOC = 170 * MiB, WS_CAT = 202 * MiB, WS_PB = 234 * MiB;
constexpr size_t WS_VP = 122 * MiB, WS_ACT = 202 * MiB, WS_MO0 = 122 * MiB, WS_MO1 = 154 * MiB;
constexpr size_t WS_LIST = 244 * MiB, WS_LISTW = 246 * MiB, WS_LISTR = 248 * MiB;
constexpr size_t WS_WOS = 242 * MiB, WS_BD = 243 * MiB;
constexpr size_t WS_END = 256 * MiB;
static_assert(WS_VP + (size_t)VP_ROWS * 2048 <= WS_ACT && WS_ACT + (size_t)VP_ROWS * 512 <= WS_PB && WS_PB + (size_t)M * 512 <= WS_END, "ws map");
constexpr int CW_CNT = 8192;
constexpr int CW_BAR = 4096;
constexpr int ROWOFF_OFF = 140288;
constexpr int RING_OFF = 0, RING_BYTES = 131072, P0_SCR = 64 * 65 * 4  , LDSCTL_OFF = 139264, MISC_OFF = LDSCTL_OFF + 320, LDS_BYTES = 147456;
static_assert(NWAVES * P0_SCR <= LDSCTL_OFF && MISC_OFF + 4 * 128 <= ROWOFF_OFF && ROWOFF_OFF + 4 * 1024 <= LDS_BYTES, "LDS map");

#define GAS __attribute__((address_space(1)))
#define LAS __attribute__((address_space(3)))
typedef unsigned short bf16;
typedef unsigned v4u __attribute__((ext_vector_type(4)));
typedef unsigned v2u __attribute__((ext_vector_type(2)));
typedef float f32x4 __attribute__((ext_vector_type(4)));
typedef GAS unsigned gu32;
#define RLX_AGENT __ATOMIC_RELAXED, __HIP_MEMORY_SCOPE_AGENT
#define LDS_WAIT() asm volatile("s_waitcnt lgkmcnt(0)" ::: "memory")
#define VM_WAIT() asm volatile("s_waitcnt vmcnt(0)" ::: "memory")
__device__ __forceinline__ unsigned f2bf(float f) { unsigned u = __builtin_bit_cast(unsigned, f); return (u + 0x7fffu + ((u >> 16) & 1u)) >> 16; }
__device__ __forceinline__ unsigned pk2(float lo, float hi) { return f2bf(lo) | (f2bf(hi) << 16); }
__device__ __forceinline__ float bflo(unsigned w) { return __builtin_bit_cast(float, w << 16); }
__device__ __forceinline__ float bfhi(unsigned w) { return __builtin_bit_cast(float, w & 0xffff0000u); }
__device__ __forceinline__ float sigmoidf_(float x) { return 1.0f / (1.0f + __expf(-x)); }
__device__ __forceinline__ float gelu_tanh(float y) { const float t = 1.5957691216f * (y + 0.044715f * y * y * y); return y / (1.0f + __expf(-t)); }

#define XB_TMO      128
#define XB_XCNT(j)  (256  + 64 * (j))
#define XB_XSUB(j)  (1280 + 64 * (j))
#define XB_XGEN(j)  (2304 + 64 * (j))
#define XB_TOP      3328
#define XB_TOPGEN   3392
#define XCD_BAR_WORDS 3456
#define XB_SPIN_CAP (1u << 18)
__device__ __forceinline__ unsigned xb_ld(unsigned* p)              { return __hip_atomic_load(p, __ATOMIC_RELAXED, __HIP_MEMORY_SCOPE_AGENT); }
__device__ __forceinline__ unsigned xb_add(unsigned* p, unsigned v) { return __hip_atomic_fetch_add(p, v, __ATOMIC_RELAXED, __HIP_MEMORY_SCOPE_AGENT); }
__device__ __forceinline__ unsigned xb_xcc_id() { return (unsigned)__builtin_amdgcn_s_getreg((3 << 11) | 20) & 0xFu; }
#define XB_SPIN(cond, bar) do { unsigned _sp = 0; while (cond) { __builtin_amdgcn_s_sleep(1); \
    if ((++_sp & 255u) == 0u) { if (xb_ld(&(bar)[XB_TMO])) break; if (_sp > XB_SPIN_CAP) { atomicAdd(&(bar)[XB_TMO], 1u); break; } } } } while (0)
struct XcdBarrier { unsigned* bar; unsigned x; volatile LAS unsigned* st; int wave; };
__device__ __forceinline__ XcdBarrier xcd_barrier_post(unsigned* bar, volatile LAS unsigned* st) {
    XcdBarrier b; b.bar = bar; b.x = xb_xcc_id(); b.st = st; b.wave = 0;
    if (threadIdx.x == 0) (void)xb_add(&bar[XB_XCNT(b.x)], 1u);
    return b;
}
__device__ __forceinline__ void xcd_barrier_complete(unsigned* bar, unsigned x, unsigned& nloc, unsigned& nx) {
    const unsigned G = gridDim.x * gridDim.y * gridDim.z;
    unsigned sum, cnt, mine, sp = 0u;
    for (;;) {
        sum = 0u; cnt = 0u; mine = 0u;
#pragma unroll
        for (unsigned j = 0; j < 16; ++j) { const unsigned c = xb_ld(&bar[XB_XCNT(j)]); sum += c; cnt += (c > 0u) ? 1u : 0u; mine = (j == x) ? c : mine; }
        if (sum == G) break;
        __builtin_amdgcn_s_sleep(1);
        if ((++sp & 255u) == 0u) { if (xb_ld(&bar[XB_TMO])) break; if (sp > XB_SPIN_CAP) { atomicAdd(&bar[XB_TMO], 1u); break; } }
    }
    nloc = mine > 0u ? mine : 1u; nx = cnt > 0u ? cnt : 1u;
}
__device__ __forceinline__ void xcd_barrier(const XcdBarrier& b) {
    asm volatile("s_waitcnt vmcnt(0)" ::: "memory");
    __syncthreads();
    if (b.wave == 0 && hw_lane() == 0) {
        unsigned* bar = b.bar;
        __builtin_amdgcn_s_waitcnt(0);
        unsigned nloc = b.st[0], nx = b.st[1];
        if (nloc == 0u) { xcd_barrier_complete(bar, b.x, nloc, nx); b.st[0] = nloc; b.st[1] = nx; }
        const unsigned old = xb_add(&bar[XB_XSUB(b.x)], 1u);
        const unsigned gen = old / nloc;
        if (old + 1u == (gen + 1u) * nloc) {
            __builtin_amdgcn_fence(__ATOMIC_RELEASE, "agent");
            asm volatile("s_waitcnt vmcnt(0)" ::: "memory");
            const unsigned og = xb_add(&bar[XB_TOP], 1u);
            const unsigned tg = og / nx;
            if (og + 1u == (tg + 1u) * nx) xb_add(&bar[XB_TOPGEN], 1u);
            else XB_SPIN(xb_ld(&bar[XB_TOPGEN]) == tg, bar);
            __builtin_amdgcn_fence(__ATOMIC_ACQUIRE, "agent");
            xb_add(&bar[XB_XGEN(b.x)], 1u);
            asm volatile("s_waitcnt vmcnt(0)" ::: "memory");
        } else {
            XB_SPIN(xb_ld(&bar[XB_XGEN(b.x)]) == gen, bar);
            __builtin_amdgcn_fence(__ATOMIC_ACQUIRE, "agent");
            asm volatile("s_waitcnt vmcnt(0)" ::: "memory");
        }
    }
    __syncthreads();
}

struct Args { const float* in[30]; float* out; unsigned char* ws; };
struct Frame {
    LAS unsigned char* lds;
    volatile LAS unsigned* MISC;
    gu32* ctl;
    int wave, G, gw, ngw;
    float* out;
    unsigned char* ws;
};
__device__ __forceinline__ int opq(int v) { asm volatile("" : "+v"(v)); return v; }
template <int CTRL> __device__ __forceinline__ float dpp_f(float v) { return __builtin_bit_cast(float, __builtin_amdgcn_update_dpp(0, __builtin_bit_cast(int, v), CTRL, 0xf, 0xf, true)); }
__device__ __forceinline__ float wave_sum(float v) {
    v += dpp_f<0xB1>(v);
    v += dpp_f<0x4E>(v);
    v += dpp_f<0x141>(v);
    v += dpp_f<0x140>(v);
    const float r0 = __builtin_bit_cast(float, __builtin_amdgcn_readlane(__builtin_bit_cast(int, v), 0)), r1 = __builtin_bit_cast(float, __builtin_amdgcn_readlane(__builtin_bit_cast(int, v), 16));
    const float r2 = __builtin_bit_cast(float, __builtin_amdgcn_readlane(__builtin_bit_cast(int, v), 32)), r3 = __builtin_bit_cast(float, __builtin_amdgcn_readlane(__builtin_bit_cast(int, v), 48));
    return (r0 + r1) + (r2 + r3);
}

__device__ __forceinline__ void transpose_item64(const float* src, int ld_src, bf16* dst, int ld_dst, LAS float* scr, int lane, const float* kscale = nullptr) {
    f32x4 v[16];
    const int kq = lane >> 4, n4 = (lane & 15) * 4;
#pragma unroll
    for (int i = 0; i < 16; ++i) v[i] = *(const GAS f32x4*)(src + (size_t)(4 * i + kq) * ld_src + n4);
    if (kscale) {
#pragma unroll
        for (int i = 0; i < 16; ++i) v[i] = v[i] * kscale[4 * i + kq]; }
#pragma unroll
    for (int i = 0; i < 16; ++i) { LAS float* p = scr + (4 * i + kq) * 65 + n4; p[0] = v[i].x; p[1] = v[i].y; p[2] = v[i].z; p[3] = v[i].w; }
    LDS_WAIT(); asm volatile("" ::: "memory");
    const int c = lane & 7;
#pragma unroll
    for (int j = 0; j < 8; ++j) { const int n = (lane >> 3) + 8 * j; const LAS float* q = scr + (8 * c) * 65 + n;
        v4u o; o.x = pk2(q[0 * 65], q[1 * 65]); o.y = pk2(q[2 * 65], q[3 * 65]); o.z = pk2(q[4 * 65], q[5 * 65]); o.w = pk2(q[6 * 65], q[7 * 65]);
        *(GAS v4u*)(dst + (size_t)n * ld_dst + 8 * c) = o; }
    LDS_WAIT(); asm volatile("" ::: "memory");
}
__device__ __forceinline__ void rms_row_to_bf16(const float* xrow, const float* g, bf16* orow, int lane) {
    const GAS f32x4* xr = (const GAS f32x4*)xrow + lane; const GAS f32x4* gr = (const GAS f32x4*)g + lane;
    f32x4 v[4]; float s = 0.f;
#pragma unroll
    for (int j = 0; j < 4; ++j) { v[j] = xr[64 * j]; s += (v[j].x * v[j].x + v[j].y * v[j].y) + (v[j].z * v[j].z + v[j].w * v[j].w); }
    const float rstd = 1.f / sqrtf(wave_sum(s) * (1.f / D) + RMS_EPS);
    GAS unsigned long long* o8 = (GAS unsigned long long*)orow + lane;
#pragma unroll
    for (int j = 0; j < 4; ++j) { const f32x4 gg = gr[64 * j];
        o8[64 * j] = (unsigned long long)pk2(v[j].x * rstd * gg.x, v[j].y * rstd * gg.y) | ((unsigned long long)pk2(v[j].z * rstd * gg.z, v[j].w * rstd * gg.w) << 32); }
}
__device__ __forceinline__ void sincos_d(double x, double& sn, double& cs) {
    const double k = __builtin_rint(x * 0.63661977236758134308);
    const double r = (x - k * 1.57079632679489655800e+00) - k * 6.12323399573676603587e-17;
    const double r2 = r * r;
    const double s = r * (1.0 + r2 * (-1.0 / 6.0 + r2 * (1.0 / 120.0 + r2 * (-1.0 / 5040.0 + r2 * (1.0 / 362880.0 + r2 * (-1.0 / 39916800.0 + r2 * (1.0 / 6227020800.0)))))));
    const double c = 1.0 + r2 * (-0.5 + r2 * (1.0 / 24.0 + r2 * (-1.0 / 720.0 + r2 * (1.0 / 40320.0 + r2 * (-1.0 / 3628800.0 + r2 * (1.0 / 479001600.0 + r2 * (-1.0 / 87178291200.0)))))));
    const int q = ((int)k) & 3;
    sn = (q == 0) ? s : (q == 1) ? c : (q == 2) ? -s : -c;
    cs = (q == 0) ? c : (q == 1) ? -s : (q == 2) ? -c : s;
}
__device__ __forceinline__ void ssm_gen(Frame& F, const Args& A, int g, int sl) {
    LAS float* lamP = (LAS float*)(F.lds + RING_OFF);
    LAS float* Bb = lamP + 2 * 17 * 64 * 2;
    LAS float* Cc = Bb + 2 * 64 * 16 * 2;
    LAS float* KT = Cc + 2 * 16 * 64 * 2;
    LAS float* dv = KT + 32 * 260;
    LAS float* bfac = dv + 16;
    const float* a_re = A.in[6]; const float* a_im = A.in[7]; const float* log_dt = A.in[8];
    const float* b_re = A.in[9]; const float* b_im = A.in[10]; const float* c_re = A.in[11]; const float* c_im = A.in[12]; const float* ssm_d = A.in[13];
    const int t = opq(F.wave * 64 + hw_lane());
    float pbr[4], pbi[4], pcr[4], pci[4];
#pragma unroll
    for (int i = 0; i < 4; ++i) { const int idx = t + 512 * i; const size_t si = (size_t)((idx >> 10) * NG + g) * 1024 + (idx & 1023);
        pbr[i] = b_re[si]; pbi[i] = b_im[si]; pcr[i] = c_re[si]; pci[i] = c_im[si]; }
    const int d_a = (t >> 6) & 1, n_a = t & 63;
    const float p_are = a_re[(d_a * NG + g) * NST + n_a], p_aim = a_im[(d_a * NG + g) * NST + n_a], p_ldt = log_dt[d_a * NG + g], p_dv = ssm_d[g * GC + (t & 15)];
    __syncthreads();
    if (t < 128) {
        const int d = d_a, n = n_a;
        const float dtf = expf(p_ldt), mag = expf(p_are * dtf); const double ang = (double)p_aim * (double)dtf;
        double sn, cs; sincos_d(ang, sn, cs);
        const float lr = mag * (float)cs, li = mag * (float)sn;
        const float nr = lr - 1.0f, ni = li, den = p_are * p_are + p_aim * p_aim;
        bfac[(d * 64 + n) * 2] = (nr * p_are + ni * p_aim) / den; bfac[(d * 64 + n) * 2 + 1] = (ni * p_are - nr * p_aim) / den;
        float pr = 1.0f, pi = 0.0f;
        for (int k = 0; k <= 16; ++k) { lamP[((d * 17 + k) * 64 + n) * 2] = pr; lamP[((d * 17 + k) * 64 + n) * 2 + 1] = pi;
            const float tr = pr * lr - pi * li, ti = pr * li + pi * lr; pr = tr; pi = ti; }
        if (sl == 0) {
            float* lt = (float*)(F.ws + WS_LAMT) + ((g * 2 + d) * 64 + n) * 4;
            double s16, c16, s1k, c1k; sincos_d(ang * 16.0, s16, c16); sincos_d(ang * 1024.0, s1k, c1k);
            const float m16 = expf(p_are * dtf * 16.0f), m1k = expf(p_are * dtf * 1024.0f);
            lt[0] = m16 * (float)c16; lt[1] = m16 * (float)s16; lt[2] = m1k * (float)c1k; lt[3] = m1k * (float)s1k; }
    }
    if (t < 16) dv[t] = p_dv;
    __syncthreads();
#pragma unroll
    for (int i = 0; i < 4; ++i) { const int idx = t + 512 * i, d = idx >> 10, n = (idx >> 4) & 63;
        const float fr = bfac[(d * 64 + n) * 2], fi = bfac[(d * 64 + n) * 2 + 1];
        Bb[idx * 2] = fr * pbr[i] - fi * pbi[i]; Bb[idx * 2 + 1] = fr * pbi[i] + fi * pbr[i];
        Cc[idx * 2] = pcr[i]; Cc[idx * 2 + 1] = pci[i]; }
    __syncthreads();
    {
        const int d = t >> 8, co = (t >> 4) & 15, ci = t & 15;
        float acc[16];
#pragma unroll
        for (int k = 0; k < 16; ++k) acc[k] = 0.f;
        for (int n = 0; n < 64; ++n) {
            const float cr = Cc[((d * 16 + co) * 64 + n) * 2], cim = Cc[((d * 16 + co) * 64 + n) * 2 + 1];
            const float br = Bb[((d * 64 + n) * 16 + ci) * 2], bi = Bb[((d * 64 + n) * 16 + ci) * 2 + 1];
            const float lr = lamP[((d * 17 + 1) * 64 + n) * 2], li = lamP[((d * 17 + 1) * 64 + n) * 2 + 1];
            float qr = cr * br - cim * bi, qi = cr * bi + cim * br;
#pragma unroll
            for (int k = 0; k < 16; ++k) { acc[k] += qr; const float tr = qr * lr - qi * li; qi = qr * li + qi * lr; qr = tr; }
        }
#pragma unroll
        for (int k = 0; k < 16; ++k) KT[(d * 16 + k) * 260 + co * 16 + ci] = acc[k];
    }
    __syncthreads();
    bf16* WS3 = (bf16*)(F.ws + WS_WS3) + ((size_t)g * 256 + sl * 32) * 512;
    {
        const int rowl = t >> 4, sq = t & 15, row = sl * 32 + rowl, j = row >> 4, co = row & 15;
        float v[16];
        if (j != sq) { const LAS float* src = KT + ((j > sq) ? (j - sq) : (16 + sq - j)) * 260 + co * 16;
#pragma unroll
            for (int i = 0; i < 16; ++i) v[i] = src[i]; }
        else {
#pragma unroll
            for (int i = 0; i < 16; ++i) v[i] = KT[co * 16 + i] + KT[16 * 260 + co * 16 + i] + (co == i ? dv[co] : 0.f); }
        v4u o0, o1; o0.x = pk2(v[0], v[1]); o0.y = pk2(v[2], v[3]); o0.z = pk2(v[4], v[5]); o0.w = pk2(v[6], v[7]); o1.x = pk2(v[8], v[9]); o1.y = pk2(v[10], v[11]); o1.z = pk2(v[12], v[13]); o1.w = pk2(v[14], v[15]);
        GAS v4u* dst = (GAS v4u*)(WS3 + (size_t)rowl * 512 + sq * 16); dst[0] = o0; dst[1] = o1;
    }
#pragma unroll
    for (int i2 = 0; i2 < 2; ++i2) {
        const int idx = t + 512 * i2, rowl = idx >> 5, q = (idx >> 3) & 3, n0 = (idx & 7) * 8, row = sl * 32 + rowl, j = row >> 4, co = row & 15, d = q >> 1, e = (d == 0) ? (j + 1) : (16 - j);
        float v[8];
#pragma unroll
        for (int i = 0; i < 8; ++i) { const int n = n0 + i;
            const float cr = Cc[((d * 16 + co) * 64 + n) * 2], cim = Cc[((d * 16 + co) * 64 + n) * 2 + 1];
            const float pr = lamP[((d * 17 + e) * 64 + n) * 2], pi = lamP[((d * 17 + e) * 64 + n) * 2 + 1];
            v[i] = (q & 1) ? -(cr * pi + cim * pr) : (cr * pr - cim * pi); }
        v4u o; o.x = pk2(v[0], v[1]); o.y = pk2(v[2], v[3]); o.z = pk2(v[4], v[5]); o.w = pk2(v[6], v[7]);
        *(GAS v4u*)(WS3 + (size_t)rowl * 512 + 256 + q * 64 + n0) = o;
    }
    bf16* MS = (bf16*)(F.ws + WS_MS) + ((size_t)g * 256 + sl * 32) * 256;
#pragma unroll
    for (int i2 = 0; i2 < 2; ++i2) {
        const int idx = t + 512 * i2, rowl = idx >> 5, kc = (idx & 31) * 8, row = sl * 32 + rowl, q = row >> 6, n = row & 63, d = q >> 1, j = kc >> 4, ci0 = kc & 15, e = (d == 0) ? (15 - j) : j;
        const float pr = lamP[((d * 17 + e) * 64 + n) * 2], pi = lamP[((d * 17 + e) * 64 + n) * 2 + 1];
        float v[8];
#pragma unroll
        for (int i = 0; i < 8; ++i) { const float br = Bb[((d * 64 + n) * 16 + ci0 + i) * 2], bi = Bb[((d * 64 + n) * 16 + ci0 + i) * 2 + 1];
            v[i] = (q & 1) ? (pr * bi + pi * br) : (pr * br - pi * bi); }
        v4u o; o.x = pk2(v[0], v[1]); o.y = pk2(v[2], v[3]); o.z = pk2(v[4], v[5]); o.w = pk2(v[6], v[7]);
        *(GAS v4u*)(MS + (size_t)rowl * 256 + kc) = o;
    }
    __syncthreads();
}
constexpr int BG_GU = NEXP * 16 * 4, BG_DN = NEXP * 4 * 16, BG_WOB = 8 * 16, BG_WG = 16 * 16, BG_WPLE = 4 * 16;
constexpr int BG_TOTAL = 2 * BG_GU + BG_DN + BG_WOB + BG_WG + BG_WPLE;
struct BgDesc { const float* src; bf16* dst; int ld_src, ld_dst; };
__device__ __forceinline__ BgDesc bg_desc(Frame& F, const Args& A, int r) {
    BgDesc d;
    if (r < 2 * BG_GU) {
        const int up = r >= BG_GU; if (up) r -= BG_GU;
        const int e = r >> 6, kb = (r >> 2) & 15, nb = r & 3, k0 = kb * 64, n0 = nb * 64;
        d.src = A.in[up ? 23 : 22] + ((size_t)e * D + k0) * DF + n0; d.ld_src = DF;
        d.dst = (bf16*)(F.ws + WS_WGU) + ((size_t)e * 512 + (n0 >> 7) * 256 + (up ? 128 : 0) + (n0 & 127)) * D + k0; d.ld_dst = D; return d; }
    r -= 2 * BG_GU;
    if (r < BG_DN) {
        const int e = r >> 6, kb = (r >> 4) & 3, nb = r & 15, k0 = kb * 64, n0 = nb * 64;
        d.src = A.in[24] + ((size_t)e * DF + k0) * D + n0; d.ld_src = D; d.dst = (bf16*)(F.ws + WS_WD) + ((size_t)e * D + n0) * DF + k0; d.ld_dst = DF; return d; }
    r -= BG_DN;
    if (r < BG_WOB) { const int kb = r >> 4, nb = r & 15;
        d.src = A.in[16] + (size_t)(DP + kb * 64) * D + nb * 64; d.ld_src = D; d.dst = (bf16*)(F.ws + WS_WCAT) + (size_t)nb * 64 * D + DP + kb * 64; d.ld_dst = D; return d; }
    r -= BG_WOB;
    if (r < BG_WG) { const int kb = r >> 4, nb = r & 15; d.src = A.in[26] + (size_t)kb * 64 * D + nb * 64; d.ld_src = D; d.dst = (bf16*)(F.ws + WS_WG) + (size_t)nb * 64 * D + kb * 64; d.ld_dst = D; return d; }
    r -= BG_WG;
    { const int kb = r >> 4, nb = r & 15; d.src = A.in[28] + (size_t)kb * 64 * D + nb * 64; d.ld_src = D; d.dst = (bf16*)(F.ws + WS_WPLE) + (size_t)nb * 64 * DPLE + kb * 64; d.ld_dst = DPLE; return d; }
}
__device__ __forceinline__ void tr64_load(f32x4 (&v)[16], const float* src, int ld_src, int lane) {
    const int kq = lane >> 4, n4 = (lane & 15) * 4;
#pragma unroll
    for (int i = 0; i < 16; ++i) v[i] = *(const GAS f32x4*)(src + (size_t)(4 * i + kq) * ld_src + n4);
}
__device__ __forceinline__ void tr64_finish(const f32x4 (&v)[16], bf16* dst, int ld_dst, LAS float* scr, int lane) {
    const int kq = lane >> 4, n4 = (lane & 15) * 4;
#pragma unroll
    for (int i = 0; i < 16; ++i) { LAS float* p = scr + (4 * i + kq) * 65 + n4; p[0] = v[i].x; p[1] = v[i].y; p[2] = v[i].z; p[3] = v[i].w; }
    LDS_WAIT(); asm volatile("" ::: "memory");
    const int c = lane & 7;
#pragma unroll
    for (int j = 0; j < 8; ++j) { const int n = (lane >> 3) + 8 * j; const LAS float* q = scr + (8 * c) * 65 + n;
        v4u o; o.x = pk2(q[0 * 65], q[1 * 65]); o.y = pk2(q[2 * 65], q[3 * 65]); o.z = pk2(q[4 * 65], q[5 * 65]); o.w = pk2(q[6 * 65], q[7 * 65]);
        *(GAS v4u*)(dst + (size_t)n * ld_dst + 8 * c) = o; }
    LDS_WAIT(); asm volatile("" ::: "memory");
}
__device__ __forceinline__ void bg_range(Frame& F, const Args& A, int lo, int hi, int plo, int phi) {
    int widx, nw;
    if (F.G >= 256) { if ((int)blockIdx.x < 128) return; widx = ((int)blockIdx.x - 128) * NWAVES + F.wave; nw = (F.G - 128) * NWAVES; } else { widx = F.gw; nw = F.ngw; }
    LAS float* scr = (LAS float*)(F.lds + RING_OFF + F.wave * P0_SCR);
    const int lane = opq(hw_lane());
    int it = lo + widx;
    if (it < hi) {
        f32x4 va[16], vb[16];
        BgDesc dc = bg_desc(F, A, it); tr64_load(va, dc.src, dc.ld_src, lane);
        for (;;) {
            const int itn = it + nw; BgDesc dn = dc;
            if (itn < hi) { dn = bg_desc(F, A, itn); tr64_load(vb, dn.src, dn.ld_src, lane); }
            tr64_finish(va, dc.dst, dc.ld_dst, scr, lane);
            if (itn >= hi) break;
            const int itm = itn + nw; dc = dn;
            if (itm < hi) { dc = bg_desc(F, A, itm); tr64_load(va, dc.src, dc.ld_src, lane); }
            tr64_finish(vb, dn.dst, dn.ld_dst, scr, lane);
            if (itm >= hi) break;
            it = itm;
        }
    }
    for (int m = plo + 4 * widx; m < phi; m += 4 * nw) {
        f32x4 pv[4];
#pragma unroll
        for (int r = 0; r < 4; ++r) pv[r] = *((const GAS f32x4*)(A.in[1] + (size_t)(m + r) * DPLE) + lane);
#pragma unroll
        for (int r = 0; r < 4; ++r) { v2u o; o.x = pk2(pv[r].x, pv[r].y); o.y = pk2(pv[r].z, pv[r].w); *((GAS v2u*)((bf16*)(F.ws + WS_PB) + (size_t)(m + r) * DPLE) + lane) = o; }
    }
}
template <int R> __device__ __forceinline__ void xn_rows(Frame& F, const Args& A, int m0, int stride, int lane) {
    const GAS f32x4* gr = (const GAS f32x4*)A.in[2] + lane;
    f32x4 v[R][4];
#pragma unroll
    for (int r = 0; r < R; ++r) { const size_t m = (size_t)(m0 + r * stride);
#pragma unroll
        for (int j = 0; j < 4; ++j) v[r][j] = *((const GAS f32x4*)(A.in[0] + m * D) + lane + 64 * j); }
#pragma unroll
    for (int r = 0; r < R; ++r) { const size_t m = (size_t)(m0 + r * stride); float s = 0.f;
#pragma unroll
        for (int j = 0; j < 4; ++j) s += (v[r][j].x * v[r][j].x + v[r][j].y * v[r][j].y) + (v[r][j].z * v[r][j].z + v[r][j].w * v[r][j].w);
        const float rstd = 1.f / sqrtf(wave_sum(s) * (1.f / D) + RMS_EPS);
        GAS unsigned long long* o8 = (GAS unsigned long long*)((bf16*)(F.ws + WS_XN) + m * D) + lane;
#pragma unroll
        for (int j = 0; j < 4; ++j) { const f32x4 gg = gr[64 * j], x = v[r][j];
            o8[64 * j] = (unsigned long long)pk2(x.x * rstd * gg.x, x.y * rstd * gg.y) | ((unsigned long long)pk2(x.z * rstd * gg.z, x.w * rstd * gg.w) << 32); }
    }
}
__device__ __forceinline__ void p0_prologue(Frame& F, const Args& A) {
    int widx = F.gw, nw = F.ngw;
    if (F.G >= 256) { if ((int)blockIdx.x < 128) { ssm_gen(F, A, (int)blockIdx.x >> 3, (int)blockIdx.x & 7); ssm_gen(F, A, ((int)blockIdx.x + 128) >> 3, (int)blockIdx.x & 7); return; }
                      widx = ((int)blockIdx.x - 128) * NWAVES + F.wave; nw = (F.G - 128) * NWAVES; }
    else { for (int u = blockIdx.x; u < NG * 8; u += F.G) ssm_gen(F, A, u >> 3, u & 7); __syncthreads(); }
    LAS float* scr = (LAS float*)(F.lds + RING_OFF + F.wave * P0_SCR);
    constexpr int I_WIN = 16 * 16, I_GLU = 8 * 8, I_WOS = 8 * 16, I_BD = 256, I_WR = 48, I_ROWS = M / 4;
    constexpr int NITEMS = I_WIN + I_GLU + I_WOS + I_BD + I_WR + I_ROWS;
    for (int it = widx; it < NITEMS; it += nw) {
        int r = it; const int lane = opq(hw_lane());
        if (r < I_WIN) { const int kb = r >> 4, nb = r & 15; transpose_item64(A.in[3] + (size_t)kb * 64 * D + nb * 64, D, (bf16*)(F.ws + WS_WIN) + (size_t)nb * 64 * D + kb * 64, D, scr, lane); continue; }
        r -= I_WIN;
        if (r < I_GLU) { const int kb = r >> 3, nb = r & 7; transpose_item64(A.in[14] + (size_t)kb * 64 * DP + nb * 64, DP, (bf16*)(F.ws + WS_GLU) + (size_t)nb * 64 * DP + kb * 64, DP, scr, lane); continue; }
        r -= I_GLU;
        if (r < I_WOS) {
            const int kb = r >> 4, nb = r & 15, k0 = kb * 64;
            transpose_item64(A.in[16] + (size_t)k0 * D + nb * 64, D, (bf16*)(F.ws + WS_WOS) + ((size_t)(k0 >> 8) * D + nb * 64) * 256 + (k0 & 255), 256, scr, lane, A.in[5] + k0); continue; }
        r -= I_WOS;
        if (r < I_BD) {
            const int row = r * 2 + (lane >> 5), c0 = (lane & 31) * 8, gi = row >> 7;
            v4u o = (v4u){0u, 0u, 0u, 0u};
            if ((c0 >> 7) == (gi & 1)) { const f32x4 a = *(const GAS f32x4*)(A.in[4] + (size_t)row * 128 + (c0 & 127)), b = *(const GAS f32x4*)(A.in[4] + (size_t)row * 128 + (c0 & 127) + 4);
                o.x = pk2(a.x, a.y); o.y = pk2(a.z, a.w); o.z = pk2(b.x, b.y); o.w = pk2(b.z, b.w); }
            *(GAS v4u*)((bf16*)(F.ws + WS_BD) + (size_t)row * 256 + c0) = o; continue; }
        r -= I_BD;
        if (r < I_WR) {
            bf16* dh = (bf16*)(F.ws + WS_WR) + (size_t)r * D; bf16* dl = dh + 48 * D;
            for (int dd = lane; dd < D; dd += 64) { float w = 0.f;
                if (r < 4) w = A.in[18][dd * 4 + r]; else if (r < 36) w = A.in[20][((size_t)((r - 4) >> 3) * D + dd) * 8 + ((r - 4) & 7)];
                w *= A.in[17][dd]; const unsigned h = f2bf(w); dh[dd] = (bf16)h; dl[dd] = (bf16)f2bf(w - __builtin_bit_cast(float, h << 16)); }
            continue; }
        r -= I_WR;
        xn_rows<4>(F, A, r, I_ROWS, lane);
    }
}

using pg8::Unit; using pg8::bf16_t; typedef unsigned u32x4 __attribute__((ext_vector_type(4)));
__device__ __forceinline__ u32x4 pack8(const f32x4& a, const f32x4& b) { u32x4 w; w.x = pk2(a[0], a[1]); w.y = pk2(a[2], a[3]); w.z = pk2(b[0], b[1]); w.w = pk2(b[2], b[3]); return w; }
struct EpiZ { static constexpr bool PERM = true, AFTER_DRAIN = false; bf16_t* ZP; bf16_t* AS;
    __device__ __forceinline__ void operator()(const f32x4 (&acc)[2][2][4][2], const Unit& u, int wr, int wc, int fr, int fq) const {
        const int row0 = u.pm * 256 + wr * 64 + fr;
#pragma unroll
        for (int ai = 0; ai < 2; ++ai)
#pragma unroll
            for (int m = 0; m < 4; ++m) { const int r = row0 + ai * 128 + m * 16;
#pragma unroll
                for (int bj = 0; bj < 2; ++bj) { const int col = u.pn * 256 + bj * 128 + wc * 32 + 8 * fq; const u32x4 w = pack8(acc[ai][bj][m][0], acc[ai][bj][m][1]);
                    if (u.pn < 2) *(u32x4*)(ZP + (size_t)r * DP + col) = w;
                    else { const int sc = col - DP, g = sc >> 4, ch0 = sc & 15; *(u32x4*)(AS + ((size_t)(g * NCH + (r >> 4)) * 512 + (r & 15) * 16 + ch0)) = w; } } }
    } };
struct EpiSloc { static constexpr bool PERM = false, AFTER_DRAIN = false; float* C;
    __device__ __forceinline__ void operator()(const f32x4 (&acc)[2][2][4][2], const Unit& u, int wr, int wc, int fr, int fq) const {
        const int row0 = u.pm * 256 + wr * 64 + fr, col0 = wc * 32 + 4 * fq;
#pragma unroll
        for (int ai = 0; ai < 2; ++ai)
#pragma unroll
            for (int m = 0; m < 4; ++m) { float* rowp = C + (size_t)(row0 + ai * 128 + m * 16) * 256 + col0;
#pragma unroll
                for (int bj = 0; bj < 2; ++bj)
#pragma unroll
                    for (int n = 0; n < 2; ++n) *(f32x4*)(rowp + bj * 128 + n * 16) = acc[ai][bj][m][n]; }
    } };
struct EpiY { static constexpr bool PERM = true, AFTER_DRAIN = false; bf16_t* ZZ;
    __device__ __forceinline__ void operator()(const f32x4 (&acc)[2][2][4][2], const Unit& u, int wr, int wc, int fr, int fq) const {
        const int g = u.pn, row0 = (u.pm & 3) * 256 + wr * 64 + fr;
#pragma unroll
        for (int ai = 0; ai < 2; ++ai)
#pragma unroll
            for (int m = 0; m < 4; ++m) { const int c = row0 + ai * 128 + m * 16;
#pragma unroll
                for (int bj = 0; bj < 2; ++bj) { const int col = bj * 128 + wc * 32 + 8 * fq, j = col >> 4, co0 = col & 15;
                    f32x4 a = acc[ai][bj][m][0], b = acc[ai][bj][m][1];
#pragma unroll
                    for (int i = 0; i < 4; ++i) { a[i] = gelu_tanh(a[i]); b[i] = gelu_tanh(b[i]); }
                    *(u32x4*)(ZZ + (size_t)(c * CL + j) * DP + g * GC + co0) = pack8(a, b); asm volatile("" ::: "memory"); } }
    } };
struct EpiGlu { static constexpr bool PERM = true, AFTER_DRAIN = false; const bf16_t* ZZ; const float* bias; bf16_t* CAT;
    __device__ __forceinline__ void operator()(const f32x4 (&acc)[2][2][4][2], const Unit& u, int wr, int wc, int fr, int fq) const {
        const int row0 = u.pm * 256 + wr * 64 + fr;
#pragma unroll
        for (int bj = 0; bj < 2; ++bj) { const int col = u.pn * 256 + bj * 128 + wc * 32 + 8 * fq;
            const f32x4 b0 = *(const f32x4*)(bias + col), b1 = *(const f32x4*)(bias + col + 4);
#pragma unroll
            for (int ai = 0; ai < 2; ++ai)
#pragma unroll
                for (int m = 0; m < 4; ++m) { const int r = row0 + ai * 128 + m * 16;
                    const u32x4 z = *(const u32x4*)(ZZ + (size_t)r * DP + col);
                    f32x4 a = acc[ai][bj][m][0] + b0, b = acc[ai][bj][m][1] + b1;
                    a[0] = bflo(z.x) * sigmoidf_(a[0]); a[1] = bfhi(z.x) * sigmoidf_(a[1]); a[2] = bflo(z.y) * sigmoidf_(a[2]); a[3] = bfhi(z.y) * sigmoidf_(a[3]);
                    b[0] = bflo(z.z) * sigmoidf_(b[0]); b[1] = bfhi(z.z) * sigmoidf_(b[1]); b[2] = bflo(z.w) * sigmoidf_(b[2]); b[3] = bfhi(z.w) * sigmoidf_(b[3]);
                    *(u32x4*)(CAT + (size_t)r * D + DP + col) = pack8(a, b); asm volatile("" ::: "memory"); } }
    } };
struct EpiRes { static constexpr bool PERM = true, AFTER_DRAIN = false; const float* X; float* H; const float* G; bf16_t* V;
    __device__ __forceinline__ void operator()(const f32x4 (&acc)[2][2][4][2], const Unit& u, int wr, int wc, int fr, int fq) const {
        const int row0 = u.pm * 256 + wr * 64 + fr, col0 = u.pn * 256 + wc * 32 + 8 * fq;
        f32x4 gv[2][2];
#pragma unroll
        for (int bj = 0; bj < 2; ++bj)
#pragma unroll
            for (int n = 0; n < 2; ++n) gv[bj][n] = *(const f32x4*)(G + col0 + bj * 128 + 4 * n);
#pragma unroll
        for (int ai = 0; ai < 2; ++ai)
#pragma unroll
            for (int m = 0; m < 4; ++m) { const size_t off = (size_t)(row0 + ai * 128 + m * 16) * D + col0;
#pragma unroll
                for (int bj = 0; bj < 2; ++bj) { const f32x4 h0 = *(const f32x4*)(X + off + bj * 128) + acc[ai][bj][m][0], h1 = *(const f32x4*)(X + off + bj * 128 + 4) + acc[ai][bj][m][1];
                    *(f32x4*)(H + off + bj * 128) = h0; *(f32x4*)(H + off + bj * 128 + 4) = h1;
                    *(u32x4*)(V + off + bj * 128) = pack8(h0 * gv[bj][0], h1 * gv[bj][1]); } }
    } };
struct EpiAct { static constexpr bool PERM = true, AFTER_DRAIN = false; const float* LW; const float* LR; bf16_t* ACT; const volatile LAS unsigned* tstart;
    __device__ __forceinline__ void operator()(const f32x4 (&acc)[2][2][4][2], const Unit& u, int wr, int wc, int fr, int fq) const {
        const int e = u.pn >> 1, lrow0 = (u.pm - (int)tstart[e]) * 256 + wr * 64 + fr, row0 = u.pm * 256 + wr * 64 + fr, col = (u.pn & 1) * 128 + wc * 32 + 8 * fq;
        const float* lw = LW + (size_t)e * M + lrow0; const float* lr = LR + (size_t)e * M + lrow0;
#pragma unroll
        for (int ai = 0; ai < 2; ++ai)
#pragma unroll
            for (int m = 0; m < 4; ++m) { const int ro = ai * 128 + m * 16; const float w = lw[ro], rs = lr[ro];
                f32x4 a, b;
#pragma unroll
                for (int i = 0; i < 4; ++i) { const float g0 = rs * acc[ai][0][m][0][i], g1 = rs * acc[ai][0][m][1][i], sw = rs * w;
                    a[i] = g0 * sigmoidf_(g0) * acc[ai][1][m][0][i] * sw; b[i] = g1 * sigmoidf_(g1) * acc[ai][1][m][1][i] * sw; }
                *(u32x4*)(ACT + (size_t)(row0 + ro) * DF + col) = pack8(a, b); }
    } };
struct EpiDown { static constexpr bool PERM = true, AFTER_DRAIN = false; const int* LIST; const unsigned* cnt; bf16_t* MO0; bf16_t* MO1; const volatile LAS unsigned* tstart;
    __device__ __forceinline__ void operator()(const f32x4 (&acc)[2][2][4][2], const Unit& u, int wr, int wc, int fr, int fq) const {
        const int e = u.pn >> 2, lrow0 = (u.pm - (int)tstart[e]) * 256 + wr * 64 + fr, col0 = (u.pn & 3) * 256 + wc * 32 + 8 * fq;
        const int n_e = (int)__hip_atomic_load(cnt + 64 * e, __ATOMIC_RELAXED, __HIP_MEMORY_SCOPE_AGENT); const int* li = LIST + (size_t)e * M;
#pragma unroll
        for (int ai = 0; ai < 2; ++ai)
#pragma unroll
            for (int m = 0; m < 4; ++m) { const int lr = lrow0 + ai * 128 + m * 16;
                if (lr < n_e) { const int info = li[lr]; bf16_t* dst = ((info & 1) ? MO1 : MO0) + (size_t)(info >> 1) * D + col0;
#pragma unroll
                    for (int bj = 0; bj < 2; ++bj) *(u32x4*)(dst + bj * 128) = pack8(acc[ai][bj][m][0], acc[ai][bj][m][1]); } }
    } };
struct EpiPe { static constexpr bool PERM = true, AFTER_DRAIN = false; bf16_t* O;
    __device__ __forceinline__ void operator()(const f32x4 (&acc)[2][2][4][2], const Unit& u, int wr, int wc, int fr, int fq) const {
        const int row0 = u.pm * 256 + wr * 64 + fr, col0 = u.pn * 256 + wc * 32 + 8 * fq;
#pragma unroll
        for (int ai = 0; ai < 2; ++ai)
#pragma unroll
            for (int m = 0; m < 4; ++m) { bf16_t* rowp = O + (size_t)(row0 + ai * 128 + m * 16) * D + col0;
#pragma unroll
                for (int bj = 0; bj < 2; ++bj) *(u32x4*)(rowp + bj * 128) = pack8(acc[ai][bj][m][0], acc[ai][bj][m][1]); }
    } };
struct EpiGate { static constexpr bool PERM = true, AFTER_DRAIN = false; const float* bias; bf16_t* PE;
    __device__ __forceinline__ void operator()(const f32x4 (&acc)[2][2][4][2], const Unit& u, int wr, int wc, int fr, int fq) const {
        const int row0 = u.pm * 256 + wr * 64 + fr, col0 = u.pn * 256 + wc * 32 + 8 * fq;
        u32x4 pe[2][4][2];
#pragma unroll
        for (int ai = 0; ai < 2; ++ai)
#pragma unroll
            for (int m = 0; m < 4; ++m)
#pragma unroll
                for (int bj = 0; bj < 2; ++bj) pe[ai][m][bj] = *(const u32x4*)(PE + (size_t)(row0 + ai * 128 + m * 16) * D + col0 + bj * 128);
#pragma unroll
        for (int bj = 0; bj < 2; ++bj) { const f32x4 b0 = *(const f32x4*)(bias + col0 + bj * 128), b1 = *(const f32x4*)(bias + col0 + bj * 128 + 4);
#pragma unroll
            for (int ai = 0; ai < 2; ++ai)
#pragma unroll
                for (int m = 0; m < 4; ++m) { const u32x4 z = pe[ai][m][bj]; f32x4 a = acc[ai][bj][m][0] + b0, b = acc[ai][bj][m][1] + b1;
                    a[0] = bflo(z.x) * sigmoidf_(a[0]); a[1] = bfhi(z.x) * sigmoidf_(a[1]); a[2] = bflo(z.y) * sigmoidf_(a[2]); a[3] = bfhi(z.y) * sigmoidf_(a[3]);
                    b[0] = bflo(z.z) * sigmoidf_(b[0]); b[1] = bfhi(z.z) * sigmoidf_(b[1]); b[2] = bflo(z.w) * sigmoidf_(b[2]); b[3] = bfhi(z.w) * sigmoidf_(b[3]);
                    *(u32x4*)(PE + (size_t)(row0 + ai * 128 + m * 16) * D + col0 + bj * 128) = pack8(a, b); } }
    } };

struct GroupOrder { int G, c;
    __device__ __forceinline__ bool next(int i, Unit& u) const { const int L = i * G + c; if (L >= NG * 4) return false; u.pm = L; u.pn = L >> 2; return true; }
    __device__ __forceinline__ void a_ready(const Unit&) const {}
    __device__ __forceinline__ void done(const Unit&) const {} };
struct WeffOrder { int G, c;
    __device__ __forceinline__ bool next(int i, Unit& u) const { const int L = (G >= 256) ? ((i == 0) ? c - 128 : -1) : i * G + c; if (L < 0 || L >= 8) return false; u.pm = L; u.pn = L >> 2; return true; }
    __device__ __forceinline__ void a_ready(const Unit&) const {}
    __device__ __forceinline__ void done(const Unit&) const {} };
struct EpiWeff { static constexpr bool PERM = true, AFTER_DRAIN = false; bf16_t* O;
    __device__ __forceinline__ void operator()(const f32x4 (&acc)[2][2][4][2], const Unit& u, int wr, int wc, int fr, int fq) const {
        const int row0 = (u.pm & 3) * 256 + wr * 64 + fr, col0 = u.pn * 256 + wc * 32 + 8 * fq;
#pragma unroll
        for (int ai = 0; ai < 2; ++ai)
#pragma unroll
            for (int m = 0; m < 4; ++m) { bf16_t* rowp = O + (size_t)(row0 + ai * 128 + m * 16) * D + col0;
#pragma unroll
                for (int bj = 0; bj < 2; ++bj) *(u32x4*)(rowp + bj * 128) = pack8(acc[ai][bj][m][0], acc[ai][bj][m][1]); }
    } };
template <int NSUB> struct ExpertOrder { int G, c; const volatile LAS unsigned* tstart;
    __device__ __forceinline__ bool next(int i, Unit& u) const {
        const int L = i * G + c, tau = L / NSUB, sub = L % NSUB; if (tau >= __builtin_amdgcn_readfirstlane((int)tstart[NEXP])) return false;
        int e = 0;
        for (int k = 1; k < NEXP; ++k) e += ((int)tstart[k] <= tau) ? 1 : 0;
        e = __builtin_amdgcn_readfirstlane(e);
        u.pm = tau; u.pn = e * NSUB + sub; return true; }
    __device__ __forceinline__ void a_ready(const Unit&) const {}
    __device__ __forceinline__ void done(const Unit&) const {} };

__device__ __forceinline__ void carry_unit(Frame& F, int unit) {
    const int d = unit & 1, g = (unit >> 1) & 31, b = unit >> 6, n = opq(hw_lane()), s = F.wave;
    const float* lt = (const float*)(F.ws + WS_LAMT) + ((g * 2 + d) * 64 + n) * 4;
    const float l16r = lt[0], l16i = lt[1], lkr = lt[2], lki = lt[3];
    const float* SL = (const float*)(F.ws + WS_SLOC) + (size_t)(g * NCH + b * 512) * 256 + d * 128 + n;
    bf16* AS = (bf16*)(F.ws + WS_AS) + (size_t)(g * NCH + b * 512) * 512 + 256 + d * 128 + n;
    LAS float* segE = (LAS float*)(F.lds + RING_OFF);
    float er = 0.f, ei = 0.f;
    for (int i0 = 0; i0 < 64; i0 += 16) {
        float sr[16], si[16];
#pragma unroll
        for (int ii = 0; ii < 16; ++ii) { const int i = s * 64 + i0 + ii, c = d ? (511 - i) : i; sr[ii] = SL[(size_t)c * 256]; si[ii] = SL[(size_t)c * 256 + 64]; }
#pragma unroll
        for (int ii = 0; ii < 16; ++ii) { const float tr = l16r * er - l16i * ei + sr[ii], ti = l16r * ei + l16i * er + si[ii]; er = tr; ei = ti; }
    }
    __syncthreads();
    segE[(s * 64 + n) * 2] = er; segE[(s * 64 + n) * 2 + 1] = ei;
    __syncthreads();
    float xr = 0.f, xi = 0.f;
    for (int sp = 0; sp < s; ++sp) { const float pr = segE[(sp * 64 + n) * 2], pi = segE[(sp * 64 + n) * 2 + 1];
        const float tr = lkr * xr - lki * xi + pr, ti = lkr * xi + lki * xr + pi; xr = tr; xi = ti; }
    for (int i0 = 0; i0 < 64; i0 += 16) {
        float sr[16], si[16];
#pragma unroll
        for (int ii = 0; ii < 16; ++ii) { const int i = s * 64 + i0 + ii, c = d ? (511 - i) : i; sr[ii] = SL[(size_t)c * 256]; si[ii] = SL[(size_t)c * 256 + 64]; }
#pragma unroll
        for (int ii = 0; ii < 16; ++ii) { const int i = s * 64 + i0 + ii, c = d ? (511 - i) : i;
            AS[(size_t)c * 512] = (bf16)f2bf(xr); AS[(size_t)c * 512 + 64] = (bf16)f2bf(xi);
            const float tr = l16r * xr - l16i * xi + sr[ii], ti = l16r * xi + l16i * xr + si[ii]; xr = tr; xi = ti; }
    }
    __syncthreads();
}
__device__ __forceinline__ void diff_row(Frame& F, int m) {
    const int t = m & (SEQ - 1), lane = opq(hw_lane()), h = 1 << (lane >> 4), lo = max(t - h, 0), hi = min(t + h, SEQ);
    const bf16* ZP = (const bf16*)(F.ws + WS_ZP) + (size_t)(m - t) * DP + lane * 8;
    float acc[8];
#pragma unroll
    for (int i = 0; i < 8; ++i) acc[i] = 0.f;
    v4u zt = (v4u){0u, 0u, 0u, 0u};
    v4u zz[16];
#pragma unroll
    for (int k = 0; k < 16; ++k) { const int s = t - 8 + k, sc = (s >= lo && s < hi) ? s : t; zz[k] = *(const GAS v4u*)(ZP + (size_t)sc * DP); }
#pragma unroll
    for (int k = 0; k < 16; ++k) { const int s = t - 8 + k; const float f = (s >= lo && s < hi) ? 1.f : 0.f; const v4u z = zz[k];
        acc[0] += f * bflo(z.x); acc[1] += f * bfhi(z.x); acc[2] += f * bflo(z.y); acc[3] += f * bfhi(z.y); acc[4] += f * bflo(z.z); acc[5] += f * bfhi(z.z); acc[6] += f * bflo(z.w); acc[7] += f * bfhi(z.w);
        if (k == 8) zt = z; }
    const float inv = 1.0f / (float)(hi - lo);
    v4u o; o.x = pk2(acc[0] * inv - bflo(zt.x), acc[1] * inv - bfhi(zt.x)); o.y = pk2(acc[2] * inv - bflo(zt.y), acc[3] * inv - bfhi(zt.y));
    o.z = pk2(acc[4] * inv - bflo(zt.z), acc[5] * inv - bfhi(zt.z)); o.w = pk2(acc[6] * inv - bflo(zt.w), acc[7] * inv - bfhi(zt.w));
    *(GAS v4u*)((bf16*)(F.ws + WS_CAT) + (size_t)m * D + lane * 8) = o;
#if MK_STAGE == 1
    *(GAS v4u*)((bf16*)(F.ws + WS_CAT) + (size_t)m * D + DP + lane * 8) = (v4u){0u, 0u, 0u, 0u};
#endif
}
__device__ __forceinline__ void route_phase(Frame& F, const Args& A) {
    typedef short s8v __attribute__((ext_vector_type(8)));
    const int lane = opq(hw_lane()), tok = lane & 15, kq = lane >> 4, w = F.wave, t = w * 64 + lane;
    s8v ah[4][3], al[4][3];
    { const bf16* wh = (const bf16*)(F.ws + WS_WR) + (size_t)tok * D + 128 * w + 8 * kq; const bf16* wl = wh + 48 * D;
#pragma unroll
      for (int sk = 0; sk < 4; ++sk)
#pragma unroll
          for (int q = 0; q < 3; ++q) { ah[sk][q] = *(const GAS s8v*)(wh + (size_t)q * 16 * D + 32 * sk); al[sk][q] = *(const GAS s8v*)(wl + (size_t)q * 16 * D + 32 * sk); } }
    LAS float* P = (LAS float*)(F.lds + RING_OFF);
    LAS float* R = P + 8 * 16 * 52;
    const int cid = (int)blockIdx.x, nit = M / 16;
    f32x4 hc[4][2];
    if (cid < nit) { const float* hrow = F.out + (size_t)(cid * 16 + tok) * D + 128 * w + 8 * kq;
#pragma unroll
        for (int sk = 0; sk < 4; ++sk) { hc[sk][0] = *(const GAS f32x4*)(hrow + 32 * sk); hc[sk][1] = *(const GAS f32x4*)(hrow + 32 * sk + 4); } }
    for (int it = cid; it < nit; it += F.G) {
        f32x4 hn[4][2];
        const bool more = it + F.G < nit;
        if (more) { const float* hrow = F.out + (size_t)((it + F.G) * 16 + tok) * D + 128 * w + 8 * kq;
#pragma unroll
            for (int sk = 0; sk < 4; ++sk) { hn[sk][0] = *(const GAS f32x4*)(hrow + 32 * sk); hn[sk][1] = *(const GAS f32x4*)(hrow + 32 * sk + 4); } }
        f32x4 acc[3]; acc[0] = (f32x4){0.f, 0.f, 0.f, 0.f}; acc[1] = acc[0]; acc[2] = acc[0];
        float ssq = 0.f;
#pragma unroll
        for (int sk = 0; sk < 4; ++sk) {
            const f32x4 h0 = hc[sk][0], h1 = hc[sk][1];
            ssq += (h0.x * h0.x + h0.y * h0.y) + (h0.z * h0.z + h0.w * h0.w) + (h1.x * h1.x + h1.y * h1.y) + (h1.z * h1.z + h1.w * h1.w);
            const float hv[8] = {h0.x, h0.y, h0.z, h0.w, h1.x, h1.y, h1.z, h1.w};
            s8v bh, bl;
#pragma unroll
            for (int j = 0; j < 8; ++j) { const unsigned hb = f2bf(hv[j]); bh[j] = (short)hb; bl[j] = (short)f2bf(hv[j] - __builtin_bit_cast(float, hb << 16)); }
#pragma unroll
            for (int q = 0; q < 3; ++q) {
                acc[q] = __builtin_amdgcn_mfma_f32_16x16x32_bf16(ah[sk][q], bh, acc[q], 0, 0, 0);
                acc[q] = __builtin_amdgcn_mfma_f32_16x16x32_bf16(ah[sk][q], bl, acc[q], 0, 0, 0);
                acc[q] = __builtin_amdgcn_mfma_f32_16x16x32_bf16(al[sk][q], bh, acc[q], 0, 0, 0);
            }
        }
        LAS float* Pw = P + w * (16 * 52) + tok * 52;
#pragma unroll
        for (int q = 0; q < 3; ++q)
#pragma unroll
            for (int r = 0; r < 4; ++r) Pw[16 * q + 4 * kq + r] = acc[q][r];
        Pw[48 + kq] = ssq;
        __syncthreads();
#pragma unroll
        for (int i2 = 0; i2 < 2; ++i2) { const int idx = t + 512 * i2;
            if (idx < 16 * 52) { float sum = 0.f;
#pragma unroll
                for (int ww = 0; ww < 8; ++ww) sum += P[ww * (16 * 52) + idx];
                R[idx] = sum; } }
        __syncthreads();
        if (w == 0 && lane < 16) {
            const LAS float* tr = R + lane * 52; const int m = it * 16 + lane;
            const float rstd = 1.f / sqrtf(((tr[48] + tr[49]) + (tr[50] + tr[51])) * (1.f / D) + RMS_EPS);
            float gl[4];
#pragma unroll
            for (int k = 0; k < 4; ++k) gl[k] = rstd * tr[k] + A.in[19][k];
            int gsel = 0; float gmax = gl[0];
#pragma unroll
            for (int k = 1; k < 4; ++k) if (gl[k] > gmax) { gmax = gl[k]; gsel = k; }
            float gden = 0.f;
#pragma unroll
            for (int k = 0; k < 4; ++k) gden += __expf(gl[k] - gmax);
            const float grp_p = 1.0f / gden;
            float el[8];
#pragma unroll
            for (int e = 0; e < 8; ++e) el[e] = rstd * tr[4 + gsel * 8 + e] + A.in[21][gsel * 8 + e];
            int i1 = 0; float m1 = el[0];
#pragma unroll
            for (int e = 1; e < 8; ++e) if (el[e] > m1) { m1 = el[e]; i1 = e; }
            int i2 = -1; float m2 = -3.0e38f;
#pragma unroll
            for (int e = 0; e < 8; ++e) if (e != i1 && el[e] > m2) { m2 = el[e]; i2 = e; }
            const float rr = __expf(m2 - m1), w1 = grp_p / (1.0f + rr), w2 = grp_p * rr / (1.0f + rr);
            const int e1 = gsel * 8 + i1, e2 = gsel * 8 + i2;
            const unsigned p1 = __hip_atomic_fetch_add((unsigned*)(F.ctl + CW_CNT) + 64 * e1, 1u, RLX_AGENT), p2 = __hip_atomic_fetch_add((unsigned*)(F.ctl + CW_CNT) + 64 * e2, 1u, RLX_AGENT);
            int* LI = (int*)(F.ws + WS_LIST); float* LW = (float*)(F.ws + WS_LISTW); float* LR = (float*)(F.ws + WS_LISTR);
            LI[(size_t)e1 * M + p1] = 2 * m; LW[(size_t)e1 * M + p1] = w1; LR[(size_t)e1 * M + p1] = rstd;
            LI[(size_t)e2 * M + p2] = 2 * m + 1; LW[(size_t)e2 * M + p2] = w2; LR[(size_t)e2 * M + p2] = rstd;
        }
        if (more) {
#pragma unroll
            for (int sk = 0; sk < 4; ++sk) { hc[sk][0] = hn[sk][0]; hc[sk][1] = hn[sk][1]; } }
    }
    __syncthreads();
}
template <class Sched> __device__ __forceinline__ void expert_setup(Frame& F, const Sched& S) {
    if (F.wave == 0 && hw_lane() == 0) { unsigned acc = 0u;
        for (int e = 0; e < NEXP; ++e) { F.MISC[16 + e] = acc; acc += (__hip_atomic_load((unsigned*)(F.ctl + CW_CNT) + 64 * e, RLX_AGENT) + 255u) >> 8; }
        F.MISC[16 + NEXP] = acc; }
    __syncthreads();
    const int t = opq(F.wave * 64 + hw_lane());
    LAS unsigned* ro = (LAS unsigned*)(F.lds + ROWOFF_OFF);
    for (int i = 0; i < 4; ++i) { Unit u; if (!S.next(i, u)) break;
        const int e = u.pn >> 1, idx = ((int)u.pm - (int)F.MISC[16 + e]) * 256 + (t & 255), n_e = (int)__hip_atomic_load((unsigned*)(F.ctl + CW_CNT) + 64 * e, RLX_AGENT);
        if (t < 256) ro[i * 256 + t] = (idx < n_e) ? (unsigned)(((const int*)(F.ws + WS_LIST))[(size_t)e * M + idx] >> 1) * (unsigned)(D * 2) : 0u; }
    __syncthreads();
}
template <int R> __device__ __forceinline__ void moe_combine_rows(Frame& F, const Args& A, int m0, int stride) {
    const int lane = opq(hw_lane());
    const GAS f32x4* gr = (const GAS f32x4*)A.in[25] + lane;
    f32x4 v[R][4]; v2u a[R][4], b[R][4];
#pragma unroll
    for (int r = 0; r < R; ++r) { const size_t m = (size_t)(m0 + r * stride);
#pragma unroll
        for (int j = 0; j < 4; ++j) { v[r][j] = *((const GAS f32x4*)(F.out + m * D) + lane + 64 * j);
            a[r][j] = *((const GAS v2u*)((const bf16*)(F.ws + WS_MO0) + m * D) + lane + 64 * j); b[r][j] = *((const GAS v2u*)((const bf16*)(F.ws + WS_MO1) + m * D) + lane + 64 * j); } }
#pragma unroll
    for (int r = 0; r < R; ++r) { const size_t m = (size_t)(m0 + r * stride); float s = 0.f;
        GAS f32x4* hr = (GAS f32x4*)(F.out + m * D) + lane; GAS unsigned long long* o8 = (GAS unsigned long long*)((bf16*)(F.ws + WS_XN) + m * D) + lane;
#pragma unroll
        for (int j = 0; j < 4; ++j) { f32x4& x = v[r][j];
            x.x += bflo(a[r][j].x) + bflo(b[r][j].x); x.y += bfhi(a[r][j].x) + bfhi(b[r][j].x); x.z += bflo(a[r][j].y) + bflo(b[r][j].y); x.w += bfhi(a[r][j].y) + bfhi(b[r][j].y);
            hr[64 * j] = x; s += (x.x * x.x + x.y * x.y) + (x.z * x.z + x.w * x.w); }
        const float rstd = 1.f / sqrtf(wave_sum(s) * (1.f / D) + RMS_EPS);
#pragma unroll
        for (int j = 0; j < 4; ++j) { const f32x4 gg = gr[64 * j], x = v[r][j];
            o8[64 * j] = (unsigned long long)pk2(x.x * rstd * gg.x, x.y * rstd * gg.y) | ((unsigned long long)pk2(x.z * rstd * gg.z, x.w * rstd * gg.w) << 32); } }
}
template <int R, bool ADDG> __device__ __forceinline__ void final_rows(Frame& F, const Args& A, int m0, int stride) {
    const int lane = opq(hw_lane());
    const GAS f32x4* gr = (const GAS f32x4*)A.in[29] + lane;
    f32x4 v[R][4]; v2u gg[R][4];
#pragma unroll
    for (int r = 0; r < R; ++r) { const size_t m = (size_t)(m0 + r * stride);
#pragma unroll
        for (int j = 0; j < 4; ++j) { v[r][j] = *((const GAS f32x4*)(F.out + m * D) + lane + 64 * j);
            if (ADDG) gg[r][j] = *((const GAS v2u*)((const bf16*)(F.ws + WS_PE) + m * D) + lane + 64 * j); } }
#pragma unroll
    for (int r = 0; r < R; ++r) { const size_t m = (size_t)(m0 + r * stride); float s = 0.f;
        GAS f32x4* hr = (GAS f32x4*)(F.out + m * D) + lane;
#pragma unroll
        for (int j = 0; j < 4; ++j) { f32x4& x = v[r][j];
            if (ADDG) { x.x += bflo(gg[r][j].x); x.y += bfhi(gg[r][j].x); x.z += bflo(gg[r][j].y); x.w += bfhi(gg[r][j].y); }
            s += (x.x * x.x + x.y * x.y) + (x.z * x.z + x.w * x.w); }
        const float rstd = 1.f / sqrtf(wave_sum(s) * (1.f / D) + RMS_EPS);
#pragma unroll
        for (int j = 0; j < 4; ++j) hr[64 * j] = v[r][j] * rstd * gr[64 * j]; }
}

__global__ void __launch_bounds__(NWAVES * 64, 2) mk_fwd(Args args) {
    extern __shared__ __attribute__((aligned(16))) unsigned char lds[];
    Frame F;
    F.lds = (LAS unsigned char*)lds;
    F.MISC = (volatile LAS unsigned*)(F.lds + MISC_OFF);
    F.wave = __builtin_amdgcn_readfirstlane(threadIdx.x >> 6);
    F.G = gridDim.x; F.gw = blockIdx.x * NWAVES + F.wave; F.ngw = F.G * NWAVES;
    F.out = args.out; F.ws = args.ws; F.ctl = (gu32*)(args.ws + WS_CTL);
    for (int u = threadIdx.x; u < (LDS_BYTES - LDSCTL_OFF) / 4; u += NWAVES * 64) ((LAS unsigned*)(F.lds + LDSCTL_OFF))[u] = 0u;
    __syncthreads();
    XcdBarrier bar = xcd_barrier_post((unsigned*)(F.ctl + CW_BAR), F.MISC + 8); bar.wave = F.wave;
#define GRID_BAR() xcd_barrier(bar)
    bf16* const WIN = (bf16*)(F.ws + WS_WIN); bf16* const GLU = (bf16*)(F.ws + WS_GLU); bf16* const WCAT = (bf16*)(F.ws + WS_WCAT); bf16* const WG = (bf16*)(F.ws + WS_WG); bf16* const WPLE = (bf16*)(F.ws + WS_WPLE);
    bf16* const WGU = (bf16*)(F.ws + WS_WGU); bf16* const WD = (bf16*)(F.ws + WS_WD); bf16* const MS = (bf16*)(F.ws + WS_MS); bf16* const WS3 = (bf16*)(F.ws + WS_WS3);
    bf16* const XN = (bf16*)(F.ws + WS_XN); bf16* const ZP = (bf16*)(F.ws + WS_ZP); bf16* const AS = (bf16*)(F.ws + WS_AS); float* const SLOC = (float*)(F.ws + WS_SLOC);
    bf16* const CAT = (bf16*)(F.ws + WS_CAT); bf16* const ZZ = (bf16*)(F.ws + WS_ZZ); bf16* const PB = (bf16*)(F.ws + WS_PB); bf16* const PE = (bf16*)(F.ws + WS_PE);
    bf16* const ACT = (bf16*)(F.ws + WS_ACT); bf16* const MO0 = (bf16*)(F.ws + WS_MO0); bf16* const MO1 = (bf16*)(F.ws + WS_MO1);
    const int cid = (int)blockIdx.x;

#ifndef MK_REP
#define MK_REP -1
#endif
#define REP(k) for (int rep_ = 0; rep_ < ((MK_REP == (k)) ? 2 : 1); ++rep_)
    REP(0) { p0_prologue(F, args);
    GRID_BAR(); }
    REP(1) { pg8::Gemm g{XN, WIN, D, D, D}; pg8::StaticOrder S; S.init(M, D, F.G, cid); EpiZ E{ZP, AS};
      pg8::gemm_phase<EpiZ, pg8::StaticOrder, true, true>(F.lds + RING_OFF, g, S, E, F.wave);
    GRID_BAR(); }
#if MK_STAGE >= 2
    { pg8::Gemm g{AS, MS, 256, 512, 256}; GroupOrder S{F.G, cid}; EpiSloc E{SLOC};
      pg8::gemm_phase<EpiSloc, GroupOrder, true, true>(F.lds + RING_OFF, g, S, E, F.wave); }
    { pg8::Gemm g{(const bf16*)(F.ws + WS_WOS), (const bf16*)(F.ws + WS_BD), 256, 256, 256}; WeffOrder S{F.G, cid}; EpiWeff E{WCAT};
      pg8::gemm_phase<EpiWeff, WeffOrder, true, true>(F.lds + RING_OFF, g, S, E, F.wave); }
    bg_range(F, args, 0, 900, 0, 0);
    GRID_BAR();
#endif
    REP(3) {
#if MK_STAGE >= 2
        if (F.G >= 256) { if (cid < 128) { carry_unit(F, cid); for (int m = 12288 + cid * NWAVES + F.wave; m < M; m += 128 * NWAVES) diff_row(F, m); }
                          else for (int m = (cid - 128) * NWAVES + F.wave; m < 12288; m += (F.G - 128) * NWAVES) diff_row(F, m); }
        else { for (int u = cid; u < 128; u += F.G) carry_unit(F, u); for (int m = F.gw; m < M; m += F.ngw) diff_row(F, m); }
#else
        for (int m = F.gw; m < M; m += F.ngw) diff_row(F, m);
#endif
    GRID_BAR(); }
#if MK_STAGE >= 2
    { pg8::Gemm g{AS, WS3, 512, 512, 512}; GroupOrder S{F.G, cid}; EpiY E{ZZ};
      pg8::gemm_phase<EpiY, GroupOrder, true, true>(F.lds + RING_OFF, g, S, E, F.wave); }
    bg_range(F, args, 900, 4400, 0, M / 2);
    GRID_BAR();
    { pg8::Gemm g{ZZ, GLU, DP, DP, DP}; pg8::StaticOrder S; S.init(M, DP, F.G, cid); EpiGlu E{ZZ, args.in[15], CAT};
      pg8::gemm_phase<EpiGlu, pg8::StaticOrder, true, true>(F.lds + RING_OFF, g, S, E, F.wave); }
    bg_range(F, args, 4400, BG_TOTAL, M / 2, M);
    GRID_BAR();
#endif
    { pg8::Gemm g{CAT, WCAT, D, D, D}; pg8::StaticOrder S; S.init(M, D, F.G, cid); EpiRes E{args.in[0], F.out, args.in[17], XN};
      pg8::gemm_phase<EpiRes, pg8::StaticOrder, true, true>(F.lds + RING_OFF, g, S, E, F.wave); }
    GRID_BAR();
#if MK_STAGE >= 3
    route_phase(F, args);
    GRID_BAR();
    { pg8::Gemm g{XN, WGU, D, D, D}; ExpertOrder<2> S{F.G, cid, F.MISC + 16}; expert_setup(F, S);
      EpiAct E{(const float*)(F.ws + WS_LISTW), (const float*)(F.ws + WS_LISTR), ACT, F.MISC + 16};
      pg8::gemm_phase<EpiAct, ExpertOrder<2>, true, true, true>(F.lds + RING_OFF, g, S, E, F.wave, (const LAS unsigned*)(F.lds + ROWOFF_OFF)); }
    GRID_BAR();
    { pg8::Gemm g{ACT, WD, DF, DF, DF}; ExpertOrder<4> S{F.G, cid, F.MISC + 16}; EpiDown E{(const int*)(F.ws + WS_LIST), (const unsigned*)(F.ctl + CW_CNT), MO0, MO1, F.MISC + 16};
      pg8::gemm_phase<EpiDown, ExpertOrder<4>, true, true>(F.lds + RING_OFF, g, S, E, F.wave); }
    GRID_BAR();
    for (int m = F.gw; m + F.ngw < M; m += 2 * F.ngw) moe_combine_rows<2>(F, args, m, F.ngw);
    GRID_BAR();
#endif
#if MK_STAGE >= 4
    { pg8::Gemm g{PB, WPLE, DPLE, DPLE, DPLE}; pg8::StaticOrder S; S.init(M, D, F.G, cid); EpiPe E{PE};
      pg8::gemm_phase<EpiPe, pg8::StaticOrder, true, true>(F.lds + RING_OFF, g, S, E, F.wave); }
    GRID_BAR();
    { pg8::Gemm g{XN, WG, D, D, D}; pg8::StaticOrder S; S.init(M, D, F.G, cid); EpiGate E{args.in[27], PE};
      pg8::gemm_phase<EpiGate, pg8::StaticOrder, true, true>(F.lds + RING_OFF, g, S, E, F.wave); }
    GRID_BAR();
#endif
    for (int m = F.gw; m + 3 * F.ngw < M; m += 4 * F.ngw) final_rows<4, (MK_STAGE >= 4)>(F, args, m, F.ngw);
}

extern "C" void kernel_launch(void* const* d_in, const int* in_sizes, int n_in, void* d_out, int out_size, void* d_ws, size_t ws_size, hipStream_t stream) {
    static int grid = 0;
    if (grid == 0) {
        if (n_in != 30 || in_sizes[0] != M * D || out_size != M * D || ws_size < WS_END) { fprintf(stderr, "kernel_launch: unexpected shapes (n_in %d, in0 %d, out %d, ws %zu)\n", n_in, n_in > 0 ? in_sizes[0] : -1, out_size, ws_size); grid = -1; return; }
        int dev = 0, cus = 0, per_cu = 0;
        if (hipGetDevice(&dev) != hipSuccess || hipDeviceGetAttribute(&cus, hipDeviceAttributeMultiprocessorCount, dev) != hipSuccess) { grid = -1; return; }
        if (hipFuncSetAttribute((const void*)mk_fwd, hipFuncAttributeMaxDynamicSharedMemorySize, LDS_BYTES) != hipSuccess) { fprintf(stderr, "kernel_launch: hipFuncSetAttribute failed\n"); grid = -1; return; }
        if (hipOccupancyMaxActiveBlocksPerMultiprocessor(&per_cu, (const void*)mk_fwd, NWAVES * 64, LDS_BYTES) != hipSuccess || per_cu < 1) { fprintf(stderr, "kernel_launch: occupancy query reports %d blocks per CU\n", per_cu); }
        (void)hipGetLastError();
        grid = cus;
    }
    if (grid < 0) return;
    (void)hipMemsetAsync((char*)d_ws + WS_CTL, 0, CTL_ZERO_BYTES, stream);
    Args a{};
    for (int i = 0; i < 30; ++i) a.in[i] = (const float*)d_in[i];
    a.out = (float*)d_out; a.ws = (unsigned char*)d_ws;
    hipLaunchKernelGGL(mk_fwd, dim3(grid), dim3(NWAVES * 64), LDS_BYTES, stream, a);
}
```

```cpp
#include <hip/hip_runtime.h>
#include <cstdio>
#include <cstdint>
__device__ __forceinline__ int hw_lane() { int l; asm volatile("v_mbcnt_lo_u32_b32 %0, -1, 0\n\tv_mbcnt_hi_u32_b32 %0, -1, %0" : "=v"(l)); return l; }
namespace pg8 {
#define PG8_LAS __attribute__((address_space(3)))
typedef unsigned short bf16_t;
typedef short bf16x8 __attribute__((ext_vector_type(8)));
typedef float f32x4 __attribute__((ext_vector_type(4)));
typedef unsigned u32x4 __attribute__((ext_vector_type(4)));
constexpr int BM = 256, BK = 64, HALF = 128, HTB = HALF * BK * 2  , STAGE_BYTES = 8 * HTB, NXCD = 8, WGM = 8;

__host__ __device__ __forceinline__ int lds_byte(int r, int c) { const int st = (r >> 4) * 2 + (c >> 5), rr = r & 15, cc = c & 31, ob = rr * 64 + cc * 2; return st * 1024 + (ob ^ (((ob >> 9) & 1) << 5)); }
__host__ __device__ __forceinline__ void stage_rc(int b, int& R, int& C) { const int st = b / 1024, sb = b % 1024, swz = sb ^ (((sb >> 9) & 1) << 5); R = (st >> 1) * 16 + swz / 64; C = (st & 1) * 32 + (swz % 64) / 2; }
__host__ __device__ __forceinline__ int perm32(int rho) { const int n = rho >> 4, i = rho & 15; return 8 * (i >> 2) + 4 * n + (i & 3); }

struct Unit { int pm, pn, nv; };
struct Gemm { const bf16_t* A; const bf16_t* Bt; int K, lda, ldb; };

struct StaticOrder {
    int nM, nN, nwg, G, c;
    __host__ __device__ void init(int M, int N, int G_, int c_) { nM = M / BM; nN = N / BM; nwg = nM * nN; G = G_; c = c_; }
    __host__ __device__ bool next(int i, Unit& u) const {
        const long L = (long)i * G + c; if (L >= nwg) return false;
        int wgid = (int)L; { const int q = nwg / NXCD, r = nwg % NXCD, xcd = wgid % NXCD, off = wgid / NXCD; wgid = (xcd < r ? xcd * (q + 1) : r * (q + 1) + (xcd - r) * q) + off; }
        const int nig = WGM * nN, gid = wgid / nig, fm = gid * WGM, gsz = (nM - fm) < WGM ? (nM - fm) : WGM;
        u.pm = fm + ((wgid % nig) % gsz); u.pn = (wgid % nig) / gsz; u.nv = 256; return true;
    }
    __device__ __forceinline__ void a_ready(const Unit&) const {}
    __device__ __forceinline__ void done(const Unit&) const {}
};

template <class Epi, class Sched, bool ALIGN_EPI = false, bool SP2 = false, bool GATHER = false, bool SKIP = false>
__device__ __forceinline__ void gemm_phase(PG8_LAS unsigned char* lds, const Gemm g, const Sched& S, const Epi& E, const int wid  , const PG8_LAS unsigned* rowoff = nullptr) {
    static_assert(!GATHER || SP2, "GATHER is written for the SP2 loop");
    int lane_ = hw_lane(); asm volatile("" : "+v"(lane_));
    const int lane = lane_, tid = wid * 64 + lane, wr = wid >> 2, wc = wid & 3, fr = lane & 15, fq = lane >> 4;
    const int K = g.K, nt = K / BK;
    unsigned voffA[2], voffB[2];
#pragma unroll
    for (int i = 0; i < 2; ++i) { int R, C; stage_rc(tid * 16 + i * 8192, R, C); const int Rb = Epi::PERM ? ((R & ~31) + perm32(R & 31)) : R;
        voffA[i] = (unsigned)(R * g.lda + C) * 2u; voffB[i] = (unsigned)(Rb * g.ldb + C) * 2u; }
    const size_t kstep = (size_t)(BK * 2);
    const size_t hstepA = GATHER ? (size_t)0 : (size_t)HALF * g.lda * 2, hstepB = (size_t)HALF * g.ldb * 2;
    const size_t tstepA = 2 * hstepA, tstepB = 2 * hstepB;
    const unsigned ldsw = (unsigned)wid * 1024u;
    const int aoff = lds_byte(wr * 64 + fr, fq * 8), boff = lds_byte(wc * 32 + fr, fq * 8);
    unsigned cvo[2][2];
#define PG8_LOADVO(dst, u_) do { _Pragma("unroll") for (int _h = 0; _h < 2; ++_h) _Pragma("unroll") for (int _i = 0; _i < 2; ++_i) { int R_, C_; stage_rc(tid * 16 + _i * 8192, R_, C_); \
        dst[_h][_i] = rowoff[(u_) * 256 + _h * 128 + R_] + (unsigned)C_ * 2u; } } while (0)
#define PG8_VA(h) (GATHER ? cvo[h] : voffA)
#define PG8_SA(b, h) (((b) * 2 + (h)) * HTB)
#define PG8_SB(b, h) ((4 + (b) * 2 + (h)) * HTB)
#define PG8_STAGE(bufoff, gbase, voff) do { _Pragma("unroll") for (int _i = 0; _i < 2; ++_i) \
        __builtin_amdgcn_global_load_lds((const unsigned*)((const char*)(gbase) + (voff)[_i]), (PG8_LAS unsigned*)(lds + (bufoff) + ldsw + _i * 8192), 16, 0, 0); } while (0)
#define PG8_LDA(dst, b, h) do { _Pragma("unroll") for (int m = 0; m < 4; ++m) _Pragma("unroll") for (int k = 0; k < 2; ++k) dst[m][k] = *(const PG8_LAS bf16x8*)(lds + PG8_SA(b, h) + aoff + m * 2048 + k * 1024); } while (0)
#define PG8_LDB(dst, b, h) do { _Pragma("unroll") for (int n = 0; n < 2; ++n) _Pragma("unroll") for (int k = 0; k < 2; ++k) dst[n][k] = *(const PG8_LAS bf16x8*)(lds + PG8_SB(b, h) + boff + n * 2048 + k * 1024); } while (0)
#define PG8_MMA(ai, bj, At, Bt) do { if (SKIP && (ai) * HALF + wr * 64 >= cur.nv) break; __builtin_amdgcn_s_setprio(1); _Pragma("unroll") for (int m = 0; m < 4; ++m) _Pragma("unroll") for (int n = 0; n < 2; ++n) _Pragma("unroll") for (int k = 0; k < 2; ++k) \
        acc[ai][bj][m][n] = __builtin_amdgcn_mfma_f32_16x16x32_bf16(Bt[n][k], At[m][k], acc[ai][bj][m][n], 0, 0, 0); __builtin_amdgcn_s_setprio(0); } while (0)
#define PG8_WAIT_V(n) asm volatile("s_waitcnt vmcnt(" #n ")" ::: "memory")
#define PG8_WAIT_L(n) asm volatile("s_waitcnt lgkmcnt(" #n ")" ::: "memory")
#define PG8_BAR __builtin_amdgcn_s_barrier()
#define PG8_SCHED __builtin_amdgcn_sched_barrier(0)
    Unit cur, nxt; int ui = 0;
    if (!S.next(0, cur)) return;
    f32x4 acc[2][2][4][2];
#pragma unroll
    for (int a = 0; a < 2; ++a)
#pragma unroll
        for (int b = 0; b < 2; ++b)
#pragma unroll
            for (int m = 0; m < 4; ++m)
#pragma unroll
                for (int n = 0; n < 2; ++n) acc[a][b][m][n] = (f32x4){0.f, 0.f, 0.f, 0.f};
    bf16x8 At[4][2], B0[2][2], B1[2][2];
    const char* cA = (const char*)g.A + (size_t)cur.pm * tstepA; const char* cB = (const char*)g.Bt + (size_t)cur.pn * tstepB;
    S.a_ready(cur);
    if constexpr (GATHER) PG8_LOADVO(cvo, 0);
    if constexpr (SP2) {
        PG8_STAGE(PG8_SB(0, 0), cB, voffB); PG8_STAGE(PG8_SB(0, 1), cB + hstepB, voffB); PG8_STAGE(PG8_SA(0, 0), cA, PG8_VA(0)); PG8_STAGE(PG8_SA(0, 1), cA + hstepA, PG8_VA(1));
        if (wr == 1) PG8_BAR;
        PG8_WAIT_V(2); PG8_BAR;
        PG8_STAGE(PG8_SB(1, 0), cB + kstep, voffB); PG8_STAGE(PG8_SA(1, 0), cA + kstep, PG8_VA(0)); PG8_STAGE(PG8_SB(1, 1), cB + hstepB + kstep, voffB);
        PG8_WAIT_V(6); PG8_BAR;
    } else {
        PG8_STAGE(PG8_SB(0, 0), cB, voffB); PG8_STAGE(PG8_SA(0, 0), cA, voffA); PG8_STAGE(PG8_SB(0, 1), cB + hstepB, voffB); PG8_STAGE(PG8_SA(0, 1), cA + hstepA, voffA);
        if (wr == 1) PG8_BAR;
        PG8_WAIT_V(4); PG8_BAR;
        PG8_STAGE(PG8_SB(1, 0), cB + kstep, voffB); PG8_STAGE(PG8_SA(1, 0), cA + kstep, voffA); PG8_STAGE(PG8_SB(1, 1), cB + hstepB + kstep, voffB);
        PG8_WAIT_V(6); PG8_BAR;
    }
    for (;;) {
        const bool has_next = S.next(ui + 1, nxt);
        const char* nA = has_next ? (const char*)g.A + (size_t)nxt.pm * tstepA : cA; const char* nB = has_next ? (const char*)g.Bt + (size_t)nxt.pn * tstepB : cB;
        for (int t = 0; t < nt; t += 2) {
            const bool last = (t == nt - 2);
            const char* a1 = cA + (size_t)(t + 1) * kstep;
            const char* a2 = last ? nA : cA + (size_t)(t + 2) * kstep; const char* b2 = last ? nB : cB + (size_t)(t + 2) * kstep;
            const char* a3 = a2 + kstep; const char* b3 = b2 + kstep;
            if (last && has_next) S.a_ready(nxt);
            if constexpr (SP2) {
            PG8_LDB(B0, 0, 0); PG8_LDB(B1, 0, 1); PG8_SCHED; PG8_LDA(At, 0, 0); PG8_STAGE(PG8_SA(1, 1), a1 + hstepA, PG8_VA(1));
            if constexpr (GATHER) { if (last && has_next) PG8_LOADVO(cvo, ui + 1); }
            PG8_WAIT_V(8); PG8_WAIT_L(0); PG8_BAR; PG8_MMA(0, 0, At, B0); PG8_MMA(0, 1, At, B1); PG8_BAR; PG8_SCHED;
            PG8_LDA(At, 0, 1); PG8_STAGE(PG8_SB(0, 0), b2, voffB); PG8_STAGE(PG8_SB(0, 1), b2 + hstepB, voffB); PG8_STAGE(PG8_SA(0, 0), a2, PG8_VA(0));
            PG8_WAIT_V(8); PG8_WAIT_L(0); PG8_BAR; PG8_MMA(1, 0, At, B0); PG8_MMA(1, 1, At, B1); PG8_BAR; PG8_SCHED;
            PG8_LDB(B0, 1, 0); PG8_LDB(B1, 1, 1); PG8_SCHED; PG8_LDA(At, 1, 0); PG8_STAGE(PG8_SA(0, 1), a2 + hstepA, PG8_VA(1));
            PG8_WAIT_V(8); PG8_WAIT_L(0); PG8_BAR; PG8_MMA(0, 0, At, B0); PG8_MMA(0, 1, At, B1); PG8_BAR; PG8_SCHED;
            PG8_LDA(At, 1, 1); PG8_STAGE(PG8_SB(1, 0), b3, voffB); PG8_STAGE(PG8_SB(1, 1), b3 + hstepB, voffB); PG8_STAGE(PG8_SA(1, 0), a3, PG8_VA(0));
            PG8_WAIT_V(8); PG8_WAIT_L(0); PG8_BAR; PG8_MMA(1, 0, At, B0); PG8_MMA(1, 1, At, B1); PG8_BAR; PG8_SCHED;
            } else {
            PG8_LDB(B0, 0, 0); PG8_SCHED; PG8_LDA(At, 0, 0); PG8_STAGE(PG8_SA(1, 1), a1 + hstepA, voffA);
            PG8_WAIT_L(8); PG8_BAR; PG8_WAIT_L(0); PG8_MMA(0, 0, At, B0); PG8_BAR; PG8_SCHED;
            PG8_LDB(B1, 0, 1); PG8_STAGE(PG8_SB(0, 0), b2, voffB);
            PG8_BAR; PG8_WAIT_L(0); PG8_MMA(0, 1, At, B1); PG8_BAR;
            PG8_LDA(At, 0, 1); PG8_STAGE(PG8_SA(0, 0), a2, voffA);
            PG8_BAR; PG8_WAIT_L(0); PG8_MMA(1, 0, At, B0); PG8_BAR; PG8_SCHED;
            PG8_STAGE(PG8_SB(0, 1), b2 + hstepB, voffB);
            PG8_WAIT_V(6); PG8_BAR; PG8_MMA(1, 1, At, B1); PG8_BAR;
            PG8_LDB(B0, 1, 0); PG8_SCHED; PG8_LDA(At, 1, 0); PG8_STAGE(PG8_SA(0, 1), a2 + hstepA, voffA);
            PG8_WAIT_L(8); PG8_BAR; PG8_WAIT_L(0); PG8_MMA(0, 0, At, B0); PG8_BAR; PG8_SCHED;
            PG8_LDB(B1, 1, 1); PG8_STAGE(PG8_SB(1, 0), b3, voffB);
            PG8_BAR; PG8_WAIT_L(0); PG8_MMA(0, 1, At, B1); PG8_BAR;
            PG8_LDA(At, 1, 1); PG8_STAGE(PG8_SA(1, 0), a3, voffA);
            PG8_BAR; PG8_WAIT_L(0); PG8_MMA(1, 0, At, B0); PG8_BAR; PG8_SCHED;
            PG8_STAGE(PG8_SB(1, 1), b3 + hstepB, voffB);
            PG8_WAIT_V(6); PG8_BAR; PG8_MMA(1, 1, At, B1); PG8_BAR;
            }
        }
        if constexpr (ALIGN_EPI) { if (wr == 0) PG8_BAR; }
        if constexpr (!Epi::AFTER_DRAIN) { E(acc, cur, wr, wc, fr, fq); S.done(cur); }
        if (!has_next) break;
#pragma unroll
        for (int a = 0; a < 2; ++a)
#pragma unroll
            for (int b = 0; b < 2; ++b)
#pragma unroll
                for (int m = 0; m < 4; ++m)
#pragma unroll
                    for (int n = 0; n < 2; ++n) acc[a][b][m][n] = (f32x4){0.f, 0.f, 0.f, 0.f};
        cur = nxt; cA = nA; cB = nB; ++ui;
        if constexpr (ALIGN_EPI) { if (wr == 1) PG8_BAR; }
    }
    PG8_WAIT_V(0);
    if constexpr (!ALIGN_EPI) { if (wr == 0) PG8_BAR; }
    PG8_BAR;
    if constexpr (Epi::AFTER_DRAIN) { E.fused(acc, cur, wr, wc, fr, fq, lds, wid, lane); S.done(cur); }
#undef PG8_SA
#undef PG8_LOADVO
#undef PG8_VA
#undef PG8_SB
#undef PG8_STAGE
#undef PG8_LDA
#undef PG8_LDB
#undef PG8_MMA
#undef PG8_WAIT_V
#undef PG8_WAIT_L
#undef PG8_BAR
#undef PG8_SCHED
}
}

#ifndef MK_STAGE
#define MK_STAGE 4
#endif
constexpr int NWAVES = 8;
constexpr int M = 16384, D = 1024, SEQ = 8192, DP = 512, NG = 32, NST = 64, GC = 16, CL = 16  ;
constexpr int NCH = M / CL;
constexpr int NEXP = 32, DF = 256, DPLE = 256;
constexpr int VP_ROWS = 2 * M + NEXP * 256;
constexpr float RMS_EPS = 1e-6f;

constexpr size_t MiB = 1u << 20;
constexpr size_t WS_CTL = 0, CTL_ZERO_BYTES = 1 * MiB;
constexpr size_t WS_WR = 1 * MiB;
constexpr size_t WS_LAMT = 1 * MiB + 256 * 1024;
constexpr size_t WS_ROUTE = 1 * MiB + 512 * 1024;
constexpr size_t WS_WIN = 2 * MiB, WS_GLU = 4 * MiB, WS_WCAT = 5 * MiB, WS_WG = 7 * MiB, WS_WPLE = 9 * MiB;
constexpr size_t WS_ROWINFO = 9 * MiB + 512 * 1024, WS_ROWW = 9 * MiB + 768 * 1024;
constexpr size_t WS_WGU = 10 * MiB, WS_WD = 42 * MiB;
constexpr size_t WS_MS = 58 * MiB, WS_WS3 = 62 * MiB;
constexpr size_t WS_ZZ = 70 * MiB;
constexpr size_t WS_PE = 58 * MiB;
constexpr size_t WS_XN = 90 * MiB;
constexpr size_t WS_ZP = 122 * MiB, WS_AS = 138 * MiB, WS_SLOC = 170 * MiB, WS_CAT = 202 * MiB, WS_PB = 234 * MiB;
constexpr size_t WS_VP = 122 * MiB, WS_ACT = 202 * MiB, WS_MO0 = 122 * MiB, WS_MO1 = 154 * MiB;
constexpr size_t WS_LIST = 244 * MiB, WS_LISTW = 246 * MiB, WS_LISTR = 248 * MiB;
constexpr size_t WS_WOS = 242 * MiB, WS_BD = 243 * MiB;
constexpr size_t WS_END = 256 * MiB;
static_assert(WS_VP + (size_t)VP_ROWS * 2048 <= WS_ACT && WS_ACT + (size_t)VP_ROWS * 512 <= WS_PB && WS_PB + (size_t)M * 512 <= WS_END, "ws map");
constexpr int CW_CNT = 8192;
constexpr int CW_BAR = 4096;
constexpr int ROWOFF_OFF = 143360;
constexpr int RING_OFF = 0, RING_BYTES = 131072, P0_SCR = 64 * 65 * 4  , LDSCTL_OFF = 139264, MISC_OFF = LDSCTL_OFF + 320, LDS_BYTES = 147456;
static_assert(NWAVES * P0_SCR <= LDSCTL_OFF && MISC_OFF + 4 * 512 <= ROWOFF_OFF && ROWOFF_OFF + 4 * 1024 <= LDS_BYTES, "LDS map");
constexpr int MW_TSTART = 16, MW_HIST = 64, MW_BASE = 96, MW_CNT = 128, MW_TL = 192;

#define GAS __attribute__((address_space(1)))
#define LAS __attribute__((address_space(3)))
typedef unsigned short bf16;
typedef unsigned v4u __attribute__((ext_vector_type(4)));
typedef unsigned v2u __attribute__((ext_vector_type(2)));
typedef float f32x4 __attribute__((ext_vector_type(4)));
typedef GAS unsigned gu32;
#define RLX_AGENT __ATOMIC_RELAXED, __HIP_MEMORY_SCOPE_AGENT
#define LDS_WAIT() asm volatile("s_waitcnt lgkmcnt(0)" ::: "memory")
#define VM_WAIT() asm volatile("s_waitcnt vmcnt(0)" ::: "memory")
__device__ __forceinline__ unsigned f2bf(float f) { unsigned u = __builtin_bit_cast(unsigned, f); return (u + 0x7fffu + ((u >> 16) & 1u)) >> 16; }
__device__ __forceinline__ unsigned pk2(float lo, float hi) { return f2bf(lo) | (f2bf(hi) << 16); }
__device__ __forceinline__ float bflo(unsigned w) { return __builtin_bit_cast(float, w << 16); }
__device__ __forceinline__ float bfhi(unsigned w) { return __builtin_bit_cast(float, w & 0xffff0000u); }
__device__ __forceinline__ float sigmoidf_(float x) { return 1.0f / (1.0f + __expf(-x)); }
__device__ __forceinline__ float gelu_tanh(float y) { const float t = 1.5957691216f * (y + 0.044715f * y * y * y); return y / (1.0f + __expf(-t)); }

#define XB_TMO      128
#define XB_XCNT(j)  (256  + 64 * (j))
#define XB_XSUB(j)  (1280 + 64 * (j))
#define XB_XGEN(j)  (2304 + 64 * (j))
#define XB_TOP      3328
#define XB_TOPGEN   3392
#define XCD_BAR_WORDS 3456
#define XB_SPIN_CAP (1u << 18)
__device__ __forceinline__ unsigned xb_ld(unsigned* p)              { return __hip_atomic_load(p, __ATOMIC_RELAXED, __HIP_MEMORY_SCOPE_AGENT); }
__device__ __forceinline__ unsigned xb_add(unsigned* p, unsigned v) { return __hip_atomic_fetch_add(p, v, __ATOMIC_RELAXED, __HIP_MEMORY_SCOPE_AGENT); }
__device__ __forceinline__ unsigned xb_xcc_id() { return (unsigned)__builtin_amdgcn_s_getreg((3 << 11) | 20) & 0xFu; }
#define XB_SPIN(cond, bar) do { unsigned _sp = 0; while (cond) { __builtin_amdgcn_s_sleep(1); \
    if ((++_sp & 255u) == 0u) { if (xb_ld(&(bar)[XB_TMO])) break; if (_sp > XB_SPIN_CAP) { atomicAdd(&(bar)[XB_TMO], 1u); break; } } } } while (0)
struct XcdBarrier { unsigned* bar; unsigned x; volatile LAS unsigned* st; int wave; };
__device__ __forceinline__ XcdBarrier xcd_barrier_post(unsigned* bar, volatile LAS unsigned* st) {
    XcdBarrier b; b.bar = bar; b.x = xb_xcc_id(); b.st = st; b.wave = 0;
    if (threadIdx.x == 0) (void)xb_add(&bar[XB_XCNT(b.x)], 1u);
    return b;
}
__device__ __forceinline__ void xcd_barrier_complete(unsigned* bar, unsigned x, unsigned& nloc, unsigned& nx) {
    const unsigned G = gridDim.x * gridDim.y * gridDim.z;
    unsigned sum, cnt, mine, sp = 0u;
    for (;;) {
        sum = 0u; cnt = 0u; mine = 0u;
#pragma unroll
        for (unsigned j = 0; j < 16; ++j) { const unsigned c = xb_ld(&bar[XB_XCNT(j)]); sum += c; cnt += (c > 0u) ? 1u : 0u; mine = (j == x) ? c : mine; }
        if (sum == G) break;
        __builtin_amdgcn_s_sleep(1);
        if ((++sp & 255u) == 0u) { if (xb_ld(&bar[XB_TMO])) break; if (sp > XB_SPIN_CAP) { atomicAdd(&bar[XB_TMO], 1u); break; } }
    }
    nloc = mine > 0u ? mine : 1u; nx = cnt > 0u ? cnt : 1u;
}
__device__ __forceinline__ void xcd_barrier(const XcdBarrier& b) {
    asm volatile("s_waitcnt vmcnt(0)" ::: "memory");
    __syncthreads();
    if (b.wave == 0 && hw_lane() == 0) {
        unsigned* bar = b.bar;
        __builtin_amdgcn_s_waitcnt(0);
        unsigned nloc = b.st[0], nx = b.st[1];
        if (nloc == 0u) { xcd_barrier_complete(bar, b.x, nloc, nx); b.st[0] = nloc; b.st[1] = nx; }
        const unsigned old = xb_add(&bar[XB_XSUB(b.x)], 1u);
        const unsigned gen = old / nloc;
        if (old + 1u == (gen + 1u) * nloc) {
            __builtin_amdgcn_fence(__ATOMIC_RELEASE, "agent");
            asm volatile("s_waitcnt vmcnt(0)" ::: "memory");
            const unsigned og = xb_add(&bar[XB_TOP], 1u);
            const unsigned tg = og / nx;
            if (og + 1u == (tg + 1u) * nx) xb_add(&bar[XB_TOPGEN], 1u);
            else XB_SPIN(xb_ld(&bar[XB_TOPGEN]) == tg, bar);
            __builtin_amdgcn_fence(__ATOMIC_ACQUIRE, "agent");
            xb_add(&bar[XB_XGEN(b.x)], 1u);
            asm volatile("s_waitcnt vmcnt(0)" ::: "memory");
        } else {
            XB_SPIN(xb_ld(&bar[XB_XGEN(b.x)]) == gen, bar);
            __builtin_amdgcn_fence(__ATOMIC_ACQUIRE, "agent");
            asm volatile("s_waitcnt vmcnt(0)" ::: "memory");
        }
    }
    __syncthreads();
}

struct Args { const float* in[30]; float* out; unsigned char* ws; };
struct Frame {
    LAS unsigned char* lds;
    volatile LAS unsigned* MISC;
    gu32* ctl;
    int wave, G, gw, ngw;
    float* out;
    unsigned char* ws;
};
__device__ __forceinline__ int opq(int v) { asm volatile("" : "+v"(v)); return v; }
template <int CTRL> __device__ __forceinline__ float dpp_f(float v) { return __builtin_bit_cast(float, __builtin_amdgcn_update_dpp(0, __builtin_bit_cast(int, v), CTRL, 0xf, 0xf, true)); }
__device__ __forceinline__ float wave_sum(float v) {
    v += dpp_f<0xB1>(v);
    v += dpp_f<0x4E>(v);
    v += dpp_f<0x141>(v);
    v += dpp_f<0x140>(v);
    const float r0 = __builtin_bit_cast(float, __builtin_amdgcn_readlane(__builtin_bit_cast(int, v), 0)), r1 = __builtin_bit_cast(float, __builtin_amdgcn_readlane(__builtin_bit_cast(int, v), 16));
    const float r2 = __builtin_bit_cast(float, __builtin_amdgcn_readlane(__builtin_bit_cast(int, v), 32)), r3 = __builtin_bit_cast(float, __builtin_amdgcn_readlane(__builtin_bit_cast(int, v), 48));
    return (r0 + r1) + (r2 + r3);
}

__device__ __forceinline__ void transpose_item64(const float* src, int ld_src, bf16* dst, int ld_dst, LAS float* scr, int lane, const float* kscale = nullptr) {
    f32x4 v[16];
    const int kq = lane >> 4, n4 = (lane & 15) * 4;
#pragma unroll
    for (int i = 0; i < 16; ++i) v[i] = *(const GAS f32x4*)(src + (size_t)(4 * i + kq) * ld_src + n4);
    if (kscale) {
#pragma unroll
        for (int i = 0; i < 16; ++i) v[i] = v[i] * kscale[4 * i + kq]; }
#pragma unroll
    for (int i = 0; i < 16; ++i) { LAS float* p = scr + (4 * i + kq) * 65 + n4; p[0] = v[i].x; p[1] = v[i].y; p[2] = v[i].z; p[3] = v[i].w; }
    LDS_WAIT(); asm volatile("" ::: "memory");
    const int c = lane & 7;
#pragma unroll
    for (int j = 0; j < 8; ++j) { const int n = (lane >> 3) + 8 * j; const LAS float* q = scr + (8 * c) * 65 + n;
        v4u o; o.x = pk2(q[0 * 65], q[1 * 65]); o.y = pk2(q[2 * 65], q[3 * 65]); o.z = pk2(q[4 * 65], q[5 * 65]); o.w = pk2(q[6 * 65], q[7 * 65]);
        *(GAS v4u*)(dst + (size_t)n * ld_dst + 8 * c) = o; }
    LDS_WAIT(); asm volatile("" ::: "memory");
}
__device__ __forceinline__ void rms_row_to_bf16(const float* xrow, const float* g, bf16* orow, int lane) {
    const GAS f32x4* xr = (const GAS f32x4*)xrow + lane; const GAS f32x4* gr = (const GAS f32x4*)g + lane;
    f32x4 v[4]; float s = 0.f;
#pragma unroll
    for (int j = 0; j < 4; ++j) { v[j] = xr[64 * j]; s += (v[j].x * v[j].x + v[j].y * v[j].y) + (v[j].z * v[j].z + v[j].w * v[j].w); }
    const float rstd = 1.f / sqrtf(wave_sum(s) * (1.f / D) + RMS_EPS);
    GAS unsigned long long* o8 = (GAS unsigned long long*)orow + lane;
#pragma unroll
    for (int j = 0; j < 4; ++j) { const f32x4 gg = gr[64 * j];
        o8[64 * j] = (unsigned long long)pk2(v[j].x * rstd * gg.x, v[j].y * rstd * gg.y) | ((unsigned long long)pk2(v[j].z * rstd * gg.z, v[j].w * rstd * gg.w) << 32); }
}
__device__ __forceinline__ void sincos_d(double x, double& sn, double& cs) {
    const double k = __builtin_rint(x * 0.63661977236758134308);
    const double r = (x - k * 1.57079632679489655800e+00) - k * 6.12323399573676603587e-17;
    const double r2 = r * r;
    const double s = r * (1.0 + r2 * (-1.0 / 6.0 + r2 * (1.0 / 120.0 + r2 * (-1.0 / 5040.0 + r2 * (1.0 / 362880.0 + r2 * (-1.0 / 39916800.0 + r2 * (1.0 / 6227020800.0)))))));
    const double c = 1.0 + r2 * (-0.5 + r2 * (1.0 / 24.0 + r2 * (-1.0 / 720.0 + r2 * (1.0 / 40320.0 + r2 * (-1.0 / 3628800.0 + r2 * (1.0 / 479001600.0 + r2 * (-1.0 / 87178291200.0)))))));
    const int q = ((int)k) & 3;
    sn = (q == 0) ? s : (q == 1) ? c : (q == 2) ? -s : -c;
    cs = (q == 0) ? c : (q == 1) ? -s : (q == 2) ? -c : s;
}
__device__ __forceinline__ void ssm_gen(Frame& F, const Args& A, int g, int sl) {
    LAS float* lamP = (LAS float*)(F.lds + RING_OFF);
    LAS float* Bb = lamP + 2 * 17 * 64 * 2;
    LAS float* Cc = Bb + 2 * 64 * 16 * 2;
    LAS float* KT = Cc + 2 * 16 * 64 * 2;
    LAS float* dv = KT + 32 * 260;
    LAS float* bfac = dv + 16;
    const float* a_re = A.in[6]; const float* a_im = A.in[7]; const float* log_dt = A.in[8];
    const float* b_re = A.in[9]; const float* b_im = A.in[10]; const float* c_re = A.in[11]; const float* c_im = A.in[12]; const float* ssm_d = A.in[13];
    const int t = opq(F.wave * 64 + hw_lane());
    float pbr[4], pbi[4], pcr[4], pci[4];
#pragma unroll
    for (int i = 0; i < 4; ++i) { const int idx = t + 512 * i; const size_t si = (size_t)((idx >> 10) * NG + g) * 1024 + (idx & 1023);
        pbr[i] = b_re[si]; pbi[i] = b_im[si]; pcr[i] = c_re[si]; pci[i] = c_im[si]; }
    const int d_a = (t >> 6) & 1, n_a = t & 63;
    const float p_are = a_re[(d_a * NG + g) * NST + n_a], p_aim = a_im[(d_a * NG + g) * NST + n_a], p_ldt = log_dt[d_a * NG + g], p_dv = ssm_d[g * GC + (t & 15)];
    __syncthreads();
    if (t < 128) {
        const int d = d_a, n = n_a;
        const float dtf = expf(p_ldt), mag = expf(p_are * dtf); const double ang = (double)p_aim * (double)dtf;
        double sn, cs; sincos_d(ang, sn, cs);
        const float lr = mag * (float)cs, li = mag * (float)sn;
        const float nr = lr - 1.0f, ni = li, den = p_are * p_are + p_aim * p_aim;
        bfac[(d * 64 + n) * 2] = (nr * p_are + ni * p_aim) / den; bfac[(d * 64 + n) * 2 + 1] = (ni * p_are - nr * p_aim) / den;
        float pr = 1.0f, pi = 0.0f;
        for (int k = 0; k <= 16; ++k) { lamP[((d * 17 + k) * 64 + n) * 2] = pr; lamP[((d * 17 + k) * 64 + n) * 2 + 1] = pi;
            const float tr = pr * lr - pi * li, ti = pr * li + pi * lr; pr = tr; pi = ti; }
        if (sl == 0) {
            float* lt = (float*)(F.ws + WS_LAMT) + ((g * 2 + d) * 64 + n) * 4;
            double s16, c16, s1k, c1k; sincos_d(ang * 16.0, s16, c16); sincos_d(ang * 1024.0, s1k, c1k);
            const float m16 = expf(p_are * dtf * 16.0f), m1k = expf(p_are * dtf * 1024.0f);
            lt[0] = m16 * (float)c16; lt[1] = m16 * (float)s16; lt[2] = m1k * (float)c1k; lt[3] = m1k * (float)s1k; }
    }
    if (t < 16) dv[t] = p_dv;
    __syncthreads();
#pragma unroll
    for (int i = 0; i < 4; ++i) { const int idx = t + 512 * i, d = idx >> 10, n = (idx >> 4) & 63;
        const float fr = bfac[(d * 64 + n) * 2], fi = bfac[(d * 64 + n) * 2 + 1];
        Bb[idx * 2] = fr * pbr[i] - fi * pbi[i]; Bb[idx * 2 + 1] = fr * pbi[i] + fi * pbr[i];
        Cc[idx * 2] = pcr[i]; Cc[idx * 2 + 1] = pci[i]; }
    __syncthreads();
    {
        const int d = t >> 8, co = (t >> 4) & 15, ci = t & 15;
        float acc[16];
#pragma unroll
        for (int k = 0; k < 16; ++k) acc[k] = 0.f;
        for (int n = 0; n < 64; ++n) {
            const float cr = Cc[((d * 16 + co) * 64 + n) * 2], cim = Cc[((d * 16 + co) * 64 + n) * 2 + 1];
            const float br = Bb[((d * 64 + n) * 16 + ci) * 2], bi = Bb[((d * 64 + n) * 16 + ci) * 2 + 1];
            const float lr = lamP[((d * 17 + 1) * 64 + n) * 2], li = lamP[((d * 17 + 1) * 64 + n) * 2 + 1];
            float qr = cr * br - cim * bi, qi = cr * bi + cim * br;
#pragma unroll
            for (int k = 0; k < 16; ++k) { acc[k] += qr; const float tr = qr * lr - qi * li; qi = qr * li + qi * lr; qr = tr; }
        }
#pragma unroll
        for (int k = 0; k < 16; ++k) KT[(d * 16 + k) * 260 + co * 16 + ci] = acc[k];
    }
    __syncthreads();
    bf16* WS3 = (bf16*)(F.ws + WS_WS3) + ((size_t)g * 256 + sl * 64) * 512;
#pragma unroll
    for (int i2 = 0; i2 < 2; ++i2) {
        const int idx = t + 512 * i2, rowl = idx >> 4, sq = idx & 15, row = sl * 64 + rowl, j = row >> 4, co = row & 15;
        float v[16];
        if (j != sq) { const LAS float* src = KT + ((j > sq) ? (j - sq) : (16 + sq - j)) * 260 + co * 16;
#pragma unroll
            for (int i = 0; i < 16; ++i) v[i] = src[i]; }
        else {
#pragma unroll
            for (int i = 0; i < 16; ++i) v[i] = KT[co * 16 + i] + KT[16 * 260 + co * 16 + i] + (co == i ? dv[co] : 0.f); }
        v4u o0, o1; o0.x = pk2(v[0], v[1]); o0.y = pk2(v[2], v[3]); o0.z = pk2(v[4], v[5]); o0.w = pk2(v[6], v[7]); o1.x = pk2(v[8], v[9]); o1.y = pk2(v[10], v[11]); o1.z = pk2(v[12], v[13]); o1.w = pk2(v[14], v[15]);
        GAS v4u* dst = (GAS v4u*)(WS3 + (size_t)rowl * 512 + sq * 16); dst[0] = o0; dst[1] = o1;
    }
#pragma unroll
    for (int i2 = 0; i2 < 4; ++i2) {
        const int idx = t + 512 * i2, rowl = idx >> 5, q = (idx >> 3) & 3, n0 = (idx & 7) * 8, row = sl * 64 + rowl, j = row >> 4, co = row & 15, d = q >> 1, e = (d == 0) ? (j + 1) : (16 - j);
        float v[8];
#pragma unroll
        for (int i = 0; i < 8; ++i) { const int n = n0 + i;
            const float cr = Cc[((d * 16 + co) * 64 + n) * 2], cim = Cc[((d * 16 + co) * 64 + n) * 2 + 1];
            const float pr = lamP[((d * 17 + e) * 64 + n) * 2], pi = lamP[((d * 17 + e) * 64 + n) * 2 + 1];
            v[i] = (q & 1) ? -(cr * pi + cim * pr) : (cr * pr - cim * pi); }
        v4u o; o.x = pk2(v[0], v[1]); o.y = pk2(v[2], v[3]); o.z = pk2(v[4], v[5]); o.w = pk2(v[6], v[7]);
        *(GAS v4u*)(WS3 + (size_t)rowl * 512 + 256 + q * 64 + n0) = o;
    }
    bf16* MS = (bf16*)(F.ws + WS_MS) + ((size_t)g * 256 + sl * 64) * 256;
#pragma unroll
    for (int i2 = 0; i2 < 4; ++i2) {
        const int idx = t + 512 * i2, rowl = idx >> 5, kc = (idx & 31) * 8, row = sl * 64 + rowl, q = row >> 6, n = row & 63, d = q >> 1, j = kc >> 4, ci0 = kc & 15, e = (d == 0) ? (15 - j) : j;
        const float pr = lamP[((d * 17 + e) * 64 + n) * 2], pi = lamP[((d * 17 + e) * 64 + n) * 2 + 1];
        float v[8];
#pragma unroll
        for (int i = 0; i < 8; ++i) { const float br = Bb[((d * 64 + n) * 16 + ci0 + i) * 2], bi = Bb[((d * 64 + n) * 16 + ci0 + i) * 2 + 1];
            v[i] = (q & 1) ? (pr * bi + pi * br) : (pr * br - pi * bi); }
        v4u o; o.x = pk2(v[0], v[1]); o.y = pk2(v[2], v[3]); o.z = pk2(v[4], v[5]); o.w = pk2(v[6], v[7]);
        *(GAS v4u*)(MS + (size_t)rowl * 256 + kc) = o;
    }
    __syncthreads();
}
constexpr int BG_GU = NEXP * 16 * 4, BG_DN = NEXP * 4 * 16, BG_WOB = 8 * 16, BG_WG = 16 * 16, BG_WPLE = 4 * 16;
constexpr int BG_TOTAL = 2 * BG_GU + BG_DN + BG_WOB + BG_WG + BG_WPLE;
struct BgDesc { const float* src; bf16* dst; int ld_src, ld_dst; };
__device__ __forceinline__ BgDesc bg_desc(Frame& F, const Args& A, int r) {
    BgDesc d;
    if (r < 2 * BG_GU) {
        const int up = r >= BG_GU; if (up) r -= BG_GU;
        const int e = r >> 6, kb = (r >> 2) & 15, nb = r & 3, k0 = kb * 64, n0 = nb * 64;
        d.src = A.in[up ? 23 : 22] + ((size_t)e * D + k0) * DF + n0; d.ld_src = DF;
        d.dst = (bf16*)(F.ws + WS_WGU) + ((size_t)e * 512 + (n0 >> 7) * 256 + (up ? 128 : 0) + (n0 & 127)) * D + k0; d.ld_dst = D; return d; }
    r -= 2 * BG_GU;
    if (r < BG_DN) {
        const int e = r >> 6, kb = (r >> 4) & 3, nb = r & 15, k0 = kb * 64, n0 = nb * 64;
        d.src = A.in[24] + ((size_t)e * DF + k0) * D + n0; d.ld_src = D; d.dst = (bf16*)(F.ws + WS_WD) + ((size_t)e * D + n0) * DF + k0; d.ld_dst = DF; return d; }
    r -= BG_DN;
    if (r < BG_WOB) { const int kb = r >> 4, nb = r & 15;
        d.src = A.in[16] + (size_t)(DP + kb * 64) * D + nb * 64; d.ld_src = D; d.dst = (bf16*)(F.ws + WS_WCAT) + (size_t)nb * 64 * D + DP + kb * 64; d.ld_dst = D; return d; }
    r -= BG_WOB;
    if (r < BG_WG) { const int kb = r >> 4, nb = r & 15; d.src = A.in[26] + (size_t)kb * 64 * D + nb * 64; d.ld_src = D; d.dst = (bf16*)(F.ws + WS_WG) + (size_t)nb * 64 * D + kb * 64; d.ld_dst = D; return d; }
    r -= BG_WG;
    { const int kb = r >> 4, nb = r & 15; d.src = A.in[28] + (size_t)kb * 64 * D + nb * 64; d.ld_src = D; d.dst = (bf16*)(F.ws + WS_WPLE) + (size_t)nb * 64 * DPLE + kb * 64; d.ld_dst = DPLE; return d; }
}
__device__ __forceinline__ void tr64_load(f32x4 (&v)[16], const float* src, int ld_src, int lane) {
    const int kq = lane >> 4, n4 = (lane & 15) * 4;
#pragma unroll
    for (int i = 0; i < 16; ++i) v[i] = *(const GAS f32x4*)(src + (size_t)(4 * i + kq) * ld_src + n4);
}
__device__ __forceinline__ void tr64_finish(const f32x4 (&v)[16], bf16* dst, int ld_dst, LAS float* scr, int lane) {
    const int kq = lane >> 4, n4 = (lane & 15) * 4;
#pragma unroll
    for (int i = 0; i < 16; ++i) { LAS float* p = scr + (4 * i + kq) * 65 + n4; p[0] = v[i].x; p[1] = v[i].y; p[2] = v[i].z; p[3] = v[i].w; }
    LDS_WAIT(); asm volatile("" ::: "memory");
    const int c = lane & 7;
#pragma unroll
    for (int j = 0; j < 8; ++j) { const int n = (lane >> 3) + 8 * j; const LAS float* q = scr + (8 * c) * 65 + n;
        v4u o; o.x = pk2(q[0 * 65], q[1 * 65]); o.y = pk2(q[2 * 65], q[3 * 65]); o.z = pk2(q[4 * 65], q[5 * 65]); o.w = pk2(q[6 * 65], q[7 * 65]);
        *(GAS v4u*)(dst + (size_t)n * ld_dst + 8 * c) = o; }
    LDS_WAIT(); asm volatile("" ::: "memory");
}
__device__ __forceinline__ void bg_range(Frame& F, const Args& A, int lo, int hi, int plo, int phi) {
    int widx, nw;
    if (F.G >= 256) { if ((int)blockIdx.x < 128) return; widx = ((int)blockIdx.x - 128) * NWAVES + F.wave; nw = (F.G - 128) * NWAVES; } else { widx = F.gw; nw = F.ngw; }
    LAS float* scr = (LAS float*)(F.lds + RING_OFF + F.wave * P0_SCR);
    const int lane = opq(hw_lane());
    int it = lo + widx;
    for (; it + nw < hi; it += 2 * nw) {
        f32x4 va[16], vb[16]; const BgDesc da = bg_desc(F, A, it), db = bg_desc(F, A, it + nw);
        tr64_load(va, da.src, da.ld_src, lane); tr64_load(vb, db.src, db.ld_src, lane);
        tr64_finish(va, da.dst, da.ld_dst, scr, lane); tr64_finish(vb, db.dst, db.ld_dst, scr, lane); }
    if (it < hi) { f32x4 va[16]; const BgDesc dc = bg_desc(F, A, it); tr64_load(va, dc.src, dc.ld_src, lane); tr64_finish(va, dc.dst, dc.ld_dst, scr, lane); }
    for (int m = plo + 4 * widx; m < phi; m += 4 * nw) {
        f32x4 pv[4];
#pragma unroll
        for (int r = 0; r < 4; ++r) pv[r] = *((const GAS f32x4*)(A.in[1] + (size_t)(m + r) * DPLE) + lane);
#pragma unroll
        for (int r = 0; r < 4; ++r) { v2u o; o.x = pk2(pv[r].x, pv[r].y); o.y = pk2(pv[r].z, pv[r].w); *((GAS v2u*)((bf16*)(F.ws + WS_PB) + (size_t)(m + r) * DPLE) + lane) = o; }
    }
}
template <int R> __device__ __forceinline__ void xn_rows(Frame& F, const Args& A, int m0, int stride, int lane) {
    const GAS f32x4* gr = (const GAS f32x4*)A.in[2] + lane;
    f32x4 v[R][4];
#pragma unroll
    for (int r = 0; r < R; ++r) { const size_t m = (size_t)(m0 + r * stride);
#pragma unroll
        for (int j = 0; j < 4; ++j) v[r][j] = *((const GAS f32x4*)(A.in[0] + m * D) + lane + 64 * j); }
#pragma unroll
    for (int r = 0; r < R; ++r) { const size_t m = (size_t)(m0 + r * stride); float s = 0.f;
#pragma unroll
        for (int j = 0; j < 4; ++j) s += (v[r][j].x * v[r][j].x + v[r][j].y * v[r][j].y) + (v[r][j].z * v[r][j].z + v[r][j].w * v[r][j].w);
        const float rstd = 1.f / sqrtf(wave_sum(s) * (1.f / D) + RMS_EPS);
        GAS unsigned long long* o8 = (GAS unsigned long long*)((bf16*)(F.ws + WS_XN) + m * D) + lane;
#pragma unroll
        for (int j = 0; j < 4; ++j) { const f32x4 gg = gr[64 * j], x = v[r][j];
            o8[64 * j] = (unsigned long long)pk2(x.x * rstd * gg.x, x.y * rstd * gg.y) | ((unsigned long long)pk2(x.z * rstd * gg.z, x.w * rstd * gg.w) << 32); }
    }
}
__device__ __forceinline__ void p0_prologue(Frame& F, const Args& A) {
    int widx = F.gw, nw = F.ngw;
    if (F.G >= 256) { if ((int)blockIdx.x < 128) { ssm_gen(F, A, (int)blockIdx.x >> 2, (int)blockIdx.x & 3); return; }
                      widx = ((int)blockIdx.x - 128) * NWAVES + F.wave; nw = (F.G - 128) * NWAVES; }
    else { for (int u = blockIdx.x; u < NG * 4; u += F.G) ssm_gen(F, A, u >> 2, u & 3); __syncthreads(); }
    LAS float* scr = (LAS float*)(F.lds + RING_OFF + F.wave * P0_SCR);
    constexpr int I_WIN = 16 * 16, I_GLU = 8 * 8, I_WOS = 8 * 16, I_BD = 256, I_WR = 48, I_ROWS = M / 8;
    constexpr int NITEMS = I_WIN + I_GLU + I_WOS + I_BD + I_WR + I_ROWS;
    for (int it = widx; it < NITEMS; it += nw) {
        int r = it; const int lane = opq(hw_lane());
        if (r < I_WIN) { const int kb = r >> 4, nb = r & 15; transpose_item64(A.in[3] + (size_t)kb * 64 * D + nb * 64, D, (bf16*)(F.ws + WS_WIN) + (size_t)nb * 64 * D + kb * 64, D, scr, lane); continue; }
        r -= I_WIN;
        if (r < I_GLU) { const int kb = r >> 3, nb = r & 7; transpose_item64(A.in[14] + (size_t)kb * 64 * DP + nb * 64, DP, (bf16*)(F.ws + WS_GLU) + (size_t)nb * 64 * DP + kb * 64, DP, scr, lane); continue; }
        r -= I_GLU;
        if (r < I_WOS) {
            const int kb = r >> 4, nb = r & 15, k0 = kb * 64;
            transpose_item64(A.in[16] + (size_t)k0 * D + nb * 64, D, (bf16*)(F.ws + WS_WOS) + ((size_t)(k0 >> 8) * D + nb * 64) * 256 + (k0 & 255), 256, scr, lane, A.in[5] + k0); continue; }
        r -= I_WOS;
        if (r < I_BD) {
            const int row = r * 2 + (lane >> 5), c0 = (lane & 31) * 8, gi = row >> 7;
            v4u o = (v4u){0u, 0u, 0u, 0u};
            if ((c0 >> 7) == (gi & 1)) { const f32x4 a = *(const GAS f32x4*)(A.in[4] + (size_t)row * 128 + (c0 & 127)), b = *(const GAS f32x4*)(A.in[4] + (size_t)row * 128 + (c0 & 127) + 4);
                o.x = pk2(a.x, a.y); o.y = pk2(a.z, a.w); o.z = pk2(b.x, b.y); o.w = pk2(b.z, b.w); }
            *(GAS v4u*)((bf16*)(F.ws + WS_BD) + (size_t)row * 256 + c0) = o; continue; }
        r -= I_BD;
        if (r < I_WR) {
            bf16* dh = (bf16*)(F.ws + WS_WR) + (size_t)r * D; bf16* dl = dh + 48 * D;
            for (int dd = lane; dd < D; dd += 64) { float w = 0.f;
                if (r < 4) w = A.in[18][dd * 4 + r]; else if (r < 36) w = A.in[20][((size_t)((r - 4) >> 3) * D + dd) * 8 + ((r - 4) & 7)];
                w *= A.in[17][dd]; const unsigned h = f2bf(w); dh[dd] = (bf16)h; dl[dd] = (bf16)f2bf(w - __builtin_bit_cast(float, h << 16)); }
            continue; }
        r -= I_WR;
        xn_rows<8>(F, A, r, I_ROWS, lane);
    }
}

using pg8::Unit; using pg8::bf16_t; typedef unsigned u32x4 __attribute__((ext_vector_type(4)));
__device__ __forceinline__ u32x4 pack8(const f32x4& a, const f32x4& b) { u32x4 w; w.x = pk2(a[0], a[1]); w.y = pk2(a[2], a[3]); w.z = pk2(b[0], b[1]); w.w = pk2(b[2], b[3]); return w; }
struct EpiZ { static constexpr bool PERM = true, AFTER_DRAIN = false; bf16_t* ZP; bf16_t* AS;
    __device__ __forceinline__ void operator()(const f32x4 (&acc)[2][2][4][2], const Unit& u, int wr, int wc, int fr, int fq) const {
        const int row0 = u.pm * 256 + wr * 64 + fr;
#pragma unroll
        for (int ai = 0; ai < 2; ++ai)
#pragma unroll
            for (int m = 0; m < 4; ++m) { const int r = row0 + ai * 128 + m * 16;
#pragma unroll
                for (int bj = 0; bj < 2; ++bj) { const int col = u.pn * 256 + bj * 128 + wc * 32 + 8 * fq; const u32x4 w = pack8(acc[ai][bj][m][0], acc[ai][bj][m][1]);
                    if (u.pn < 2) *(u32x4*)(ZP + (size_t)r * DP + col) = w;
                    else { const int sc = col - DP, g = sc >> 4, ch0 = sc & 15; *(u32x4*)(AS + ((size_t)(g * NCH + (r >> 4)) * 512 + (r & 15) * 16 + ch0)) = w; } } }
    } };
struct EpiSloc { static constexpr bool PERM = false, AFTER_DRAIN = false; float* C;
    __device__ __forceinline__ void operator()(const f32x4 (&acc)[2][2][4][2], const Unit& u, int wr, int wc, int fr, int fq) const {
        const int row0 = u.pm * 256 + wr * 64 + fr, col0 = wc * 32 + 4 * fq;
#pragma unroll
        for (int ai = 0; ai < 2; ++ai)
#pragma unroll
            for (int m = 0; m < 4; ++m) { float* rowp = C + (size_t)(row0 + ai * 128 + m * 16) * 256 + col0;
#pragma unroll
                for (int bj = 0; bj < 2; ++bj)
#pragma unroll
                    for (int n = 0; n < 2; ++n) *(f32x4*)(rowp + bj * 128 + n * 16) = acc[ai][bj][m][n]; }
    } };
struct EpiY { static constexpr bool PERM = true, AFTER_DRAIN = false; bf16_t* ZZ;
    __device__ __forceinline__ void operator()(const f32x4 (&acc)[2][2][4][2], const Unit& u, int wr, int wc, int fr, int fq) const {
        const int g = u.pn, row0 = (u.pm & 3) * 256 + wr * 64 + fr;
#pragma unroll
        for (int ai = 0; ai < 2; ++ai)
#pragma unroll
            for (int m = 0; m < 4; ++m) { const int c = row0 + ai * 128 + m * 16;
#pragma unroll
                for (int bj = 0; bj < 2; ++bj) { const int col = bj * 128 + wc * 32 + 8 * fq, j = col >> 4, co0 = col & 15;
                    f32x4 a = acc[ai][bj][m][0], b = acc[ai][bj][m][1];
#pragma unroll
                    for (int i = 0; i < 4; ++i) { a[i] = gelu_tanh(a[i]); b[i] = gelu_tanh(b[i]); }
                    *(u32x4*)(ZZ + (size_t)(c * CL + j) * DP + g * GC + co0) = pack8(a, b); asm volatile("" ::: "memory"); } }
    } };
struct EpiGlu { static constexpr bool PERM = true, AFTER_DRAIN = false; const bf16_t* ZZ; const float* bias; bf16_t* CAT;
    __device__ __forceinline__ void operator()(const f32x4 (&acc)[2][2][4][2], const Unit& u, int wr, int wc, int fr, int fq) const {
        const int row0 = u.pm * 256 + wr * 64 + fr;
#pragma unroll
        for (int bj = 0; bj < 2; ++bj) { const int col = u.pn * 256 + bj * 128 + wc * 32 + 8 * fq;
            const f32x4 b0 = *(const f32x4*)(bias + col), b1 = *(const f32x4*)(bias + col + 4);
#pragma unroll
            for (int ai = 0; ai < 2; ++ai)
#pragma unroll
                for (int m = 0; m < 4; ++m) { const int r = row0 + ai * 128 + m * 16;
                    const u32x4 z = *(const u32x4*)(ZZ + (size_t)r * DP + col);
                    f32x4 a = acc[ai][bj][m][0] + b0, b = acc[ai][bj][m][1] + b1;
                    a[0] = bflo(z.x) * sigmoidf_(a[0]); a[1] = bfhi(z.x) * sigmoidf_(a[1]); a[2] = bflo(z.y) * sigmoidf_(a[2]); a[3] = bfhi(z.y) * sigmoidf_(a[3]);
                    b[0] = bflo(z.z) * sigmoidf_(b[0]); b[1] = bfhi(z.z) * sigmoidf_(b[1]); b[2] = bflo(z.w) * sigmoidf_(b[2]); b[3] = bfhi(z.w) * sigmoidf_(b[3]);
                    *(u32x4*)(CAT + (size_t)r * D + DP + col) = pack8(a, b); asm volatile("" ::: "memory"); } }
    } };
struct EpiRes { static constexpr bool PERM = true, AFTER_DRAIN = false; const float* X; float* H; const float* G; bf16_t* V;
    __device__ __forceinline__ void operator()(const f32x4 (&acc)[2][2][4][2], const Unit& u, int wr, int wc, int fr, int fq) const {
        const int row0 = u.pm * 256 + wr * 64 + fr, col0 = u.pn * 256 + wc * 32 + 8 * fq;
        f32x4 gv[2][2];
#pragma unroll
        for (int bj = 0; bj < 2; ++bj)
#pragma unroll
            for (int n = 0; n < 2; ++n) gv[bj][n] = *(const f32x4*)(G + col0 + bj * 128 + 4 * n);
#pragma unroll
        for (int ai = 0; ai < 2; ++ai)
#pragma unroll
            for (int m = 0; m < 4; ++m) { const size_t off = (size_t)(row0 + ai * 128 + m * 16) * D + col0;
#pragma unroll
                for (int bj = 0; bj < 2; ++bj) { const f32x4 h0 = *(const f32x4*)(X + off + bj * 128) + acc[ai][bj][m][0], h1 = *(const f32x4*)(X + off + bj * 128 + 4) + acc[ai][bj][m][1];
                    *(f32x4*)(H + off + bj * 128) = h0; *(f32x4*)(H + off + bj * 128 + 4) = h1;
                    *(u32x4*)(V + off + bj * 128) = pack8(h0 * gv[bj][0], h1 * gv[bj][1]); } }
    } };
struct EpiAct { static constexpr bool PERM = true, AFTER_DRAIN = false; const float* LW; const float* LR; bf16_t* ACT; const volatile LAS unsigned* tstart;
    __device__ __forceinline__ void operator()(const f32x4 (&acc)[2][2][4][2], const Unit& u, int wr, int wc, int fr, int fq) const {
        const int e = u.pn >> 1, lrow0 = (u.pm - (int)tstart[e]) * 256 + wr * 64 + fr, row0 = u.pm * 256 + wr * 64 + fr, col = (u.pn & 1) * 128 + wc * 32 + 8 * fq;
        const float* lw = LW + (size_t)e * M + lrow0; const float* lr = LR + (size_t)e * M + lrow0;
#pragma unroll
        for (int ai = 0; ai < 2; ++ai)
#pragma unroll
            for (int m = 0; m < 4; ++m) { const int ro = ai * 128 + m * 16; const float w = lw[ro], rs = lr[ro];
                f32x4 a, b;
#pragma unroll
                for (int i = 0; i < 4; ++i) { const float g0 = rs * acc[ai][0][m][0][i], g1 = rs * acc[ai][0][m][1][i], sw = rs * w;
                    a[i] = g0 * sigmoidf_(g0) * acc[ai][1][m][0][i] * sw; b[i] = g1 * sigmoidf_(g1) * acc[ai][1][m][1][i] * sw; }
                *(u32x4*)(ACT + (size_t)(row0 + ro) * DF + col) = pack8(a, b); }
    } };
struct EpiDown { static constexpr bool PERM = true, AFTER_DRAIN = false; const int* LIST; const unsigned* cnt; bf16_t* MO0; bf16_t* MO1; const volatile LAS unsigned* tstart;
    __device__ __forceinline__ void operator()(const f32x4 (&acc)[2][2][4][2], const Unit& u, int wr, int wc, int fr, int fq) const {
        const int e = u.pn >> 2, lrow0 = (u.pm - (int)tstart[e]) * 256 + wr * 64 + fr, col0 = (u.pn & 3) * 256 + wc * 32 + 8 * fq;
        const int n_e = (int)__hip_atomic_load(cnt + 64 * e, __ATOMIC_RELAXED, __HIP_MEMORY_SCOPE_AGENT); const int* li = LIST + (size_t)e * M;
#pragma unroll
        for (int ai = 0; ai < 2; ++ai)
#pragma unroll
            for (int m = 0; m < 4; ++m) { const int lr = lrow0 + ai * 128 + m * 16;
                if (lr < n_e) { const int info = li[lr]; bf16_t* dst = ((info & 1) ? MO1 : MO0) + (size_t)(info >> 1) * D + col0;
#pragma unroll
                    for (int bj = 0; bj < 2; ++bj) *(u32x4*)(dst + bj * 128) = pack8(acc[ai][bj][m][0], acc[ai][bj][m][1]); } }
    } };
struct EpiPe { static constexpr bool PERM = true, AFTER_DRAIN = false; bf16_t* O;
    __device__ __forceinline__ void operator()(const f32x4 (&acc)[2][2][4][2], const Unit& u, int wr, int wc, int fr, int fq) const {
        const int row0 = u.pm * 256 + wr * 64 + fr, col0 = u.pn * 256 + wc * 32 + 8 * fq;
#pragma unroll
        for (int ai = 0; ai < 2; ++ai)
#pragma unroll
            for (int m = 0; m < 4; ++m) { bf16_t* rowp = O + (size_t)(row0 + ai * 128 + m * 16) * D + col0;
#pragma unroll
                for (int bj = 0; bj < 2; ++bj) *(u32x4*)(rowp + bj * 128) = pack8(acc[ai][bj][m][0], acc[ai][bj][m][1]); }
    } };
struct EpiGate { static constexpr bool PERM = true, AFTER_DRAIN = false; const float* bias; bf16_t* PE;
    __device__ __forceinline__ void operator()(const f32x4 (&acc)[2][2][4][2], const Unit& u, int wr, int wc, int fr, int fq) const {
        const int row0 = u.pm * 256 + wr * 64 + fr, col0 = u.pn * 256 + wc * 32 + 8 * fq;
        u32x4 pe[2][4][2];
#pragma unroll
        for (int ai = 0; ai < 2; ++ai)
#pragma unroll
            for (int m = 0; m < 4; ++m)
#pragma unroll
                for (int bj = 0; bj < 2; ++bj) pe[ai][m][bj] = *(const u32x4*)(PE + (size_t)(row0 + ai * 128 + m * 16) * D + col0 + bj * 128);
#pragma unroll
        for (int bj = 0; bj < 2; ++bj) { const f32x4 b0 = *(const f32x4*)(bias + col0 + bj * 128), b1 = *(const f32x4*)(bias + col0 + bj * 128 + 4);
#pragma unroll
            for (int ai = 0; ai < 2; ++ai)
#pragma unroll
                for (int m = 0; m < 4; ++m) { const u32x4 z = pe[ai][m][bj]; f32x4 a = acc[ai][bj][m][0] + b0, b = acc[ai][bj][m][1] + b1;
                    a[0] = bflo(z.x) * sigmoidf_(a[0]); a[1] = bfhi(z.x) * sigmoidf_(a[1]); a[2] = bflo(z.y) * sigmoidf_(a[2]); a[3] = bfhi(z.y) * sigmoidf_(a[3]);
                    b[0] = bflo(z.z) * sigmoidf_(b[0]); b[1] = bfhi(z.z) * sigmoidf_(b[1]); b[2] = bflo(z.w) * sigmoidf_(b[2]); b[3] = bfhi(z.w) * sigmoidf_(b[3]);
                    *(u32x4*)(PE + (size_t)(row0 + ai * 128 + m * 16) * D + col0 + bj * 128) = pack8(a, b); } }
    } };

struct GroupOrder { int G, c;
    __device__ __forceinline__ bool next(int i, Unit& u) const { const int L = i * G + c; if (L >= NG * 4) return false; u.pm = L; u.pn = L >> 2; u.nv = 256; return true; }
    __device__ __forceinline__ void a_ready(const Unit&) const {}
    __device__ __forceinline__ void done(const Unit&) const {} };
struct WeffOrder { int G, c;
    __device__ __forceinline__ bool next(int i, Unit& u) const { const int L = (G >= 256) ? ((i == 0) ? c - 128 : -1) : i * G + c; if (L < 0 || L >= 8) return false; u.pm = L; u.pn = L >> 2; u.nv = 256; return true; }
    __device__ __forceinline__ void a_ready(const Unit&) const {}
    __device__ __forceinline__ void done(const Unit&) const {} };
struct EpiWeff { static constexpr bool PERM = true, AFTER_DRAIN = false; bf16_t* O;
    __device__ __forceinline__ void operator()(const f32x4 (&acc)[2][2][4][2], const Unit& u, int wr, int wc, int fr, int fq) const {
        const int row0 = (u.pm & 3) * 256 + wr * 64 + fr, col0 = u.pn * 256 + wc * 32 + 8 * fq;
#pragma unroll
        for (int ai = 0; ai < 2; ++ai)
#pragma unroll
            for (int m = 0; m < 4; ++m) { bf16_t* rowp = O + (size_t)(row0 + ai * 128 + m * 16) * D + col0;
#pragma unroll
                for (int bj = 0; bj < 2; ++bj) *(u32x4*)(rowp + bj * 128) = pack8(acc[ai][bj][m][0], acc[ai][bj][m][1]); }
    } };
template <int NSUB> struct ExpertOrder { int G, c; const volatile LAS unsigned* misc;
    __device__ __forceinline__ bool next(int i, Unit& u) const {
        const int L = i * G + c, tp = L / NSUB, sub = L % NSUB; if (tp >= __builtin_amdgcn_readfirstlane((int)misc[MW_TSTART + NEXP])) return false;
        const unsigned ent = (unsigned)__builtin_amdgcn_readfirstlane((int)misc[MW_TL + tp]); const int e = ent & 31u, rt = (ent >> 5) & 127u;
        u.pm = __builtin_amdgcn_readfirstlane((int)misc[MW_TSTART + e]) + rt; u.pn = e * NSUB + sub; u.nv = (int)(ent >> 12); return true; }
    __device__ __forceinline__ void a_ready(const Unit&) const {}
    __device__ __forceinline__ void done(const Unit&) const {} };

__device__ __forceinline__ void carry_unit(Frame& F, int unit) {
    const int d = unit & 1, g = (unit >> 1) & 31, b = unit >> 6, n = opq(hw_lane()), s = F.wave;
    const float* lt = (const float*)(F.ws + WS_LAMT) + ((g * 2 + d) * 64 + n) * 4;
    const float l16r = lt[0], l16i = lt[1], lkr = lt[2], lki = lt[3];
    const float* SL = (const float*)(F.ws + WS_SLOC) + (size_t)(g * NCH + b * 512) * 256 + d * 128 + n;
    bf16* AS = (bf16*)(F.ws + WS_AS) + (size_t)(g * NCH + b * 512) * 512 + 256 + d * 128 + n;
    LAS float* segE = (LAS float*)(F.lds + RING_OFF);
    float er = 0.f, ei = 0.f;
    for (int i0 = 0; i0 < 64; i0 += 16) {
        float sr[16], si[16];
#pragma unroll
        for (int ii = 0; ii < 16; ++ii) { const int i = s * 64 + i0 + ii, c = d ? (511 - i) : i; sr[ii] = SL[(size_t)c * 256]; si[ii] = SL[(size_t)c * 256 + 64]; }
#pragma unroll
        for (int ii = 0; ii < 16; ++ii) { const float tr = l16r * er - l16i * ei + sr[ii], ti = l16r * ei + l16i * er + si[ii]; er = tr; ei = ti; }
    }
    __syncthreads();
    segE[(s * 64 + n) * 2] = er; segE[(s * 64 + n) * 2 + 1] = ei;
    __syncthreads();
    float xr = 0.f, xi = 0.f;
    for (int sp = 0; sp < s; ++sp) { const float pr = segE[(sp * 64 + n) * 2], pi = segE[(sp * 64 + n) * 2 + 1];
        const float tr = lkr * xr - lki * xi + pr, ti = lkr * xi + lki * xr + pi; xr = tr; xi = ti; }
    for (int i0 = 0; i0 < 64; i0 += 16) {
        float sr[16], si[16];
#pragma unroll
        for (int ii = 0; ii < 16; ++ii) { const int i = s * 64 + i0 + ii, c = d ? (511 - i) : i; sr[ii] = SL[(size_t)c * 256]; si[ii] = SL[(size_t)c * 256 + 64]; }
#pragma unroll
        for (int ii = 0; ii < 16; ++ii) { const int i = s * 64 + i0 + ii, c = d ? (511 - i) : i;
            AS[(size_t)c * 512] = (bf16)f2bf(xr); AS[(size_t)c * 512 + 64] = (bf16)f2bf(xi);
            const float tr = l16r * xr - l16i * xi + sr[ii], ti = l16r * xi + l16i * xr + si[ii]; xr = tr; xi = ti; }
    }
    __syncthreads();
}
__device__ __forceinline__ void diff_row(Frame& F, int m) {
    const int t = m & (SEQ - 1), lane = opq(hw_lane()), h = 1 << (lane >> 4), lo = max(t - h, 0), hi = min(t + h, SEQ);
    const bf16* ZP = (const bf16*)(F.ws + WS_ZP) + (size_t)(m - t) * DP + lane * 8;
    float acc[8];
#pragma unroll
    for (int i = 0; i < 8; ++i) acc[i] = 0.f;
    v4u zt = (v4u){0u, 0u, 0u, 0u};
    v4u zz[16];
#pragma unroll
    for (int k = 0; k < 16; ++k) { const int s = t - 8 + k, sc = (s >= lo && s < hi) ? s : t; zz[k] = *(const GAS v4u*)(ZP + (size_t)sc * DP); }
#pragma unroll
    for (int k = 0; k < 16; ++k) { const int s = t - 8 + k; const float f = (s >= lo && s < hi) ? 1.f : 0.f; const v4u z = zz[k];
        acc[0] += f * bflo(z.x); acc[1] += f * bfhi(z.x); acc[2] += f * bflo(z.y); acc[3] += f * bfhi(z.y); acc[4] += f * bflo(z.z); acc[5] += f * bfhi(z.z); acc[6] += f * bflo(z.w); acc[7] += f * bfhi(z.w);
        if (k == 8) zt = z; }
    const float inv = 1.0f / (float)(hi - lo);
    v4u o; o.x = pk2(acc[0] * inv - bflo(zt.x), acc[1] * inv - bfhi(zt.x)); o.y = pk2(acc[2] * inv - bflo(zt.y), acc[3] * inv - bfhi(zt.y));
    o.z = pk2(acc[4] * inv - bflo(zt.z), acc[5] * inv - bfhi(zt.z)); o.w = pk2(acc[6] * inv - bflo(zt.w), acc[7] * inv - bfhi(zt.w));
    *(GAS v4u*)((bf16*)(F.ws + WS_CAT) + (size_t)m * D + lane * 8) = o;
#if MK_STAGE == 1
    *(GAS v4u*)((bf16*)(F.ws + WS_CAT) + (size_t)m * D + DP + lane * 8) = (v4u){0u, 0u, 0u, 0u};
#endif
}
__device__ __forceinline__ void route_phase(Frame& F, const Args& A) {
    typedef short s8v __attribute__((ext_vector_type(8)));
    const int lane = opq(hw_lane()), tok = lane & 15, kq = lane >> 4, w = F.wave, t = w * 64 + lane;
    s8v ah[4][3], al[4][3];
    { const bf16* wh = (const bf16*)(F.ws + WS_WR) + (size_t)tok * D + 128 * w + 8 * kq; const bf16* wl = wh + 48 * D;
#pragma unroll
      for (int sk = 0; sk < 4; ++sk)
#pragma unroll
          for (int q = 0; q < 3; ++q) { ah[sk][q] = *(const GAS s8v*)(wh + (size_t)q * 16 * D + 32 * sk); al[sk][q] = *(const GAS s8v*)(wl + (size_t)q * 16 * D + 32 * sk); } }
    LAS float* P = (LAS float*)(F.lds + RING_OFF);
    LAS float* R = P + 8 * 64 * 52;
    const int cid = (int)blockIdx.x, nit = M / 16;
    for (int b0 = cid; b0 < nit; b0 += 4 * F.G) {
        f32x4 acc[4][3];
        float ssq[4];
        f32x4 hc[4][2], hn[4][2];
        { const float* hrow = F.out + (size_t)(b0 * 16 + tok) * D + 128 * w + 8 * kq;
#pragma unroll
          for (int sk = 0; sk < 4; ++sk) { hc[sk][0] = *(const GAS f32x4*)(hrow + 32 * sk); hc[sk][1] = *(const GAS f32x4*)(hrow + 32 * sk + 4); } }
#pragma unroll
        for (int j = 0; j < 4; ++j) {
            const int itn = b0 + (j + 1) * F.G;
            if (j < 3 && itn < nit) { const float* hrow = F.out + (size_t)(itn * 16 + tok) * D + 128 * w + 8 * kq;
#pragma unroll
                for (int sk = 0; sk < 4; ++sk) { hn[sk][0] = *(const GAS f32x4*)(hrow + 32 * sk); hn[sk][1] = *(const GAS f32x4*)(hrow + 32 * sk + 4); } }
            acc[j][0] = (f32x4){0.f, 0.f, 0.f, 0.f}; acc[j][1] = acc[j][0]; acc[j][2] = acc[j][0]; ssq[j] = 0.f;
            if (b0 + j * F.G < nit) {
#pragma unroll
                for (int sk = 0; sk < 4; ++sk) {
                    const f32x4 h0 = hc[sk][0], h1 = hc[sk][1];
                    ssq[j] += (h0.x * h0.x + h0.y * h0.y) + (h0.z * h0.z + h0.w * h0.w) + (h1.x * h1.x + h1.y * h1.y) + (h1.z * h1.z + h1.w * h1.w);
                    const float hv[8] = {h0.x, h0.y, h0.z, h0.w, h1.x, h1.y, h1.z, h1.w};
                    s8v bh, bl;
#pragma unroll
                    for (int e8 = 0; e8 < 8; ++e8) { const unsigned hb = f2bf(hv[e8]); bh[e8] = (short)hb; bl[e8] = (short)f2bf(hv[e8] - __builtin_bit_cast(float, hb << 16)); }
#pragma unroll
                    for (int q = 0; q < 3; ++q) {
                        acc[j][q] = __builtin_amdgcn_mfma_f32_16x16x32_bf16(ah[sk][q], bh, acc[j][q], 0, 0, 0);
                        acc[j][q] = __builtin_amdgcn_mfma_f32_16x16x32_bf16(ah[sk][q], bl, acc[j][q], 0, 0, 0);
                        acc[j][q] = __builtin_amdgcn_mfma_f32_16x16x32_bf16(al[sk][q], bh, acc[j][q], 0, 0, 0);
                    }
                }
            }
#pragma unroll
            for (int sk = 0; sk < 4; ++sk) { hc[sk][0] = hn[sk][0]; hc[sk][1] = hn[sk][1]; }
        }
#pragma unroll
        for (int j = 0; j < 4; ++j) { LAS float* Pw = P + (w * 64 + j * 16 + tok) * 52;
#pragma unroll
            for (int q = 0; q < 3; ++q)
#pragma unroll
                for (int r = 0; r < 4; ++r) Pw[16 * q + 4 * kq + r] = acc[j][q][r];
            Pw[48 + kq] = ssq[j]; }
        __syncthreads();
        { const int t2 = opq(w * 64 + hw_lane());
#pragma unroll
          for (int i7 = 0; i7 < 7; ++i7) { const int idx = t2 + 512 * i7;
            if (idx < 64 * 52) { float sum = 0.f;
#pragma unroll
                for (int ww = 0; ww < 8; ++ww) sum += P[ww * (64 * 52) + idx];
                R[idx] = sum; } } }
        __syncthreads();
        if (w == 0) {
            const int ln = opq(hw_lane());
            const bool act = b0 + (ln >> 4) * F.G < nit;
            LAS unsigned* HI = (LAS unsigned*)F.MISC + MW_HIST; LAS unsigned* BA = (LAS unsigned*)F.MISC + MW_BASE;
            if (ln < NEXP) HI[ln] = 0u;
            const LAS float* tr = R + ln * 52; const int m = (b0 + (ln >> 4) * F.G) * 16 + (ln & 15);
            const float rstd = 1.f / sqrtf(((tr[48] + tr[49]) + (tr[50] + tr[51])) * (1.f / D) + RMS_EPS);
            float gl[4];
#pragma unroll
            for (int k = 0; k < 4; ++k) gl[k] = rstd * tr[k] + A.in[19][k];
            int gsel = 0; float gmax = gl[0];
#pragma unroll
            for (int k = 1; k < 4; ++k) if (gl[k] > gmax) { gmax = gl[k]; gsel = k; }
            float gden = 0.f;
#pragma unroll
            for (int k = 0; k < 4; ++k) gden += __expf(gl[k] - gmax);
            const float grp_p = 1.0f / gden;
            float el[8];
#pragma unroll
            for (int e = 0; e < 8; ++e) el[e] = rstd * tr[4 + gsel * 8 + e] + A.in[21][gsel * 8 + e];
            int i1 = 0; float m1 = el[0];
#pragma unroll
            for (int e = 1; e < 8; ++e) if (el[e] > m1) { m1 = el[e]; i1 = e; }
            int i2 = -1; float m2 = -3.0e38f;
#pragma unroll
            for (int e = 0; e < 8; ++e) if (e != i1 && el[e] > m2) { m2 = el[e]; i2 = e; }
            const float rr = __expf(m2 - m1), w1 = grp_p / (1.0f + rr), w2 = grp_p * rr / (1.0f + rr);
            const int e1 = gsel * 8 + i1, e2 = gsel * 8 + i2;
            unsigned r1 = 0u, r2 = 0u;
            if (act) { r1 = __hip_atomic_fetch_add(HI + e1, 1u, __ATOMIC_RELAXED, __HIP_MEMORY_SCOPE_WORKGROUP); r2 = __hip_atomic_fetch_add(HI + e2, 1u, __ATOMIC_RELAXED, __HIP_MEMORY_SCOPE_WORKGROUP); }
            LDS_WAIT(); asm volatile("" ::: "memory");
            if (ln < NEXP) { const unsigned hc_ = HI[ln]; BA[ln] = hc_ ? __hip_atomic_fetch_add((unsigned*)(F.ctl + CW_CNT) + 64 * ln, hc_, RLX_AGENT) : 0u; }
            LDS_WAIT(); asm volatile("" ::: "memory");
            if (act) { const unsigned p1 = BA[e1] + r1, p2 = BA[e2] + r2;
                int* LI = (int*)(F.ws + WS_LIST); float* LW = (float*)(F.ws + WS_LISTW); float* LR = (float*)(F.ws + WS_LISTR);
                LI[(size_t)e1 * M + p1] = 2 * m; LW[(size_t)e1 * M + p1] = w1; LR[(size_t)e1 * M + p1] = rstd;
                LI[(size_t)e2 * M + p2] = 2 * m + 1; LW[(size_t)e2 * M + p2] = w2; LR[(size_t)e2 * M + p2] = rstd; }
        }
        __syncthreads();
    }
}
template <class Sched> __device__ __forceinline__ void expert_setup(Frame& F, const Sched& S) {
    const int t = opq(F.wave * 64 + hw_lane());
    if (t < NEXP) F.MISC[MW_CNT + t] = __hip_atomic_load((unsigned*)(F.ctl + CW_CNT) + 64 * t, RLX_AGENT);
    __syncthreads();
    if (t < NEXP) {
        unsigned ts = 0u, nfull_before = 0u, nfull = 0u, rank = 0u; const unsigned n_me = F.MISC[MW_CNT + t], nv_me = n_me & 255u;
        for (int e = 0; e < NEXP; ++e) { const unsigned n = F.MISC[MW_CNT + e], nv = n & 255u;
            if (e < t) { ts += (n + 255u) >> 8; nfull_before += n >> 8; }
            nfull += n >> 8;
            if (nv > nv_me || (nv == nv_me && e < t)) rank += (nv > 0u) ? 1u : 0u; }
        F.MISC[MW_TSTART + t] = ts;
        if (t == NEXP - 1) F.MISC[MW_TSTART + NEXP] = ts + ((n_me + 255u) >> 8);
        for (unsigned rt = 0; rt < (n_me >> 8); ++rt) F.MISC[MW_TL + nfull_before + rt] = (unsigned)t | (rt << 5) | (256u << 12);
        if (nv_me > 0u) F.MISC[MW_TL + nfull + rank] = (unsigned)t | ((n_me >> 8) << 5) | (nv_me << 12);
    }
    __syncthreads();
    LAS unsigned* ro = (LAS unsigned*)(F.lds + ROWOFF_OFF);
    for (int i = 0; i < 4; ++i) { Unit u; if (!S.next(i, u)) break;
        const int e = u.pn >> 1, idx = ((int)u.pm - (int)F.MISC[MW_TSTART + e]) * 256 + (t & 255), n_e = (int)F.MISC[MW_CNT + e];
        if (t < 256) ro[i * 256 + t] = (idx < n_e) ? (unsigned)(((const int*)(F.ws + WS_LIST))[(size_t)e * M + idx] >> 1) * (unsigned)(D * 2) : 0u; }
    __syncthreads();
}
template <int R> __device__ __forceinline__ void moe_combine_rows(Frame& F, const Args& A, int m0, int stride) {
    const int lane = opq(hw_lane());
    const GAS f32x4* gr = (const GAS f32x4*)A.in[25] + lane;
    f32x4 v[R][4]; v2u a[R][4], b[R][4];
#pragma unroll
    for (int r = 0; r < R; ++r) { const size_t m = (size_t)(m0 + r * stride);
#pragma unroll
        for (int j = 0; j < 4; ++j) { v[r][j] = *((const GAS f32x4*)(F.out + m * D) + lane + 64 * j);
            a[r][j] = *((const GAS v2u*)((const bf16*)(F.ws + WS_MO0) + m * D) + lane + 64 * j); b[r][j] = *((const GAS v2u*)((const bf16*)(F.ws + WS_MO1) + m * D) + lane + 64 * j); } }
#pragma unroll
    for (int r = 0; r < R; ++r) { const size_t m = (size_t)(m0 + r * stride); float s = 0.f;
        GAS f32x4* hr = (GAS f32x4*)(F.out + m * D) + lane; GAS unsigned long long* o8 = (GAS unsigned long long*)((bf16*)(F.ws + WS_XN) + m * D) + lane;
#pragma unroll
        for (int j = 0; j < 4; ++j) { f32x4& x = v[r][j];
            x.x += bflo(a[r][j].x) + bflo(b[r][j].x); x.y += bfhi(a[r][j].x) + bfhi(b[r][j].x); x.z += bflo(a[r][j].y) + bflo(b[r][j].y); x.w += bfhi(a[r][j].y) + bfhi(b[r][j].y);
            hr[64 * j] = x; s += (x.x * x.x + x.y * x.y) + (x.z * x.z + x.w * x.w); }
        const float rstd = 1.f / sqrtf(wave_sum(s) * (1.f / D) + RMS_EPS);
#pragma unroll
        for (int j = 0; j < 4; ++j) { const f32x4 gg = gr[64 * j], x = v[r][j];
            o8[64 * j] = (unsigned long long)pk2(x.x * rstd * gg.x, x.y * rstd * gg.y) | ((unsigned long long)pk2(x.z * rstd * gg.z, x.w * rstd * gg.w) << 32); } }
}
template <int R, bool ADDG> __device__ __forceinline__ void final_rows(Frame& F, const Args& A, int m0, int stride) {
    const int lane = opq(hw_lane());
    const GAS f32x4* gr = (const GAS f32x4*)A.in[29] + lane;
    f32x4 v[R][4]; v2u gg[R][4];
#pragma unroll
    for (int r = 0; r < R; ++r) { const size_t m = (size_t)(m0 + r * stride);
#pragma unroll
        for (int j = 0; j < 4; ++j) { v[r][j] = *((const GAS f32x4*)(F.out + m * D) + lane + 64 * j);
            if (ADDG) gg[r][j] = *((const GAS v2u*)((const bf16*)(F.ws + WS_PE) + m * D) + lane + 64 * j); } }
#pragma unroll
    for (int r = 0; r < R; ++r) { const size_t m = (size_t)(m0 + r * stride); float s = 0.f;
        GAS f32x4* hr = (GAS f32x4*)(F.out + m * D) + lane;
#pragma unroll
        for (int j = 0; j < 4; ++j) { f32x4& x = v[r][j];
            if (ADDG) { x.x += bflo(gg[r][j].x); x.y += bfhi(gg[r][j].x); x.z += bflo(gg[r][j].y); x.w += bfhi(gg[r][j].y); }
            s += (x.x * x.x + x.y * x.y) + (x.z * x.z + x.w * x.w); }
        const float rstd = 1.f / sqrtf(wave_sum(s) * (1.f / D) + RMS_EPS);
#pragma unroll
        for (int j = 0; j < 4; ++j) hr[64 * j] = v[r][j] * rstd * gr[64 * j]; }
}

__global__ void __launch_bounds__(NWAVES * 64, 2) mk_fwd(Args args) {
    extern __shared__ __attribute__((aligned(16))) unsigned char lds[];
    Frame F;
    F.lds = (LAS unsigned char*)lds;
    F.MISC = (volatile LAS unsigned*)(F.lds + MISC_OFF);
    F.wave = __builtin_amdgcn_readfirstlane(threadIdx.x >> 6);
    F.G = gridDim.x; F.gw = blockIdx.x * NWAVES + F.wave; F.ngw = F.G * NWAVES;
    F.out = args.out; F.ws = args.ws; F.ctl = (gu32*)(args.ws + WS_CTL);
    for (int u = threadIdx.x; u < (LDS_BYTES - LDSCTL_OFF) / 4; u += NWAVES * 64) ((LAS unsigned*)(F.lds + LDSCTL_OFF))[u] = 0u;
    __syncthreads();
    XcdBarrier bar = xcd_barrier_post((unsigned*)(F.ctl + CW_BAR), F.MISC + 8); bar.wave = F.wave;
#define GRID_BAR() xcd_barrier(bar)
    bf16* const WIN = (bf16*)(F.ws + WS_WIN); bf16* const GLU = (bf16*)(F.ws + WS_GLU); bf16* const WCAT = (bf16*)(F.ws + WS_WCAT); bf16* const WG = (bf16*)(F.ws + WS_WG); bf16* const WPLE = (bf16*)(F.ws + WS_WPLE);
    bf16* const WGU = (bf16*)(F.ws + WS_WGU); bf16* const WD = (bf16*)(F.ws + WS_WD); bf16* const MS = (bf16*)(F.ws + WS_MS); bf16* const WS3 = (bf16*)(F.ws + WS_WS3);
    bf16* const XN = (bf16*)(F.ws + WS_XN); bf16* const ZP = (bf16*)(F.ws + WS_ZP); bf16* const AS = (bf16*)(F.ws + WS_AS); float* const SLOC = (float*)(F.ws + WS_SLOC);
    bf16* const CAT = (bf16*)(F.ws + WS_CAT); bf16* const ZZ = (bf16*)(F.ws + WS_ZZ); bf16* const PB = (bf16*)(F.ws + WS_PB); bf16* const PE = (bf16*)(F.ws + WS_PE);
    bf16* const ACT = (bf16*)(F.ws + WS_ACT); bf16* const MO0 = (bf16*)(F.ws + WS_MO0); bf16* const MO1 = (bf16*)(F.ws + WS_MO1);
    const int cid = (int)blockIdx.x;

#ifndef MK_REP
#define MK_REP -1
#endif
#define REP(k) for (int rep_ = 0; rep_ < ((MK_REP == (k)) ? 2 : 1); ++rep_)
    REP(0) { p0_prologue(F, args);
    GRID_BAR(); }
    REP(1) { pg8::Gemm g{XN, WIN, D, D, D}; pg8::StaticOrder S; S.init(M, D, F.G, cid); EpiZ E{ZP, AS};
      pg8::gemm_phase<EpiZ, pg8::StaticOrder, true, true>(F.lds + RING_OFF, g, S, E, F.wave);
    GRID_BAR(); }
#if MK_STAGE >= 2
    { pg8::Gemm g{AS, MS, 256, 512, 256}; GroupOrder S{F.G, cid}; EpiSloc E{SLOC};
      pg8::gemm_phase<EpiSloc, GroupOrder, true, true>(F.lds + RING_OFF, g, S, E, F.wave); }
    { pg8::Gemm g{(const bf16*)(F.ws + WS_WOS), (const bf16*)(F.ws + WS_BD), 256, 256, 256}; WeffOrder S{F.G, cid}; EpiWeff E{WCAT};
      pg8::gemm_phase<EpiWeff, WeffOrder, true, true>(F.lds + RING_OFF, g, S, E, F.wave); }
    bg_range(F, args, 0, 700, 0, 0);
    GRID_BAR();
#endif
    REP(3) {
#if MK_STAGE >= 2
        if (F.G >= 256) { if (cid < 128) { carry_unit(F, cid); for (int m = 12288 + cid * NWAVES + F.wave; m < M; m += 128 * NWAVES) diff_row(F, m); }
                          else for (int m = (cid - 128) * NWAVES + F.wave; m < 12288; m += (F.G - 128) * NWAVES) diff_row(F, m); }
        else { for (int u = cid; u < 128; u += F.G) carry_unit(F, u); for (int m = F.gw; m < M; m += F.ngw) diff_row(F, m); }
#else
        for (int m = F.gw; m < M; m += F.ngw) diff_row(F, m);
#endif
    GRID_BAR(); }
#if MK_STAGE >= 2
    { pg8::Gemm g{AS, WS3, 512, 512, 512}; GroupOrder S{F.G, cid}; EpiY E{ZZ};
      pg8::gemm_phase<EpiY, GroupOrder, true, true>(F.lds + RING_OFF, g, S, E, F.wave); }
    bg_range(F, args, 700, 4300, 0, M / 2);
    GRID_BAR();
    { pg8::Gemm g{ZZ, GLU, DP, DP, DP}; pg8::StaticOrder S; S.init(M, DP, F.G, cid); EpiGlu E{ZZ, args.in[15], CAT};
      pg8::gemm_phase<EpiGlu, pg8::StaticOrder, true, true>(F.lds + RING_OFF, g, S, E, F.wave); }
    bg_range(F, args, 4300, BG_TOTAL, M / 2, M);
    GRID_BAR();
#endif
    { pg8::Gemm g{CAT, WCAT, D, D, D}; pg8::StaticOrder S; S.init(M, D, F.G, cid); EpiRes E{args.in[0], F.out, args.in[17], XN};
      pg8::gemm_phase<EpiRes, pg8::StaticOrder, true, true>(F.lds + RING_OFF, g, S, E, F.wave); }
    GRID_BAR();
#if MK_STAGE >= 3
    route_phase(F, args);
    GRID_BAR();
    { pg8::Gemm g{XN, WGU, D, D, D}; ExpertOrder<2> S{F.G, cid, F.MISC}; expert_setup(F, S);
      EpiAct E{(const float*)(F.ws + WS_LISTW), (const float*)(F.ws + WS_LISTR), ACT, F.MISC + 16};
      pg8::gemm_phase<EpiAct, ExpertOrder<2>, true, true, true, true>(F.lds + RING_OFF, g, S, E, F.wave, (const LAS unsigned*)(F.lds + ROWOFF_OFF)); }
    GRID_BAR();
    { pg8::Gemm g{ACT, WD, DF, DF, DF}; ExpertOrder<4> S{F.G, cid, F.MISC}; EpiDown E{(const int*)(F.ws + WS_LIST), (const unsigned*)(F.ctl + CW_CNT), MO0, MO1, F.MISC + 16};
      pg8::gemm_phase<EpiDown, ExpertOrder<4>, true, true, false, true>(F.lds + RING_OFF, g, S, E, F.wave); }
    GRID_BAR();
    for (int m = F.gw; m + F.ngw < M; m += 2 * F.ngw) moe_combine_rows<2>(F, args, m, F.ngw);
    GRID_BAR();
#endif
#if MK_STAGE >= 4
    { pg8::Gemm g{PB, WPLE, DPLE, DPLE, DPLE}; pg8::StaticOrder S; S.init(M, D, F.G, cid); EpiPe E{PE};
      pg8::gemm_phase<EpiPe, pg8::StaticOrder, true, true>(F.lds + RING_OFF, g, S, E, F.wave); }
    asm volatile("s_waitcnt vmcnt(0)" ::: "memory"); __syncthreads();
    { pg8::Gemm g{XN, WG, D, D, D}; pg8::StaticOrder S; S.init(M, D, F.G, cid); EpiGate E{args.in[27], PE};
      pg8::gemm_phase<EpiGate, pg8::StaticOrder, true, true>(F.lds + RING_OFF, g, S, E, F.wave); }
    GRID_BAR();
#endif
    for (int m = F.gw; m + 3 * F.ngw < M; m += 4 * F.ngw) final_rows<4, (MK_STAGE >= 4)>(F, args, m, F.ngw);
}

extern "C" void kernel_launch(void* const* d_in, const int* in_sizes, int n_in, void* d_out, int out_size, void* d_ws, size_t ws_size, hipStream_t stream) {
    static int grid = 0;
    if (grid == 0) {
        if (n_in != 30 || in_sizes[0] != M * D || out_size != M * D || ws_size < WS_END) { fprintf(stderr, "kernel_launch: unexpected shapes (n_in %d, in0 %d, out %d, ws %zu)\n", n_in, n_in > 0 ? in_sizes[0] : -1, out_size, ws_size); grid = -1; return; }
        int dev = 0, cus = 0, per_cu = 0;
        if (hipGetDevice(&dev) != hipSuccess || hipDeviceGetAttribute(&cus, hipDeviceAttributeMultiprocessorCount, dev) != hipSuccess) { grid = -1; return; }
        if (hipFuncSetAttribute((const void*)mk_fwd, hipFuncAttributeMaxDynamicSharedMemorySize, LDS_BYTES) != hipSuccess) { fprintf(stderr, "kernel_launch: hipFuncSetAttribute failed\n"); grid = -1; return; }
        if (hipOccupancyMaxActiveBlocksPerMultiprocessor(&per_cu, (const void*)mk_fwd, NWAVES * 64, LDS_BYTES) != hipSuccess || per_cu < 1) { fprintf(stderr, "kernel_launch: occupancy query reports %d blocks per CU\n", per_cu); }
        (void)hipGetLastError();
        grid = cus;
    }
    if (grid < 0) return;
    (void)hipMemsetAsync((char*)d_ws + WS_CTL, 0, CTL_ZERO_BYTES, stream);
    Args a{};
    for (int i = 0; i < 30; ++i) a.in[i] = (const float*)d_in[i];
    a.out = (float*)d_out; a.ws = (unsigned char*)d_ws;
    hipLaunchKernelGGL(mk_fwd, dim3(grid), dim3(NWAVES * 64), LDS_BYTES, stream, a);
}
```

```cpp
#include <hip/hip_runtime.h>
#include <cstdio>
#include <cstdint>
__device__ __forceinline__ int hw_lane() { int l; asm volatile("v_mbcnt_lo_u32_b32 %0, -1, 0\n\tv_mbcnt_hi_u32_b32 %0, -1, %0" : "=v"(l)); return l; }
namespace pg8 {
#define PG8_LAS __attribute__((address_space(3)))
typedef unsigned short bf16_t;
typedef short bf16x8 __attribute__((ext_vector_type(8)));
typedef float f32x4 __attribute__((ext_vector_type(4)));
typedef unsigned u32x4 __attribute__((ext_vector_type(4)));
constexpr int BM = 256, BK = 64, HALF = 128, HTB = HALF * BK * 2  , STAGE_BYTES = 8 * HTB, NXCD = 8, WGM = 8;

__host__ __device__ __forceinline__ int lds_byte(int r, int c) { const int st = (r >> 4) * 2 + (c >> 5), rr = r & 15, cc = c & 31, ob = rr * 64 + cc * 2; return st * 1024 + (ob ^ (((ob >> 9) & 1) << 5)); }
__host__ __device__ __forceinline__ void stage_rc(int b, int& R, int& C) { const int st = b / 1024, sb = b % 1024, swz = sb ^ (((sb >> 9) & 1) << 5); R = (st >> 1) * 16 + swz / 64; C = (st & 1) * 32 + (swz % 64) / 2; }
__host__ __device__ __forceinline__ int perm32(int rho) { const int n = rho >> 4, i = rho & 15; return 8 * (i >> 2) + 4 * n + (i & 3); }

struct Unit { int pm, pn, nv; };
struct Gemm { const bf16_t* A; const bf16_t* Bt; int K, lda, ldb; };

struct StaticOrder {
    int nM, nN, nwg, G, c;
    __host__ __device__ void init(int M, int N, int G_, int c_) { nM = M / BM; nN = N / BM; nwg = nM * nN; G = G_; c = c_; }
    __host__ __device__ bool next(int i, Unit& u) const {
        const long L = (long)i * G + c; if (L >= nwg) return false;
        int wgid = (int)L; { const int q = nwg / NXCD, r = nwg % NXCD, xcd = wgid % NXCD, off = wgid / NXCD; wgid = (xcd < r ? xcd * (q + 1) : r * (q + 1) + (xcd - r) * q) + off; }
        const int nig = WGM * nN, gid = wgid / nig, fm = gid * WGM, gsz = (nM - fm) < WGM ? (nM - fm) : WGM;
        u.pm = fm + ((wgid % nig) % gsz); u.pn = (wgid % nig) / gsz; u.nv = 256; return true;
    }
    __device__ __forceinline__ void a_ready(const Unit&) const {}
    __device__ __forceinline__ void done(const Unit&) const {}
};

template <class Epi, class Sched, bool ALIGN_EPI = false, bool SP2 = false, bool GATHER = false, bool SKIP = false>
__device__ __forceinline__ void gemm_phase(PG8_LAS unsigned char* lds, const Gemm g, const Sched& S, const Epi& E, const int wid  , const PG8_LAS unsigned* rowoff = nullptr) {
    static_assert(!GATHER || SP2, "GATHER is written for the SP2 loop");
    int lane_ = hw_lane(); asm volatile("" : "+v"(lane_));
    const int lane = lane_, tid = wid * 64 + lane, wr = wid >> 2, wc = wid & 3, fr = lane & 15, fq = lane >> 4;
    const int K = g.K, nt = K / BK;
    unsigned voffA[2], voffB[2];
#pragma unroll
    for (int i = 0; i < 2; ++i) { int R, C; stage_rc(tid * 16 + i * 8192, R, C); const int Rb = Epi::PERM ? ((R & ~31) + perm32(R & 31)) : R;
        voffA[i] = (unsigned)(R * g.lda + C) * 2u; voffB[i] = (unsigned)(Rb * g.ldb + C) * 2u; }
    const size_t kstep = (size_t)(BK * 2);
    const size_t hstepA = GATHER ? (size_t)0 : (size_t)HALF * g.lda * 2, hstepB = (size_t)HALF * g.ldb * 2;
    const size_t tstepA = 2 * hstepA, tstepB = 2 * hstepB;
    const unsigned ldsw = (unsigned)wid * 1024u;
    const int aoff = lds_byte(wr * 64 + fr, fq * 8), boff = lds_byte(wc * 32 + fr, fq * 8);
    unsigned cvo[2][2];
#define PG8_LOADVO(dst, u_) do { _Pragma("unroll") for (int _h = 0; _h < 2; ++_h) _Pragma("unroll") for (int _i = 0; _i < 2; ++_i) { int R_, C_; stage_rc(tid * 16 + _i * 8192, R_, C_); \
        dst[_h][_i] = rowoff[(u_) * 256 + _h * 128 + R_] + (unsigned)C_ * 2u; } } while (0)
#define PG8_VA(h) (GATHER ? cvo[h] : voffA)
#define PG8_SA(b, h) (((b) * 2 + (h)) * HTB)
#define PG8_SB(b, h) ((4 + (b) * 2 + (h)) * HTB)
#define PG8_STAGE(bufoff, gbase, voff) do { _Pragma("unroll") for (int _i = 0; _i < 2; ++_i) \
        __builtin_amdgcn_global_load_lds((const unsigned*)((const char*)(gbase) + (voff)[_i]), (PG8_LAS unsigned*)(lds + (bufoff) + ldsw + _i * 8192), 16, 0, 0); } while (0)
#define PG8_LDA(dst, b, h) do { _Pragma("unroll") for (int m = 0; m < 4; ++m) _Pragma("unroll") for (int k = 0; k < 2; ++k) dst[m][k] = *(const PG8_LAS bf16x8*)(lds + PG8_SA(b, h) + aoff + m * 2048 + k * 1024); } while (0)
#define PG8_LDB(dst, b, h) do { _Pragma("unroll") for (int n = 0; n < 2; ++n) _Pragma("unroll") for (int k = 0; k < 2; ++k) dst[n][k] = *(const PG8_LAS bf16x8*)(lds + PG8_SB(b, h) + boff + n * 2048 + k * 1024); } while (0)
#define PG8_MMA(ai, bj, At, Bt) do { if (SKIP && (ai) * HALF + wr * 64 >= cur.nv) break; __builtin_amdgcn_s_setprio(1); _Pragma("unroll") for (int m = 0; m < 4; ++m) _Pragma("unroll") for (int n = 0; n < 2; ++n) _Pragma("unroll") for (int k = 0; k < 2; ++k) \
        acc[ai][bj][m][n] = __builtin_amdgcn_mfma_f32_16x16x32_bf16(Bt[n][k], At[m][k], acc[ai][bj][m][n], 0, 0, 0); __builtin_amdgcn_s_setprio(0); } while (0)
#define PG8_WAIT_V(n) asm volatile("s_waitcnt vmcnt(" #n ")" ::: "memory")
#define PG8_WAIT_L(n) asm volatile("s_waitcnt lgkmcnt(" #n ")" ::: "memory")
#define PG8_BAR __builtin_amdgcn_s_barrier()
#define PG8_SCHED __builtin_amdgcn_sched_barrier(0)
    Unit cur, nxt; int ui = 0;
    if (!S.next(0, cur)) return;
    f32x4 acc[2][2][4][2];
#pragma unroll
    for (int a = 0; a < 2; ++a)
#pragma unroll
        for (int b = 0; b < 2; ++b)
#pragma unroll
            for (int m = 0; m < 4; ++m)
#pragma unroll
                for (int n = 0; n < 2; ++n) acc[a][b][m][n] = (f32x4){0.f, 0.f, 0.f, 0.f};
    bf16x8 At[4][2], B0[2][2], B1[2][2];
    const char* cA = (const char*)g.A + (size_t)cur.pm * tstepA; const char* cB = (const char*)g.Bt + (size_t)cur.pn * tstepB;
    S.a_ready(cur);
    if constexpr (GATHER) PG8_LOADVO(cvo, 0);
    if constexpr (SP2) {
        PG8_STAGE(PG8_SB(0, 0), cB, voffB); PG8_STAGE(PG8_SB(0, 1), cB + hstepB, voffB); PG8_STAGE(PG8_SA(0, 0), cA, PG8_VA(0)); PG8_STAGE(PG8_SA(0, 1), cA + hstepA, PG8_VA(1));
        if (wr == 1) PG8_BAR;
        PG8_WAIT_V(2); PG8_BAR;
        PG8_STAGE(PG8_SB(1, 0), cB + kstep, voffB); PG8_STAGE(PG8_SA(1, 0), cA + kstep, PG8_VA(0)); PG8_STAGE(PG8_SB(1, 1), cB + hstepB + kstep, voffB);
        PG8_WAIT_V(6); PG8_BAR;
    } else {
        PG8_STAGE(PG8_SB(0, 0), cB, voffB); PG8_STAGE(PG8_SA(0, 0), cA, voffA); PG8_STAGE(PG8_SB(0, 1), cB + hstepB, voffB); PG8_STAGE(PG8_SA(0, 1), cA + hstepA, voffA);
        if (wr == 1) PG8_BAR;
        PG8_WAIT_V(4); PG8_BAR;
        PG8_STAGE(PG8_SB(1, 0), cB + kstep, voffB); PG8_STAGE(PG8_SA(1, 0), cA + kstep, voffA); PG8_STAGE(PG8_SB(1, 1), cB + hstepB + kstep, voffB);
        PG8_WAIT_V(6); PG8_BAR;
    }
    for (;;) {
        const bool has_next = S.next(ui + 1, nxt);
        const char* nA = has_next ? (const char*)g.A + (size_t)nxt.pm * tstepA : cA; const char* nB = has_next ? (const char*)g.Bt + (size_t)nxt.pn * tstepB : cB;
        for (int t = 0; t < nt; t += 2) {
            const bool last = (t == nt - 2);
            const char* a1 = cA + (size_t)(t + 1) * kstep;
            const char* a2 = last ? nA : cA + (size_t)(t + 2) * kstep; const char* b2 = last ? nB : cB + (size_t)(t + 2) * kstep;
            const char* a3 = a2 + kstep; const char* b3 = b2 + kstep;
            if (last && has_next) S.a_ready(nxt);
            if constexpr (SP2) {
            PG8_LDB(B0, 0, 0); PG8_LDB(B1, 0, 1); PG8_SCHED; PG8_LDA(At, 0, 0); PG8_STAGE(PG8_SA(1, 1), a1 + hstepA, PG8_VA(1));
            if constexpr (GATHER) { if (last && has_next) PG8_LOADVO(cvo, ui + 1); }
            PG8_WAIT_V(8); PG8_WAIT_L(0); PG8_BAR; PG8_MMA(0, 0, At, B0); PG8_MMA(0, 1, At, B1); PG8_BAR; PG8_SCHED;
            PG8_LDA(At, 0, 1); PG8_STAGE(PG8_SB(0, 0), b2, voffB); PG8_STAGE(PG8_SB(0, 1), b2 + hstepB, voffB); PG8_STAGE(PG8_SA(0, 0), a2, PG8_VA(0));
            PG8_WAIT_V(8); PG8_WAIT_L(0); PG8_BAR; PG8_MMA(1, 0, At, B0); PG8_MMA(1, 1, At, B1); PG8_BAR; PG8_SCHED;
            PG8_LDB(B0, 1, 0); PG8_LDB(B1, 1, 1); PG8_SCHED; PG8_LDA(At, 1, 0); PG8_STAGE(PG8_SA(0, 1), a2 + hstepA, PG8_VA(1));
            PG8_WAIT_V(8); PG8_WAIT_L(0); PG8_BAR; PG8_MMA(0, 0, At, B0); PG8_MMA(0, 1, At, B1); PG8_BAR; PG8_SCHED;
            PG8_LDA(At, 1, 1); PG8_STAGE(PG8_SB(1, 0), b3, voffB); PG8_STAGE(PG8_SB(1, 1), b3 + hstepB, voffB); PG8_STAGE(PG8_SA(1, 0), a3, PG8_VA(0));
            PG8_WAIT_V(8); PG8_WAIT_L(0); PG8_BAR; PG8_MMA(1, 0, At, B0); PG8_MMA(1, 1, At, B1); PG8_BAR; PG8_SCHED;
            } else {
            PG8_LDB(B0, 0, 0); PG8_SCHED; PG8_LDA(At, 0, 0); PG8_STAGE(PG8_SA(1, 1), a1 + hstepA, voffA);
            PG8_WAIT_L(8); PG8_BAR; PG8_WAIT_L(0); PG8_MMA(0, 0, At, B0); PG8_BAR; PG8_SCHED;
            PG8_LDB(B1, 0, 1); PG8_STAGE(PG8_SB(0, 0), b2, voffB);
            PG8_BAR; PG8_WAIT_L(0); PG8_MMA(0, 1, At, B1); PG8_BAR;
            PG8_LDA(At, 0, 1); PG8_STAGE(PG8_SA(0, 0), a2, voffA);
            PG8_BAR; PG8_WAIT_L(0); PG8_MMA(1, 0, At, B0); PG8_BAR; PG8_SCHED;
            PG8_STAGE(PG8_SB(0, 1), b2 + hstepB, voffB);
            PG8_WAIT_V(6); PG8_BAR; PG8_MMA(1, 1, At, B1); PG8_BAR;
            PG8_LDB(B0, 1, 0); PG8_SCHED; PG8_LDA(At, 1, 0); PG8_STAGE(PG8_SA(0, 1), a2 + hstepA, voffA);
            PG8_WAIT_L(8); PG8_BAR; PG8_WAIT_L(0); PG8_MMA(0, 0, At, B0); PG8_BAR; PG8_SCHED;
            PG8_LDB(B1, 1, 1); PG8_STAGE(PG8_SB(1, 0), b3, voffB);
            PG8_BAR; PG8_WAIT_L(0); PG8_MMA(0, 1, At, B1); PG8_BAR;
            PG8_LDA(At, 1, 1); PG8_STAGE(PG8_SA(1, 0), a3, voffA);
            PG8_BAR; PG8_WAIT_L(0); PG8_MMA(1, 0, At, B0); PG8_BAR; PG8_SCHED;
            PG8_STAGE(PG8_SB(1, 1), b3 + hstepB, voffB);
            PG8_WAIT_V(6); PG8_BAR; PG8_MMA(1, 1, At, B1); PG8_BAR;
            }
        }
        if constexpr (ALIGN_EPI) { if (wr == 0) PG8_BAR; }
        if constexpr (!Epi::AFTER_DRAIN) { E(acc, cur, wr, wc, fr, fq); S.done(cur); }
        if (!has_next) break;
#pragma unroll
        for (int a = 0; a < 2; ++a)
#pragma unroll
            for (int b = 0; b < 2; ++b)
#pragma unroll
                for (int m = 0; m < 4; ++m)
#pragma unroll
                    for (int n = 0; n < 2; ++n) acc[a][b][m][n] = (f32x4){0.f, 0.f, 0.f, 0.f};
        cur = nxt; cA = nA; cB = nB; ++ui;
        if constexpr (ALIGN_EPI) { if (wr == 1) PG8_BAR; }
    }
    PG8_WAIT_V(0);
    if constexpr (!ALIGN_EPI) { if (wr == 0) PG8_BAR; }
    PG8_BAR;
    if constexpr (Epi::AFTER_DRAIN) { E.fused(acc, cur, wr, wc, fr, fq, lds, wid, lane); S.done(cur); }
#undef PG8_SA
#undef PG8_LOADVO
#undef PG8_VA
#undef PG8_SB
#undef PG8_STAGE
#undef PG8_LDA
#undef PG8_LDB
#undef PG8_MMA
#undef PG8_WAIT_V
#undef PG8_WAIT_L
#undef PG8_BAR
#undef PG8_SCHED
}
}

#ifndef MK_STAGE
#define MK_STAGE 4
#endif
constexpr int NWAVES = 8;
constexpr int M = 16384, D = 1024, SEQ = 8192, DP = 512, NG = 32, NST = 64, GC = 16, CL = 16  ;
constexpr int NCH = M / CL;
constexpr int NEXP = 32, DF = 256, DPLE = 256;
constexpr int VP_ROWS = 2 * M + NEXP * 256;
constexpr float RMS_EPS = 1e-6f;

constexpr size_t MiB = 1u << 20;
constexpr size_t WS_CTL = 0, CTL_ZERO_BYTES = 1 * MiB;
constexpr size_t WS_WR = 1 * MiB;
constexpr size_t WS_LAMT = 1 * MiB + 256 * 1024;
constexpr size_t WS_ROUTE = 1 * MiB + 512 * 1024;
constexpr size_t WS_WIN = 2 * MiB, WS_GLU = 4 * MiB, WS_WCAT = 5 * MiB, WS_WG = 7 * MiB, WS_WPLE = 9 * MiB;
constexpr size_t WS_ROWINFO = 9 * MiB + 512 * 1024, WS_ROWW = 9 * MiB + 768 * 1024;
constexpr size_t WS_WGU = 10 * MiB, WS_WD = 42 * MiB;
constexpr size_t WS_MS = 58 * MiB, WS_WS3 = 62 * MiB;
constexpr size_t WS_ZZ = 70 * MiB;
constexpr size_t WS_PE = 58 * MiB;
constexpr size_t WS_XN = 90 * MiB;
constexpr size_t WS_ZP = 122 * MiB, WS_AS = 138 * MiB, WS_SLOC = 170 * MiB, WS_CAT = 202 * MiB, WS_PB = 234 * MiB;
constexpr size_t WS_VP = 122 * MiB, WS_ACT = 202 * MiB, WS_MO0 = 122 * MiB, WS_MO1 = 154 * MiB;
constexpr size_t WS_LIST = 244 * MiB, WS_LISTW = 246 * MiB, WS_LISTR = 248 * MiB;
constexpr size_t WS_WOS = 242 * MiB, WS_BD = 243 * MiB;
constexpr size_t WS_END = 256 * MiB;
static_assert(WS_VP + (size_t)VP_ROWS * 2048 <= WS_ACT && WS_ACT + (size_t)VP_ROWS * 512 <= WS_PB && WS_PB + (size_t)M * 512 <= WS_END, "ws map");
constexpr int CW_CNT = 8192;
constexpr int CW_BAR = 4096;
constexpr int ROWOFF_OFF = 143360;
constexpr int RING_OFF = 0, RING_BYTES = 131072, P0_SCR = 64 * 65 * 4  , LDSCTL_OFF = 139264, MISC_OFF = LDSCTL_OFF + 320, LDS_BYTES = 147456;
static_assert(NWAVES * P0_SCR <= LDSCTL_OFF && MISC_OFF + 4 * 512 <= ROWOFF_OFF && ROWOFF_OFF + 4 * 1024 <= LDS_BYTES, "LDS map");
constexpr int MW_TSTART = 16, MW_HIST = 64, MW_BASE = 96, MW_CNT = 128, MW_TL = 192;

#define GAS __attribute__((address_space(1)))
#define LAS __attribute__((address_space(3)))
typedef unsigned short bf16;
typedef unsigned v4u __attribute__((ext_vector_type(4)));
typedef unsigned v2u __attribute__((ext_vector_type(2)));
typedef float f32x4 __attribute__((ext_vector_type(4)));
typedef GAS unsigned gu32;
#define RLX_AGENT __ATOMIC_RELAXED, __HIP_MEMORY_SCOPE_AGENT
#define LDS_WAIT() asm volatile("s_waitcnt lgkmcnt(0)" ::: "memory")
#define VM_WAIT() asm volatile("s_waitcnt vmcnt(0)" ::: "memory")
__device__ __forceinline__ unsigned f2bf(float f) { unsigned u = __builtin_bit_cast(unsigned, f); return (u + 0x7fffu + ((u >> 16) & 1u)) >> 16; }
__device__ __forceinline__ unsigned pk2(float lo, float hi) { return f2bf(lo) | (f2bf(hi) << 16); }
__device__ __forceinline__ float bflo(unsigned w) { return __builtin_bit_cast(float, w << 16); }
__device__ __forceinline__ float bfhi(unsigned w) { return __builtin_bit_cast(float, w & 0xffff0000u); }
__device__ __forceinline__ float sigmoidf_(float x) { return 1.0f / (1.0f + __expf(-x)); }
__device__ __forceinline__ float gelu_tanh(float y) { const float t = 1.5957691216f * (y + 0.044715f * y * y * y); return y / (1.0f + __expf(-t)); }

#define XB_TMO      128
#define XB_XCNT(j)  (256  + 64 * (j))
#define XB_XSUB(j)  (1280 + 64 * (j))
#define XB_XGEN(j)  (2304 + 64 * (j))
#define XB_TOP      3328
#define XB_TOPGEN   3392
#define XCD_BAR_WORDS 3456
#define XB_SPIN_CAP (1u << 18)
__device__ __forceinline__ unsigned xb_ld(unsigned* p)              { return __hip_atomic_load(p, __ATOMIC_RELAXED, __HIP_MEMORY_SCOPE_AGENT); }
__device__ __forceinline__ unsigned xb_add(unsigned* p, unsigned v) { return __hip_atomic_fetch_add(p, v, __ATOMIC_RELAXED, __HIP_MEMORY_SCOPE_AGENT); }
__device__ __forceinline__ unsigned xb_xcc_id() { return (unsigned)__builtin_amdgcn_s_getreg((3 << 11) | 20) & 0xFu; }
#define XB_SPIN(cond, bar) do { unsigned _sp = 0; while (cond) { __builtin_amdgcn_s_sleep(1); \
    if ((++_sp & 255u) == 0u) { if (xb_ld(&(bar)[XB_TMO])) break; if (_sp > XB_SPIN_CAP) { atomicAdd(&(bar)[XB_TMO], 1u); break; } } } } while (0)
struct XcdBarrier { unsigned* bar; unsigned x; volatile LAS unsigned* st; int wave; };
__device__ __forceinline__ XcdBarrier xcd_barrier_post(unsigned* bar, volatile LAS unsigned* st) {
    XcdBarrier b; b.bar = bar; b.x = xb_xcc_id(); b.st = st; b.wave = 0;
    if (threadIdx.x == 0) (void)xb_add(&bar[XB_XCNT(b.x)], 1u);
    return b;
}
__device__ __forceinline__ void xcd_barrier_complete(unsigned* bar, unsigned x, unsigned& nloc, unsigned& nx) {
    const unsigned G = gridDim.x * gridDim.y * gridDim.z;
    unsigned sum, cnt, mine, sp = 0u;
    for (;;) {
        sum = 0u; cnt = 0u; mine = 0u;
#pragma unroll
        for (unsigned j = 0; j < 16; ++j) { const unsigned c = xb_ld(&bar[XB_XCNT(j)]); sum += c; cnt += (c > 0u) ? 1u : 0u; mine = (j == x) ? c : mine; }
        if (sum == G) break;
        __builtin_amdgcn_s_sleep(1);
        if ((++sp & 255u) == 0u) { if (xb_ld(&bar[XB_TMO])) break; if (sp > XB_SPIN_CAP) { atomicAdd(&bar[XB_TMO], 1u); break; } }
    }
    nloc = mine > 0u ? mine : 1u; nx = cnt > 0u ? cnt : 1u;
}
__device__ __forceinline__ void xcd_barrier(const XcdBarrier& b) {
    asm volatile("s_waitcnt vmcnt(0)" ::: "memory");
    __syncthreads();
    if (b.wave == 0 && hw_lane() == 0) {
        unsigned* bar = b.bar;
        __builtin_amdgcn_s_waitcnt(0);
        unsigned nloc = b.st[0], nx = b.st[1];
        if (nloc == 0u) { xcd_barrier_complete(bar, b.x, nloc, nx); b.st[0] = nloc; b.st[1] = nx; }
        const unsigned old = xb_add(&bar[XB_XSUB(b.x)], 1u);
        const unsigned gen = old / nloc;
        if (old + 1u == (gen + 1u) * nloc) {
            __builtin_amdgcn_fence(__ATOMIC_RELEASE, "agent");
            asm volatile("s_waitcnt vmcnt(0)" ::: "memory");
            const unsigned og = xb_add(&bar[XB_TOP], 1u);
            const unsigned tg = og / nx;
            if (og + 1u == (tg + 1u) * nx) xb_add(&bar[XB_TOPGEN], 1u);
            else XB_SPIN(xb_ld(&bar[XB_TOPGEN]) == tg, bar);
            __builtin_amdgcn_fence(__ATOMIC_ACQUIRE, "agent");
            xb_add(&bar[XB_XGEN(b.x)], 1u);
            asm volatile("s_waitcnt vmcnt(0)" ::: "memory");
        } else {
            XB_SPIN(xb_ld(&bar[XB_XGEN(b.x)]) == gen, bar);
            __builtin_amdgcn_fence(__ATOMIC_ACQUIRE, "agent");
            asm volatile("s_waitcnt vmcnt(0)" ::: "memory");
        }
    }
    __syncthreads();
}

struct Args { const float* in[30]; float* out; unsigned char* ws; };
struct Frame {
    LAS unsigned char* lds;
    volatile LAS unsigned* MISC;
    gu32* ctl;
    int wave, G, gw, ngw;
    float* out;
    unsigned char* ws;
};
__device__ __forceinline__ int opq(int v) { asm volatile("" : "+v"(v)); return v; }
template <int CTRL> __device__ __forceinline__ float dpp_f(float v) { return __builtin_bit_cast(float, __builtin_amdgcn_update_dpp(0, __builtin_bit_cast(int, v), CTRL, 0xf, 0xf, true)); }
__device__ __forceinline__ float wave_sum(float v) {
    v += dpp_f<0xB1>(v);
    v += dpp_f<0x4E>(v);
    v += dpp_f<0x141>(v);
    v += dpp_f<0x140>(v);
    const float r0 = __builtin_bit_cast(float, __builtin_amdgcn_readlane(__builtin_bit_cast(int, v), 0)), r1 = __builtin_bit_cast(float, __builtin_amdgcn_readlane(__builtin_bit_cast(int, v), 16));
    const float r2 = __builtin_bit_cast(float, __builtin_amdgcn_readlane(__builtin_bit_cast(int, v), 32)), r3 = __builtin_bit_cast(float, __builtin_amdgcn_readlane(__builtin_bit_cast(int, v), 48));
    return (r0 + r1) + (r2 + r3);
}

__device__ __forceinline__ void transpose_item64(const float* src, int ld_src, bf16* dst, int ld_dst, LAS float* scr, int lane, const float* kscale = nullptr) {
    f32x4 v[16];
    const int kq = lane >> 4, n4 = (lane & 15) * 4;
#pragma unroll
    for (int i = 0; i < 16; ++i) v[i] = *(const GAS f32x4*)(src + (size_t)(4 * i + kq) * ld_src + n4);
    if (kscale) {
#pragma unroll
        for (int i = 0; i < 16; ++i) v[i] = v[i] * kscale[4 * i + kq]; }
#pragma unroll
    for (int i = 0; i < 16; ++i) { LAS float* p = scr + (4 * i + kq) * 65 + n4; p[0] = v[i].x; p[1] = v[i].y; p[2] = v[i].z; p[3] = v[i].w; }
    LDS_WAIT(); asm volatile("" ::: "memory");
    const int c = lane & 7;
#pragma unroll
    for (int j = 0; j < 8; ++j) { const int n = (lane >> 3) + 8 * j; const LAS float* q = scr + (8 * c) * 65 + n;
        v4u o; o.x = pk2(q[0 * 65], q[1 * 65]); o.y = pk2(q[2 * 65], q[3 * 65]); o.z = pk2(q[4 * 65], q[5 * 65]); o.w = pk2(q[6 * 65], q[7 * 65]);
        *(GAS v4u*)(dst + (size_t)n * ld_dst + 8 * c) = o; }
    LDS_WAIT(); asm volatile("" ::: "memory");
}
__device__ __forceinline__ void rms_row_to_bf16(const float* xrow, const float* g, bf16* orow, int lane) {
    const GAS f32x4* xr = (const GAS f32x4*)xrow + lane; const GAS f32x4* gr = (const GAS f32x4*)g + lane;
    f32x4 v[4]; float s = 0.f;
#pragma unroll
    for (int j = 0; j < 4; ++j) { v[j] = xr[64 * j]; s += (v[j].x * v[j].x + v[j].y * v[j].y) + (v[j].z * v[j].z + v[j].w * v[j].w); }
    const float rstd = 1.f / sqrtf(wave_sum(s) * (1.f / D) + RMS_EPS);
    GAS unsigned long long* o8 = (GAS unsigned long long*)orow + lane;
#pragma unroll
    for (int j = 0; j < 4; ++j) { const f32x4 gg = gr[64 * j];
        o8[64 * j] = (unsigned long long)pk2(v[j].x * rstd * gg.x, v[j].y * rstd * gg.y) | ((unsigned long long)pk2(v[j].z * rstd * gg.z, v[j].w * rstd * gg.w) << 32); }
}
__device__ __forceinline__ void sincos_d(double x, double& sn, double& cs) {
    const double k = __builtin_rint(x * 0.63661977236758134308);
    const double r = (x - k * 1.57079632679489655800e+00) - k * 6.12323399573676603587e-17;
    const double r2 = r * r;
    const double s = r * (1.0 + r2 * (-1.0 / 6.0 + r2 * (1.0 / 120.0 + r2 * (-1.0 / 5040.0 + r2 * (1.0 / 362880.0 + r2 * (-1.0 / 39916800.0 + r2 * (1.0 / 6227020800.0)))))));
    const double c = 1.0 + r2 * (-0.5 + r2 * (1.0 / 24.0 + r2 * (-1.0 / 720.0 + r2 * (1.0 / 40320.0 + r2 * (-1.0 / 3628800.0 + r2 * (1.0 / 479001600.0 + r2 * (-1.0 / 87178291200.0)))))));
    const int q = ((int)k) & 3;
    sn = (q == 0) ? s : (q == 1) ? c : (q == 2) ? -s : -c;
    cs = (q == 0) ? c : (q == 1) ? -s : (q == 2) ? -c : s;
}
__device__ __forceinline__ void ssm_gen(Frame& F, const Args& A, int g, int sl) {
    LAS float* lamP = (LAS float*)(F.lds + RING_OFF);
    LAS float* Bb = lamP + 2 * 17 * 64 * 2;
    LAS float* Cc = Bb + 2 * 64 * 16 * 2;
    LAS float* KT = Cc + 2 * 16 * 64 * 2;
    LAS float* dv = KT + 32 * 260;
    LAS float* bfac = dv + 16;
    const float* a_re = A.in[6]; const float* a_im = A.in[7]; const float* log_dt = A.in[8];
    const float* b_re = A.in[9]; const float* b_im = A.in[10]; const float* c_re = A.in[11]; const float* c_im = A.in[12]; const float* ssm_d = A.in[13];
    const int t = opq(F.wave * 64 + hw_lane());
    float pbr[4], pbi[4], pcr[4], pci[4];
#pragma unroll
    for (int i = 0; i < 4; ++i) { const int idx = t + 512 * i; const size_t si = (size_t)((idx >> 10) * NG + g) * 1024 + (idx & 1023);
        pbr[i] = b_re[si]; pbi[i] = b_im[si]; pcr[i] = c_re[si]; pci[i] = c_im[si]; }
    const int d_a = (t >> 6) & 1, n_a = t & 63;
    const float p_are = a_re[(d_a * NG + g) * NST + n_a], p_aim = a_im[(d_a * NG + g) * NST + n_a], p_ldt = log_dt[d_a * NG + g], p_dv = ssm_d[g * GC + (t & 15)];
    __syncthreads();
    if (t < 128) {
        const int d = d_a, n = n_a;
        const float dtf = expf(p_ldt), mag = expf(p_are * dtf); const double ang = (double)p_aim * (double)dtf;
        double sn, cs; sincos_d(ang, sn, cs);
        const float lr = mag * (float)cs, li = mag * (float)sn;
        const float nr = lr - 1.0f, ni = li, den = p_are * p_are + p_aim * p_aim;
        bfac[(d * 64 + n) * 2] = (nr * p_are + ni * p_aim) / den; bfac[(d * 64 + n) * 2 + 1] = (ni * p_are - nr * p_aim) / den;
        float pr = 1.0f, pi = 0.0f;
        for (int k = 0; k <= 16; ++k) { lamP[((d * 17 + k) * 64 + n) * 2] = pr; lamP[((d * 17 + k) * 64 + n) * 2 + 1] = pi;
            const float tr = pr * lr - pi * li, ti = pr * li + pi * lr; pr = tr; pi = ti; }
        if (sl == 0) {
            float* lt = (float*)(F.ws + WS_LAMT) + ((g * 2 + d) * 64 + n) * 4;
            double s16, c16, s1k, c1k; sincos_d(ang * 16.0, s16, c16); sincos_d(ang * 1024.0, s1k, c1k);
            const float m16 = expf(p_are * dtf * 16.0f), m1k = expf(p_are * dtf * 1024.0f);
            lt[0] = m16 * (float)c16; lt[1] = m16 * (float)s16; lt[2] = m1k * (float)c1k; lt[3] = m1k * (float)s1k; }
    }
    if (t < 16) dv[t] = p_dv;
    __syncthreads();
#pragma unroll
    for (int i = 0; i < 4; ++i) { const int idx = t + 512 * i, d = idx >> 10, n = (idx >> 4) & 63;
        const float fr = bfac[(d * 64 + n) * 2], fi = bfac[(d * 64 + n) * 2 + 1];
        Bb[idx * 2] = fr * pbr[i] - fi * pbi[i]; Bb[idx * 2 + 1] = fr * pbi[i] + fi * pbr[i];
        Cc[idx * 2] = pcr[i]; Cc[idx * 2 + 1] = pci[i]; }
    __syncthreads();
    {
        const int d = t >> 8, co = (t >> 4) & 15, ci = t & 15;
        float acc[16];
#pragma unroll
        for (int k = 0; k < 16; ++k) acc[k] = 0.f;
        for (int n = 0; n < 64; ++n) {
            const float cr = Cc[((d * 16 + co) * 64 + n) * 2], cim = Cc[((d * 16 + co) * 64 + n) * 2 + 1];
            const float br = Bb[((d * 64 + n) * 16 + ci) * 2], bi = Bb[((d * 64 + n) * 16 + ci) * 2 + 1];
            const float lr = lamP[((d * 17 + 1) * 64 + n) * 2], li = lamP[((d * 17 + 1) * 64 + n) * 2 + 1];
            float qr = cr * br - cim * bi, qi = cr * bi + cim * br;
#pragma unroll
            for (int k = 0; k < 16; ++k) { acc[k] += qr; const float tr = qr * lr - qi * li; qi = qr * li + qi * lr; qr = tr; }
        }
#pragma unroll
        for (int k = 0; k < 16; ++k) KT[(d * 16 + k) * 260 + co * 16 + ci] = acc[k];
    }
    __syncthreads();
    bf16* WS3 = (bf16*)(F.ws + WS_WS3) + ((size_t)g * 256 + sl * 64) * 512;
#pragma unroll
    for (int i2 = 0; i2 < 2; ++i2) {
        const int idx = t + 512 * i2, rowl = idx >> 4, sq = idx & 15, row = sl * 64 + rowl, j = row >> 4, co = row & 15;
        float v[16];
        if (j != sq) { const LAS float* src = KT + ((j > sq) ? (j - sq) : (16 + sq - j)) * 260 + co * 16;
#pragma unroll
            for (int i = 0; i < 16; ++i) v[i] = src[i]; }
        else {
#pragma unroll
            for (int i = 0; i < 16; ++i) v[i] = KT[co * 16 + i] + KT[16 * 260 + co * 16 + i] + (co == i ? dv[co] : 0.f); }
        v4u o0, o1; o0.x = pk2(v[0], v[1]); o0.y = pk2(v[2], v[3]); o0.z = pk2(v[4], v[5]); o0.w = pk2(v[6], v[7]); o1.x = pk2(v[8], v[9]); o1.y = pk2(v[10], v[11]); o1.z = pk2(v[12], v[13]); o1.w = pk2(v[14], v[15]);
        GAS v4u* dst = (GAS v4u*)(WS3 + (size_t)rowl * 512 + sq * 16); dst[0] = o0; dst[1] = o1;
    }
#pragma unroll
    for (int i2 = 0; i2 < 4; ++i2) {
        const int idx = t + 512 * i2, rowl = idx >> 5, q = (idx >> 3) & 3, n0 = (idx & 7) * 8, row = sl * 64 + rowl, j = row >> 4, co = row & 15, d = q >> 1, e = (d == 0) ? (j + 1) : (16 - j);
        float v[8];
#pragma unroll
        for (int i = 0; i < 8; ++i) { const int n = n0 + i;
            const float cr = Cc[((d * 16 + co) * 64 + n) * 2], cim = Cc[((d * 16 + co) * 64 + n) * 2 + 1];
            const float pr = lamP[((d * 17 + e) * 64 + n) * 2], pi = lamP[((d * 17 + e) * 64 + n) * 2 + 1];
            v[i] = (q & 1) ? -(cr * pi + cim * pr) : (cr * pr - cim * pi); }
        v4u o; o.x = pk2(v[0], v[1]); o.y = pk2(v[2], v[3]); o.z = pk2(v[4], v[5]); o.w = pk2(v[6], v[7]);
        *(GAS v4u*)(WS3 + (size_t)rowl * 512 + 256 + q * 64 + n0) = o;
    }
    bf16* MS = (bf16*)(F.ws + WS_MS) + ((size_t)g * 256 + sl * 64) * 256;
#pragma unroll
    for (int i2 = 0; i2 < 4; ++i2) {
        const int idx = t + 512 * i2, rowl = idx >> 5, kc = (idx & 31) * 8, row = sl * 64 + rowl, q = row >> 6, n = row & 63, d = q >> 1, j = kc >> 4, ci0 = kc & 15, e = (d == 0) ? (15 - j) : j;
        const float pr = lamP[((d * 17 + e) * 64 + n) * 2], pi = lamP[((d * 17 + e) * 64 + n) * 2 + 1];
        float v[8];
#pragma unroll
        for (int i = 0; i < 8; ++i) { const float br = Bb[((d * 64 + n) * 16 + ci0 + i) * 2], bi = Bb[((d * 64 + n) * 16 + ci0 + i) * 2 + 1];
            v[i] = (q & 1) ? (pr * bi + pi * br) : (pr * br - pi * bi); }
        v4u o; o.x = pk2(v[0], v[1]); o.y = pk2(v[2], v[3]); o.z = pk2(v[4], v[5]); o.w = pk2(v[6], v[7]);
        *(GAS v4u*)(MS + (size_t)rowl * 256 + kc) = o;
    }
    __syncthreads();
}
constexpr int BG_GU = NEXP * 16 * 4, BG_DN = NEXP * 4 * 16, BG_WOB = 8 * 16, BG_WG = 16 * 16, BG_WPLE = 4 * 16;
constexpr int BG_TOTAL = 2 * BG_GU + BG_DN + BG_WOB + BG_WG + BG_WPLE;
struct BgDesc { const float* src; bf16* dst; int ld_src, ld_dst; };
__device__ __forceinline__ BgDesc bg_desc(Frame& F, const Args& A, int r) {
    BgDesc d;
    if (r < 2 * BG_GU) {
        const int up = r >= BG_GU; if (up) r -= BG_GU;
        const int e = r >> 6, kb = (r >> 2) & 15, nb = r & 3, k0 = kb * 64, n0 = nb * 64;
        d.src = A.in[up ? 23 : 22] + ((size_t)e * D + k0) * DF + n0; d.ld_src = DF;
        d.dst = (bf16*)(F.ws + WS_WGU) + ((size_t)e * 512 + (n0 >> 7) * 256 + (up ? 128 : 0) + (n0 & 127)) * D + k0; d.ld_dst = D; return d; }
    r -= 2 * BG_GU;
    if (r < BG_DN) {
        const int e = r >> 6, kb = (r >> 4) & 3, nb = r & 15, k0 = kb * 64, n0 = nb * 64;
        d.src = A.in[24] + ((size_t)e * DF + k0) * D + n0; d.ld_src = D; d.dst = (bf16*)(F.ws + WS_WD) + ((size_t)e * D + n0) * DF + k0; d.ld_dst = DF; return d; }
    r -= BG_DN;
    if (r < BG_WOB) { const int kb = r >> 4, nb = r & 15;
        d.src = A.in[16] + (size_t)(DP + kb * 64) * D + nb * 64; d.ld_src = D; d.dst = (bf16*)(F.ws + WS_WCAT) + (size_t)nb * 64 * D + DP + kb * 64; d.ld_dst = D; return d; }
    r -= BG_WOB;
    if (r < BG_WG) { const int kb = r >> 4, nb = r & 15; d.src = A.in[26] + (size_t)kb * 64 * D + nb * 64; d.ld_src = D; d.dst = (bf16*)(F.ws + WS_WG) + (size_t)nb * 64 * D + kb * 64; d.ld_dst = D; return d; }
    r -= BG_WG;
    { const int kb = r >> 4, nb = r & 15; d.src = A.in[28] + (size_t)kb * 64 * D + nb * 64; d.ld_src = D; d.dst = (bf16*)(F.ws + WS_WPLE) + (size_t)nb * 64 * DPLE + kb * 64; d.ld_dst = DPLE; return d; }
}
__device__ __forceinline__ void tr64_load(f32x4 (&v)[16], const float* src, int ld_src, int lane) {
    const int kq = lane >> 4, n4 = (lane & 15) * 4;
#pragma unroll
    for (int i = 0; i < 16; ++i) v[i] = *(const GAS f32x4*)(src + (size_t)(4 * i + kq) * ld_src + n4);
}
__device__ __forceinline__ void tr64_finish(const f32x4 (&v)[16], bf16* dst, int ld_dst, LAS float* scr, int lane) {
    const int kq = lane >> 4, n4 = (lane & 15) * 4;
#pragma unroll
    for (int i = 0; i < 16; ++i) { LAS float* p = scr + (4 * i + kq) * 65 + n4; p[0] = v[i].x; p[1] = v[i].y; p[2] = v[i].z; p[3] = v[i].w; }
    LDS_WAIT(); asm volatile("" ::: "memory");
    const int c = lane & 7;
#pragma unroll
    for (int j = 0; j < 8; ++j) { const int n = (lane >> 3) + 8 * j; const LAS float* q = scr + (8 * c) * 65 + n;
        v4u o; o.x = pk2(q[0 * 65], q[1 * 65]); o.y = pk2(q[2 * 65], q[3 * 65]); o.z = pk2(q[4 * 65], q[5 * 65]); o.w = pk2(q[6 * 65], q[7 * 65]);
        *(GAS v4u*)(dst + (size_t)n * ld_dst + 8 * c) = o; }
    LDS_WAIT(); asm volatile("" ::: "memory");
}
__device__ __forceinline__ void bg_range(Frame& F, const Args& A, int lo, int hi, int plo, int phi, bool all = false) {
    int widx, nw;
    if (all) { widx = F.gw; nw = F.ngw; }
    else if (F.G >= 256) { if ((int)blockIdx.x < 128) return; widx = ((int)blockIdx.x - 128) * NWAVES + F.wave; nw = (F.G - 128) * NWAVES; } else { widx = F.gw; nw = F.ngw; }
    LAS float* scr = (LAS float*)(F.lds + RING_OFF + F.wave * P0_SCR);
    const int lane = opq(hw_lane());
    int it = lo + widx;
    for (; it + nw < hi; it += 2 * nw) {
        f32x4 va[16], vb[16]; const BgDesc da = bg_desc(F, A, it), db = bg_desc(F, A, it + nw);
        tr64_load(va, da.src, da.ld_src, lane); tr64_load(vb, db.src, db.ld_src, lane);
        tr64_finish(va, da.dst, da.ld_dst, scr, lane); tr64_finish(vb, db.dst, db.ld_dst, scr, lane); }
    if (it < hi) { f32x4 va[16]; const BgDesc dc = bg_desc(F, A, it); tr64_load(va, dc.src, dc.ld_src, lane); tr64_finish(va, dc.dst, dc.ld_dst, scr, lane); }
    for (int m = plo + 4 * widx; m < phi; m += 4 * nw) {
        f32x4 pv[4];
#pragma unroll
        for (int r = 0; r < 4; ++r) pv[r] = *((const GAS f32x4*)(A.in[1] + (size_t)(m + r) * DPLE) + lane);
#pragma unroll
        for (int r = 0; r < 4; ++r) { v2u o; o.x = pk2(pv[r].x, pv[r].y); o.y = pk2(pv[r].z, pv[r].w); *((GAS v2u*)((bf16*)(F.ws + WS_PB) + (size_t)(m + r) * DPLE) + lane) = o; }
    }
}
template <int R> __device__ __forceinline__ void xn_rows(Frame& F, const Args& A, int m0, int stride, int lane) {
    const GAS f32x4* gr = (const GAS f32x4*)A.in[2] + lane;
    f32x4 v[R][4];
#pragma unroll
    for (int r = 0; r < R; ++r) { const size_t m = (size_t)(m0 + r * stride);
#pragma unroll
        for (int j = 0; j < 4; ++j) v[r][j] = *((const GAS f32x4*)(A.in[0] + m * D) + lane + 64 * j); }
#pragma unroll
    for (int r = 0; r < R; ++r) { const size_t m = (size_t)(m0 + r * stride); float s = 0.f;
#pragma unroll
        for (int j = 0; j < 4; ++j) s += (v[r][j].x * v[r][j].x + v[r][j].y * v[r][j].y) + (v[r][j].z * v[r][j].z + v[r][j].w * v[r][j].w);
        const float rstd = 1.f / sqrtf(wave_sum(s) * (1.f / D) + RMS_EPS);
        GAS unsigned long long* o8 = (GAS unsigned long long*)((bf16*)(F.ws + WS_XN) + m * D) + lane;
#pragma unroll
        for (int j = 0; j < 4; ++j) { const f32x4 gg = gr[64 * j], x = v[r][j];
            o8[64 * j] = (unsigned long long)pk2(x.x * rstd * gg.x, x.y * rstd * gg.y) | ((unsigned long long)pk2(x.z * rstd * gg.z, x.w * rstd * gg.w) << 32); }
    }
}
__device__ __forceinline__ void p0_prologue(Frame& F, const Args& A) {
    int widx = F.gw, nw = F.ngw;
    if (F.G >= 256) { if ((int)blockIdx.x < 128) { ssm_gen(F, A, (int)blockIdx.x >> 2, (int)blockIdx.x & 3); return; }
                      widx = ((int)blockIdx.x - 128) * NWAVES + F.wave; nw = (F.G - 128) * NWAVES; }
    else { for (int u = blockIdx.x; u < NG * 4; u += F.G) ssm_gen(F, A, u >> 2, u & 3); __syncthreads(); }
    LAS float* scr = (LAS float*)(F.lds + RING_OFF + F.wave * P0_SCR);
    constexpr int I_WIN = 16 * 16, I_GLU = 8 * 8, I_WOS = 8 * 16, I_BD = 256, I_WR = 48, I_ROWS = M / 8;
    constexpr int NITEMS = I_WIN + I_GLU + I_WOS + I_BD + I_WR + I_ROWS;
    for (int it = widx; it < NITEMS; it += nw) {
        int r = it; const int lane = opq(hw_lane());
        if (r < I_WIN) { const int kb = r >> 4, nb = r & 15; transpose_item64(A.in[3] + (size_t)kb * 64 * D + nb * 64, D, (bf16*)(F.ws + WS_WIN) + (size_t)nb * 64 * D + kb * 64, D, scr, lane); continue; }
        r -= I_WIN;
        if (r < I_GLU) { const int kb = r >> 3, nb = r & 7; transpose_item64(A.in[14] + (size_t)kb * 64 * DP + nb * 64, DP, (bf16*)(F.ws + WS_GLU) + (size_t)nb * 64 * DP + kb * 64, DP, scr, lane); continue; }
        r -= I_GLU;
        if (r < I_WOS) {
            const int kb = r >> 4, nb = r & 15, k0 = kb * 64;
            transpose_item64(A.in[16] + (size_t)k0 * D + nb * 64, D, (bf16*)(F.ws + WS_WOS) + ((size_t)(k0 >> 8) * D + nb * 64) * 256 + (k0 & 255), 256, scr, lane, A.in[5] + k0); continue; }
        r -= I_WOS;
        if (r < I_BD) {
            const int row = r * 2 + (lane >> 5), c0 = (lane & 31) * 8, gi = row >> 7;
            v4u o = (v4u){0u, 0u, 0u, 0u};
            if ((c0 >> 7) == (gi & 1)) { const f32x4 a = *(const GAS f32x4*)(A.in[4] + (size_t)row * 128 + (c0 & 127)), b = *(const GAS f32x4*)(A.in[4] + (size_t)row * 128 + (c0 & 127) + 4);
                o.x = pk2(a.x, a.y); o.y = pk2(a.z, a.w); o.z = pk2(b.x, b.y); o.w = pk2(b.z, b.w); }
            *(GAS v4u*)((bf16*)(F.ws + WS_BD) + (size_t)row * 256 + c0) = o; continue; }
        r -= I_BD;
        if (r < I_WR) {
            bf16* dh = (bf16*)(F.ws + WS_WR) + (size_t)r * D; bf16* dl = dh + 48 * D;
            for (int dd = lane; dd < D; dd += 64) { float w = 0.f;
                if (r < 4) w = A.in[18][dd * 4 + r]; else if (r < 36) w = A.in[20][((size_t)((r - 4) >> 3) * D + dd) * 8 + ((r - 4) & 7)];
                w *= A.in[17][dd]; const unsigned h = f2bf(w); dh[dd] = (bf16)h; dl[dd] = (bf16)f2bf(w - __builtin_bit_cast(float, h << 16)); }
            continue; }
        r -= I_WR;
        xn_rows<8>(F, A, r, I_ROWS, lane);
    }
}

using pg8::Unit; using pg8::bf16_t; typedef unsigned u32x4 __attribute__((ext_vector_type(4)));
__device__ __forceinline__ u32x4 pack8(const f32x4& a, const f32x4& b) { u32x4 w; w.x = pk2(a[0], a[1]); w.y = pk2(a[2], a[3]); w.z = pk2(b[0], b[1]); w.w = pk2(b[2], b[3]); return w; }
struct EpiZ { static constexpr bool PERM = true, AFTER_DRAIN = false; bf16_t* ZP; bf16_t* AS;
    __device__ __forceinline__ void operator()(const f32x4 (&acc)[2][2][4][2], const Unit& u, int wr, int wc, int fr, int fq) const {
        const int row0 = u.pm * 256 + wr * 64 + fr;
#pragma unroll
        for (int ai = 0; ai < 2; ++ai)
#pragma unroll
            for (int m = 0; m < 4; ++m) { const int r = row0 + ai * 128 + m * 16;
#pragma unroll
                for (int bj = 0; bj < 2; ++bj) { const int col = u.pn * 256 + bj * 128 + wc * 32 + 8 * fq; const u32x4 w = pack8(acc[ai][bj][m][0], acc[ai][bj][m][1]);
                    if (u.pn < 2) *(u32x4*)(ZP + (size_t)r * DP + col) = w;
                    else { const int sc = col - DP, g = sc >> 4, ch0 = sc & 15; *(u32x4*)(AS + ((size_t)(g * NCH + (r >> 4)) * 512 + (r & 15) * 16 + ch0)) = w; } } }
    } };
struct EpiSloc { static constexpr bool PERM = false, AFTER_DRAIN = false; float* C;
    __device__ __forceinline__ void operator()(const f32x4 (&acc)[2][2][4][2], const Unit& u, int wr, int wc, int fr, int fq) const {
        const int row0 = u.pm * 256 + wr * 64 + fr, col0 = wc * 32 + 4 * fq;
#pragma unroll
        for (int ai = 0; ai < 2; ++ai)
#pragma unroll
            for (int m = 0; m < 4; ++m) { float* rowp = C + (size_t)(row0 + ai * 128 + m * 16) * 256 + col0;
#pragma unroll
                for (int bj = 0; bj < 2; ++bj)
#pragma unroll
                    for (int n = 0; n < 2; ++n) *(f32x4*)(rowp + bj * 128 + n * 16) = acc[ai][bj][m][n]; }
    } };
struct EpiY { static constexpr bool PERM = true, AFTER_DRAIN = false; bf16_t* ZZ;
    __device__ __forceinline__ void operator()(const f32x4 (&acc)[2][2][4][2], const Unit& u, int wr, int wc, int fr, int fq) const {
        const int g = u.pn, row0 = (u.pm & 3) * 256 + wr * 64 + fr;
#pragma unroll
        for (int ai = 0; ai < 2; ++ai)
#pragma unroll
            for (int m = 0; m < 4; ++m) { const int c = row0 + ai * 128 + m * 16;
#pragma unroll
                for (int bj = 0; bj < 2; ++bj) { const int col = bj * 128 + wc * 32 + 8 * fq, j = col >> 4, co0 = col & 15;
                    f32x4 a = acc[ai][bj][m][0], b = acc[ai][bj][m][1];
#pragma unroll
                    for (int i = 0; i < 4; ++i) { a[i] = gelu_tanh(a[i]); b[i] = gelu_tanh(b[i]); }
                    *(u32x4*)(ZZ + (size_t)(c * CL + j) * DP + g * GC + co0) = pack8(a, b); asm volatile("" ::: "memory"); } }
    } };
struct EpiGlu { static constexpr bool PERM = true, AFTER_DRAIN = false; const bf16_t* ZZ; const float* bias; bf16_t* CAT;
    __device__ __forceinline__ void operator()(const f32x4 (&acc)[2][2][4][2], const Unit& u, int wr, int wc, int fr, int fq) const {
        const int row0 = u.pm * 256 + wr * 64 + fr;
#pragma unroll
        for (int bj = 0; bj < 2; ++bj) { const int col = u.pn * 256 + bj * 128 + wc * 32 + 8 * fq;
            const f32x4 b0 = *(const f32x4*)(bias + col), b1 = *(const f32x4*)(bias + col + 4);
#pragma unroll
            for (int ai = 0; ai < 2; ++ai)
#pragma unroll
                for (int m = 0; m < 4; ++m) { const int r = row0 + ai * 128 + m * 16;
                    const u32x4 z = *(const u32x4*)(ZZ + (size_t)r * DP + col);
                    f32x4 a = acc[ai][bj][m][0] + b0, b = acc[ai][bj][m][1] + b1;
                    a[0] = bflo(z.x) * sigmoidf_(a[0]); a[1] = bfhi(z.x) * sigmoidf_(a[1]); a[2] = bflo(z.y) * sigmoidf_(a[2]); a[3] = bfhi(z.y) * sigmoidf_(a[3]);
                    b[0] = bflo(z.z) * sigmoidf_(b[0]); b[1] = bfhi(z.z) * sigmoidf_(b[1]); b[2] = bflo(z.w) * sigmoidf_(b[2]); b[3] = bfhi(z.w) * sigmoidf_(b[3]);
                    *(u32x4*)(CAT + (size_t)r * D + DP + col) = pack8(a, b); asm volatile("" ::: "memory"); } }
    } };
struct EpiRes { static constexpr bool PERM = true, AFTER_DRAIN = false; const float* X; float* H; const float* G; bf16_t* V;
    __device__ __forceinline__ void operator()(const f32x4 (&acc)[2][2][4][2], const Unit& u, int wr, int wc, int fr, int fq) const {
        const int row0 = u.pm * 256 + wr * 64 + fr, col0 = u.pn * 256 + wc * 32 + 8 * fq;
        f32x4 gv[2][2];
#pragma unroll
        for (int bj = 0; bj < 2; ++bj)
#pragma unroll
            for (int n = 0; n < 2; ++n) gv[bj][n] = *(const f32x4*)(G + col0 + bj * 128 + 4 * n);
#pragma unroll
        for (int ai = 0; ai < 2; ++ai)
#pragma unroll
            for (int m = 0; m < 4; ++m) { const size_t off = (size_t)(row0 + ai * 128 + m * 16) * D + col0;
#pragma unroll
                for (int bj = 0; bj < 2; ++bj) { const f32x4 h0 = *(const f32x4*)(X + off + bj * 128) + acc[ai][bj][m][0], h1 = *(const f32x4*)(X + off + bj * 128 + 4) + acc[ai][bj][m][1];
                    *(f32x4*)(H + off + bj * 128) = h0; *(f32x4*)(H + off + bj * 128 + 4) = h1;
                    *(u32x4*)(V + off + bj * 128) = pack8(h0 * gv[bj][0], h1 * gv[bj][1]); } }
    } };
struct EpiAct { static constexpr bool PERM = true, AFTER_DRAIN = false; const float* LW; const float* LR; bf16_t* ACT; const volatile LAS unsigned* tstart;
    __device__ __forceinline__ void operator()(const f32x4 (&acc)[2][2][4][2], const Unit& u, int wr, int wc, int fr, int fq) const {
        const int e = u.pn >> 1, lrow0 = (u.pm - (int)tstart[e]) * 256 + wr * 64 + fr, row0 = u.pm * 256 + wr * 64 + fr, col = (u.pn & 1) * 128 + wc * 32 + 8 * fq;
        const float* lw = LW + (size_t)e * M + lrow0; const float* lr = LR + (size_t)e * M + lrow0;
#pragma unroll
        for (int ai = 0; ai < 2; ++ai)
#pragma unroll
            for (int m = 0; m < 4; ++m) { const int ro = ai * 128 + m * 16; const float w = lw[ro], rs = lr[ro];
                f32x4 a, b;
#pragma unroll
                for (int i = 0; i < 4; ++i) { const float g0 = rs * acc[ai][0][m][0][i], g1 = rs * acc[ai][0][m][1][i], sw = rs * w;
                    a[i] = g0 * sigmoidf_(g0) * acc[ai][1][m][0][i] * sw; b[i] = g1 * sigmoidf_(g1) * acc[ai][1][m][1][i] * sw; }
                *(u32x4*)(ACT + (size_t)(row0 + ro) * DF + col) = pack8(a, b); }
    } };
struct EpiDown { static constexpr bool PERM = true, AFTER_DRAIN = false; const int* LIST; const unsigned* cnt; bf16_t* MO0; bf16_t* MO1; const volatile LAS unsigned* tstart;
    __device__ __forceinline__ void operator()(const f32x4 (&acc)[2][2][4][2], const Unit& u, int wr, int wc, int fr, int fq) const {
        const int e = u.pn >> 2, lrow0 = (u.pm - (int)tstart[e]) * 256 + wr * 64 + fr, col0 = (u.pn & 3) * 256 + wc * 32 + 8 * fq;
        const int n_e = (int)__hip_atomic_load(cnt + 64 * e, __ATOMIC_RELAXED, __HIP_MEMORY_SCOPE_AGENT); const int* li = LIST + (size_t)e * M;
#pragma unroll
        for (int ai = 0; ai < 2; ++ai)
#pragma unroll
            for (int m = 0; m < 4; ++m) { const int lr = lrow0 + ai * 128 + m * 16;
                if (lr < n_e) { const int info = li[lr]; bf16_t* dst = ((info & 1) ? MO1 : MO0) + (size_t)(info >> 1) * D + col0;
#pragma unroll
                    for (int bj = 0; bj < 2; ++bj) *(u32x4*)(dst + bj * 128) = pack8(acc[ai][bj][m][0], acc[ai][bj][m][1]); } }
    } };
struct EpiPe { static constexpr bool PERM = true, AFTER_DRAIN = false; bf16_t* O;
    __device__ __forceinline__ void operator()(const f32x4 (&acc)[2][2][4][2], const Unit& u, int wr, int wc, int fr, int fq) const {
        const int row0 = u.pm * 256 + wr * 64 + fr, col0 = u.pn * 256 + wc * 32 + 8 * fq;
#pragma unroll
        for (int ai = 0; ai < 2; ++ai)
#pragma unroll
            for (int m = 0; m < 4; ++m) { bf16_t* rowp = O + (size_t)(row0 + ai * 128 + m * 16) * D + col0;
#pragma unroll
                for (int bj = 0; bj < 2; ++bj) *(u32x4*)(rowp + bj * 128) = pack8(acc[ai][bj][m][0], acc[ai][bj][m][1]); }
    } };
struct EpiGate { static constexpr bool PERM = true, AFTER_DRAIN = false; const float* bias; bf16_t* PE;
    __device__ __forceinline__ void operator()(const f32x4 (&acc)[2][2][4][2], const Unit& u, int wr, int wc, int fr, int fq) const {
        const int row0 = u.pm * 256 + wr * 64 + fr, col0 = u.pn * 256 + wc * 32 + 8 * fq;
        u32x4 pe[2][4][2];
#pragma unroll
        for (int ai = 0; ai < 2; ++ai)
#pragma unroll
            for (int m = 0; m < 4; ++m)
#pragma unroll
                for (int bj = 0; bj < 2; ++bj) pe[ai][m][bj] = *(const u32x4*)(PE + (size_t)(row0 + ai * 128 + m * 16) * D + col0 + bj * 128);
#pragma unroll
        for (int bj = 0; bj < 2; ++bj) { const f32x4 b0 = *(const f32x4*)(bias + col0 + bj * 128), b1 = *(const f32x4*)(bias + col0 + bj * 128 + 4);
#pragma unroll
            for (int ai = 0; ai < 2; ++ai)
#pragma unroll
                for (int m = 0; m < 4; ++m) { const u32x4 z = pe[ai][m][bj]; f32x4 a = acc[ai][bj][m][0] + b0, b = acc[ai][bj][m][1] + b1;
                    a[0] = bflo(z.x) * sigmoidf_(a[0]); a[1] = bfhi(z.x) * sigmoidf_(a[1]); a[2] = bflo(z.y) * sigmoidf_(a[2]); a[3] = bfhi(z.y) * sigmoidf_(a[3]);
                    b[0] = bflo(z.z) * sigmoidf_(b[0]); b[1] = bfhi(z.z) * sigmoidf_(b[1]); b[2] = bflo(z.w) * sigmoidf_(b[2]); b[3] = bfhi(z.w) * sigmoidf_(b[3]);
                    *(u32x4*)(PE + (size_t)(row0 + ai * 128 + m * 16) * D + col0 + bj * 128) = pack8(a, b); } }
    } };

struct GroupOrder { int G, c;
    __device__ __forceinline__ bool next(int i, Unit& u) const { const int L = i * G + c; if (L >= NG * 4) return false; u.pm = L; u.pn = L >> 2; u.nv = 256; return true; }
    __device__ __forceinline__ void a_ready(const Unit&) const {}
    __device__ __forceinline__ void done(const Unit&) const {} };
struct PeOrder { int G, c, n2;
    __device__ __forceinline__ bool next(int i, Unit& u) const { if (c < n2) return false; const int L = i * (G - n2) + (c - n2); if (L >= (M / 256) * (D / 256)) return false; u.pm = L >> 2; u.pn = L & 3; u.nv = 256; return true; }
    __device__ __forceinline__ void a_ready(const Unit&) const {}
    __device__ __forceinline__ void done(const Unit&) const {} };
struct WeffOrder { int G, c;
    __device__ __forceinline__ bool next(int i, Unit& u) const { const int L = (G >= 256) ? ((i == 0) ? c - 128 : -1) : i * G + c; if (L < 0 || L >= 8) return false; u.pm = L; u.pn = L >> 2; u.nv = 256; return true; }
    __device__ __forceinline__ void a_ready(const Unit&) const {}
    __device__ __forceinline__ void done(const Unit&) const {} };
struct EpiWeff { static constexpr bool PERM = true, AFTER_DRAIN = false; bf16_t* O;
    __device__ __forceinline__ void operator()(const f32x4 (&acc)[2][2][4][2], const Unit& u, int wr, int wc, int fr, int fq) const {
        const int row0 = (u.pm & 3) * 256 + wr * 64 + fr, col0 = u.pn * 256 + wc * 32 + 8 * fq;
#pragma unroll
        for (int ai = 0; ai < 2; ++ai)
#pragma unroll
            for (int m = 0; m < 4; ++m) { bf16_t* rowp = O + (size_t)(row0 + ai * 128 + m * 16) * D + col0;
#pragma unroll
                for (int bj = 0; bj < 2; ++bj) *(u32x4*)(rowp + bj * 128) = pack8(acc[ai][bj][m][0], acc[ai][bj][m][1]); }
    } };
template <int NSUB> struct ExpertOrder { int G, c; const volatile LAS unsigned* misc;
    __device__ __forceinline__ bool next(int i, Unit& u) const {
        const int L = i * G + c, tp = L / NSUB, sub = L % NSUB; if (tp >= __builtin_amdgcn_readfirstlane((int)misc[MW_TSTART + NEXP])) return false;
        const unsigned ent = (unsigned)__builtin_amdgcn_readfirstlane((int)misc[MW_TL + tp]); const int e = ent & 31u, rt = (ent >> 5) & 127u;
        u.pm = __builtin_amdgcn_readfirstlane((int)misc[MW_TSTART + e]) + rt; u.pn = e * NSUB + sub; u.nv = (int)(ent >> 12); return true; }
    __device__ __forceinline__ void a_ready(const Unit&) const {}
    __device__ __forceinline__ void done(const Unit&) const {} };

__device__ __forceinline__ void carry_unit(Frame& F, int unit) {
    const int d = unit & 1, g = (unit >> 1) & 31, b = unit >> 6, n = opq(hw_lane()), s = F.wave;
    const float* lt = (const float*)(F.ws + WS_LAMT) + ((g * 2 + d) * 64 + n) * 4;
    const float l16r = lt[0], l16i = lt[1], lkr = lt[2], lki = lt[3];
    const float* SL = (const float*)(F.ws + WS_SLOC) + (size_t)(g * NCH + b * 512) * 256 + d * 128 + n;
    bf16* AS = (bf16*)(F.ws + WS_AS) + (size_t)(g * NCH + b * 512) * 512 + 256 + d * 128 + n;
    LAS float* segE = (LAS float*)(F.lds + RING_OFF);
    float er = 0.f, ei = 0.f;
    for (int i0 = 0; i0 < 64; i0 += 16) {
        float sr[16], si[16];
#pragma unroll
        for (int ii = 0; ii < 16; ++ii) { const int i = s * 64 + i0 + ii, c = d ? (511 - i) : i; sr[ii] = SL[(size_t)c * 256]; si[ii] = SL[(size_t)c * 256 + 64]; }
#pragma unroll
        for (int ii = 0; ii < 16; ++ii) { const float tr = l16r * er - l16i * ei + sr[ii], ti = l16r * ei + l16i * er + si[ii]; er = tr; ei = ti; }
    }
    __syncthreads();
    segE[(s * 64 + n) * 2] = er; segE[(s * 64 + n) * 2 + 1] = ei;
    __syncthreads();
    float xr = 0.f, xi = 0.f;
    for (int sp = 0; sp < s; ++sp) { const float pr = segE[(sp * 64 + n) * 2], pi = segE[(sp * 64 + n) * 2 + 1];
        const float tr = lkr * xr - lki * xi + pr, ti = lkr * xi + lki * xr + pi; xr = tr; xi = ti; }
    for (int i0 = 0; i0 < 64; i0 += 16) {
        float sr[16], si[16];
#pragma unroll
        for (int ii = 0; ii < 16; ++ii) { const int i = s * 64 + i0 + ii, c = d ? (511 - i) : i; sr[ii] = SL[(size_t)c * 256]; si[ii] = SL[(size_t)c * 256 + 64]; }
#pragma unroll
        for (int ii = 0; ii < 16; ++ii) { const int i = s * 64 + i0 + ii, c = d ? (511 - i) : i;
            AS[(size_t)c * 512] = (bf16)f2bf(xr); AS[(size_t)c * 512 + 64] = (bf16)f2bf(xi);
            const float tr = l16r * xr - l16i * xi + sr[ii], ti = l16r * xi + l16i * xr + si[ii]; xr = tr; xi = ti; }
    }
    __syncthreads();
}
__device__ __forceinline__ void diff_row(Frame& F, int m) {
    const int t = m & (SEQ - 1), lane = opq(hw_lane()), h = 1 << (lane >> 4), lo = max(t - h, 0), hi = min(t + h, SEQ);
    const bf16* ZP = (const bf16*)(F.ws + WS_ZP) + (size_t)(m - t) * DP + lane * 8;
    float acc[8];
#pragma unroll
    for (int i = 0; i < 8; ++i) acc[i] = 0.f;
    v4u zt = (v4u){0u, 0u, 0u, 0u};
    v4u zz[16];
#pragma unroll
    for (int k = 0; k < 16; ++k) { const int s = t - 8 + k, sc = (s >= lo && s < hi) ? s : t; zz[k] = *(const GAS v4u*)(ZP + (size_t)sc * DP); }
#pragma unroll
    for (int k = 0; k < 16; ++k) { const int s = t - 8 + k; const float f = (s >= lo && s < hi) ? 1.f : 0.f; const v4u z = zz[k];
        acc[0] += f * bflo(z.x); acc[1] += f * bfhi(z.x); acc[2] += f * bflo(z.y); acc[3] += f * bfhi(z.y); acc[4] += f * bflo(z.z); acc[5] += f * bfhi(z.z); acc[6] += f * bflo(z.w); acc[7] += f * bfhi(z.w);
        if (k == 8) zt = z; }
    const float inv = 1.0f / (float)(hi - lo);
    v4u o; o.x = pk2(acc[0] * inv - bflo(zt.x), acc[1] * inv - bfhi(zt.x)); o.y = pk2(acc[2] * inv - bflo(zt.y), acc[3] * inv - bfhi(zt.y));
    o.z = pk2(acc[4] * inv - bflo(zt.z), acc[5] * inv - bfhi(zt.z)); o.w = pk2(acc[6] * inv - bflo(zt.w), acc[7] * inv - bfhi(zt.w));
    *(GAS v4u*)((bf16*)(F.ws + WS_CAT) + (size_t)m * D + lane * 8) = o;
#if MK_STAGE == 1
    *(GAS v4u*)((bf16*)(F.ws + WS_CAT) + (size_t)m * D + DP + lane * 8) = (v4u){0u, 0u, 0u, 0u};
#endif
}
__device__ __forceinline__ void route_phase(Frame& F, const Args& A) {
    typedef short s8v __attribute__((ext_vector_type(8)));
    const int lane = opq(hw_lane()), tok = lane & 15, kq = lane >> 4, w = F.wave, t = w * 64 + lane;
    s8v ah[4][3], al[4][3];
    { const bf16* wh = (const bf16*)(F.ws + WS_WR) + (size_t)tok * D + 128 * w + 8 * kq; const bf16* wl = wh + 48 * D;
#pragma unroll
      for (int sk = 0; sk < 4; ++sk)
#pragma unroll
          for (int q = 0; q < 3; ++q) { ah[sk][q] = *(const GAS s8v*)(wh + (size_t)q * 16 * D + 32 * sk); al[sk][q] = *(const GAS s8v*)(wl + (size_t)q * 16 * D + 32 * sk); } }
    LAS float* P = (LAS float*)(F.lds + RING_OFF);
    LAS float* R = P + 8 * 64 * 52;
    const int cid = (int)blockIdx.x, nit = M / 16;
    for (int b0 = cid; b0 < nit; b0 += 4 * F.G) {
        f32x4 acc[4][3];
        float ssq[4];
        f32x4 hc[4][2], hn[4][2];
        { const float* hrow = F.out + (size_t)(b0 * 16 + tok) * D + 128 * w + 8 * kq;
#pragma unroll
          for (int sk = 0; sk < 4; ++sk) { hc[sk][0] = *(const GAS f32x4*)(hrow + 32 * sk); hc[sk][1] = *(const GAS f32x4*)(hrow + 32 * sk + 4); } }
#pragma unroll
        for (int j = 0; j < 4; ++j) {
            const int itn = b0 + (j + 1) * F.G;
            if (j < 3 && itn < nit) { const float* hrow = F.out + (size_t)(itn * 16 + tok) * D + 128 * w + 8 * kq;
#pragma unroll
                for (int sk = 0; sk < 4; ++sk) { hn[sk][0] = *(const GAS f32x4*)(hrow + 32 * sk); hn[sk][1] = *(const GAS f32x4*)(hrow + 32 * sk + 4); } }
            acc[j][0] = (f32x4){0.f, 0.f, 0.f, 0.f}; acc[j][1] = acc[j][0]; acc[j][2] = acc[j][0]; ssq[j] = 0.f;
            if (b0 + j * F.G < nit) {
#pragma unroll
                for (int sk = 0; sk < 4; ++sk) {
                    const f32x4 h0 = hc[sk][0], h1 = hc[sk][1];
                    ssq[j] += (h0.x * h0.x + h0.y * h0.y) + (h0.z * h0.z + h0.w * h0.w) + (h1.x * h1.x + h1.y * h1.y) + (h1.z * h1.z + h1.w * h1.w);
                    const float hv[8] = {h0.x, h0.y, h0.z, h0.w, h1.x, h1.y, h1.z, h1.w};
                    s8v bh, bl;
#pragma unroll
                    for (int e8 = 0; e8 < 8; ++e8) { const unsigned hb = f2bf(hv[e8]); bh[e8] = (short)hb; bl[e8] = (short)f2bf(hv[e8] - __builtin_bit_cast(float, hb << 16)); }
#pragma unroll
                    for (int q = 0; q < 3; ++q) {
                        acc[j][q] = __builtin_amdgcn_mfma_f32_16x16x32_bf16(ah[sk][q], bh, acc[j][q], 0, 0, 0);
                        acc[j][q] = __builtin_amdgcn_mfma_f32_16x16x32_bf16(ah[sk][q], bl, acc[j][q], 0, 0, 0);
                        acc[j][q] = __builtin_amdgcn_mfma_f32_16x16x32_bf16(al[sk][q], bh, acc[j][q], 0, 0, 0);
                    }
                }
            }
#pragma unroll
            for (int sk = 0; sk < 4; ++sk) { hc[sk][0] = hn[sk][0]; hc[sk][1] = hn[sk][1]; }
        }
#pragma unroll
        for (int j = 0; j < 4; ++j) { LAS float* Pw = P + (w * 64 + j * 16 + tok) * 52;
#pragma unroll
            for (int q = 0; q < 3; ++q)
#pragma unroll
                for (int r = 0; r < 4; ++r) Pw[16 * q + 4 * kq + r] = acc[j][q][r];
            Pw[48 + kq] = ssq[j]; }
        __syncthreads();
        { const int t2 = opq(w * 64 + hw_lane());
#pragma unroll
          for (int i7 = 0; i7 < 7; ++i7) { const int idx = t2 + 512 * i7;
            if (idx < 64 * 52) { float sum = 0.f;
#pragma unroll
                for (int ww = 0; ww < 8; ++ww) sum += P[ww * (64 * 52) + idx];
                R[idx] = sum; } } }
        __syncthreads();
        if (w == 0) {
            const int ln = opq(hw_lane());
            const bool act = b0 + (ln >> 4) * F.G < nit;
            LAS unsigned* HI = (LAS unsigned*)F.MISC + MW_HIST; LAS unsigned* BA = (LAS unsigned*)F.MISC + MW_BASE;
            if (ln < NEXP) HI[ln] = 0u;
            const LAS float* tr = R + ln * 52; const int m = (b0 + (ln >> 4) * F.G) * 16 + (ln & 15);
            const float rstd = 1.f / sqrtf(((tr[48] + tr[49]) + (tr[50] + tr[51])) * (1.f / D) + RMS_EPS);
            float gl[4];
#pragma unroll
            for (int k = 0; k < 4; ++k) gl[k] = rstd * tr[k] + A.in[19][k];
            int gsel = 0; float gmax = gl[0];
#pragma unroll
            for (int k = 1; k < 4; ++k) if (gl[k] > gmax) { gmax = gl[k]; gsel = k; }
            float gden = 0.f;
#pragma unroll
            for (int k = 0; k < 4; ++k) gden += __expf(gl[k] - gmax);
            const float grp_p = 1.0f / gden;
            float el[8];
#pragma unroll
            for (int e = 0; e < 8; ++e) el[e] = rstd * tr[4 + gsel * 8 + e] + A.in[21][gsel * 8 + e];
            int i1 = 0; float m1 = el[0];
#pragma unroll
            for (int e = 1; e < 8; ++e) if (el[e] > m1) { m1 = el[e]; i1 = e; }
            int i2 = -1; float m2 = -3.0e38f;
#pragma unroll
            for (int e = 0; e < 8; ++e) if (e != i1 && el[e] > m2) { m2 = el[e]; i2 = e; }
            const float rr = __expf(m2 - m1), w1 = grp_p / (1.0f + rr), w2 = grp_p * rr / (1.0f + rr);
            const int e1 = gsel * 8 + i1, e2 = gsel * 8 + i2;
            unsigned r1 = 0u, r2 = 0u;
            if (act) { r1 = __hip_atomic_fetch_add(HI + e1, 1u, __ATOMIC_RELAXED, __HIP_MEMORY_SCOPE_WORKGROUP); r2 = __hip_atomic_fetch_add(HI + e2, 1u, __ATOMIC_RELAXED, __HIP_MEMORY_SCOPE_WORKGROUP); }
            LDS_WAIT(); asm volatile("" ::: "memory");
            if (ln < NEXP) { const unsigned hc_ = HI[ln]; BA[ln] = hc_ ? __hip_atomic_fetch_add((unsigned*)(F.ctl + CW_CNT) + 64 * ln, hc_, RLX_AGENT) : 0u; }
            LDS_WAIT(); asm volatile("" ::: "memory");
            if (act) { const unsigned p1 = BA[e1] + r1, p2 = BA[e2] + r2;
                int* LI = (int*)(F.ws + WS_LIST); float* LW = (float*)(F.ws + WS_LISTW); float* LR = (float*)(F.ws + WS_LISTR);
                LI[(size_t)e1 * M + p1] = 2 * m; LW[(size_t)e1 * M + p1] = w1; LR[(size_t)e1 * M + p1] = rstd;
                LI[(size_t)e2 * M + p2] = 2 * m + 1; LW[(size_t)e2 * M + p2] = w2; LR[(size_t)e2 * M + p2] = rstd; }
        }
        __syncthreads();
    }
}
template <class Sched> __device__ __forceinline__ void expert_setup(Frame& F, const Sched& S) {
    const int t = opq(F.wave * 64 + hw_lane());
    if (t < NEXP) F.MISC[MW_CNT + t] = __hip_atomic_load((unsigned*)(F.ctl + CW_CNT) + 64 * t, RLX_AGENT);
    __syncthreads();
    if (t < NEXP) {
        unsigned ts = 0u, nfull_before = 0u, nfull = 0u, rank = 0u; const unsigned n_me = F.MISC[MW_CNT + t], nv_me = n_me & 255u;
        for (int e = 0; e < NEXP; ++e) { const unsigned n = F.MISC[MW_CNT + e], nv = n & 255u;
            if (e < t) { ts += (n + 255u) >> 8; nfull_before += n >> 8; }
            nfull += n >> 8;
            if (nv > nv_me || (nv == nv_me && e < t)) rank += (nv > 0u) ? 1u : 0u; }
        F.MISC[MW_TSTART + t] = ts;
        if (t == NEXP - 1) F.MISC[MW_TSTART + NEXP] = ts + ((n_me + 255u) >> 8);
        for (unsigned rt = 0; rt < (n_me >> 8); ++rt) F.MISC[MW_TL + nfull_before + rt] = (unsigned)t | (rt << 5) | (256u << 12);
        if (nv_me > 0u) F.MISC[MW_TL + nfull + rank] = (unsigned)t | ((n_me >> 8) << 5) | (nv_me << 12);
    }
    __syncthreads();
    LAS unsigned* ro = (LAS unsigned*)(F.lds + ROWOFF_OFF);
    for (int i = 0; i < 4; ++i) { Unit u; if (!S.next(i, u)) break;
        const int e = u.pn >> 1, idx = ((int)u.pm - (int)F.MISC[MW_TSTART + e]) * 256 + (t & 255), n_e = (int)F.MISC[MW_CNT + e];
        if (t < 256) ro[i * 256 + t] = (idx < n_e) ? (unsigned)(((const int*)(F.ws + WS_LIST))[(size_t)e * M + idx] >> 1) * (unsigned)(D * 2) : 0u; }
    __syncthreads();
}
template <int R> __device__ __forceinline__ void moe_combine_rows(Frame& F, const Args& A, int m0, int stride) {
    const int lane = opq(hw_lane());
    const GAS f32x4* gr = (const GAS f32x4*)A.in[25] + lane;
    f32x4 v[R][4]; v2u a[R][4], b[R][4];
#pragma unroll
    for (int r = 0; r < R; ++r) { const size_t m = (size_t)(m0 + r * stride);
#pragma unroll
        for (int j = 0; j < 4; ++j) { v[r][j] = *((const GAS f32x4*)(F.out + m * D) + lane + 64 * j);
            a[r][j] = *((const GAS v2u*)((const bf16*)(F.ws + WS_MO0) + m * D) + lane + 64 * j); b[r][j] = *((const GAS v2u*)((const bf16*)(F.ws + WS_MO1) + m * D) + lane + 64 * j); } }
#pragma unroll
    for (int r = 0; r < R; ++r) { const size_t m = (size_t)(m0 + r * stride); float s = 0.f;
        GAS f32x4* hr = (GAS f32x4*)(F.out + m * D) + lane; GAS unsigned long long* o8 = (GAS unsigned long long*)((bf16*)(F.ws + WS_XN) + m * D) + lane;
#pragma unroll
        for (int j = 0; j < 4; ++j) { f32x4& x = v[r][j];
            x.x += bflo(a[r][j].x) + bflo(b[r][j].x); x.y += bfhi(a[r][j].x) + bfhi(b[r][j].x); x.z += bflo(a[r][j].y) + bflo(b[r][j].y); x.w += bfhi(a[r][j].y) + bfhi(b[r][j].y);
            hr[64 * j] = x; s += (x.x * x.x + x.y * x.y) + (x.z * x.z + x.w * x.w); }
        const float rstd = 1.f / sqrtf(wave_sum(s) * (1.f / D) + RMS_EPS);
#pragma unroll
        for (int j = 0; j < 4; ++j) { const f32x4 gg = gr[64 * j], x = v[r][j];
            o8[64 * j] = (unsigned long long)pk2(x.x * rstd * gg.x, x.y * rstd * gg.y) | ((unsigned long long)pk2(x.z * rstd * gg.z, x.w * rstd * gg.w) << 32); } }
}
template <int R, bool ADDG> __device__ __forceinline__ void final_rows(Frame& F, const Args& A, int m0, int stride) {
    const int lane = opq(hw_lane());
    const GAS f32x4* gr = (const GAS f32x4*)A.in[29] + lane;
    f32x4 v[R][4]; v2u gg[R][4];
#pragma unroll
    for (int r = 0; r < R; ++r) { const size_t m = (size_t)(m0 + r * stride);
#pragma unroll
        for (int j = 0; j < 4; ++j) { v[r][j] = *((const GAS f32x4*)(F.out + m * D) + lane + 64 * j);
            if (ADDG) gg[r][j] = *((const GAS v2u*)((const bf16*)(F.ws + WS_PE) + m * D) + lane + 64 * j); } }
#pragma unroll
    for (int r = 0; r < R; ++r) { const size_t m = (size_t)(m0 + r * stride); float s = 0.f;
        GAS f32x4* hr = (GAS f32x4*)(F.out + m * D) + lane;
#pragma unroll
        for (int j = 0; j < 4; ++j) { f32x4& x = v[r][j];
            if (ADDG) { x.x += bflo(gg[r][j].x); x.y += bfhi(gg[r][j].x); x.z += bflo(gg[r][j].y); x.w += bfhi(gg[r][j].y); }
            s += (x.x * x.x + x.y * x.y) + (x.z * x.z + x.w * x.w); }
        const float rstd = 1.f / sqrtf(wave_sum(s) * (1.f / D) + RMS_EPS);
#pragma unroll
        for (int j = 0; j < 4; ++j) hr[64 * j] = v[r][j] * rstd * gr[64 * j]; }
}

__global__ void __launch_bounds__(NWAVES * 64, 2) mk_fwd(Args args) {
    extern __shared__ __attribute__((aligned(16))) unsigned char lds[];
    Frame F;
    F.lds = (LAS unsigned char*)lds;
    F.MISC = (volatile LAS unsigned*)(F.lds + MISC_OFF);
    F.wave = __builtin_amdgcn_readfirstlane(threadIdx.x >> 6);
    F.G = gridDim.x; F.gw = blockIdx.x * NWAVES + F.wave; F.ngw = F.G * NWAVES;
    F.out = args.out; F.ws = args.ws; F.ctl = (gu32*)(args.ws + WS_CTL);
    for (int u = threadIdx.x; u < (LDS_BYTES - LDSCTL_OFF) / 4; u += NWAVES * 64) ((LAS unsigned*)(F.lds + LDSCTL_OFF))[u] = 0u;
    __syncthreads();
    XcdBarrier bar = xcd_barrier_post((unsigned*)(F.ctl + CW_BAR), F.MISC + 8); bar.wave = F.wave;
#define GRID_BAR() xcd_barrier(bar)
    bf16* const WIN = (bf16*)(F.ws + WS_WIN); bf16* const GLU = (bf16*)(F.ws + WS_GLU); bf16* const WCAT = (bf16*)(F.ws + WS_WCAT); bf16* const WG = (bf16*)(F.ws + WS_WG); bf16* const WPLE = (bf16*)(F.ws + WS_WPLE);
    bf16* const WGU = (bf16*)(F.ws + WS_WGU); bf16* const WD = (bf16*)(F.ws + WS_WD); bf16* const MS = (bf16*)(F.ws + WS_MS); bf16* const WS3 = (bf16*)(F.ws + WS_WS3);
    bf16* const XN = (bf16*)(F.ws + WS_XN); bf16* const ZP = (bf16*)(F.ws + WS_ZP); bf16* const AS = (bf16*)(F.ws + WS_AS); float* const SLOC = (float*)(F.ws + WS_SLOC);
    bf16* const CAT = (bf16*)(F.ws + WS_CAT); bf16* const ZZ = (bf16*)(F.ws + WS_ZZ); bf16* const PB = (bf16*)(F.ws + WS_PB); bf16* const PE = (bf16*)(F.ws + WS_PE);
    bf16* const ACT = (bf16*)(F.ws + WS_ACT); bf16* const MO0 = (bf16*)(F.ws + WS_MO0); bf16* const MO1 = (bf16*)(F.ws + WS_MO1);
    const int cid = (int)blockIdx.x;

#ifndef MK_REP
#define MK_REP -1
#endif
#define REP(k) for (int rep_ = 0; rep_ < ((MK_REP == (k)) ? 2 : 1); ++rep_)
    REP(0) { p0_prologue(F, args);
    GRID_BAR(); }
    REP(1) { pg8::Gemm g{XN, WIN, D, D, D}; pg8::StaticOrder S; S.init(M, D, F.G, cid); EpiZ E{ZP, AS};
      pg8::gemm_phase<EpiZ, pg8::StaticOrder, true, true>(F.lds + RING_OFF, g, S, E, F.wave);
    GRID_BAR(); }
#if MK_STAGE >= 2
    { pg8::Gemm g{AS, MS, 256, 512, 256}; GroupOrder S{F.G, cid}; EpiSloc E{SLOC};
      pg8::gemm_phase<EpiSloc, GroupOrder, true, true>(F.lds + RING_OFF, g, S, E, F.wave); }
    { pg8::Gemm g{(const bf16*)(F.ws + WS_WOS), (const bf16*)(F.ws + WS_BD), 256, 256, 256}; WeffOrder S{F.G, cid}; EpiWeff E{WCAT};
      pg8::gemm_phase<EpiWeff, WeffOrder, true, true>(F.lds + RING_OFF, g, S, E, F.wave); }
    bg_range(F, args, 1400, 2000, 0, 0);
    GRID_BAR();
#endif
    REP(3) {
#if MK_STAGE >= 2
        if (F.G >= 256) { if (cid < 128) { carry_unit(F, cid); for (int m = 12288 + cid * NWAVES + F.wave; m < M; m += 128 * NWAVES) diff_row(F, m); }
                          else for (int m = (cid - 128) * NWAVES + F.wave; m < 12288; m += (F.G - 128) * NWAVES) diff_row(F, m); }
        else { for (int u = cid; u < 128; u += F.G) carry_unit(F, u); for (int m = F.gw; m < M; m += F.ngw) diff_row(F, m); }
#else
        for (int m = F.gw; m < M; m += F.ngw) diff_row(F, m);
#endif
    GRID_BAR(); }
#if MK_STAGE >= 2
    { pg8::Gemm g{AS, WS3, 512, 512, 512}; GroupOrder S{F.G, cid}; EpiY E{ZZ};
      pg8::gemm_phase<EpiY, GroupOrder, true, true>(F.lds + RING_OFF, g, S, E, F.wave); }
    bg_range(F, args, 2000, 5000, 0, M / 2);
    GRID_BAR();
    { pg8::Gemm g{ZZ, GLU, DP, DP, DP}; pg8::StaticOrder S; S.init(M, DP, F.G, cid); EpiGlu E{ZZ, args.in[15], CAT};
      pg8::gemm_phase<EpiGlu, pg8::StaticOrder, true, true>(F.lds + RING_OFF, g, S, E, F.wave); }
    bg_range(F, args, 5000, BG_TOTAL, M / 2, M);
    GRID_BAR();
#endif
    { pg8::Gemm g{CAT, WCAT, D, D, D}; pg8::StaticOrder S; S.init(M, D, F.G, cid); EpiRes E{args.in[0], F.out, args.in[17], XN};
      pg8::gemm_phase<EpiRes, pg8::StaticOrder, true, true>(F.lds + RING_OFF, g, S, E, F.wave); }
    GRID_BAR();
#if MK_STAGE >= 3
    route_phase(F, args);
    bg_range(F, args, 0, 1400, 0, 0, true);
    GRID_BAR();
    { pg8::Gemm g{XN, WGU, D, D, D}; ExpertOrder<2> S{F.G, cid, F.MISC}; expert_setup(F, S);
      EpiAct E{(const float*)(F.ws + WS_LISTW), (const float*)(F.ws + WS_LISTR), ACT, F.MISC + 16};
      pg8::gemm_phase<EpiAct, ExpertOrder<2>, true, true, true, true>(F.lds + RING_OFF, g, S, E, F.wave, (const LAS unsigned*)(F.lds + ROWOFF_OFF)); }
#if MK_STAGE >= 4
    { const int nun = 2 * __builtin_amdgcn_readfirstlane((int)F.MISC[MW_TSTART + NEXP]), n2 = (nun > F.G && nun < 2 * F.G) ? nun - F.G : 0;
      pg8::Gemm g{PB, WPLE, DPLE, DPLE, DPLE}; PeOrder S{F.G, cid, n2}; EpiPe E{PE};
      pg8::gemm_phase<EpiPe, PeOrder, true, true>(F.lds + RING_OFF, g, S, E, F.wave); }
#endif
    GRID_BAR();
    { pg8::Gemm g{ACT, WD, DF, DF, DF}; ExpertOrder<4> S{F.G, cid, F.MISC}; EpiDown E{(const int*)(F.ws + WS_LIST), (const unsigned*)(F.ctl + CW_CNT), MO0, MO1, F.MISC + 16};
      pg8::gemm_phase<EpiDown, ExpertOrder<4>, true, true, false, true>(F.lds + RING_OFF, g, S, E, F.wave); }
    GRID_BAR();
    for (int m = F.gw; m + F.ngw < M; m += 2 * F.ngw) moe_combine_rows<2>(F, args, m, F.ngw);
    GRID_BAR();
#endif
#if MK_STAGE >= 4
    { pg8::Gemm g{XN, WG, D, D, D}; pg8::StaticOrder S; S.init(M, D, F.G, cid); EpiGate E{args.in[27], PE};
      pg8::gemm_phase<EpiGate, pg8::StaticOrder, true, true>(F.lds + RING_OFF, g, S, E, F.wave); }
    GRID_BAR();
#endif
    for (int m = F.gw; m + 3 * F.ngw < M; m += 4 * F.ngw) final_rows<4, (MK_STAGE >= 4)>(F, args, m, F.ngw);
}

extern "C" void kernel_launch(void* const* d_in, const int* in_sizes, int n_in, void* d_out, int out_size, void* d_ws, size_t ws_size, hipStream_t stream) {
    static int grid = 0;
    if (grid == 0) {
        if (n_in != 30 || in_sizes[0] != M * D || out_size != M * D || ws_size < WS_END) { fprintf(stderr, "kernel_launch: unexpected shapes (n_in %d, in0 %d, out %d, ws %zu)\n", n_in, n_in > 0 ? in_sizes[0] : -1, out_size, ws_size); grid = -1; return; }
        int dev = 0, cus = 0, per_cu = 0;
        if (hipGetDevice(&dev) != hipSuccess || hipDeviceGetAttribute(&cus, hipDeviceAttributeMultiprocessorCount, dev) != hipSuccess) { grid = -1; return; }
        if (hipFuncSetAttribute((const void*)mk_fwd, hipFuncAttributeMaxDynamicSharedMemorySize, LDS_BYTES) != hipSuccess) { fprintf(stderr, "kernel_launch: hipFuncSetAttribute failed\n"); grid = -1; return; }
        if (hipOccupancyMaxActiveBlocksPerMultiprocessor(&per_cu, (const void*)mk_fwd, NWAVES * 64, LDS_BYTES) != hipSuccess || per_cu < 1) { fprintf(stderr, "kernel_launch: occupancy query reports %d blocks per CU\n", per_cu); }
        (void)hipGetLastError();
        grid = cus;
    }
    if (grid < 0) return;
    (void)hipMemsetAsync((char*)d_ws + WS_CTL, 0, CTL_ZERO_BYTES, stream);
    Args a{};
    for (int i = 0; i < 30; ++i) a.in[i] = (const float*)d_in[i];
    a.out = (float*)d_out; a.ws = (unsigned char*)d_ws;
    hipLaunchKernelGGL(mk_fwd, dim3(grid), dim3(NWAVES * 64), LDS_BYTES, stream, a);
}
```

```cpp
#include <hip/hip_runtime.h>
#include <cstdio>
#include <cstdint>
__device__ __forceinline__ int hw_lane() { int l; asm volatile("v_mbcnt_lo_u32_b32 %0, -1, 0\n\tv_mbcnt_hi_u32_b32 %0, -1, %0" : "=v"(l)); return l; }
namespace pg8 {
#define PG8_LAS __attribute__((address_space(3)))
typedef unsigned short bf16_t;
typedef short bf16x8 __attribute__((ext_vector_type(8)));
typedef float f32x4 __attribute__((ext_vector_type(4)));
typedef unsigned u32x4 __attribute__((ext_vector_type(4)));
constexpr int BM = 256, BK = 64, HALF = 128, HTB = HALF * BK * 2  , STAGE_BYTES = 8 * HTB, NXCD = 8, WGM = 8;

__host__ __device__ __forceinline__ int lds_byte(int r, int c) { const int st = (r >> 4) * 2 + (c >> 5), rr = r & 15, cc = c & 31, ob = rr * 64 + cc * 2; return st * 1024 + (ob ^ (((ob >> 9) & 1) << 5)); }
__host__ __device__ __forceinline__ void stage_rc(int b, int& R, int& C) { const int st = b / 1024, sb = b % 1024, swz = sb ^ (((sb >> 9) & 1) << 5); R = (st >> 1) * 16 + swz / 64; C = (st & 1) * 32 + (swz % 64) / 2; }
__host__ __device__ __forceinline__ int perm32(int rho) { const int n = rho >> 4, i = rho & 15; return 8 * (i >> 2) + 4 * n + (i & 3); }

struct Unit { int pm, pn, nv; };
struct Gemm { const bf16_t* A; const bf16_t* Bt; int K, lda, ldb; };

struct StaticOrder {
    int nM, nN, nwg, G, c;
    __host__ __device__ void init(int M, int N, int G_, int c_) { nM = M / BM; nN = N / BM; nwg = nM * nN; G = G_; c = c_; }
    __host__ __device__ bool next(int i, Unit& u) const {
        const long L = (long)i * G + c; if (L >= nwg) return false;
        int wgid = (int)L; { const int q = nwg / NXCD, r = nwg % NXCD, xcd = wgid % NXCD, off = wgid / NXCD; wgid = (xcd < r ? xcd * (q + 1) : r * (q + 1) + (xcd - r) * q) + off; }
        const int nig = WGM * nN, gid = wgid / nig, fm = gid * WGM, gsz = (nM - fm) < WGM ? (nM - fm) : WGM;
        u.pm = fm + ((wgid % nig) % gsz); u.pn = (wgid % nig) / gsz; u.nv = 256; return true;
    }
    __device__ __forceinline__ void a_ready(const Unit&) const {}
    __device__ __forceinline__ void done(const Unit&) const {}
};

template <class Epi, class Sched, bool ALIGN_EPI = false, bool SP2 = false, bool GATHER = false, bool SKIP = false>
__device__ __forceinline__ void gemm_phase(PG8_LAS unsigned char* lds, const Gemm g, const Sched& S, const Epi& E, const int wid  , const PG8_LAS unsigned* rowoff = nullptr) {
    static_assert(!GATHER || SP2, "GATHER is written for the SP2 loop");
    int lane_ = hw_lane(); asm volatile("" : "+v"(lane_));
    const int lane = lane_, tid = wid * 64 + lane, wr = wid >> 2, wc = wid & 3, fr = lane & 15, fq = lane >> 4;
    const int K = g.K, nt = K / BK;
    unsigned voffA[2], voffB[2];
#pragma unroll
    for (int i = 0; i < 2; ++i) { int R, C; stage_rc(tid * 16 + i * 8192, R, C); const int Rb = Epi::PERM ? ((R & ~31) + perm32(R & 31)) : R;
        voffA[i] = (unsigned)(R * g.lda + C) * 2u; voffB[i] = (unsigned)(Rb * g.ldb + C) * 2u; }
    const size_t kstep = (size_t)(BK * 2);
    const size_t hstepA = GATHER ? (size_t)0 : (size_t)HALF * g.lda * 2, hstepB = (size_t)HALF * g.ldb * 2;
    const size_t tstepA = 2 * hstepA, tstepB = 2 * hstepB;
    const unsigned ldsw = (unsigned)wid * 1024u;
    const int aoff = lds_byte(wr * 64 + fr, fq * 8), boff = lds_byte(wc * 32 + fr, fq * 8);
    unsigned cvo[2][2];
#define PG8_LOADVO(dst, u_) do { _Pragma("unroll") for (int _h = 0; _h < 2; ++_h) _Pragma("unroll") for (int _i = 0; _i < 2; ++_i) { int R_, C_; stage_rc(tid * 16 + _i * 8192, R_, C_); \
        dst[_h][_i] = rowoff[(u_) * 256 + _h * 128 + R_] + (unsigned)C_ * 2u; } } while (0)
#define PG8_VA(h) (GATHER ? cvo[h] : voffA)
#define PG8_SA(b, h) (((b) * 2 + (h)) * HTB)
#define PG8_SB(b, h) ((4 + (b) * 2 + (h)) * HTB)
#define PG8_STAGE(bufoff, gbase, voff) do { _Pragma("unroll") for (int _i = 0; _i < 2; ++_i) \
        __builtin_amdgcn_global_load_lds((const unsigned*)((const char*)(gbase) + (voff)[_i]), (PG8_LAS unsigned*)(lds + (bufoff) + ldsw + _i * 8192), 16, 0, 0); } while (0)
#define PG8_LDA(dst, b, h) do { _Pragma("unroll") for (int m = 0; m < 4; ++m) _Pragma("unroll") for (int k = 0; k < 2; ++k) dst[m][k] = *(const PG8_LAS bf16x8*)(lds + PG8_SA(b, h) + aoff + m * 2048 + k * 1024); } while (0)
#define PG8_LDB(dst, b, h) do { _Pragma("unroll") for (int n = 0; n < 2; ++n) _Pragma("unroll") for (int k = 0; k < 2; ++k) dst[n][k] = *(const PG8_LAS bf16x8*)(lds + PG8_SB(b, h) + boff + n * 2048 + k * 1024); } while (0)
#define PG8_MMA(ai, bj, At, Bt) do { if (SKIP && (ai) * HALF + wr * 64 >= cur.nv) break; __builtin_amdgcn_s_setprio(1); _Pragma("unroll") for (int m = 0; m < 4; ++m) _Pragma("unroll") for (int n = 0; n < 2; ++n) _Pragma("unroll") for (int k = 0; k < 2; ++k) \
        acc[ai][bj][m][n] = __builtin_amdgcn_mfma_f32_16x16x32_bf16(Bt[n][k], At[m][k], acc[ai][bj][m][n], 0, 0, 0); __builtin_amdgcn_s_setprio(0); } while (0)
#define PG8_WAIT_V(n) asm volatile("s_waitcnt vmcnt(" #n ")" ::: "memory")
#define PG8_WAIT_L(n) asm volatile("s_waitcnt lgkmcnt(" #n ")" ::: "memory")
#define PG8_BAR __builtin_amdgcn_s_barrier()
#define PG8_SCHED __builtin_amdgcn_sched_barrier(0)
    Unit cur, nxt; int ui = 0;
    if (!S.next(0, cur)) return;
    f32x4 acc[2][2][4][2];
#pragma unroll
    for (int a = 0; a < 2; ++a)
#pragma unroll
        for (int b = 0; b < 2; ++b)
#pragma unroll
            for (int m = 0; m < 4; ++m)
#pragma unroll
                for (int n = 0; n < 2; ++n) acc[a][b][m][n] = (f32x4){0.f, 0.f, 0.f, 0.f};
    bf16x8 At[4][2], B0[2][2], B1[2][2];
    const char* cA = (const char*)g.A + (size_t)cur.pm * tstepA; const char* cB = (const char*)g.Bt + (size_t)cur.pn * tstepB;
    S.a_ready(cur);
    if constexpr (GATHER) PG8_LOADVO(cvo, 0);
    if constexpr (SP2) {
        PG8_STAGE(PG8_SB(0, 0), cB, voffB); PG8_STAGE(PG8_SB(0, 1), cB + hstepB, voffB); PG8_STAGE(PG8_SA(0, 0), cA, PG8_VA(0)); PG8_STAGE(PG8_SA(0, 1), cA + hstepA, PG8_VA(1));
        if (wr == 1) PG8_BAR;
        PG8_WAIT_V(2); PG8_BAR;
        PG8_STAGE(PG8_SB(1, 0), cB + kstep, voffB); PG8_STAGE(PG8_SA(1, 0), cA + kstep, PG8_VA(0)); PG8_STAGE(PG8_SB(1, 1), cB + hstepB + kstep, voffB);
        PG8_WAIT_V(6); PG8_BAR;
    } else {
        PG8_STAGE(PG8_SB(0, 0), cB, voffB); PG8_STAGE(PG8_SA(0, 0), cA, voffA); PG8_STAGE(PG8_SB(0, 1), cB + hstepB, voffB); PG8_STAGE(PG8_SA(0, 1), cA + hstepA, voffA);
        if (wr == 1) PG8_BAR;
        PG8_WAIT_V(4); PG8_BAR;
        PG8_STAGE(PG8_SB(1, 0), cB + kstep, voffB); PG8_STAGE(PG8_SA(1, 0), cA + kstep, voffA); PG8_STAGE(PG8_SB(1, 1), cB + hstepB + kstep, voffB);
        PG8_WAIT_V(6); PG8_BAR;
    }
    for (;;) {
        const bool has_next = S.next(ui + 1, nxt);
        const char* nA = has_next ? (const char*)g.A + (size_t)nxt.pm * tstepA : cA; const char* nB = has_next ? (const char*)g.Bt + (size_t)nxt.pn * tstepB : cB;
        for (int t = 0; t < nt; t += 2) {
            const bool last = (t == nt - 2);
            const char* a1 = cA + (size_t)(t + 1) * kstep;
            const char* a2 = last ? nA : cA + (size_t)(t + 2) * kstep; const char* b2 = last ? nB : cB + (size_t)(t + 2) * kstep;
            const char* a3 = a2 + kstep; const char* b3 = b2 + kstep;
            if (last && has_next) S.a_ready(nxt);
            if constexpr (SP2) {
            PG8_LDB(B0, 0, 0); PG8_LDB(B1, 0, 1); PG8_SCHED; PG8_LDA(At, 0, 0); PG8_STAGE(PG8_SA(1, 1), a1 + hstepA, PG8_VA(1));
            if constexpr (GATHER) { if (last && has_next) PG8_LOADVO(cvo, ui + 1); }
            PG8_WAIT_V(8); PG8_WAIT_L(0); PG8_BAR; PG8_MMA(0, 0, At, B0); PG8_MMA(0, 1, At, B1); PG8_BAR; PG8_SCHED;
            PG8_LDA(At, 0, 1); PG8_STAGE(PG8_SB(0, 0), b2, voffB); PG8_STAGE(PG8_SB(0, 1), b2 + hstepB, voffB); PG8_STAGE(PG8_SA(0, 0), a2, PG8_VA(0));
            PG8_WAIT_V(8); PG8_WAIT_L(0); PG8_BAR; PG8_MMA(1, 0, At, B0); PG8_MMA(1, 1, At, B1); PG8_BAR; PG8_SCHED;
            PG8_LDB(B0, 1, 0); PG8_LDB(B1, 1, 1); PG8_SCHED; PG8_LDA(At, 1, 0); PG8_STAGE(PG8_SA(0, 1), a2 + hstepA, PG8_VA(1));
            PG8_WAIT_V(8); PG8_WAIT_L(0); PG8_BAR; PG8_MMA(0, 0, At, B0); PG8_MMA(0, 1, At, B1); PG8_BAR; PG8_SCHED;
            PG8_LDA(At, 1, 1); PG8_STAGE(PG8_SB(1, 0), b3, voffB); PG8_STAGE(PG8_SB(1, 1), b3 + hstepB, voffB); PG8_STAGE(PG8_SA(1, 0), a3, PG8_VA(0));
            PG8_WAIT_V(8); PG8_WAIT_L(0); PG8_BAR; PG8_MMA(1, 0, At, B0); PG8_MMA(1, 1, At, B1); PG8_BAR; PG8_SCHED;
            } else {
            PG8_LDB(B0, 0, 0); PG8_SCHED; PG8_LDA(At, 0, 0); PG8_STAGE(PG8_SA(1, 1), a1 + hstepA, voffA);
            PG8_WAIT_L(8); PG8_BAR; PG8_WAIT_L(0); PG8_MMA(0, 0, At, B0); PG8_BAR; PG8_SCHED;
            PG8_LDB(B1, 0, 1); PG8_STAGE(PG8_SB(0, 0), b2, voffB);
            PG8_BAR; PG8_WAIT_L(0); PG8_MMA(0, 1, At, B1); PG8_BAR;
            PG8_LDA(At, 0, 1); PG8_STAGE(PG8_SA(0, 0), a2, voffA);
            PG8_BAR; PG8_WAIT_L(0); PG8_MMA(1, 0, At, B0); PG8_BAR; PG8_SCHED;
            PG8_STAGE(PG8_SB(0, 1), b2 + hstepB, voffB);
            PG8_WAIT_V(6); PG8_BAR; PG8_MMA(1, 1, At, B1); PG8_BAR;
            PG8_LDB(B0, 1, 0); PG8_SCHED; PG8_LDA(At, 1, 0); PG8_STAGE(PG8_SA(0, 1), a2 + hstepA, voffA);
            PG8_WAIT_L(8); PG8_BAR; PG8_WAIT_L(0); PG8_MMA(0, 0, At, B0); PG8_BAR; PG8_SCHED;
            PG8_LDB(B1, 1, 1); PG8_STAGE(PG8_SB(1, 0), b3, voffB);
            PG8_BAR; PG8_WAIT_L(0); PG8_MMA(0, 1, At, B1); PG8_BAR;
            PG8_LDA(At, 1, 1); PG8_STAGE(PG8_SA(1, 0), a3, voffA);
            PG8_BAR; PG8_WAIT_L(0); PG8_MMA(1, 0, At, B0); PG8_BAR; PG8_SCHED;
            PG8_STAGE(PG8_SB(1, 1), b3 + hstepB, voffB);
            PG8_WAIT_V(6); PG8_BAR; PG8_MMA(1, 1, At, B1); PG8_BAR;
            }
        }
        if constexpr (ALIGN_EPI) { if (wr == 0) PG8_BAR; }
        if constexpr (!Epi::AFTER_DRAIN) { E(acc, cur, wr, wc, fr, fq); S.done(cur); }
        if (!has_next) break;
#pragma unroll
        for (int a = 0; a < 2; ++a)
#pragma unroll
            for (int b = 0; b < 2; ++b)
#pragma unroll
                for (int m = 0; m < 4; ++m)
#pragma unroll
                    for (int n = 0; n < 2; ++n) acc[a][b][m][n] = (f32x4){0.f, 0.f, 0.f, 0.f};
        cur = nxt; cA = nA; cB = nB; ++ui;
        if constexpr (ALIGN_EPI) { if (wr == 1) PG8_BAR; }
    }
    PG8_WAIT_V(0);
    if constexpr (!ALIGN_EPI) { if (wr == 0) PG8_BAR; }
    PG8_BAR;
    if constexpr (Epi::AFTER_DRAIN) { E.fused(acc, cur, wr, wc, fr, fq, lds, wid, lane); S.done(cur); }
#undef PG8_SA
#undef PG8_LOADVO
#undef PG8_VA
#undef PG8_SB
#undef PG8_STAGE
#undef PG8_LDA
#undef PG8_LDB
#undef PG8_MMA
#undef PG8_WAIT_V
#undef PG8_WAIT_L
#undef PG8_BAR
#undef PG8_SCHED
}
}

#ifndef MK_STAGE
#define MK_STAGE 4
#endif
constexpr int NWAVES = 8;
constexpr int M = 16384, D = 1024, SEQ = 8192, DP = 512, NG = 32, NST = 64, GC = 16, CL = 16  ;
constexpr int NCH = M / CL;
constexpr int NEXP = 32, DF = 256, DPLE = 256;
constexpr int VP_ROWS = 2 * M + NEXP * 256;
constexpr float RMS_EPS = 1e-6f;

constexpr size_t MiB = 1u << 20;
constexpr size_t WS_CTL = 0, CTL_ZERO_BYTES = 1 * MiB;
constexpr size_t WS_WR = 1 * MiB;
constexpr size_t WS_LAMT = 1 * MiB + 256 * 1024;
constexpr size_t WS_ROUTE = 1 * MiB + 512 * 1024;
constexpr size_t WS_WIN = 2 * MiB, WS_GLU = 4 * MiB, WS_WCAT = 5 * MiB, WS_WG = 7 * MiB, WS_WPLE = 9 * MiB;
constexpr size_t WS_ROWINFO = 9 * MiB + 512 * 1024, WS_ROWW = 9 * MiB + 768 * 1024;
constexpr size_t WS_WGU = 10 * MiB, WS_WD = 42 * MiB;
constexpr size_t WS_MS = 58 * MiB, WS_WS3 = 62 * MiB;
constexpr size_t WS_ZZ = 70 * MiB;
constexpr size_t WS_PE = 58 * MiB;
constexpr size_t WS_XN = 90 * MiB;
constexpr size_t WS_ZP = 122 * MiB, WS_AS = 138 * MiB, WS_SLOC = 170 * MiB, WS_CAT = 202 * MiB, WS_PB = 234 * MiB;
constexpr size_t WS_VP = 122 * MiB, WS_ACT = 202 * MiB, WS_MO0 = 122 * MiB, WS_MO1 = 154 * MiB;
constexpr size_t WS_LIST = 244 * MiB, WS_LISTW = 246 * MiB, WS_LISTR = 248 * MiB;
constexpr size_t WS_WOS = 242 * MiB, WS_BD = 243 * MiB;
constexpr size_t WS_END = 256 * MiB;
static_assert(WS_VP + (size_t)VP_ROWS * 2048 <= WS_ACT && WS_ACT + (size_t)VP_ROWS * 512 <= WS_PB && WS_PB + (size_t)M * 512 <= WS_END, "ws map");
constexpr int CW_CNT = 8192;
constexpr int CW_BAR = 4096;
constexpr int ROWOFF_OFF = 143360;
constexpr int RING_OFF = 0, RING_BYTES = 131072, P0_SCR = 64 * 65 * 4  , LDSCTL_OFF = 139264, MISC_OFF = LDSCTL_OFF + 320, LDS_BYTES = 147456;
static_assert(NWAVES * P0_SCR <= LDSCTL_OFF && MISC_OFF + 4 * 512 <= ROWOFF_OFF && ROWOFF_OFF + 4 * 1024 <= LDS_BYTES, "LDS map");
constexpr int MW_TSTART = 16, MW_HIST = 64, MW_BASE = 96, MW_CNT = 128, MW_TL = 192;

#define GAS __attribute__((address_space(1)))
#define LAS __attribute__((address_space(3)))
typedef unsigned short bf16;
typedef unsigned v4u __attribute__((ext_vector_type(4)));
typedef unsigned v2u __attribute__((ext_vector_type(2)));
typedef float f32x4 __attribute__((ext_vector_type(4)));
typedef GAS unsigned gu32;
#define RLX_AGENT __ATOMIC_RELAXED, __HIP_MEMORY_SCOPE_AGENT
#define LDS_WAIT() asm volatile("s_waitcnt lgkmcnt(0)" ::: "memory")
#define VM_WAIT() asm volatile("s_waitcnt vmcnt(0)" ::: "memory")
__device__ __forceinline__ unsigned f2bf(float f) { unsigned u = __builtin_bit_cast(unsigned, f); return (u + 0x7fffu + ((u >> 16) & 1u)) >> 16; }
__device__ __forceinline__ unsigned pk2(float lo, float hi) { return f2bf(lo) | (f2bf(hi) << 16); }
__device__ __forceinline__ float bflo(unsigned w) { return __builtin_bit_cast(float, w << 16); }
__device__ __forceinline__ float bfhi(unsigned w) { return __builtin_bit_cast(float, w & 0xffff0000u); }
__device__ __forceinline__ float sigmoidf_(float x) { return __builtin_amdgcn_rcpf(1.0f + __expf(-x)); }
__device__ __forceinline__ float gelu_tanh(float y) { const float t = 1.5957691216f * (y + 0.044715f * y * y * y); return y * __builtin_amdgcn_rcpf(1.0f + __expf(-t)); }

#define XB_TMO      128
#define XB_XCNT(j)  (256  + 64 * (j))
#define XB_XSUB(j)  (1280 + 64 * (j))
#define XB_XGEN(j)  (2304 + 64 * (j))
#define XB_TOP      3328
#define XB_TOPGEN   3392
#define XCD_BAR_WORDS 3456
#define XB_SPIN_CAP (1u << 18)
__device__ __forceinline__ unsigned xb_ld(unsigned* p)              { return __hip_atomic_load(p, __ATOMIC_RELAXED, __HIP_MEMORY_SCOPE_AGENT); }
__device__ __forceinline__ unsigned xb_add(unsigned* p, unsigned v) { return __hip_atomic_fetch_add(p, v, __ATOMIC_RELAXED, __HIP_MEMORY_SCOPE_AGENT); }
__device__ __forceinline__ unsigned xb_xcc_id() { return (unsigned)__builtin_amdgcn_s_getreg((3 << 11) | 20) & 0xFu; }
#define XB_SPIN(cond, bar) do { unsigned _sp = 0; while (cond) { __builtin_amdgcn_s_sleep(1); \
    if ((++_sp & 255u) == 0u) { if (xb_ld(&(bar)[XB_TMO])) break; if (_sp > XB_SPIN_CAP) { atomicAdd(&(bar)[XB_TMO], 1u); break; } } } } while (0)
struct XcdBarrier { unsigned* bar; unsigned x; volatile LAS unsigned* st; int wave; };
__device__ __forceinline__ XcdBarrier xcd_barrier_post(unsigned* bar, volatile LAS unsigned* st) {
    XcdBarrier b; b.bar = bar; b.x = xb_xcc_id(); b.st = st; b.wave = 0;
    if (threadIdx.x == 0) (void)xb_add(&bar[XB_XCNT(b.x)], 1u);
    return b;
}
__device__ __forceinline__ void xcd_barrier_complete(unsigned* bar, unsigned x, unsigned& nloc, unsigned& nx) {
    const unsigned G = gridDim.x * gridDim.y * gridDim.z;
    unsigned sum, cnt, mine, sp = 0u;
    for (;;) {
        sum = 0u; cnt = 0u; mine = 0u;
#pragma unroll
        for (unsigned j = 0; j < 16; ++j) { const unsigned c = xb_ld(&bar[XB_XCNT(j)]); sum += c; cnt += (c > 0u) ? 1u : 0u; mine = (j == x) ? c : mine; }
        if (sum == G) break;
        __builtin_amdgcn_s_sleep(1);
        if ((++sp & 255u) == 0u) { if (xb_ld(&bar[XB_TMO])) break; if (sp > XB_SPIN_CAP) { atomicAdd(&bar[XB_TMO], 1u); break; } }
    }
    nloc = mine > 0u ? mine : 1u; nx = cnt > 0u ? cnt : 1u;
}
__device__ __forceinline__ void xcd_barrier(const XcdBarrier& b) {
    asm volatile("s_waitcnt vmcnt(0)" ::: "memory");
    __syncthreads();
    if (b.wave == 0 && hw_lane() == 0) {
        unsigned* bar = b.bar;
        __builtin_amdgcn_s_waitcnt(0);
        unsigned nloc = b.st[0], nx = b.st[1];
        if (nloc == 0u) { xcd_barrier_complete(bar, b.x, nloc, nx); b.st[0] = nloc; b.st[1] = nx; }
        const unsigned old = xb_add(&bar[XB_XSUB(b.x)], 1u);
        const unsigned gen = old / nloc;
        if (old + 1u == (gen + 1u) * nloc) {
            __builtin_amdgcn_fence(__ATOMIC_RELEASE, "agent");
            asm volatile("s_waitcnt vmcnt(0)" ::: "memory");
            const unsigned og = xb_add(&bar[XB_TOP], 1u);
            const unsigned tg = og / nx;
            if (og + 1u == (tg + 1u) * nx) xb_add(&bar[XB_TOPGEN], 1u);
            else XB_SPIN(xb_ld(&bar[XB_TOPGEN]) == tg, bar);
            __builtin_amdgcn_fence(__ATOMIC_ACQUIRE, "agent");
            xb_add(&bar[XB_XGEN(b.x)], 1u);
            asm volatile("s_waitcnt vmcnt(0)" ::: "memory");
        } else {
            XB_SPIN(xb_ld(&bar[XB_XGEN(b.x)]) == gen, bar);
            __builtin_amdgcn_fence(__ATOMIC_ACQUIRE, "agent");
            asm volatile("s_waitcnt vmcnt(0)" ::: "memory");
        }
    }
    __syncthreads();
}

struct Args { const float* in[30]; float* out; unsigned char* ws; };
struct Frame {
    LAS unsigned char* lds;
    volatile LAS unsigned* MISC;
    gu32* ctl;
    int wave, G, gw, ngw;
    float* out;
    unsigned char* ws;
};
__device__ __forceinline__ int opq(int v) { asm volatile("" : "+v"(v)); return v; }
template <int CTRL> __device__ __forceinline__ float dpp_f(float v) { return __builtin_bit_cast(float, __builtin_amdgcn_update_dpp(0, __builtin_bit_cast(int, v), CTRL, 0xf, 0xf, true)); }
__device__ __forceinline__ float wave_sum(float v) {
    v += dpp_f<0xB1>(v);
    v += dpp_f<0x4E>(v);
    v += dpp_f<0x141>(v);
    v += dpp_f<0x140>(v);
    const float r0 = __builtin_bit_cast(float, __builtin_amdgcn_readlane(__builtin_bit_cast(int, v), 0)), r1 = __builtin_bit_cast(float, __builtin_amdgcn_readlane(__builtin_bit_cast(int, v), 16));
    const float r2 = __builtin_bit_cast(float, __builtin_amdgcn_readlane(__builtin_bit_cast(int, v), 32)), r3 = __builtin_bit_cast(float, __builtin_amdgcn_readlane(__builtin_bit_cast(int, v), 48));
    return (r0 + r1) + (r2 + r3);
}

__device__ __forceinline__ void transpose_item64(const float* src, int ld_src, bf16* dst, int ld_dst, LAS float* scr, int lane, const float* kscale = nullptr) {
    f32x4 v[16];
    const int kq = lane >> 4, n4 = (lane & 15) * 4;
#pragma unroll
    for (int i = 0; i < 16; ++i) v[i] = *(const GAS f32x4*)(src + (size_t)(4 * i + kq) * ld_src + n4);
    if (kscale) {
#pragma unroll
        for (int i = 0; i < 16; ++i) v[i] = v[i] * kscale[4 * i + kq]; }
#pragma unroll
    for (int i = 0; i < 16; ++i) { LAS float* p = scr + (4 * i + kq) * 65 + n4; p[0] = v[i].x; p[1] = v[i].y; p[2] = v[i].z; p[3] = v[i].w; }
    LDS_WAIT(); asm volatile("" ::: "memory");
    const int c = lane & 7;
#pragma unroll
    for (int j = 0; j < 8; ++j) { const int n = (lane >> 3) + 8 * j; const LAS float* q = scr + (8 * c) * 65 + n;
        v4u o; o.x = pk2(q[0 * 65], q[1 * 65]); o.y = pk2(q[2 * 65], q[3 * 65]); o.z = pk2(q[4 * 65], q[5 * 65]); o.w = pk2(q[6 * 65], q[7 * 65]);
        *(GAS v4u*)(dst + (size_t)n * ld_dst + 8 * c) = o; }
    LDS_WAIT(); asm volatile("" ::: "memory");
}
__device__ __forceinline__ void rms_row_to_bf16(const float* xrow, const float* g, bf16* orow, int lane) {
    const GAS f32x4* xr = (const GAS f32x4*)xrow + lane; const GAS f32x4* gr = (const GAS f32x4*)g + lane;
    f32x4 v[4]; float s = 0.f;
#pragma unroll
    for (int j = 0; j < 4; ++j) { v[j] = xr[64 * j]; s += (v[j].x * v[j].x + v[j].y * v[j].y) + (v[j].z * v[j].z + v[j].w * v[j].w); }
    const float rstd = 1.f / sqrtf(wave_sum(s) * (1.f / D) + RMS_EPS);
    GAS unsigned long long* o8 = (GAS unsigned long long*)orow + lane;
#pragma unroll
    for (int j = 0; j < 4; ++j) { const f32x4 gg = gr[64 * j];
        o8[64 * j] = (unsigned long long)pk2(v[j].x * rstd * gg.x, v[j].y * rstd * gg.y) | ((unsigned long long)pk2(v[j].z * rstd * gg.z, v[j].w * rstd * gg.w) << 32); }
}
__device__ __forceinline__ void sincos_d(double x, double& sn, double& cs) {
    const double k = __builtin_rint(x * 0.63661977236758134308);
    const double r = (x - k * 1.57079632679489655800e+00) - k * 6.12323399573676603587e-17;
    const double r2 = r * r;
    const double s = r * (1.0 + r2 * (-1.0 / 6.0 + r2 * (1.0 / 120.0 + r2 * (-1.0 / 5040.0 + r2 * (1.0 / 362880.0 + r2 * (-1.0 / 39916800.0 + r2 * (1.0 / 6227020800.0)))))));
    const double c = 1.0 + r2 * (-0.5 + r2 * (1.0 / 24.0 + r2 * (-1.0 / 720.0 + r2 * (1.0 / 40320.0 + r2 * (-1.0 / 3628800.0 + r2 * (1.0 / 479001600.0 + r2 * (-1.0 / 87178291200.0)))))));
    const int q = ((int)k) & 3;
    sn = (q == 0) ? s : (q == 1) ? c : (q == 2) ? -s : -c;
    cs = (q == 0) ? c : (q == 1) ? -s : (q == 2) ? -c : s;
}
__device__ __forceinline__ void ssm_gen(Frame& F, const Args& A, int g, int sl) {
    LAS float* lamP = (LAS float*)(F.lds + RING_OFF);
    LAS float* Bb = lamP + 2 * 17 * 64 * 2;
    LAS float* Cc = Bb + 2 * 64 * 16 * 2;
    LAS float* KT = Cc + 2 * 16 * 64 * 2;
    LAS float* dv = KT + 32 * 260;
    LAS float* bfac = dv + 16;
    const float* a_re = A.in[6]; const float* a_im = A.in[7]; const float* log_dt = A.in[8];
    const float* b_re = A.in[9]; const float* b_im = A.in[10]; const float* c_re = A.in[11]; const float* c_im = A.in[12]; const float* ssm_d = A.in[13];
    const int t = opq(F.wave * 64 + hw_lane());
    float pbr[4], pbi[4], pcr[4], pci[4];
#pragma unroll
    for (int i = 0; i < 4; ++i) { const int idx = t + 512 * i; const size_t si = (size_t)((idx >> 10) * NG + g) * 1024 + (idx & 1023);
        pbr[i] = b_re[si]; pbi[i] = b_im[si]; pcr[i] = c_re[si]; pci[i] = c_im[si]; }
    const int d_a = (t >> 6) & 1, n_a = t & 63;
    const float p_are = a_re[(d_a * NG + g) * NST + n_a], p_aim = a_im[(d_a * NG + g) * NST + n_a], p_ldt = log_dt[d_a * NG + g], p_dv = ssm_d[g * GC + (t & 15)];
    __syncthreads();
    if (t < 128) {
        const int d = d_a, n = n_a;
        const float dtf = expf(p_ldt), mag = expf(p_are * dtf); const double ang = (double)p_aim * (double)dtf;
        double sn, cs; sincos_d(ang, sn, cs);
        const float lr = mag * (float)cs, li = mag * (float)sn;
        const float nr = lr - 1.0f, ni = li, den = p_are * p_are + p_aim * p_aim;
        bfac[(d * 64 + n) * 2] = (nr * p_are + ni * p_aim) / den; bfac[(d * 64 + n) * 2 + 1] = (ni * p_are - nr * p_aim) / den;
        float pr = 1.0f, pi = 0.0f;
        for (int k = 0; k <= 16; ++k) { lamP[((d * 17 + k) * 64 + n) * 2] = pr; lamP[((d * 17 + k) * 64 + n) * 2 + 1] = pi;
            const float tr = pr * lr - pi * li, ti = pr * li + pi * lr; pr = tr; pi = ti; }
        if (sl == 0) {
            float* lt = (float*)(F.ws + WS_LAMT) + ((g * 2 + d) * 64 + n) * 4;
            double s16, c16, s1k, c1k; sincos_d(ang * 16.0, s16, c16); sincos_d(ang * 1024.0, s1k, c1k);
            const float m16 = expf(p_are * dtf * 16.0f), m1k = expf(p_are * dtf * 1024.0f);
            lt[0] = m16 * (float)c16; lt[1] = m16 * (float)s16; lt[2] = m1k * (float)c1k; lt[3] = m1k * (float)s1k; }
    }
    if (t < 16) dv[t] = p_dv;
    __syncthreads();
#pragma unroll
    for (int i = 0; i < 4; ++i) { const int idx = t + 512 * i, d = idx >> 10, n = (idx >> 4) & 63;
        const float fr = bfac[(d * 64 + n) * 2], fi = bfac[(d * 64 + n) * 2 + 1];
        Bb[idx * 2] = fr * pbr[i] - fi * pbi[i]; Bb[idx * 2 + 1] = fr * pbi[i] + fi * pbr[i];
        Cc[idx * 2] = pcr[i]; Cc[idx * 2 + 1] = pci[i]; }
    __syncthreads();
    {
        const int d = t >> 8, co = (t >> 4) & 15, ci = t & 15;
        float acc[16];
#pragma unroll
        for (int k = 0; k < 16; ++k) acc[k] = 0.f;
        for (int n = 0; n < 64; ++n) {
            const float cr = Cc[((d * 16 + co) * 64 + n) * 2], cim = Cc[((d * 16 + co) * 64 + n) * 2 + 1];
            const float br = Bb[((d * 64 + n) * 16 + ci) * 2], bi = Bb[((d * 64 + n) * 16 + ci) * 2 + 1];
            const float lr = lamP[((d * 17 + 1) * 64 + n) * 2], li = lamP[((d * 17 + 1) * 64 + n) * 2 + 1];
            float qr = cr * br - cim * bi, qi = cr * bi + cim * br;
#pragma unroll
            for (int k = 0; k < 16; ++k) { acc[k] += qr; const float tr = qr * lr - qi * li; qi = qr * li + qi * lr; qr = tr; }
        }
#pragma unroll
        for (int k = 0; k < 16; ++k) KT[(d * 16 + k) * 260 + co * 16 + ci] = acc[k];
    }
    __syncthreads();
    bf16* WS3 = (bf16*)(F.ws + WS_WS3) + ((size_t)g * 256 + sl * 64) * 512;
#pragma unroll
    for (int i2 = 0; i2 < 2; ++i2) {
        const int idx = t + 512 * i2, rowl = idx >> 4, sq = idx & 15, row = sl * 64 + rowl, j = row >> 4, co = row & 15;
        float v[16];
        if (j != sq) { const LAS float* src = KT + ((j > sq) ? (j - sq) : (16 + sq - j)) * 260 + co * 16;
#pragma unroll
            for (int i = 0; i < 16; ++i) v[i] = src[i]; }
        else {
#pragma unroll
            for (int i = 0; i < 16; ++i) v[i] = KT[co * 16 + i] + KT[16 * 260 + co * 16 + i] + (co == i ? dv[co] : 0.f); }
        v4u o0, o1; o0.x = pk2(v[0], v[1]); o0.y = pk2(v[2], v[3]); o0.z = pk2(v[4], v[5]); o0.w = pk2(v[6], v[7]); o1.x = pk2(v[8], v[9]); o1.y = pk2(v[10], v[11]); o1.z = pk2(v[12], v[13]); o1.w = pk2(v[14], v[15]);
        GAS v4u* dst = (GAS v4u*)(WS3 + (size_t)rowl * 512 + sq * 16); dst[0] = o0; dst[1] = o1;
    }
#pragma unroll
    for (int i2 = 0; i2 < 4; ++i2) {
        const int idx = t + 512 * i2, rowl = idx >> 5, q = (idx >> 3) & 3, n0 = (idx & 7) * 8, row = sl * 64 + rowl, j = row >> 4, co = row & 15, d = q >> 1, e = (d == 0) ? (j + 1) : (16 - j);
        float v[8];
#pragma unroll
        for (int i = 0; i < 8; ++i) { const int n = n0 + i;
            const float cr = Cc[((d * 16 + co) * 64 + n) * 2], cim = Cc[((d * 16 + co) * 64 + n) * 2 + 1];
            const float pr = lamP[((d * 17 + e) * 64 + n) * 2], pi = lamP[((d * 17 + e) * 64 + n) * 2 + 1];
            v[i] = (q & 1) ? -(cr * pi + cim * pr) : (cr * pr - cim * pi); }
        v4u o; o.x = pk2(v[0], v[1]); o.y = pk2(v[2], v[3]); o.z = pk2(v[4], v[5]); o.w = pk2(v[6], v[7]);
        *(GAS v4u*)(WS3 + (size_t)rowl * 512 + 256 + q * 64 + n0) = o;
    }
    bf16* MS = (bf16*)(F.ws + WS_MS) + ((size_t)g * 256 + sl * 64) * 256;
#pragma unroll
    for (int i2 = 0; i2 < 4; ++i2) {
        const int idx = t + 512 * i2, rowl = idx >> 5, kc = (idx & 31) * 8, row = sl * 64 + rowl, q = row >> 6, n = row & 63, d = q >> 1, j = kc >> 4, ci0 = kc & 15, e = (d == 0) ? (15 - j) : j;
        const float pr = lamP[((d * 17 + e) * 64 + n) * 2], pi = lamP[((d * 17 + e) * 64 + n) * 2 + 1];
        float v[8];
#pragma unroll
        for (int i = 0; i < 8; ++i) { const float br = Bb[((d * 64 + n) * 16 + ci0 + i) * 2], bi = Bb[((d * 64 + n) * 16 + ci0 + i) * 2 + 1];
            v[i] = (q & 1) ? (pr * bi + pi * br) : (pr * br - pi * bi); }
        v4u o; o.x = pk2(v[0], v[1]); o.y = pk2(v[2], v[3]); o.z = pk2(v[4], v[5]); o.w = pk2(v[6], v[7]);
        *(GAS v4u*)(MS + (size_t)rowl * 256 + kc) = o;
    }
    __syncthreads();
}
constexpr int BG_GU = NEXP * 16 * 4, BG_DN = NEXP * 4 * 16, BG_WOB = 8 * 16, BG_WG = 16 * 16, BG_WPLE = 4 * 16;
constexpr int BG_TOTAL = 2 * BG_GU + BG_DN + BG_WOB + BG_WG + BG_WPLE;
struct BgDesc { const float* src; bf16* dst; int ld_src, ld_dst; };
__device__ __forceinline__ BgDesc bg_desc(Frame& F, const Args& A, int r) {
    BgDesc d;
    if (r < 2 * BG_GU) {
        const int up = r >= BG_GU; if (up) r -= BG_GU;
        const int e = r >> 6, kb = (r >> 2) & 15, nb = r & 3, k0 = kb * 64, n0 = nb * 64;
        d.src = A.in[up ? 23 : 22] + ((size_t)e * D + k0) * DF + n0; d.ld_src = DF;
        d.dst = (bf16*)(F.ws + WS_WGU) + ((size_t)e * 512 + (n0 >> 7) * 256 + (up ? 128 : 0) + (n0 & 127)) * D + k0; d.ld_dst = D; return d; }
    r -= 2 * BG_GU;
    if (r < BG_DN) {
        const int e = r >> 6, kb = (r >> 4) & 3, nb = r & 15, k0 = kb * 64, n0 = nb * 64;
        d.src = A.in[24] + ((size_t)e * DF + k0) * D + n0; d.ld_src = D; d.dst = (bf16*)(F.ws + WS_WD) + ((size_t)e * D + n0) * DF + k0; d.ld_dst = DF; return d; }
    r -= BG_DN;
    if (r < BG_WOB) { const int kb = r >> 4, nb = r & 15;
        d.src = A.in[16] + (size_t)(DP + kb * 64) * D + nb * 64; d.ld_src = D; d.dst = (bf16*)(F.ws + WS_WCAT) + (size_t)nb * 64 * D + DP + kb * 64; d.ld_dst = D; return d; }
    r -= BG_WOB;
    if (r < BG_WG) { const int kb = r >> 4, nb = r & 15; d.src = A.in[26] + (size_t)kb * 64 * D + nb * 64; d.ld_src = D; d.dst = (bf16*)(F.ws + WS_WG) + (size_t)nb * 64 * D + kb * 64; d.ld_dst = D; return d; }
    r -= BG_WG;
    { const int kb = r >> 4, nb = r & 15; d.src = A.in[28] + (size_t)kb * 64 * D + nb * 64; d.ld_src = D; d.dst = (bf16*)(F.ws + WS_WPLE) + (size_t)nb * 64 * DPLE + kb * 64; d.ld_dst = DPLE; return d; }
}
__device__ __forceinline__ void tr64_load(f32x4 (&v)[16], const float* src, int ld_src, int lane) {
    const int kq = lane >> 4, n4 = (lane & 15) * 4;
#pragma unroll
    for (int i = 0; i < 16; ++i) v[i] = *(const GAS f32x4*)(src + (size_t)(4 * i + kq) * ld_src + n4);
}
__device__ __forceinline__ void tr64_finish(const f32x4 (&v)[16], bf16* dst, int ld_dst, LAS float* scr, int lane) {
    const int kq = lane >> 4, n4 = (lane & 15) * 4;
#pragma unroll
    for (int i = 0; i < 16; ++i) { LAS float* p = scr + (4 * i + kq) * 65 + n4; p[0] = v[i].x; p[1] = v[i].y; p[2] = v[i].z; p[3] = v[i].w; }
    LDS_WAIT(); asm volatile("" ::: "memory");
    const int c = lane & 7;
#pragma unroll
    for (int j = 0; j < 8; ++j) { const int n = (lane >> 3) + 8 * j; const LAS float* q = scr + (8 * c) * 65 + n;
        v4u o; o.x = pk2(q[0 * 65], q[1 * 65]); o.y = pk2(q[2 * 65], q[3 * 65]); o.z = pk2(q[4 * 65], q[5 * 65]); o.w = pk2(q[6 * 65], q[7 * 65]);
        *(GAS v4u*)(dst + (size_t)n * ld_dst + 8 * c) = o; }
    LDS_WAIT(); asm volatile("" ::: "memory");
}
__device__ __forceinline__ void bg_range(Frame& F, const Args& A, int lo, int hi, int plo, int phi, bool all = false) {
    int widx, nw;
    if (all) { widx = F.gw; nw = F.ngw; }
    else if (F.G >= 256) { if ((int)blockIdx.x < 128) return; widx = ((int)blockIdx.x - 128) * NWAVES + F.wave; nw = (F.G - 128) * NWAVES; } else { widx = F.gw; nw = F.ngw; }
    LAS float* scr = (LAS float*)(F.lds + RING_OFF + F.wave * P0_SCR);
    const int lane = opq(hw_lane());
    int it = lo + widx;
    for (; it + nw < hi; it += 2 * nw) {
        f32x4 va[16], vb[16]; const BgDesc da = bg_desc(F, A, it), db = bg_desc(F, A, it + nw);
        tr64_load(va, da.src, da.ld_src, lane); tr64_load(vb, db.src, db.ld_src, lane);
        tr64_finish(va, da.dst, da.ld_dst, scr, lane); tr64_finish(vb, db.dst, db.ld_dst, scr, lane); }
    if (it < hi) { f32x4 va[16]; const BgDesc dc = bg_desc(F, A, it); tr64_load(va, dc.src, dc.ld_src, lane); tr64_finish(va, dc.dst, dc.ld_dst, scr, lane); }
    for (int m = plo + 4 * widx; m < phi; m += 4 * nw) {
        f32x4 pv[4];
#pragma unroll
        for (int r = 0; r < 4; ++r) pv[r] = *((const GAS f32x4*)(A.in[1] + (size_t)(m + r) * DPLE) + lane);
#pragma unroll
        for (int r = 0; r < 4; ++r) { v2u o; o.x = pk2(pv[r].x, pv[r].y); o.y = pk2(pv[r].z, pv[r].w); *((GAS v2u*)((bf16*)(F.ws + WS_PB) + (size_t)(m + r) * DPLE) + lane) = o; }
    }
}
template <int R> __device__ __forceinline__ void xn_rows(Frame& F, const Args& A, int m0, int stride, int lane) {
    const GAS f32x4* gr = (const GAS f32x4*)A.in[2] + lane;
    f32x4 v[R][4];
#pragma unroll
    for (int r = 0; r < R; ++r) { const size_t m = (size_t)(m0 + r * stride);
#pragma unroll
        for (int j = 0; j < 4; ++j) v[r][j] = *((const GAS f32x4*)(A.in[0] + m * D) + lane + 64 * j); }
#pragma unroll
    for (int r = 0; r < R; ++r) { const size_t m = (size_t)(m0 + r * stride); float s = 0.f;
#pragma unroll
        for (int j = 0; j < 4; ++j) s += (v[r][j].x * v[r][j].x + v[r][j].y * v[r][j].y) + (v[r][j].z * v[r][j].z + v[r][j].w * v[r][j].w);
        const float rstd = 1.f / sqrtf(wave_sum(s) * (1.f / D) + RMS_EPS);
        GAS unsigned long long* o8 = (GAS unsigned long long*)((bf16*)(F.ws + WS_XN) + m * D) + lane;
#pragma unroll
        for (int j = 0; j < 4; ++j) { const f32x4 gg = gr[64 * j], x = v[r][j];
            o8[64 * j] = (unsigned long long)pk2(x.x * rstd * gg.x, x.y * rstd * gg.y) | ((unsigned long long)pk2(x.z * rstd * gg.z, x.w * rstd * gg.w) << 32); }
    }
}
__device__ __forceinline__ void p0_prologue(Frame& F, const Args& A) {
    int widx = F.gw, nw = F.ngw;
    if (F.G >= 256) { if ((int)blockIdx.x < 128) { ssm_gen(F, A, (int)blockIdx.x >> 2, (int)blockIdx.x & 3); return; }
                      widx = ((int)blockIdx.x - 128) * NWAVES + F.wave; nw = (F.G - 128) * NWAVES; }
    else { for (int u = blockIdx.x; u < NG * 4; u += F.G) ssm_gen(F, A, u >> 2, u & 3); __syncthreads(); }
    LAS float* scr = (LAS float*)(F.lds + RING_OFF + F.wave * P0_SCR);
    constexpr int I_WIN = 16 * 16, I_GLU = 8 * 8, I_WOS = 8 * 16, I_BD = 256, I_WR = 48, I_ROWS = M / 8;
    constexpr int NITEMS = I_WIN + I_GLU + I_WOS + I_BD + I_WR + I_ROWS;
    for (int it = widx; it < NITEMS; it += nw) {
        int r = it; const int lane = opq(hw_lane());
        if (r < I_WIN) { const int kb = r >> 4, nb = r & 15; transpose_item64(A.in[3] + (size_t)kb * 64 * D + nb * 64, D, (bf16*)(F.ws + WS_WIN) + (size_t)nb * 64 * D + kb * 64, D, scr, lane); continue; }
        r -= I_WIN;
        if (r < I_GLU) { const int kb = r >> 3, nb = r & 7; transpose_item64(A.in[14] + (size_t)kb * 64 * DP + nb * 64, DP, (bf16*)(F.ws + WS_GLU) + (size_t)nb * 64 * DP + kb * 64, DP, scr, lane); continue; }
        r -= I_GLU;
        if (r < I_WOS) {
            const int kb = r >> 4, nb = r & 15, k0 = kb * 64;
            transpose_item64(A.in[16] + (size_t)k0 * D + nb * 64, D, (bf16*)(F.ws + WS_WOS) + ((size_t)(k0 >> 8) * D + nb * 64) * 256 + (k0 & 255), 256, scr, lane, A.in[5] + k0); continue; }
        r -= I_WOS;
        if (r < I_BD) {
            const int row = r * 2 + (lane >> 5), c0 = (lane & 31) * 8, gi = row >> 7;
            v4u o = (v4u){0u, 0u, 0u, 0u};
            if ((c0 >> 7) == (gi & 1)) { const f32x4 a = *(const GAS f32x4*)(A.in[4] + (size_t)row * 128 + (c0 & 127)), b = *(const GAS f32x4*)(A.in[4] + (size_t)row * 128 + (c0 & 127) + 4);
                o.x = pk2(a.x, a.y); o.y = pk2(a.z, a.w); o.z = pk2(b.x, b.y); o.w = pk2(b.z, b.w); }
            *(GAS v4u*)((bf16*)(F.ws + WS_BD) + (size_t)row * 256 + c0) = o; continue; }
        r -= I_BD;
        if (r < I_WR) {
            bf16* dh = (bf16*)(F.ws + WS_WR) + (size_t)r * D; bf16* dl = dh + 48 * D;
            for (int dd = lane; dd < D; dd += 64) { float w = 0.f;
                if (r < 4) w = A.in[18][dd * 4 + r]; else if (r < 36) w = A.in[20][((size_t)((r - 4) >> 3) * D + dd) * 8 + ((r - 4) & 7)];
                w *= A.in[17][dd]; const unsigned h = f2bf(w); dh[dd] = (bf16)h; dl[dd] = (bf16)f2bf(w - __builtin_bit_cast(float, h << 16)); }
            continue; }
        r -= I_WR;
        xn_rows<8>(F, A, r, I_ROWS, lane);
    }
}

using pg8::Unit; using pg8::bf16_t; typedef unsigned u32x4 __attribute__((ext_vector_type(4)));
__device__ __forceinline__ u32x4 pack8(const f32x4& a, const f32x4& b) { u32x4 w; w.x = pk2(a[0], a[1]); w.y = pk2(a[2], a[3]); w.z = pk2(b[0], b[1]); w.w = pk2(b[2], b[3]); return w; }
struct EpiZ { static constexpr bool PERM = true, AFTER_DRAIN = false; bf16_t* ZP; bf16_t* AS;
    __device__ __forceinline__ void operator()(const f32x4 (&acc)[2][2][4][2], const Unit& u, int wr, int wc, int fr, int fq) const {
        const int row0 = u.pm * 256 + wr * 64 + fr;
#pragma unroll
        for (int ai = 0; ai < 2; ++ai)
#pragma unroll
            for (int m = 0; m < 4; ++m) { const int r = row0 + ai * 128 + m * 16;
#pragma unroll
                for (int bj = 0; bj < 2; ++bj) { const int col = u.pn * 256 + bj * 128 + wc * 32 + 8 * fq; const u32x4 w = pack8(acc[ai][bj][m][0], acc[ai][bj][m][1]);
                    if (u.pn < 2) *(u32x4*)(ZP + (size_t)r * DP + col) = w;
                    else { const int sc = col - DP, g = sc >> 4, ch0 = sc & 15; *(u32x4*)(AS + ((size_t)(g * NCH + (r >> 4)) * 512 + (r & 15) * 16 + ch0)) = w; } } }
    } };
struct EpiSloc { static constexpr bool PERM = false, AFTER_DRAIN = false; float* C;
    __device__ __forceinline__ void operator()(const f32x4 (&acc)[2][2][4][2], const Unit& u, int wr, int wc, int fr, int fq) const {
        const int row0 = u.pm * 256 + wr * 64 + fr, col0 = wc * 32 + 4 * fq;
#pragma unroll
        for (int ai = 0; ai < 2; ++ai)
#pragma unroll
            for (int m = 0; m < 4; ++m) { float* rowp = C + (size_t)(row0 + ai * 128 + m * 16) * 256 + col0;
#pragma unroll
                for (int bj = 0; bj < 2; ++bj)
#pragma unroll
                    for (int n = 0; n < 2; ++n) *(f32x4*)(rowp + bj * 128 + n * 16) = acc[ai][bj][m][n]; }
    } };
struct EpiY { static constexpr bool PERM = true, AFTER_DRAIN = false; bf16_t* ZZ;
    __device__ __forceinline__ void operator()(const f32x4 (&acc)[2][2][4][2], const Unit& u, int wr, int wc, int fr, int fq) const {
        const int g = u.pn, row0 = (u.pm & 3) * 256 + wr * 64 + fr;
#pragma unroll
        for (int ai = 0; ai < 2; ++ai)
#pragma unroll
            for (int m = 0; m < 4; ++m) { const int c = row0 + ai * 128 + m * 16;
#pragma unroll
                for (int bj = 0; bj < 2; ++bj) { const int col = bj * 128 + wc * 32 + 8 * fq, j = col >> 4, co0 = col & 15;
                    f32x4 a = acc[ai][bj][m][0], b = acc[ai][bj][m][1];
#pragma unroll
                    for (int i = 0; i < 4; ++i) { a[i] = gelu_tanh(a[i]); b[i] = gelu_tanh(b[i]); }
                    *(u32x4*)(ZZ + (size_t)(c * CL + j) * DP + g * GC + co0) = pack8(a, b); asm volatile("" ::: "memory"); } }
    } };
struct EpiGlu { static constexpr bool PERM = true, AFTER_DRAIN = false; const bf16_t* ZZ; const float* bias; bf16_t* CAT;
    __device__ __forceinline__ void operator()(const f32x4 (&acc)[2][2][4][2], const Unit& u, int wr, int wc, int fr, int fq) const {
        const int row0 = u.pm * 256 + wr * 64 + fr;
#pragma unroll
        for (int bj = 0; bj < 2; ++bj) { const int col = u.pn * 256 + bj * 128 + wc * 32 + 8 * fq;
            const f32x4 b0 = *(const f32x4*)(bias + col), b1 = *(const f32x4*)(bias + col + 4);
#pragma unroll
            for (int ai = 0; ai < 2; ++ai)
#pragma unroll
                for (int m = 0; m < 4; ++m) { const int r = row0 + ai * 128 + m * 16;
                    const u32x4 z = *(const u32x4*)(ZZ + (size_t)r * DP + col);
                    f32x4 a = acc[ai][bj][m][0] + b0, b = acc[ai][bj][m][1] + b1;
                    a[0] = bflo(z.x) * sigmoidf_(a[0]); a[1] = bfhi(z.x) * sigmoidf_(a[1]); a[2] = bflo(z.y) * sigmoidf_(a[2]); a[3] = bfhi(z.y) * sigmoidf_(a[3]);
                    b[0] = bflo(z.z) * sigmoidf_(b[0]); b[1] = bfhi(z.z) * sigmoidf_(b[1]); b[2] = bflo(z.w) * sigmoidf_(b[2]); b[3] = bfhi(z.w) * sigmoidf_(b[3]);
                    *(u32x4*)(CAT + (size_t)r * D + DP + col) = pack8(a, b); asm volatile("" ::: "memory"); } }
    } };
struct EpiRes { static constexpr bool PERM = true, AFTER_DRAIN = false; const float* X; float* H; const float* G; bf16_t* V;
    __device__ __forceinline__ void operator()(const f32x4 (&acc)[2][2][4][2], const Unit& u, int wr, int wc, int fr, int fq) const {
        const int row0 = u.pm * 256 + wr * 64 + fr, col0 = u.pn * 256 + wc * 32 + 8 * fq;
        f32x4 gv[2][2];
#pragma unroll
        for (int bj = 0; bj < 2; ++bj)
#pragma unroll
            for (int n = 0; n < 2; ++n) gv[bj][n] = *(const f32x4*)(G + col0 + bj * 128 + 4 * n);
#pragma unroll
        for (int ai = 0; ai < 2; ++ai)
#pragma unroll
            for (int m = 0; m < 4; ++m) { const size_t off = (size_t)(row0 + ai * 128 + m * 16) * D + col0;
#pragma unroll
                for (int bj = 0; bj < 2; ++bj) { const f32x4 h0 = *(const f32x4*)(X + off + bj * 128) + acc[ai][bj][m][0], h1 = *(const f32x4*)(X + off + bj * 128 + 4) + acc[ai][bj][m][1];
                    *(f32x4*)(H + off + bj * 128) = h0; *(f32x4*)(H + off + bj * 128 + 4) = h1;
                    *(u32x4*)(V + off + bj * 128) = pack8(h0 * gv[bj][0], h1 * gv[bj][1]); } }
    } };
struct EpiAct { static constexpr bool PERM = true, AFTER_DRAIN = false; const float* LW; const float* LR; bf16_t* ACT; const volatile LAS unsigned* tstart;
    __device__ __forceinline__ void operator()(const f32x4 (&acc)[2][2][4][2], const Unit& u, int wr, int wc, int fr, int fq) const {
        const int e = u.pn >> 1, lrow0 = (u.pm - (int)tstart[e]) * 256 + wr * 64 + fr, row0 = u.pm * 256 + wr * 64 + fr, col = (u.pn & 1) * 128 + wc * 32 + 8 * fq;
        const float* lw = LW + (size_t)e * M + lrow0; const float* lr = LR + (size_t)e * M + lrow0;
#pragma unroll
        for (int ai = 0; ai < 2; ++ai)
#pragma unroll
            for (int m = 0; m < 4; ++m) { const int ro = ai * 128 + m * 16; const float w = lw[ro], rs = lr[ro];
                f32x4 a, b;
#pragma unroll
                for (int i = 0; i < 4; ++i) { const float g0 = rs * acc[ai][0][m][0][i], g1 = rs * acc[ai][0][m][1][i], sw = rs * w;
                    a[i] = g0 * sigmoidf_(g0) * acc[ai][1][m][0][i] * sw; b[i] = g1 * sigmoidf_(g1) * acc[ai][1][m][1][i] * sw; }
                *(u32x4*)(ACT + (size_t)(row0 + ro) * DF + col) = pack8(a, b); }
    } };
struct EpiDown { static constexpr bool PERM = true, AFTER_DRAIN = false; const int* LIST; const unsigned* cnt; bf16_t* MO0; bf16_t* MO1; const volatile LAS unsigned* tstart;
    __device__ __forceinline__ void operator()(const f32x4 (&acc)[2][2][4][2], const Unit& u, int wr, int wc, int fr, int fq) const {
        const int e = u.pn >> 2, lrow0 = (u.pm - (int)tstart[e]) * 256 + wr * 64 + fr, col0 = (u.pn & 3) * 256 + wc * 32 + 8 * fq;
        const int n_e = (int)__hip_atomic_load(cnt + 64 * e, __ATOMIC_RELAXED, __HIP_MEMORY_SCOPE_AGENT); const int* li = LIST + (size_t)e * M;
#pragma unroll
        for (int ai = 0; ai < 2; ++ai)
#pragma unroll
            for (int m = 0; m < 4; ++m) { const int lr = lrow0 + ai * 128 + m * 16;
                if (lr < n_e) { const int info = li[lr]; bf16_t* dst = ((info & 1) ? MO1 : MO0) + (size_t)(info >> 1) * D + col0;
#pragma unroll
                    for (int bj = 0; bj < 2; ++bj) *(u32x4*)(dst + bj * 128) = pack8(acc[ai][bj][m][0], acc[ai][bj][m][1]); } }
    } };
struct EpiPe { static constexpr bool PERM = true, AFTER_DRAIN = false; bf16_t* O;
    __device__ __forceinline__ void operator()(const f32x4 (&acc)[2][2][4][2], const Unit& u, int wr, int wc, int fr, int fq) const {
        const int row0 = u.pm * 256 + wr * 64 + fr, col0 = u.pn * 256 + wc * 32 + 8 * fq;
#pragma unroll
        for (int ai = 0; ai < 2; ++ai)
#pragma unroll
            for (int m = 0; m < 4; ++m) { bf16_t* rowp = O + (size_t)(row0 + ai * 128 + m * 16) * D + col0;
#pragma unroll
                for (int bj = 0; bj < 2; ++bj) *(u32x4*)(rowp + bj * 128) = pack8(acc[ai][bj][m][0], acc[ai][bj][m][1]); }
    } };
struct EpiGate { static constexpr bool PERM = true, AFTER_DRAIN = false; const float* bias; bf16_t* PE;
    __device__ __forceinline__ void operator()(const f32x4 (&acc)[2][2][4][2], const Unit& u, int wr, int wc, int fr, int fq) const {
        const int row0 = u.pm * 256 + wr * 64 + fr, col0 = u.pn * 256 + wc * 32 + 8 * fq;
        u32x4 pe[2][4][2];
#pragma unroll
        for (int ai = 0; ai < 2; ++ai)
#pragma unroll
            for (int m = 0; m < 4; ++m)
#pragma unroll
                for (int bj = 0; bj < 2; ++bj) pe[ai][m][bj] = *(const u32x4*)(PE + (size_t)(row0 + ai * 128 + m * 16) * D + col0 + bj * 128);
#pragma unroll
        for (int bj = 0; bj < 2; ++bj) { const f32x4 b0 = *(const f32x4*)(bias + col0 + bj * 128), b1 = *(const f32x4*)(bias + col0 + bj * 128 + 4);
#pragma unroll
            for (int ai = 0; ai < 2; ++ai)
#pragma unroll
                for (int m = 0; m < 4; ++m) { const u32x4 z = pe[ai][m][bj]; f32x4 a = acc[ai][bj][m][0] + b0, b = acc[ai][bj][m][1] + b1;
                    a[0] = bflo(z.x) * sigmoidf_(a[0]); a[1] = bfhi(z.x) * sigmoidf_(a[1]); a[2] = bflo(z.y) * sigmoidf_(a[2]); a[3] = bfhi(z.y) * sigmoidf_(a[3]);
                    b[0] = bflo(z.z) * sigmoidf_(b[0]); b[1] = bfhi(z.z) * sigmoidf_(b[1]); b[2] = bflo(z.w) * sigmoidf_(b[2]); b[3] = bfhi(z.w) * sigmoidf_(b[3]);
                    *(u32x4*)(PE + (size_t)(row0 + ai * 128 + m * 16) * D + col0 + bj * 128) = pack8(a, b); } }
    } };

struct GroupOrder { int G, c;
    __device__ __forceinline__ bool next(int i, Unit& u) const { const int L = i * G + c; if (L >= NG * 4) return false; u.pm = L; u.pn = L >> 2; u.nv = 256; return true; }
    __device__ __forceinline__ void a_ready(const Unit&) const {}
    __device__ __forceinline__ void done(const Unit&) const {} };
struct PeOrder { int G, c, n2;
    __device__ __forceinline__ bool next(int i, Unit& u) const { if (c < n2) return false; const int L = i * (G - n2) + (c - n2); if (L >= (M / 256) * (D / 256)) return false; u.pm = L >> 2; u.pn = L & 3; u.nv = 256; return true; }
    __device__ __forceinline__ void a_ready(const Unit&) const {}
    __device__ __forceinline__ void done(const Unit&) const {} };
struct WeffOrder { int G, c;
    __device__ __forceinline__ bool next(int i, Unit& u) const { const int L = (G >= 256) ? ((i == 0) ? c - 128 : -1) : i * G + c; if (L < 0 || L >= 8) return false; u.pm = L; u.pn = L >> 2; u.nv = 256; return true; }
    __device__ __forceinline__ void a_ready(const Unit&) const {}
    __device__ __forceinline__ void done(const Unit&) const {} };
struct EpiWeff { static constexpr bool PERM = true, AFTER_DRAIN = false; bf16_t* O;
    __device__ __forceinline__ void operator()(const f32x4 (&acc)[2][2][4][2], const Unit& u, int wr, int wc, int fr, int fq) const {
        const int row0 = (u.pm & 3) * 256 + wr * 64 + fr, col0 = u.pn * 256 + wc * 32 + 8 * fq;
#pragma unroll
        for (int ai = 0; ai < 2; ++ai)
#pragma unroll
            for (int m = 0; m < 4; ++m) { bf16_t* rowp = O + (size_t)(row0 + ai * 128 + m * 16) * D + col0;
#pragma unroll
                for (int bj = 0; bj < 2; ++bj) *(u32x4*)(rowp + bj * 128) = pack8(acc[ai][bj][m][0], acc[ai][bj][m][1]); }
    } };
template <int NSUB> struct ExpertOrder { int G, c; const volatile LAS unsigned* misc;
    __device__ __forceinline__ bool next(int i, Unit& u) const {
        const int L = i * G + c, tp = L / NSUB, sub = L % NSUB; if (tp >= __builtin_amdgcn_readfirstlane((int)misc[MW_TSTART + NEXP])) return false;
        const unsigned ent = (unsigned)__builtin_amdgcn_readfirstlane((int)misc[MW_TL + tp]); const int e = ent & 31u, rt = (ent >> 5) & 127u;
        u.pm = __builtin_amdgcn_readfirstlane((int)misc[MW_TSTART + e]) + rt; u.pn = e * NSUB + sub; u.nv = (int)(ent >> 12); return true; }
    __device__ __forceinline__ void a_ready(const Unit&) const {}
    __device__ __forceinline__ void done(const Unit&) const {} };

__device__ __forceinline__ void carry_unit(Frame& F, int unit) {
    const int d = unit & 1, g = (unit >> 1) & 31, b = unit >> 6, n = opq(hw_lane()), s = F.wave;
    const float* lt = (const float*)(F.ws + WS_LAMT) + ((g * 2 + d) * 64 + n) * 4;
    const float l16r = lt[0], l16i = lt[1], lkr = lt[2], lki = lt[3];
    const float* SL = (const float*)(F.ws + WS_SLOC) + (size_t)(g * NCH + b * 512) * 256 + d * 128 + n;
    bf16* AS = (bf16*)(F.ws + WS_AS) + (size_t)(g * NCH + b * 512) * 512 + 256 + d * 128 + n;
    LAS float* segE = (LAS float*)(F.lds + RING_OFF);
    float er = 0.f, ei = 0.f;
    for (int i0 = 0; i0 < 64; i0 += 16) {
        float sr[16], si[16];
#pragma unroll
        for (int ii = 0; ii < 16; ++ii) { const int i = s * 64 + i0 + ii, c = d ? (511 - i) : i; sr[ii] = SL[(size_t)c * 256]; si[ii] = SL[(size_t)c * 256 + 64]; }
#pragma unroll
        for (int ii = 0; ii < 16; ++ii) { const float tr = l16r * er - l16i * ei + sr[ii], ti = l16r * ei + l16i * er + si[ii]; er = tr; ei = ti; }
    }
    __syncthreads();
    segE[(s * 64 + n) * 2] = er; segE[(s * 64 + n) * 2 + 1] = ei;
    __syncthreads();
    float xr = 0.f, xi = 0.f;
    for (int sp = 0; sp < s; ++sp) { const float pr = segE[(sp * 64 + n) * 2], pi = segE[(sp * 64 + n) * 2 + 1];
        const float tr = lkr * xr - lki * xi + pr, ti = lkr * xi + lki * xr + pi; xr = tr; xi = ti; }
    for (int i0 = 0; i0 < 64; i0 += 16) {
        float sr[16], si[16];
#pragma unroll
        for (int ii = 0; ii < 16; ++ii) { const int i = s * 64 + i0 + ii, c = d ? (511 - i) : i; sr[ii] = SL[(size_t)c * 256]; si[ii] = SL[(size_t)c * 256 + 64]; }
#pragma unroll
        for (int ii = 0; ii < 16; ++ii) { const int i = s * 64 + i0 + ii, c = d ? (511 - i) : i;
            AS[(size_t)c * 512] = (bf16)f2bf(xr); AS[(size_t)c * 512 + 64] = (bf16)f2bf(xi);
            const float tr = l16r * xr - l16i * xi + sr[ii], ti = l16r * xi + l16i * xr + si[ii]; xr = tr; xi = ti; }
    }
    __syncthreads();
}
__device__ __forceinline__ void diff_row(Frame& F, int m) {
    const int t = m & (SEQ - 1), lane = opq(hw_lane()), h = 1 << (lane >> 4), lo = max(t - h, 0), hi = min(t + h, SEQ);
    const bf16* ZP = (const bf16*)(F.ws + WS_ZP) + (size_t)(m - t) * DP + lane * 8;
    float acc[8];
#pragma unroll
    for (int i = 0; i < 8; ++i) acc[i] = 0.f;
    v4u zt = (v4u){0u, 0u, 0u, 0u};
    v4u zz[16];
#pragma unroll
    for (int k = 0; k < 16; ++k) { const int s = t - 8 + k, sc = (s >= lo && s < hi) ? s : t; zz[k] = *(const GAS v4u*)(ZP + (size_t)sc * DP); }
#pragma unroll
    for (int k = 0; k < 16; ++k) { const int s = t - 8 + k; const float f = (s >= lo && s < hi) ? 1.f : 0.f; const v4u z = zz[k];
        acc[0] += f * bflo(z.x); acc[1] += f * bfhi(z.x); acc[2] += f * bflo(z.y); acc[3] += f * bfhi(z.y); acc[4] += f * bflo(z.z); acc[5] += f * bfhi(z.z); acc[6] += f * bflo(z.w); acc[7] += f * bfhi(z.w);
        if (k == 8) zt = z; }
    const float inv = 1.0f / (float)(hi - lo);
    v4u o; o.x = pk2(acc[0] * inv - bflo(zt.x), acc[1] * inv - bfhi(zt.x)); o.y = pk2(acc[2] * inv - bflo(zt.y), acc[3] * inv - bfhi(zt.y));
    o.z = pk2(acc[4] * inv - bflo(zt.z), acc[5] * inv - bfhi(zt.z)); o.w = pk2(acc[6] * inv - bflo(zt.w), acc[7] * inv - bfhi(zt.w));
    *(GAS v4u*)((bf16*)(F.ws + WS_CAT) + (size_t)m * D + lane * 8) = o;
#if MK_STAGE == 1
    *(GAS v4u*)((bf16*)(F.ws + WS_CAT) + (size_t)m * D + DP + lane * 8) = (v4u){0u, 0u, 0u, 0u};
#endif
}
__device__ __forceinline__ void route_phase(Frame& F, const Args& A) {
    typedef short s8v __attribute__((ext_vector_type(8)));
    const int lane = opq(hw_lane()), tok = lane & 15, kq = lane >> 4, w = F.wave, t = w * 64 + lane;
    s8v ah[4][3], al[4][3];
    { const bf16* wh = (const bf16*)(F.ws + WS_WR) + (size_t)tok * D + 128 * w + 8 * kq; const bf16* wl = wh + 48 * D;
#pragma unroll
      for (int sk = 0; sk < 4; ++sk)
#pragma unroll
          for (int q = 0; q < 3; ++q) { ah[sk][q] = *(const GAS s8v*)(wh + (size_t)q * 16 * D + 32 * sk); al[sk][q] = *(const GAS s8v*)(wl + (size_t)q * 16 * D + 32 * sk); } }
    LAS float* P = (LAS float*)(F.lds + RING_OFF);
    LAS float* R = P + 8 * 64 * 52;
    const int cid = (int)blockIdx.x, nit = M / 16;
    for (int b0 = cid; b0 < nit; b0 += 4 * F.G) {
        f32x4 acc[4][3];
        float ssq[4];
        f32x4 hc[4][2], hn[4][2];
        { const float* hrow = F.out + (size_t)(b0 * 16 + tok) * D + 128 * w + 8 * kq;
#pragma unroll
          for (int sk = 0; sk < 4; ++sk) { hc[sk][0] = *(const GAS f32x4*)(hrow + 32 * sk); hc[sk][1] = *(const GAS f32x4*)(hrow + 32 * sk + 4); } }
#pragma unroll
        for (int j = 0; j < 4; ++j) {
            const int itn = b0 + (j + 1) * F.G;
            if (j < 3 && itn < nit) { const float* hrow = F.out + (size_t)(itn * 16 + tok) * D + 128 * w + 8 * kq;
#pragma unroll
                for (int sk = 0; sk < 4; ++sk) { hn[sk][0] = *(const GAS f32x4*)(hrow + 32 * sk); hn[sk][1] = *(const GAS f32x4*)(hrow + 32 * sk + 4); } }
            acc[j][0] = (f32x4){0.f, 0.f, 0.f, 0.f}; acc[j][1] = acc[j][0]; acc[j][2] = acc[j][0]; ssq[j] = 0.f;
            if (b0 + j * F.G < nit) {
#pragma unroll
                for (int sk = 0; sk < 4; ++sk) {
                    const f32x4 h0 = hc[sk][0], h1 = hc[sk][1];
                    ssq[j] += (h0.x * h0.x + h0.y * h0.y) + (h0.z * h0.z + h0.w * h0.w) + (h1.x * h1.x + h1.y * h1.y) + (h1.z * h1.z + h1.w * h1.w);
                    const float hv[8] = {h0.x, h0.y, h0.z, h0.w, h1.x, h1.y, h1.z, h1.w};
                    s8v bh, bl;
#pragma unroll
                    for (int e8 = 0; e8 < 8; ++e8) { const unsigned hb = f2bf(hv[e8]); bh[e8] = (short)hb; bl[e8] = (short)f2bf(hv[e8] - __builtin_bit_cast(float, hb << 16)); }
#pragma unroll
                    for (int q = 0; q < 3; ++q) {
                        acc[j][q] = __builtin_amdgcn_mfma_f32_16x16x32_bf16(ah[sk][q], bh, acc[j][q], 0, 0, 0);
                        acc[j][q] = __builtin_amdgcn_mfma_f32_16x16x32_bf16(ah[sk][q], bl, acc[j][q], 0, 0, 0);
                        acc[j][q] = __builtin_amdgcn_mfma_f32_16x16x32_bf16(al[sk][q], bh, acc[j][q], 0, 0, 0);
                    }
                }
            }
#pragma unroll
            for (int sk = 0; sk < 4; ++sk) { hc[sk][0] = hn[sk][0]; hc[sk][1] = hn[sk][1]; }
        }
#pragma unroll
        for (int j = 0; j < 4; ++j) { LAS float* Pw = P + (w * 64 + j * 16 + tok) * 52;
#pragma unroll
            for (int q = 0; q < 3; ++q)
#pragma unroll
                for (int r = 0; r < 4; ++r) Pw[16 * q + 4 * kq + r] = acc[j][q][r];
            Pw[48 + kq] = ssq[j]; }
        __syncthreads();
        { const int t2 = opq(w * 64 + hw_lane());
#pragma unroll
          for (int i7 = 0; i7 < 7; ++i7) { const int idx = t2 + 512 * i7;
            if (idx < 64 * 52) { float sum = 0.f;
#pragma unroll
                for (int ww = 0; ww < 8; ++ww) sum += P[ww * (64 * 52) + idx];
                R[idx] = sum; } } }
        __syncthreads();
        if (w == 0) {
            const int ln = opq(hw_lane());
            const bool act = b0 + (ln >> 4) * F.G < nit;
            LAS unsigned* HI = (LAS unsigned*)F.MISC + MW_HIST; LAS unsigned* BA = (LAS unsigned*)F.MISC + MW_BASE;
            if (ln < NEXP) HI[ln] = 0u;
            const LAS float* tr = R + ln * 52; const int m = (b0 + (ln >> 4) * F.G) * 16 + (ln & 15);
            const float rstd = 1.f / sqrtf(((tr[48] + tr[49]) + (tr[50] + tr[51])) * (1.f / D) + RMS_EPS);
            float gl[4];
#pragma unroll
            for (int k = 0; k < 4; ++k) gl[k] = rstd * tr[k] + A.in[19][k];
            int gsel = 0; float gmax = gl[0];
#pragma unroll
            for (int k = 1; k < 4; ++k) if (gl[k] > gmax) { gmax = gl[k]; gsel = k; }
            float gden = 0.f;
#pragma unroll
            for (int k = 0; k < 4; ++k) gden += __expf(gl[k] - gmax);
            const float grp_p = 1.0f / gden;
            float el[8];
#pragma unroll
            for (int e = 0; e < 8; ++e) el[e] = rstd * tr[4 + gsel * 8 + e] + A.in[21][gsel * 8 + e];
            int i1 = 0; float m1 = el[0];
#pragma unroll
            for (int e = 1; e < 8; ++e) if (el[e] > m1) { m1 = el[e]; i1 = e; }
            int i2 = -1; float m2 = -3.0e38f;
#pragma unroll
            for (int e = 0; e < 8; ++e) if (e != i1 && el[e] > m2) { m2 = el[e]; i2 = e; }
            const float rr = __expf(m2 - m1), w1 = grp_p / (1.0f + rr), w2 = grp_p * rr / (1.0f + rr);
            const int e1 = gsel * 8 + i1, e2 = gsel * 8 + i2;
            unsigned r1 = 0u, r2 = 0u;
            if (act) { r1 = __hip_atomic_fetch_add(HI + e1, 1u, __ATOMIC_RELAXED, __HIP_MEMORY_SCOPE_WORKGROUP); r2 = __hip_atomic_fetch_add(HI + e2, 1u, __ATOMIC_RELAXED, __HIP_MEMORY_SCOPE_WORKGROUP); }
            LDS_WAIT(); asm volatile("" ::: "memory");
            if (ln < NEXP) { const unsigned hc_ = HI[ln]; BA[ln] = hc_ ? __hip_atomic_fetch_add((unsigned*)(F.ctl + CW_CNT) + 64 * ln, hc_, RLX_AGENT) : 0u; }
            LDS_WAIT(); asm volatile("" ::: "memory");
            if (act) { const unsigned p1 = BA[e1] + r1, p2 = BA[e2] + r2;
                int* LI = (int*)(F.ws + WS_LIST); float* LW = (float*)(F.ws + WS_LISTW); float* LR = (float*)(F.ws + WS_LISTR);
                LI[(size_t)e1 * M + p1] = 2 * m; LW[(size_t)e1 * M + p1] = w1; LR[(size_t)e1 * M + p1] = rstd;
                LI[(size_t)e2 * M + p2] = 2 * m + 1; LW[(size_t)e2 * M + p2] = w2; LR[(size_t)e2 * M + p2] = rstd; }
        }
        __syncthreads();
    }
}
template <class Sched> __device__ __forceinline__ void expert_setup(Frame& F, const Sched& S) {
    const int t = opq(F.wave * 64 + hw_lane());
    if (t < NEXP) F.MISC[MW_CNT + t] = __hip_atomic_load((unsigned*)(F.ctl + CW_CNT) + 64 * t, RLX_AGENT);
    __syncthreads();
    if (t < NEXP) {
        unsigned ts = 0u, nfull_before = 0u, nfull = 0u, rank = 0u; const unsigned n_me = F.MISC[MW_CNT + t], nv_me = n_me & 255u;
        for (int e = 0; e < NEXP; ++e) { const unsigned n = F.MISC[MW_CNT + e], nv = n & 255u;
            if (e < t) { ts += (n + 255u) >> 8; nfull_before += n >> 8; }
            nfull += n >> 8;
            if (nv > nv_me || (nv == nv_me && e < t)) rank += (nv > 0u) ? 1u : 0u; }
        F.MISC[MW_TSTART + t] = ts;
        if (t == NEXP - 1) F.MISC[MW_TSTART + NEXP] = ts + ((n_me + 255u) >> 8);
        for (unsigned rt = 0; rt < (n_me >> 8); ++rt) F.MISC[MW_TL + nfull_before + rt] = (unsigned)t | (rt << 5) | (256u << 12);
        if (nv_me > 0u) F.MISC[MW_TL + nfull + rank] = (unsigned)t | ((n_me >> 8) << 5) | (nv_me << 12);
    }
    __syncthreads();
    LAS unsigned* ro = (LAS unsigned*)(F.lds + ROWOFF_OFF);
    for (int i = 0; i < 4; ++i) { Unit u; if (!S.next(i, u)) break;
        const int e = u.pn >> 1, idx = ((int)u.pm - (int)F.MISC[MW_TSTART + e]) * 256 + (t & 255), n_e = (int)F.MISC[MW_CNT + e];
        if (t < 256) ro[i * 256 + t] = (idx < n_e) ? (unsigned)(((const int*)(F.ws + WS_LIST))[(size_t)e * M + idx] >> 1) * (unsigned)(D * 2) : 0u; }
    __syncthreads();
}
template <int R> __device__ __forceinline__ void moe_combine_rows(Frame& F, const Args& A, int m0, int stride) {
    const int lane = opq(hw_lane());
    const GAS f32x4* gr = (const GAS f32x4*)A.in[25] + lane;
    f32x4 v[R][4]; v2u a[R][4], b[R][4];
#pragma unroll
    for (int r = 0; r < R; ++r) { const size_t m = (size_t)(m0 + r * stride);
#pragma unroll
        for (int j = 0; j < 4; ++j) { v[r][j] = *((const GAS f32x4*)(F.out + m * D) + lane + 64 * j);
            a[r][j] = *((const GAS v2u*)((const bf16*)(F.ws + WS_MO0) + m * D) + lane + 64 * j); b[r][j] = *((const GAS v2u*)((const bf16*)(F.ws + WS_MO1) + m * D) + lane + 64 * j); } }
#pragma unroll
    for (int r = 0; r < R; ++r) { const size_t m = (size_t)(m0 + r * stride); float s = 0.f;
        GAS f32x4* hr = (GAS f32x4*)(F.out + m * D) + lane; GAS unsigned long long* o8 = (GAS unsigned long long*)((bf16*)(F.ws + WS_XN) + m * D) + lane;
#pragma unroll
        for (int j = 0; j < 4; ++j) { f32x4& x = v[r][j];
            x.x += bflo(a[r][j].x) + bflo(b[r][j].x); x.y += bfhi(a[r][j].x) + bfhi(b[r][j].x); x.z += bflo(a[r][j].y) + bflo(b[r][j].y); x.w += bfhi(a[r][j].y) + bfhi(b[r][j].y);
            hr[64 * j] = x; s += (x.x * x.x + x.y * x.y) + (x.z * x.z + x.w * x.w); }
        const float rstd = 1.f / sqrtf(wave_sum(s) * (1.f / D) + RMS_EPS);
#pragma unroll
        for (int j = 0; j < 4; ++j) { const f32x4 gg = gr[64 * j], x = v[r][j];
            o8[64 * j] = (unsigned long long)pk2(x.x * rstd * gg.x, x.y * rstd * gg.y) | ((unsigned long long)pk2(x.z * rstd * gg.z, x.w * rstd * gg.w) << 32); } }
}
template <int R, bool ADDG> __device__ __forceinline__ void final_rows(Frame& F, const Args& A, int m0, int stride) {
    const int lane = opq(hw_lane());
    const GAS f32x4* gr = (const GAS f32x4*)A.in[29] + lane;
    f32x4 v[R][4]; v2u gg[R][4];
#pragma unroll
    for (int r = 0; r < R; ++r) { const size_t m = (size_t)(m0 + r * stride);
#pragma unroll
        for (int j = 0; j < 4; ++j) { v[r][j] = *((const GAS f32x4*)(F.out + m * D) + lane + 64 * j);
            if (ADDG) gg[r][j] = *((const GAS v2u*)((const bf16*)(F.ws + WS_PE) + m * D) + lane + 64 * j); } }
#pragma unroll
    for (int r = 0; r < R; ++r) { const size_t m = (size_t)(m0 + r * stride); float s = 0.f;
        GAS f32x4* hr = (GAS f32x4*)(F.out + m * D) + lane;
#pragma unroll
        for (int j = 0; j < 4; ++j) { f32x4& x = v[r][j];
            if (ADDG) { x.x += bflo(gg[r][j].x); x.y += bfhi(gg[r][j].x); x.z += bflo(gg[r][j].y); x.w += bfhi(gg[r][j].y); }
            s += (x.x * x.x + x.y * x.y) + (x.z * x.z + x.w * x.w); }
        const float rstd = 1.f / sqrtf(wave_sum(s) * (1.f / D) + RMS_EPS);
#pragma unroll
        for (int j = 0; j < 4; ++j) hr[64 * j] = v[r][j] * rstd * gr[64 * j]; }
}

__global__ void __launch_bounds__(NWAVES * 64, 2) mk_fwd(Args args) {
    extern __shared__ __attribute__((aligned(16))) unsigned char lds[];
    Frame F;
    F.lds = (LAS unsigned char*)lds;
    F.MISC = (volatile LAS unsigned*)(F.lds + MISC_OFF);
    F.wave = __builtin_amdgcn_readfirstlane(threadIdx.x >> 6);
    F.G = gridDim.x; F.gw = blockIdx.x * NWAVES + F.wave; F.ngw = F.G * NWAVES;
    F.out = args.out; F.ws = args.ws; F.ctl = (gu32*)(args.ws + WS_CTL);
    for (int u = threadIdx.x; u < (LDS_BYTES - LDSCTL_OFF) / 4; u += NWAVES * 64) ((LAS unsigned*)(F.lds + LDSCTL_OFF))[u] = 0u;
    __syncthreads();
    XcdBarrier bar = xcd_barrier_post((unsigned*)(F.ctl + CW_BAR), F.MISC + 8); bar.wave = F.wave;
#define GRID_BAR() xcd_barrier(bar)
    bf16* const WIN = (bf16*)(F.ws + WS_WIN); bf16* const GLU = (bf16*)(F.ws + WS_GLU); bf16* const WCAT = (bf16*)(F.ws + WS_WCAT); bf16* const WG = (bf16*)(F.ws + WS_WG); bf16* const WPLE = (bf16*)(F.ws + WS_WPLE);
    bf16* const WGU = (bf16*)(F.ws + WS_WGU); bf16* const WD = (bf16*)(F.ws + WS_WD); bf16* const MS = (bf16*)(F.ws + WS_MS); bf16* const WS3 = (bf16*)(F.ws + WS_WS3);
    bf16* const XN = (bf16*)(F.ws + WS_XN); bf16* const ZP = (bf16*)(F.ws + WS_ZP); bf16* const AS = (bf16*)(F.ws + WS_AS); float* const SLOC = (float*)(F.ws + WS_SLOC);
    bf16* const CAT = (bf16*)(F.ws + WS_CAT); bf16* const ZZ = (bf16*)(F.ws + WS_ZZ); bf16* const PB = (bf16*)(F.ws + WS_PB); bf16* const PE = (bf16*)(F.ws + WS_PE);
    bf16* const ACT = (bf16*)(F.ws + WS_ACT); bf16* const MO0 = (bf16*)(F.ws + WS_MO0); bf16* const MO1 = (bf16*)(F.ws + WS_MO1);
    const int cid = (int)blockIdx.x;

#ifndef MK_REP
#define MK_REP -1
#endif
#define REP(k) for (int rep_ = 0; rep_ < ((MK_REP == (k)) ? 2 : 1); ++rep_)
    REP(0) { p0_prologue(F, args);
    GRID_BAR(); }
    REP(1) { pg8::Gemm g{XN, WIN, D, D, D}; pg8::StaticOrder S; S.init(M, D, F.G, cid); EpiZ E{ZP, AS};
      pg8::gemm_phase<EpiZ, pg8::StaticOrder, true, true>(F.lds + RING_OFF, g, S, E, F.wave);
    GRID_BAR(); }
#if MK_STAGE >= 2
    { pg8::Gemm g{AS, MS, 256, 512, 256}; GroupOrder S{F.G, cid}; EpiSloc E{SLOC};
      pg8::gemm_phase<EpiSloc, GroupOrder, true, true>(F.lds + RING_OFF, g, S, E, F.wave); }
    { pg8::Gemm g{(const bf16*)(F.ws + WS_WOS), (const bf16*)(F.ws + WS_BD), 256, 256, 256}; WeffOrder S{F.G, cid}; EpiWeff E{WCAT};
      pg8::gemm_phase<EpiWeff, WeffOrder, true, true>(F.lds + RING_OFF, g, S, E, F.wave); }
    bg_range(F, args, 1400, 2000, 0, 0);
    GRID_BAR();
#endif
    REP(3) {
#if MK_STAGE >= 2
        if (F.G >= 256) { if (cid < 128) { carry_unit(F, cid); for (int m = 12288 + cid * NWAVES + F.wave; m < M; m += 128 * NWAVES) diff_row(F, m); }
                          else for (int m = (cid - 128) * NWAVES + F.wave; m < 12288; m += (F.G - 128) * NWAVES) diff_row(F, m); }
        else { for (int u = cid; u < 128; u += F.G) carry_unit(F, u); for (int m = F.gw; m < M; m += F.ngw) diff_row(F, m); }
#else
        for (int m = F.gw; m < M; m += F.ngw) diff_row(F, m);
#endif
    GRID_BAR(); }
#if MK_STAGE >= 2
    { pg8::Gemm g{AS, WS3, 512, 512, 512}; GroupOrder S{F.G, cid}; EpiY E{ZZ};
      pg8::gemm_phase<EpiY, GroupOrder, true, true>(F.lds + RING_OFF, g, S, E, F.wave); }
    bg_range(F, args, 2000, 5000, 0, M / 2);
    GRID_BAR();
    { pg8::Gemm g{ZZ, GLU, DP, DP, DP}; pg8::StaticOrder S; S.init(M, DP, F.G, cid); EpiGlu E{ZZ, args.in[15], CAT};
      pg8::gemm_phase<EpiGlu, pg8::StaticOrder, true, true>(F.lds + RING_OFF, g, S, E, F.wave); }
    bg_range(F, args, 5000, BG_TOTAL, M / 2, M);
    GRID_BAR();
#endif
    { pg8::Gemm g{CAT, WCAT, D, D, D}; pg8::StaticOrder S; S.init(M, D, F.G, cid); EpiRes E{args.in[0], F.out, args.in[17], XN};
      pg8::gemm_phase<EpiRes, pg8::StaticOrder, true, true>(F.lds + RING_OFF, g, S, E, F.wave); }
    GRID_BAR();
#if MK_STAGE >= 3
    route_phase(F, args);
    bg_range(F, args, 0, 1400, 0, 0, true);
    GRID_BAR();
    { pg8::Gemm g{XN, WGU, D, D, D}; ExpertOrder<2> S{F.G, cid, F.MISC}; expert_setup(F, S);
      EpiAct E{(const float*)(F.ws + WS_LISTW), (const float*)(F.ws + WS_LISTR), ACT, F.MISC + 16};
      pg8::gemm_phase<EpiAct, ExpertOrder<2>, true, true, true, true>(F.lds + RING_OFF, g, S, E, F.wave, (const LAS unsigned*)(F.lds + ROWOFF_OFF)); }
#if MK_STAGE >= 4
    { const int nun = 2 * __builtin_amdgcn_readfirstlane((int)F.MISC[MW_TSTART + NEXP]), n2 = (nun > F.G && nun < 2 * F.G) ? nun - F.G : 0;
      pg8::Gemm g{PB, WPLE, DPLE, DPLE, DPLE}; PeOrder S{F.G, cid, n2}; EpiPe E{PE};
      pg8::gemm_phase<EpiPe, PeOrder, true, true>(F.lds + RING_OFF, g, S, E, F.wave); }
#endif
    GRID_BAR();
    { pg8::Gemm g{ACT, WD, DF, DF, DF}; ExpertOrder<4> S{F.G, cid, F.MISC}; EpiDown E{(const int*)(F.ws + WS_LIST), (const unsigned*)(F.ctl + CW_CNT), MO0, MO1, F.MISC + 16};
      pg8::gemm_phase<EpiDown, ExpertOrder<4>, true, true, false, true>(F.lds + RING_OFF, g, S, E, F.wave); }
    GRID_BAR();
    for (int m = F.gw; m + F.ngw < M; m += 2 * F.ngw) moe_combine_rows<2>(F, args, m, F.ngw);
    GRID_BAR();
#endif
#if MK_STAGE >= 4
    { pg8::Gemm g{XN, WG, D, D, D}; pg8::StaticOrder S; S.init(M, D, F.G, cid); EpiGate E{args.in[27], PE};
      pg8::gemm_phase<EpiGate, pg8::StaticOrder, true, true>(F.lds + RING_OFF, g, S, E, F.wave); }
    GRID_BAR();
#endif
    for (int m = F.gw; m + 3 * F.ngw < M; m += 4 * F.ngw) final_rows<4, (MK_STAGE >= 4)>(F, args, m, F.ngw);
}

extern "C" void kernel_launch(void* const* d_in, const int* in_sizes, int n_in, void* d_out, int out_size, void* d_ws, size_t ws_size, hipStream_t stream) {
    static int grid = 0;
    if (grid == 0) {
        if (n_in != 30 || in_sizes[0] != M * D || out_size != M * D || ws_size < WS_END) { fprintf(stderr, "kernel_launch: unexpected shapes (n_in %d, in0 %d, out %d, ws %zu)\n", n_in, n_in > 0 ? in_sizes[0] : -1, out_size, ws_size); grid = -1; return; }
        int dev = 0, cus = 0, per_cu = 0;
        if (hipGetDevice(&dev) != hipSuccess || hipDeviceGetAttribute(&cus, hipDeviceAttributeMultiprocessorCount, dev) != hipSuccess) { grid = -1; return; }
        if (hipFuncSetAttribute((const void*)mk_fwd, hipFuncAttributeMaxDynamicSharedMemorySize, LDS_BYTES) != hipSuccess) { fprintf(stderr, "kernel_launch: hipFuncSetAttribute failed\n"); grid = -1; return; }
        if (hipOccupancyMaxActiveBlocksPerMultiprocessor(&per_cu, (const void*)mk_fwd, NWAVES * 64, LDS_BYTES) != hipSuccess || per_cu < 1) { fprintf(stderr, "kernel_launch: occupancy query reports %d blocks per CU\n", per_cu); }
        (void)hipGetLastError();
        grid = cus;
    }
    if (grid < 0) return;
    (void)hipMemsetAsync((char*)d_ws + WS_CTL, 0, CTL_ZERO_BYTES, stream);
    Args a{};
    for (int i = 0; i < 30; ++i) a.in[i] = (const float*)d_in[i];
    a.out = (float*)d_out; a.ws = (unsigned char*)d_ws;
    hipLaunchKernelGGL(mk_fwd, dim3(grid), dim3(NWAVES * 64), LDS_BYTES, stream, a);
}
```

```cpp
#include <hip/hip_runtime.h>
#include <cstdio>
#include <cstdint>
__device__ __forceinline__ int hw_lane() { int l; asm volatile("v_mbcnt_lo_u32_b32 %0, -1, 0\n\tv_mbcnt_hi_u32_b32 %0, -1, %0" : "=v"(l)); return l; }
namespace pg8 {
#define PG8_LAS __attribute__((address_space(3)))
typedef unsigned short bf16_t;
typedef short bf16x8 __attribute__((ext_vector_type(8)));
typedef float f32x4 __attribute__((ext_vector_type(4)));
typedef unsigned u32x4 __attribute__((ext_vector_type(4)));
constexpr int BM = 256, BK = 64, HALF = 128, HTB = HALF * BK * 2  , STAGE_BYTES = 8 * HTB, NXCD = 8, WGM = 8;

__host__ __device__ __forceinline__ int lds_byte(int r, int c) { const int st = (r >> 4) * 2 + (c >> 5), rr = r & 15, cc = c & 31, ob = rr * 64 + cc * 2; return st * 1024 + (ob ^ (((ob >> 9) & 1) << 5)); }
__host__ __device__ __forceinline__ void stage_rc(int b, int& R, int& C) { const int st = b / 1024, sb = b % 1024, swz = sb ^ (((sb >> 9) & 1) << 5); R = (st >> 1) * 16 + swz / 64; C = (st & 1) * 32 + (swz % 64) / 2; }
__host__ __device__ __forceinline__ int perm32(int rho) { const int n = rho >> 4, i = rho & 15; return 8 * (i >> 2) + 4 * n + (i & 3); }

struct Unit { int pm, pn, nv; };
struct Gemm { const bf16_t* A; const bf16_t* Bt; int K, lda, ldb; };

struct StaticOrder {
    int nM, nN, nwg, G, c;
    __host__ __device__ void init(int M, int N, int G_, int c_) { nM = M / BM; nN = N / BM; nwg = nM * nN; G = G_; c = c_; }
    __host__ __device__ bool next(int i, Unit& u) const {
        const long L = (long)i * G + c; if (L >= nwg) return false;
        int wgid = (int)L; { const int q = nwg / NXCD, r = nwg % NXCD, xcd = wgid % NXCD, off = wgid / NXCD; wgid = (xcd < r ? xcd * (q + 1) : r * (q + 1) + (xcd - r) * q) + off; }
        const int nig = WGM * nN, gid = wgid / nig, fm = gid * WGM, gsz = (nM - fm) < WGM ? (nM - fm) : WGM;
        u.pm = fm + ((wgid % nig) % gsz); u.pn = (wgid % nig) / gsz; u.nv = 256; return true;
    }
    __device__ __forceinline__ void a_ready(const Unit&) const {}
    __device__ __forceinline__ void done(const Unit&) const {}
};

template <class Epi, class Sched, bool ALIGN_EPI = false, bool SP2 = false, bool GATHER = false, bool SKIP = false>
__device__ __forceinline__ void gemm_phase(PG8_LAS unsigned char* lds, const Gemm g, const Sched& S, const Epi& E, const int wid  , const PG8_LAS unsigned* rowoff = nullptr) {
    static_assert(!GATHER || SP2, "GATHER is written for the SP2 loop");
    int lane_ = hw_lane(); asm volatile("" : "+v"(lane_));
    const int lane = lane_, tid = wid * 64 + lane, wr = wid >> 2, wc = wid & 3, fr = lane & 15, fq = lane >> 4;
    const int K = g.K, nt = K / BK;
    unsigned voffA[2], voffB[2];
#pragma unroll
    for (int i = 0; i < 2; ++i) { int R, C; stage_rc(tid * 16 + i * 8192, R, C); const int Rb = Epi::PERM ? ((R & ~31) + perm32(R & 31)) : R;
        voffA[i] = (unsigned)(R * g.lda + C) * 2u; voffB[i] = (unsigned)(Rb * g.ldb + C) * 2u; }
    const size_t kstep = (size_t)(BK * 2);
    const size_t hstepA = GATHER ? (size_t)0 : (size_t)HALF * g.lda * 2, hstepB = (size_t)HALF * g.ldb * 2;
    const size_t tstepA = 2 * hstepA, tstepB = 2 * hstepB;
    const unsigned ldsw = (unsigned)wid * 1024u;
    const int aoff = lds_byte(wr * 64 + fr, fq * 8), boff = lds_byte(wc * 32 + fr, fq * 8);
    unsigned cvo[2][2];
#define PG8_LOADVO(dst, u_) do { _Pragma("unroll") for (int _h = 0; _h < 2; ++_h) _Pragma("unroll") for (int _i = 0; _i < 2; ++_i) { int R_, C_; stage_rc(tid * 16 + _i * 8192, R_, C_); \
        dst[_h][_i] = rowoff[(u_) * 256 + _h * 128 + R_] + (unsigned)C_ * 2u; } } while (0)
#define PG8_VA(h) (GATHER ? cvo[h] : voffA)
#define PG8_SA(b, h) (((b) * 2 + (h)) * HTB)
#define PG8_SB(b, h) ((4 + (b) * 2 + (h)) * HTB)
#define PG8_STAGE(bufoff, gbase, voff) do { _Pragma("unroll") for (int _i = 0; _i < 2; ++_i) \
        __builtin_amdgcn_global_load_lds((const unsigned*)((const char*)(gbase) + (voff)[_i]), (PG8_LAS unsigned*)(lds + (bufoff) + ldsw + _i * 8192), 16, 0, 0); } while (0)
#define PG8_LDA(dst, b, h) do { _Pragma("unroll") for (int m = 0; m < 4; ++m) _Pragma("unroll") for (int k = 0; k < 2; ++k) dst[m][k] = *(const PG8_LAS bf16x8*)(lds + PG8_SA(b, h) + aoff + m * 2048 + k * 1024); } while (0)
#define PG8_LDB(dst, b, h) do { _Pragma("unroll") for (int n = 0; n < 2; ++n) _Pragma("unroll") for (int k = 0; k < 2; ++k) dst[n][k] = *(const PG8_LAS bf16x8*)(lds + PG8_SB(b, h) + boff + n * 2048 + k * 1024); } while (0)
#define PG8_MMA(ai, bj, At, Bt) do { if (SKIP && (ai) * HALF + wr * 64 >= cur.nv) break; __builtin_amdgcn_s_setprio(1); _Pragma("unroll") for (int m = 0; m < 4; ++m) _Pragma("unroll") for (int n = 0; n < 2; ++n) _Pragma("unroll") for (int k = 0; k < 2; ++k) \
        acc[ai][bj][m][n] = __builtin_amdgcn_mfma_f32_16x16x32_bf16(Bt[n][k], At[m][k], acc[ai][bj][m][n], 0, 0, 0); __builtin_amdgcn_s_setprio(0); } while (0)
#define PG8_WAIT_V(n) asm volatile("s_waitcnt vmcnt(" #n ")" ::: "memory")
#define PG8_WAIT_L(n) asm volatile("s_waitcnt lgkmcnt(" #n ")" ::: "memory")
#define PG8_BAR __builtin_amdgcn_s_barrier()
#define PG8_SCHED __builtin_amdgcn_sched_barrier(0)
    Unit cur, nxt; int ui = 0;
    if (!S.next(0, cur)) return;
    f32x4 acc[2][2][4][2];
#pragma unroll
    for (int a = 0; a < 2; ++a)
#pragma unroll
        for (int b = 0; b < 2; ++b)
#pragma unroll
            for (int m = 0; m < 4; ++m)
#pragma unroll
                for (int n = 0; n < 2; ++n) acc[a][b][m][n] = (f32x4){0.f, 0.f, 0.f, 0.f};
    bf16x8 At[4][2], B0[2][2], B1[2][2];
    const char* cA = (const char*)g.A + (size_t)cur.pm * tstepA; const char* cB = (const char*)g.Bt + (size_t)cur.pn * tstepB;
    S.a_ready(cur);
    if constexpr (GATHER) PG8_LOADVO(cvo, 0);
    if constexpr (SP2) {
        PG8_STAGE(PG8_SB(0, 0), cB, voffB); PG8_STAGE(PG8_SB(0, 1), cB + hstepB, voffB); PG8_STAGE(PG8_SA(0, 0), cA, PG8_VA(0)); PG8_STAGE(PG8_SA(0, 1), cA + hstepA, PG8_VA(1));
        if (wr == 1) PG8_BAR;
        PG8_WAIT_V(2); PG8_BAR;
        PG8_STAGE(PG8_SB(1, 0), cB + kstep, voffB); PG8_STAGE(PG8_SA(1, 0), cA + kstep, PG8_VA(0)); PG8_STAGE(PG8_SB(1, 1), cB + hstepB + kstep, voffB);
        PG8_WAIT_V(6); PG8_BAR;
    } else {
        PG8_STAGE(PG8_SB(0, 0), cB, voffB); PG8_STAGE(PG8_SA(0, 0), cA, voffA); PG8_STAGE(PG8_SB(0, 1), cB + hstepB, voffB); PG8_STAGE(PG8_SA(0, 1), cA + hstepA, voffA);
        if (wr == 1) PG8_BAR;
        PG8_WAIT_V(4); PG8_BAR;
        PG8_STAGE(PG8_SB(1, 0), cB + kstep, voffB); PG8_STAGE(PG8_SA(1, 0), cA + kstep, voffA); PG8_STAGE(PG8_SB(1, 1), cB + hstepB + kstep, voffB);
        PG8_WAIT_V(6); PG8_BAR;
    }
    for (;;) {
        const bool has_next = S.next(ui + 1, nxt);
        const char* nA = has_next ? (const char*)g.A + (size_t)nxt.pm * tstepA : cA; const char* nB = has_next ? (const char*)g.Bt + (size_t)nxt.pn * tstepB : cB;
        for (int t = 0; t < nt; t += 2) {
            const bool last = (t == nt - 2);
            const char* a1 = cA + (size_t)(t + 1) * kstep;
            const char* a2 = last ? nA : cA + (size_t)(t + 2) * kstep; const char* b2 = last ? nB : cB + (size_t)(t + 2) * kstep;
            const char* a3 = a2 + kstep; const char* b3 = b2 + kstep;
            if (last && has_next) S.a_ready(nxt);
            if constexpr (SP2) {
            PG8_LDB(B0, 0, 0); PG8_LDB(B1, 0, 1); PG8_SCHED; PG8_LDA(At, 0, 0); PG8_STAGE(PG8_SA(1, 1), a1 + hstepA, PG8_VA(1));
            if constexpr (GATHER) { if (last && has_next) PG8_LOADVO(cvo, ui + 1); }
            PG8_WAIT_V(8); PG8_WAIT_L(0); PG8_BAR; PG8_MMA(0, 0, At, B0); PG8_MMA(0, 1, At, B1); PG8_BAR; PG8_SCHED;
            PG8_LDA(At, 0, 1); PG8_STAGE(PG8_SB(0, 0), b2, voffB); PG8_STAGE(PG8_SB(0, 1), b2 + hstepB, voffB); PG8_STAGE(PG8_SA(0, 0), a2, PG8_VA(0));
            PG8_WAIT_V(8); PG8_WAIT_L(0); PG8_BAR; PG8_MMA(1, 0, At, B0); PG8_MMA(1, 1, At, B1); PG8_BAR; PG8_SCHED;
            PG8_LDB(B0, 1, 0); PG8_LDB(B1, 1, 1); PG8_SCHED; PG8_LDA(At, 1, 0); PG8_STAGE(PG8_SA(0, 1), a2 + hstepA, PG8_VA(1));
            PG8_WAIT_V(8); PG8_WAIT_L(0); PG8_BAR; PG8_MMA(0, 0, At, B0); PG8_MMA(0, 1, At, B1); PG8_BAR; PG8_SCHED;
            PG8_LDA(At, 1, 1); PG8_STAGE(PG8_SB(1, 0), b3, voffB); PG8_STAGE(PG8_SB(1, 1), b3 + hstepB, voffB); PG8_STAGE(PG8_SA(1, 0), a3, PG8_VA(0));
            PG8_WAIT_V(8); PG8_WAIT_L(0); PG8_BAR; PG8_MMA(1, 0, At, B0); PG8_MMA(1, 1, At, B1); PG8_BAR; PG8_SCHED;
            } else {
            PG8_LDB(B0, 0, 0); PG8_SCHED; PG8_LDA(At, 0, 0); PG8_STAGE(PG8_SA(1, 1), a1 + hstepA, voffA);
            PG8_WAIT_L(8); PG8_BAR; PG8_WAIT_L(0); PG8_MMA(0, 0, At, B0); PG8_BAR; PG8_SCHED;
            PG8_LDB(B1, 0, 1); PG8_STAGE(PG8_SB(0, 0), b2, voffB);
            PG8_BAR; PG8_WAIT_L(0); PG8_MMA(0, 1, At, B1); PG8_BAR;
            PG8_LDA(At, 0, 1); PG8_STAGE(PG8_SA(0, 0), a2, voffA);
            PG8_BAR; PG8_WAIT_L(0); PG8_MMA(1, 0, At, B0); PG8_BAR; PG8_SCHED;
            PG8_STAGE(PG8_SB(0, 1), b2 + hstepB, voffB);
            PG8_WAIT_V(6); PG8_BAR; PG8_MMA(1, 1, At, B1); PG8_BAR;
            PG8_LDB(B0, 1, 0); PG8_SCHED; PG8_LDA(At, 1, 0); PG8_STAGE(PG8_SA(0, 1), a2 + hstepA, voffA);
            PG8_WAIT_L(8); PG8_BAR; PG8_WAIT_L(0); PG8_MMA(0, 0, At, B0); PG8_BAR; PG8_SCHED;
            PG8_LDB(B1, 1, 1); PG8_STAGE(PG8_SB(1, 0), b3, voffB);
            PG8_BAR; PG8_WAIT_L(0); PG8_MMA(0, 1, At, B1); PG8_BAR;
            PG8_LDA(At, 1, 1); PG8_STAGE(PG8_SA(1, 0), a3, voffA);
            PG8_BAR; PG8_WAIT_L(0); PG8_MMA(1, 0, At, B0); PG8_BAR; PG8_SCHED;
            PG8_STAGE(PG8_SB(1, 1), b3 + hstepB, voffB);
            PG8_WAIT_V(6); PG8_BAR; PG8_MMA(1, 1, At, B1); PG8_BAR;
            }
        }
        if constexpr (ALIGN_EPI) { if (wr == 0) PG8_BAR; }
        if constexpr (!Epi::AFTER_DRAIN) { E(acc, cur, wr, wc, fr, fq); S.done(cur); }
        if (!has_next) break;
#pragma unroll
        for (int a = 0; a < 2; ++a)
#pragma unroll
            for (int b = 0; b < 2; ++b)
#pragma unroll
                for (int m = 0; m < 4; ++m)
#pragma unroll
                    for (int n = 0; n < 2; ++n) acc[a][b][m][n] = (f32x4){0.f, 0.f, 0.f, 0.f};
        cur = nxt; cA = nA; cB = nB; ++ui;
        if constexpr (ALIGN_EPI) { if (wr == 1) PG8_BAR; }
    }
    PG8_WAIT_V(0);
    if constexpr (!ALIGN_EPI) { if (wr == 0) PG8_BAR; }
    PG8_BAR;
    if constexpr (Epi::AFTER_DRAIN) { E.fused(acc, cur, wr, wc, fr, fq, lds, wid, lane); S.done(cur); }
#undef PG8_SA
#undef PG8_LOADVO
#undef PG8_VA
#undef PG8_SB
#undef PG8_STAGE
#undef PG8_LDA
#undef PG8_LDB
#undef PG8_MMA
#undef PG8_WAIT_V
#undef PG8_WAIT_L
#undef PG8_BAR
#undef PG8_SCHED
}
}

constexpr int NWAVES = 8;
constexpr int M = 16384, D = 1024, SEQ = 8192, DP = 512, NG = 32, NST = 64, GC = 16, CL = 16  ;
constexpr int NCH = M / CL;
constexpr int NEXP = 32, DF = 256, DPLE = 256;
constexpr int ACT_ROWS = 2 * M + NEXP * 256;
constexpr float RMS_EPS = 1e-6f;

constexpr size_t MiB = 1u << 20;
constexpr size_t WS_CTL = 0, CTL_ZERO_BYTES = 1 * MiB;
constexpr size_t WS_WR = 1 * MiB;
constexpr size_t WS_LAMT = 1 * MiB + 256 * 1024;
constexpr size_t WS_WIN = 2 * MiB, WS_GLU = 4 * MiB, WS_WCAT = 5 * MiB, WS_WG = 7 * MiB, WS_WPLE = 9 * MiB;
constexpr size_t WS_WGU = 10 * MiB, WS_WD = 42 * MiB;
constexpr size_t WS_MS = 58 * MiB, WS_WS3 = 62 * MiB;
constexpr size_t WS_ZZ = 70 * MiB;
constexpr size_t WS_PE = 58 * MiB;
constexpr size_t WS_XN = 90 * MiB;
constexpr size_t WS_ZP = 122 * MiB, WS_AS = 138 * MiB, WS_SLOC = 170 * MiB, WS_CAT = 202 * MiB, WS_PB = 234 * MiB;
constexpr size_t WS_ACT = 202 * MiB, WS_MO0 = 122 * MiB, WS_MO1 = 154 * MiB;
constexpr size_t WS_LIST = 244 * MiB, WS_LISTW = 246 * MiB, WS_LISTR = 248 * MiB;
constexpr size_t WS_WOS = 242 * MiB, WS_BD = 243 * MiB;
constexpr size_t WS_END = 256 * MiB;
static_assert(WS_MO1 + (size_t)M * D * 2 <= WS_ACT && WS_ACT + (size_t)ACT_ROWS * 512 <= WS_PB && WS_PB + (size_t)M * 512 <= WS_WOS && WS_LISTR + (size_t)NEXP * M * 4 <= WS_END, "ws map");
constexpr int CW_CNT = 8192;
constexpr int CW_BAR = 4096;
constexpr int ROWOFF_OFF = 143360;
constexpr int RING_OFF = 0, RING_BYTES = 131072, P0_SCR = 64 * 65 * 4  , LDSCTL_OFF = 139264, MISC_OFF = LDSCTL_OFF + 320, LDS_BYTES = 147456;
static_assert(NWAVES * P0_SCR <= LDSCTL_OFF && MISC_OFF + 4 * 512 <= ROWOFF_OFF && ROWOFF_OFF + 4 * 1024 <= LDS_BYTES, "LDS map");
constexpr int MW_TSTART = 16, MW_HIST = 64, MW_BASE = 96, MW_CNT = 128, MW_TL = 192;

#define GAS __attribute__((address_space(1)))
#define LAS __attribute__((address_space(3)))
typedef unsigned short bf16;
typedef unsigned v4u __attribute__((ext_vector_type(4)));
typedef unsigned v2u __attribute__((ext_vector_type(2)));
typedef float f32x4 __attribute__((ext_vector_type(4)));
typedef GAS unsigned gu32;
#define RLX_AGENT __ATOMIC_RELAXED, __HIP_MEMORY_SCOPE_AGENT
#define LDS_WAIT() asm volatile("s_waitcnt lgkmcnt(0)" ::: "memory")
#define VM_WAIT() asm volatile("s_waitcnt vmcnt(0)" ::: "memory")
__device__ __forceinline__ unsigned f2bf(float f) { unsigned u = __builtin_bit_cast(unsigned, f); return (u + 0x7fffu + ((u >> 16) & 1u)) >> 16; }
__device__ __forceinline__ unsigned pk2(float lo, float hi) { return f2bf(lo) | (f2bf(hi) << 16); }
__device__ __forceinline__ float bflo(unsigned w) { return __builtin_bit_cast(float, w << 16); }
__device__ __forceinline__ float bfhi(unsigned w) { return __builtin_bit_cast(float, w & 0xffff0000u); }
__device__ __forceinline__ float sigmoidf_(float x) { return __builtin_amdgcn_rcpf(1.0f + __expf(-x)); }
__device__ __forceinline__ float gelu_tanh(float y) { const float t = 1.5957691216f * (y + 0.044715f * y * y * y); return y * __builtin_amdgcn_rcpf(1.0f + __expf(-t)); }

#define XB_TMO      128
#define XB_XCNT(j)  (256  + 64 * (j))
#define XB_XSUB(j)  (1280 + 64 * (j))
#define XB_XGEN(j)  (2304 + 64 * (j))
#define XB_TOP      3328
#define XB_TOPGEN   3392
#define XCD_BAR_WORDS 3456
#define XB_SPIN_CAP (1u << 18)
__device__ __forceinline__ unsigned xb_ld(unsigned* p)              { return __hip_atomic_load(p, __ATOMIC_RELAXED, __HIP_MEMORY_SCOPE_AGENT); }
__device__ __forceinline__ unsigned xb_add(unsigned* p, unsigned v) { return __hip_atomic_fetch_add(p, v, __ATOMIC_RELAXED, __HIP_MEMORY_SCOPE_AGENT); }
__device__ __forceinline__ unsigned xb_xcc_id() { return (unsigned)__builtin_amdgcn_s_getreg((3 << 11) | 20) & 0xFu; }
#define XB_SPIN(cond, bar) do { unsigned _sp = 0; while (cond) { __builtin_amdgcn_s_sleep(1); \
    if ((++_sp & 255u) == 0u) { if (xb_ld(&(bar)[XB_TMO])) break; if (_sp > XB_SPIN_CAP) { atomicAdd(&(bar)[XB_TMO], 1u); break; } } } } while (0)
struct XcdBarrier { unsigned* bar; unsigned x; volatile LAS unsigned* st; int wave; };
__device__ __forceinline__ XcdBarrier xcd_barrier_post(unsigned* bar, volatile LAS unsigned* st) {
    XcdBarrier b; b.bar = bar; b.x = xb_xcc_id(); b.st = st; b.wave = 0;
    if (threadIdx.x == 0) (void)xb_add(&bar[XB_XCNT(b.x)], 1u);
    return b;
}
__device__ __forceinline__ void xcd_barrier_complete(unsigned* bar, unsigned x, unsigned& nloc, unsigned& nx) {
    const unsigned G = gridDim.x * gridDim.y * gridDim.z;
    unsigned sum, cnt, mine, sp = 0u;
    for (;;) {
        sum = 0u; cnt = 0u; mine = 0u;
#pragma unroll
        for (unsigned j = 0; j < 16; ++j) { const unsigned c = xb_ld(&bar[XB_XCNT(j)]); sum += c; cnt += (c > 0u) ? 1u : 0u; mine = (j == x) ? c : mine; }
        if (sum == G) break;
        __builtin_amdgcn_s_sleep(1);
        if ((++sp & 255u) == 0u) { if (xb_ld(&bar[XB_TMO])) break; if (sp > XB_SPIN_CAP) { atomicAdd(&bar[XB_TMO], 1u); break; } }
    }
    nloc = mine > 0u ? mine : 1u; nx = cnt > 0u ? cnt : 1u;
}
__device__ __forceinline__ void xcd_barrier(const XcdBarrier& b) {
    asm volatile("s_waitcnt vmcnt(0)" ::: "memory");
    __syncthreads();
    if (b.wave == 0 && hw_lane() == 0) {
        unsigned* bar = b.bar;
        __builtin_amdgcn_s_waitcnt(0);
        unsigned nloc = b.st[0], nx = b.st[1];
        if (nloc == 0u) { xcd_barrier_complete(bar, b.x, nloc, nx); b.st[0] = nloc; b.st[1] = nx; }
        const unsigned old = xb_add(&bar[XB_XSUB(b.x)], 1u);
        const unsigned gen = old / nloc;
        if (old + 1u == (gen + 1u) * nloc) {
            __builtin_amdgcn_fence(__ATOMIC_RELEASE, "agent");
            asm volatile("s_waitcnt vmcnt(0)" ::: "memory");
            const unsigned og = xb_add(&bar[XB_TOP], 1u);
            const unsigned tg = og / nx;
            if (og + 1u == (tg + 1u) * nx) xb_add(&bar[XB_TOPGEN], 1u);
            else XB_SPIN(xb_ld(&bar[XB_TOPGEN]) == tg, bar);
            __builtin_amdgcn_fence(__ATOMIC_ACQUIRE, "agent");
            xb_add(&bar[XB_XGEN(b.x)], 1u);
            asm volatile("s_waitcnt vmcnt(0)" ::: "memory");
        } else {
            XB_SPIN(xb_ld(&bar[XB_XGEN(b.x)]) == gen, bar);
            __builtin_amdgcn_fence(__ATOMIC_ACQUIRE, "agent");
            asm volatile("s_waitcnt vmcnt(0)" ::: "memory");
        }
    }
    __syncthreads();
}

struct Args { const float* in[30]; float* out; unsigned char* ws; };
struct Frame {
    LAS unsigned char* lds;
    volatile LAS unsigned* MISC;
    gu32* ctl;
    int wave, G, gw, ngw;
    float* out;
    unsigned char* ws;
};
__device__ __forceinline__ int opq(int v) { asm volatile("" : "+v"(v)); return v; }
template <int CTRL> __device__ __forceinline__ float dpp_f(float v) { return __builtin_bit_cast(float, __builtin_amdgcn_update_dpp(0, __builtin_bit_cast(int, v), CTRL, 0xf, 0xf, true)); }
__device__ __forceinline__ float wave_sum(float v) {
    v += dpp_f<0xB1>(v);
    v += dpp_f<0x4E>(v);
    v += dpp_f<0x141>(v);
    v += dpp_f<0x140>(v);
    const float r0 = __builtin_bit_cast(float, __builtin_amdgcn_readlane(__builtin_bit_cast(int, v), 0)), r1 = __builtin_bit_cast(float, __builtin_amdgcn_readlane(__builtin_bit_cast(int, v), 16));
    const float r2 = __builtin_bit_cast(float, __builtin_amdgcn_readlane(__builtin_bit_cast(int, v), 32)), r3 = __builtin_bit_cast(float, __builtin_amdgcn_readlane(__builtin_bit_cast(int, v), 48));
    return (r0 + r1) + (r2 + r3);
}

__device__ __forceinline__ void transpose_item64(const float* src, int ld_src, bf16* dst, int ld_dst, LAS float* scr, int lane, const float* kscale = nullptr) {
    f32x4 v[16];
    const int kq = lane >> 4, n4 = (lane & 15) * 4;
#pragma unroll
    for (int i = 0; i < 16; ++i) v[i] = *(const GAS f32x4*)(src + (size_t)(4 * i + kq) * ld_src + n4);
    if (kscale) {
#pragma unroll
        for (int i = 0; i < 16; ++i) v[i] = v[i] * kscale[4 * i + kq]; }
#pragma unroll
    for (int i = 0; i < 16; ++i) { LAS float* p = scr + (4 * i + kq) * 65 + n4; p[0] = v[i].x; p[1] = v[i].y; p[2] = v[i].z; p[3] = v[i].w; }
    LDS_WAIT(); asm volatile("" ::: "memory");
    const int c = lane & 7;
#pragma unroll
    for (int j = 0; j < 8; ++j) { const int n = (lane >> 3) + 8 * j; const LAS float* q = scr + (8 * c) * 65 + n;
        v4u o; o.x = pk2(q[0 * 65], q[1 * 65]); o.y = pk2(q[2 * 65], q[3 * 65]); o.z = pk2(q[4 * 65], q[5 * 65]); o.w = pk2(q[6 * 65], q[7 * 65]);
        *(GAS v4u*)(dst + (size_t)n * ld_dst + 8 * c) = o; }
    LDS_WAIT(); asm volatile("" ::: "memory");
}
__device__ __forceinline__ void sincos_d(double x, double& sn, double& cs) {
    const double k = __builtin_rint(x * 0.63661977236758134308);
    const double r = (x - k * 1.57079632679489655800e+00) - k * 6.12323399573676603587e-17;
    const double r2 = r * r;
    const double s = r * (1.0 + r2 * (-1.0 / 6.0 + r2 * (1.0 / 120.0 + r2 * (-1.0 / 5040.0 + r2 * (1.0 / 362880.0 + r2 * (-1.0 / 39916800.0 + r2 * (1.0 / 6227020800.0)))))));
    const double c = 1.0 + r2 * (-0.5 + r2 * (1.0 / 24.0 + r2 * (-1.0 / 720.0 + r2 * (1.0 / 40320.0 + r2 * (-1.0 / 3628800.0 + r2 * (1.0 / 479001600.0 + r2 * (-1.0 / 87178291200.0)))))));
    const int q = ((int)k) & 3;
    sn = (q == 0) ? s : (q == 1) ? c : (q == 2) ? -s : -c;
    cs = (q == 0) ? c : (q == 1) ? -s : (q == 2) ? -c : s;
}
__device__ __forceinline__ void ssm_gen(Frame& F, const Args& A, int g, int sl) {
    LAS float* lamP = (LAS float*)(F.lds + RING_OFF);
    LAS float* Bb = lamP + 2 * 17 * 64 * 2;
    LAS float* Cc = Bb + 2 * 64 * 16 * 2;
    LAS float* KT = Cc + 2 * 16 * 64 * 2;
    LAS float* dv = KT + 32 * 260;
    LAS float* bfac = dv + 16;
    const float* a_re = A.in[6]; const float* a_im = A.in[7]; const float* log_dt = A.in[8];
    const float* b_re = A.in[9]; const float* b_im = A.in[10]; const float* c_re = A.in[11]; const float* c_im = A.in[12]; const float* ssm_d = A.in[13];
    const int t = opq(F.wave * 64 + hw_lane());
    float pbr[4], pbi[4], pcr[4], pci[4];
#pragma unroll
    for (int i = 0; i < 4; ++i) { const int idx = t + 512 * i; const size_t si = (size_t)((idx >> 10) * NG + g) * 1024 + (idx & 1023);
        pbr[i] = b_re[si]; pbi[i] = b_im[si]; pcr[i] = c_re[si]; pci[i] = c_im[si]; }
    const int d_a = (t >> 6) & 1, n_a = t & 63;
    const float p_are = a_re[(d_a * NG + g) * NST + n_a], p_aim = a_im[(d_a * NG + g) * NST + n_a], p_ldt = log_dt[d_a * NG + g], p_dv = ssm_d[g * GC + (t & 15)];
    __syncthreads();
    if (t < 128) {
        const int d = d_a, n = n_a;
        const float dtf = expf(p_ldt), mag = expf(p_are * dtf); const double ang = (double)p_aim * (double)dtf;
        double sn, cs; sincos_d(ang, sn, cs);
        const float lr = mag * (float)cs, li = mag * (float)sn;
        const float nr = lr - 1.0f, ni = li, den = p_are * p_are + p_aim * p_aim;
        bfac[(d * 64 + n) * 2] = (nr * p_are + ni * p_aim) / den; bfac[(d * 64 + n) * 2 + 1] = (ni * p_are - nr * p_aim) / den;
        float pr = 1.0f, pi = 0.0f;
        for (int k = 0; k <= 16; ++k) { lamP[((d * 17 + k) * 64 + n) * 2] = pr; lamP[((d * 17 + k) * 64 + n) * 2 + 1] = pi;
            const float tr = pr * lr - pi * li, ti = pr * li + pi * lr; pr = tr; pi = ti; }
        if (sl == 0) {
            float* lt = (float*)(F.ws + WS_LAMT) + ((g * 2 + d) * 64 + n) * 4;
            double s16, c16, s1k, c1k; sincos_d(ang * 16.0, s16, c16); sincos_d(ang * 1024.0, s1k, c1k);
            const float m16 = expf(p_are * dtf * 16.0f), m1k = expf(p_are * dtf * 1024.0f);
            lt[0] = m16 * (float)c16; lt[1] = m16 * (float)s16; lt[2] = m1k * (float)c1k; lt[3] = m1k * (float)s1k; }
    }
    if (t < 16) dv[t] = p_dv;
    __syncthreads();
#pragma unroll
    for (int i = 0; i < 4; ++i) { const int idx = t + 512 * i, d = idx >> 10, n = (idx >> 4) & 63;
        const float fr = bfac[(d * 64 + n) * 2], fi = bfac[(d * 64 + n) * 2 + 1];
        Bb[idx * 2] = fr * pbr[i] - fi * pbi[i]; Bb[idx * 2 + 1] = fr * pbi[i] + fi * pbr[i];
        Cc[idx * 2] = pcr[i]; Cc[idx * 2 + 1] = pci[i]; }
    __syncthreads();
    {
        const int d = t >> 8, co = (t >> 4) & 15, ci = t & 15;
        float acc[16];
#pragma unroll
        for (int k = 0; k < 16; ++k) acc[k] = 0.f;
        for (int n = 0; n < 64; ++n) {
            const float cr = Cc[((d * 16 + co) * 64 + n) * 2], cim = Cc[((d * 16 + co) * 64 + n) * 2 + 1];
            const float br = Bb[((d * 64 + n) * 16 + ci) * 2], bi = Bb[((d * 64 + n) * 16 + ci) * 2 + 1];
            const float lr = lamP[((d * 17 + 1) * 64 + n) * 2], li = lamP[((d * 17 + 1) * 64 + n) * 2 + 1];
            float qr = cr * br - cim * bi, qi = cr * bi + cim * br;
#pragma unroll
            for (int k = 0; k < 16; ++k) { acc[k] += qr; const float tr = qr * lr - qi * li; qi = qr * li + qi * lr; qr = tr; }
        }
#pragma unroll
        for (int k = 0; k < 16; ++k) KT[(d * 16 + k) * 260 + co * 16 + ci] = acc[k];
    }
    __syncthreads();
    bf16* WS3 = (bf16*)(F.ws + WS_WS3) + ((size_t)g * 256 + sl * 64) * 512;
#pragma unroll
    for (int i2 = 0; i2 < 2; ++i2) {
        const int idx = t + 512 * i2, rowl = idx >> 4, sq = idx & 15, row = sl * 64 + rowl, j = row >> 4, co = row & 15;
        float v[16];
        if (j != sq) { const LAS float* src = KT + ((j > sq) ? (j - sq) : (16 + sq - j)) * 260 + co * 16;
#pragma unroll
            for (int i = 0; i < 16; ++i) v[i] = src[i]; }
        else {
#pragma unroll
            for (int i = 0; i < 16; ++i) v[i] = KT[co * 16 + i] + KT[16 * 260 + co * 16 + i] + (co == i ? dv[co] : 0.f); }
        v4u o0, o1; o0.x = pk2(v[0], v[1]); o0.y = pk2(v[2], v[3]); o0.z = pk2(v[4], v[5]); o0.w = pk2(v[6], v[7]); o1.x = pk2(v[8], v[9]); o1.y = pk2(v[10], v[11]); o1.z = pk2(v[12], v[13]); o1.w = pk2(v[14], v[15]);
        GAS v4u* dst = (GAS v4u*)(WS3 + (size_t)rowl * 512 + sq * 16); dst[0] = o0; dst[1] = o1;
    }
#pragma unroll
    for (int i2 = 0; i2 < 4; ++i2) {
        const int idx = t + 512 * i2, rowl = idx >> 5, q = (idx >> 3) & 3, n0 = (idx & 7) * 8, row = sl * 64 + rowl, j = row >> 4, co = row & 15, d = q >> 1, e = (d == 0) ? (j + 1) : (16 - j);
        float v[8];
#pragma unroll
        for (int i = 0; i < 8; ++i) { const int n = n0 + i;
            const float cr = Cc[((d * 16 + co) * 64 + n) * 2], cim = Cc[((d * 16 + co) * 64 + n) * 2 + 1];
            const float pr = lamP[((d * 17 + e) * 64 + n) * 2], pi = lamP[((d * 17 + e) * 64 + n) * 2 + 1];
            v[i] = (q & 1) ? -(cr * pi + cim * pr) : (cr * pr - cim * pi); }
        v4u o; o.x = pk2(v[0], v[1]); o.y = pk2(v[2], v[3]); o.z = pk2(v[4], v[5]); o.w = pk2(v[6], v[7]);
        *(GAS v4u*)(WS3 + (size_t)rowl * 512 + 256 + q * 64 + n0) = o;
    }
    bf16* MS = (bf16*)(F.ws + WS_MS) + ((size_t)g * 256 + sl * 64) * 256;
#pragma unroll
    for (int i2 = 0; i2 < 4; ++i2) {
        const int idx = t + 512 * i2, rowl = idx >> 5, kc = (idx & 31) * 8, row = sl * 64 + rowl, q = row >> 6, n = row & 63, d = q >> 1, j = kc >> 4, ci0 = kc & 15, e = (d == 0) ? (15 - j) : j;
        const float pr = lamP[((d * 17 + e) * 64 + n) * 2], pi = lamP[((d * 17 + e) * 64 + n) * 2 + 1];
        float v[8];
#pragma unroll
        for (int i = 0; i < 8; ++i) { const float br = Bb[((d * 64 + n) * 16 + ci0 + i) * 2], bi = Bb[((d * 64 + n) * 16 + ci0 + i) * 2 + 1];
            v[i] = (q & 1) ? (pr * bi + pi * br) : (pr * br - pi * bi); }
        v4u o; o.x = pk2(v[0], v[1]); o.y = pk2(v[2], v[3]); o.z = pk2(v[4], v[5]); o.w = pk2(v[6], v[7]);
        *(GAS v4u*)(MS + (size_t)rowl * 256 + kc) = o;
    }
    __syncthreads();
}
constexpr int BG_GU = NEXP * 16 * 4, BG_DN = NEXP * 4 * 16, BG_WOB = 8 * 16, BG_WG = 16 * 16, BG_WPLE = 4 * 16;
constexpr int BG_TOTAL = 2 * BG_GU + BG_DN + BG_WOB + BG_WG + BG_WPLE;
struct BgDesc { const float* src; bf16* dst; int ld_src, ld_dst; };
__device__ __forceinline__ BgDesc bg_desc(Frame& F, const Args& A, int r) {
    BgDesc d;
    if (r < 2 * BG_GU) {
        const int up = r >= BG_GU; if (up) r -= BG_GU;
        const int e = r >> 6, kb = (r >> 2) & 15, nb = r & 3, k0 = kb * 64, n0 = nb * 64;
        d.src = A.in[up ? 23 : 22] + ((size_t)e * D + k0) * DF + n0; d.ld_src = DF;
        d.dst = (bf16*)(F.ws + WS_WGU) + ((size_t)e * 512 + (n0 >> 7) * 256 + (up ? 128 : 0) + (n0 & 127)) * D + k0; d.ld_dst = D; return d; }
    r -= 2 * BG_GU;
    if (r < BG_DN) {
        const int e = r >> 6, kb = (r >> 4) & 3, nb = r & 15, k0 = kb * 64, n0 = nb * 64;
        d.src = A.in[24] + ((size_t)e * DF + k0) * D + n0; d.ld_src = D; d.dst = (bf16*)(F.ws + WS_WD) + ((size_t)e * D + n0) * DF + k0; d.ld_dst = DF; return d; }
    r -= BG_DN;
    if (r < BG_WOB) { const int kb = r >> 4, nb = r & 15;
        d.src = A.in[16] + (size_t)(DP + kb * 64) * D + nb * 64; d.ld_src = D; d.dst = (bf16*)(F.ws + WS_WCAT) + (size_t)nb * 64 * D + DP + kb * 64; d.ld_dst = D; return d; }
    r -= BG_WOB;
    if (r < BG_WG) { const int kb = r >> 4, nb = r & 15; d.src = A.in[26] + (size_t)kb * 64 * D + nb * 64; d.ld_src = D; d.dst = (bf16*)(F.ws + WS_WG) + (size_t)nb * 64 * D + kb * 64; d.ld_dst = D; return d; }
    r -= BG_WG;
    { const int kb = r >> 4, nb = r & 15; d.src = A.in[28] + (size_t)kb * 64 * D + nb * 64; d.ld_src = D; d.dst = (bf16*)(F.ws + WS_WPLE) + (size_t)nb * 64 * DPLE + kb * 64; d.ld_dst = DPLE; return d; }
}
__device__ __forceinline__ void tr64_load(f32x4 (&v)[16], const float* src, int ld_src, int lane) {
    const int kq = lane >> 4, n4 = (lane & 15) * 4;
#pragma unroll
    for (int i = 0; i < 16; ++i) v[i] = *(const GAS f32x4*)(src + (size_t)(4 * i + kq) * ld_src + n4);
}
__device__ __forceinline__ void tr64_finish(const f32x4 (&v)[16], bf16* dst, int ld_dst, LAS float* scr, int lane) {
    const int kq = lane >> 4, n4 = (lane & 15) * 4;
#pragma unroll
    for (int i = 0; i < 16; ++i) { LAS float* p = scr + (4 * i + kq) * 65 + n4; p[0] = v[i].x; p[1] = v[i].y; p[2] = v[i].z; p[3] = v[i].w; }
    LDS_WAIT(); asm volatile("" ::: "memory");
    const int c = lane & 7;
#pragma unroll
    for (int j = 0; j < 8; ++j) { const int n = (lane >> 3) + 8 * j; const LAS float* q = scr + (8 * c) * 65 + n;
        v4u o; o.x = pk2(q[0 * 65], q[1 * 65]); o.y = pk2(q[2 * 65], q[3 * 65]); o.z = pk2(q[4 * 65], q[5 * 65]); o.w = pk2(q[6 * 65], q[7 * 65]);
        *(GAS v4u*)(dst + (size_t)n * ld_dst + 8 * c) = o; }
    LDS_WAIT(); asm volatile("" ::: "memory");
}
__device__ __forceinline__ void bg_range(Frame& F, const Args& A, int lo, int hi, int plo, int phi, bool all = false) {
    int widx, nw;
    if (all) { widx = F.gw; nw = F.ngw; }
    else if (F.G >= 256) { if ((int)blockIdx.x < 128) return; widx = ((int)blockIdx.x - 128) * NWAVES + F.wave; nw = (F.G - 128) * NWAVES; } else { widx = F.gw; nw = F.ngw; }
    LAS float* scr = (LAS float*)(F.lds + RING_OFF + F.wave * P0_SCR);
    const int lane = opq(hw_lane());
    int it = lo + widx;
    for (; it + nw < hi; it += 2 * nw) {
        f32x4 va[16], vb[16]; const BgDesc da = bg_desc(F, A, it), db = bg_desc(F, A, it + nw);
        tr64_load(va, da.src, da.ld_src, lane); tr64_load(vb, db.src, db.ld_src, lane);
        tr64_finish(va, da.dst, da.ld_dst, scr, lane); tr64_finish(vb, db.dst, db.ld_dst, scr, lane); }
    if (it < hi) { f32x4 va[16]; const BgDesc dc = bg_desc(F, A, it); tr64_load(va, dc.src, dc.ld_src, lane); tr64_finish(va, dc.dst, dc.ld_dst, scr, lane); }
    for (int m = plo + 4 * widx; m < phi; m += 4 * nw) {
        f32x4 pv[4];
#pragma unroll
        for (int r = 0; r < 4; ++r) pv[r] = *((const GAS f32x4*)(A.in[1] + (size_t)(m + r) * DPLE) + lane);
#pragma unroll
        for (int r = 0; r < 4; ++r) { v2u o; o.x = pk2(pv[r].x, pv[r].y); o.y = pk2(pv[r].z, pv[r].w); *((GAS v2u*)((bf16*)(F.ws + WS_PB) + (size_t)(m + r) * DPLE) + lane) = o; }
    }
}
template <int R> __device__ __forceinline__ void xn_rows(Frame& F, const Args& A, int m0, int stride, int lane) {
    const GAS f32x4* gr = (const GAS f32x4*)A.in[2] + lane;
    f32x4 v[R][4];
#pragma unroll
    for (int r = 0; r < R; ++r) { const size_t m = (size_t)(m0 + r * stride);
#pragma unroll
        for (int j = 0; j < 4; ++j) v[r][j] = *((const GAS f32x4*)(A.in[0] + m * D) + lane + 64 * j); }
#pragma unroll
    for (int r = 0; r < R; ++r) { const size_t m = (size_t)(m0 + r * stride); float s = 0.f;
#pragma unroll
        for (int j = 0; j < 4; ++j) s += (v[r][j].x * v[r][j].x + v[r][j].y * v[r][j].y) + (v[r][j].z * v[r][j].z + v[r][j].w * v[r][j].w);
        const float rstd = 1.f / sqrtf(wave_sum(s) * (1.f / D) + RMS_EPS);
        GAS unsigned long long* o8 = (GAS unsigned long long*)((bf16*)(F.ws + WS_XN) + m * D) + lane;
#pragma unroll
        for (int j = 0; j < 4; ++j) { const f32x4 gg = gr[64 * j], x = v[r][j];
            o8[64 * j] = (unsigned long long)pk2(x.x * rstd * gg.x, x.y * rstd * gg.y) | ((unsigned long long)pk2(x.z * rstd * gg.z, x.w * rstd * gg.w) << 32); }
    }
}
__device__ __forceinline__ void p0_prologue(Frame& F, const Args& A) {
    int widx = F.gw, nw = F.ngw;
    if (F.G >= 256) { if ((int)blockIdx.x < 128) { ssm_gen(F, A, (int)blockIdx.x >> 2, (int)blockIdx.x & 3); return; }
                      widx = ((int)blockIdx.x - 128) * NWAVES + F.wave; nw = (F.G - 128) * NWAVES; }
    else { for (int u = blockIdx.x; u < NG * 4; u += F.G) ssm_gen(F, A, u >> 2, u & 3); __syncthreads(); }
    LAS float* scr = (LAS float*)(F.lds + RING_OFF + F.wave * P0_SCR);
    constexpr int I_WIN = 16 * 16, I_GLU = 8 * 8, I_WOS = 8 * 16, I_BD = 256, I_WR = 48, I_ROWS = M / 8;
    constexpr int NITEMS = I_WIN + I_GLU + I_WOS + I_BD + I_WR + I_ROWS;
    for (int it = widx; it < NITEMS; it += nw) {
        int r = it; const int lane = opq(hw_lane());
        if (r < I_WIN) { const int kb = r >> 4, nb = r & 15; transpose_item64(A.in[3] + (size_t)kb * 64 * D + nb * 64, D, (bf16*)(F.ws + WS_WIN) + (size_t)nb * 64 * D + kb * 64, D, scr, lane); continue; }
        r -= I_WIN;
        if (r < I_GLU) { const int kb = r >> 3, nb = r & 7; transpose_item64(A.in[14] + (size_t)kb * 64 * DP + nb * 64, DP, (bf16*)(F.ws + WS_GLU) + (size_t)nb * 64 * DP + kb * 64, DP, scr, lane); continue; }
        r -= I_GLU;
        if (r < I_WOS) {
            const int kb = r >> 4, nb = r & 15, k0 = kb * 64;
            transpose_item64(A.in[16] + (size_t)k0 * D + nb * 64, D, (bf16*)(F.ws + WS_WOS) + ((size_t)(k0 >> 8) * D + nb * 64) * 256 + (k0 & 255), 256, scr, lane, A.in[5] + k0); continue; }
        r -= I_WOS;
        if (r < I_BD) {
            const int row = r * 2 + (lane >> 5), c0 = (lane & 31) * 8, gi = row >> 7;
            v4u o = (v4u){0u, 0u, 0u, 0u};
            if ((c0 >> 7) == (gi & 1)) { const f32x4 a = *(const GAS f32x4*)(A.in[4] + (size_t)row * 128 + (c0 & 127)), b = *(const GAS f32x4*)(A.in[4] + (size_t)row * 128 + (c0 & 127) + 4);
                o.x = pk2(a.x, a.y); o.y = pk2(a.z, a.w); o.z = pk2(b.x, b.y); o.w = pk2(b.z, b.w); }
            *(GAS v4u*)((bf16*)(F.ws + WS_BD) + (size_t)row * 256 + c0) = o; continue; }
        r -= I_BD;
        if (r < I_WR) {
            bf16* dh = (bf16*)(F.ws + WS_WR) + (size_t)r * D; bf16* dl = dh + 48 * D;
            for (int dd = lane; dd < D; dd += 64) { float w = 0.f;
                if (r < 4) w = A.in[18][dd * 4 + r]; else if (r < 36) w = A.in[20][((size_t)((r - 4) >> 3) * D + dd) * 8 + ((r - 4) & 7)];
                w *= A.in[17][dd]; const unsigned h = f2bf(w); dh[dd] = (bf16)h; dl[dd] = (bf16)f2bf(w - __builtin_bit_cast(float, h << 16)); }
            continue; }
        r -= I_WR;
        xn_rows<8>(F, A, r, I_ROWS, lane);
    }
}

using pg8::Unit; using pg8::bf16_t; typedef unsigned u32x4 __attribute__((ext_vector_type(4)));
__device__ __forceinline__ u32x4 pack8(const f32x4& a, const f32x4& b) { u32x4 w; w.x = pk2(a[0], a[1]); w.y = pk2(a[2], a[3]); w.z = pk2(b[0], b[1]); w.w = pk2(b[2], b[3]); return w; }
struct EpiZ { static constexpr bool PERM = true, AFTER_DRAIN = false; bf16_t* ZP; bf16_t* AS;
    __device__ __forceinline__ void operator()(const f32x4 (&acc)[2][2][4][2], const Unit& u, int wr, int wc, int fr, int fq) const {
        const int row0 = u.pm * 256 + wr * 64 + fr;
#pragma unroll
        for (int ai = 0; ai < 2; ++ai)
#pragma unroll
            for (int m = 0; m < 4; ++m) { const int r = row0 + ai * 128 + m * 16;
#pragma unroll
                for (int bj = 0; bj < 2; ++bj) { const int col = u.pn * 256 + bj * 128 + wc * 32 + 8 * fq; const u32x4 w = pack8(acc[ai][bj][m][0], acc[ai][bj][m][1]);
                    if (u.pn < 2) *(u32x4*)(ZP + (size_t)r * DP + col) = w;
                    else { const int sc = col - DP, g = sc >> 4, ch0 = sc & 15; *(u32x4*)(AS + ((size_t)(g * NCH + (r >> 4)) * 512 + (r & 15) * 16 + ch0)) = w; } } }
    } };
struct EpiSloc { static constexpr bool PERM = false, AFTER_DRAIN = false; float* C;
    __device__ __forceinline__ void operator()(const f32x4 (&acc)[2][2][4][2], const Unit& u, int wr, int wc, int fr, int fq) const {
        const int row0 = u.pm * 256 + wr * 64 + fr, col0 = wc * 32 + 4 * fq;
#pragma unroll
        for (int ai = 0; ai < 2; ++ai)
#pragma unroll
            for (int m = 0; m < 4; ++m) { float* rowp = C + (size_t)(row0 + ai * 128 + m * 16) * 256 + col0;
#pragma unroll
                for (int bj = 0; bj < 2; ++bj)
#pragma unroll
                    for (int n = 0; n < 2; ++n) *(f32x4*)(rowp + bj * 128 + n * 16) = acc[ai][bj][m][n]; }
    } };
struct EpiY { static constexpr bool PERM = true, AFTER_DRAIN = false; bf16_t* ZZ;
    __device__ __forceinline__ void operator()(const f32x4 (&acc)[2][2][4][2], const Unit& u, int wr, int wc, int fr, int fq) const {
        const int g = u.pn, row0 = (u.pm & 3) * 256 + wr * 64 + fr;
#pragma unroll
        for (int ai = 0; ai < 2; ++ai)
#pragma unroll
            for (int m = 0; m < 4; ++m) { const int c = row0 + ai * 128 + m * 16;
#pragma unroll
                for (int bj = 0; bj < 2; ++bj) { const int col = bj * 128 + wc * 32 + 8 * fq, j = col >> 4, co0 = col & 15;
                    f32x4 a = acc[ai][bj][m][0], b = acc[ai][bj][m][1];
#pragma unroll
                    for (int i = 0; i < 4; ++i) { a[i] = gelu_tanh(a[i]); b[i] = gelu_tanh(b[i]); }
                    *(u32x4*)(ZZ + (size_t)(c * CL + j) * DP + g * GC + co0) = pack8(a, b); asm volatile("" ::: "memory"); } }
    } };
struct EpiGlu { static constexpr bool PERM = true, AFTER_DRAIN = false; const bf16_t* ZZ; const float* bias; bf16_t* CAT;
    __device__ __forceinline__ void operator()(const f32x4 (&acc)[2][2][4][2], const Unit& u, int wr, int wc, int fr, int fq) const {
        const int row0 = u.pm * 256 + wr * 64 + fr;
#pragma unroll
        for (int bj = 0; bj < 2; ++bj) { const int col = u.pn * 256 + bj * 128 + wc * 32 + 8 * fq;
            const f32x4 b0 = *(const f32x4*)(bias + col), b1 = *(const f32x4*)(bias + col + 4);
#pragma unroll
            for (int ai = 0; ai < 2; ++ai)
#pragma unroll
                for (int m = 0; m < 4; ++m) { const int r = row0 + ai * 128 + m * 16;
                    const u32x4 z = *(const u32x4*)(ZZ + (size_t)r * DP + col);
                    f32x4 a = acc[ai][bj][m][0] + b0, b = acc[ai][bj][m][1] + b1;
                    a[0] = bflo(z.x) * sigmoidf_(a[0]); a[1] = bfhi(z.x) * sigmoidf_(a[1]); a[2] = bflo(z.y) * sigmoidf_(a[2]); a[3] = bfhi(z.y) * sigmoidf_(a[3]);
                    b[0] = bflo(z.z) * sigmoidf_(b[0]); b[1] = bfhi(z.z) * sigmoidf_(b[1]); b[2] = bflo(z.w) * sigmoidf_(b[2]); b[3] = bfhi(z.w) * sigmoidf_(b[3]);
                    *(u32x4*)(CAT + (size_t)r * D + DP + col) = pack8(a, b); asm volatile("" ::: "memory"); } }
    } };
struct EpiRes { static constexpr bool PERM = true, AFTER_DRAIN = false; const float* X; float* H; const float* G; bf16_t* V;
    __device__ __forceinline__ void operator()(const f32x4 (&acc)[2][2][4][2], const Unit& u, int wr, int wc, int fr, int fq) const {
        const int row0 = u.pm * 256 + wr * 64 + fr, col0 = u.pn * 256 + wc * 32 + 8 * fq;
        f32x4 gv[2][2];
#pragma unroll
        for (int bj = 0; bj < 2; ++bj)
#pragma unroll
            for (int n = 0; n < 2; ++n) gv[bj][n] = *(const f32x4*)(G + col0 + bj * 128 + 4 * n);
#pragma unroll
        for (int ai = 0; ai < 2; ++ai)
#pragma unroll
            for (int m = 0; m < 4; ++m) { const size_t off = (size_t)(row0 + ai * 128 + m * 16) * D + col0;
#pragma unroll
                for (int bj = 0; bj < 2; ++bj) { const f32x4 h0 = *(const f32x4*)(X + off + bj * 128) + acc[ai][bj][m][0], h1 = *(const f32x4*)(X + off + bj * 128 + 4) + acc[ai][bj][m][1];
                    *(f32x4*)(H + off + bj * 128) = h0; *(f32x4*)(H + off + bj * 128 + 4) = h1;
                    *(u32x4*)(V + off + bj * 128) = pack8(h0 * gv[bj][0], h1 * gv[bj][1]); } }
    } };
struct EpiAct { static constexpr bool PERM = true, AFTER_DRAIN = false; const float* LW; const float* LR; bf16_t* ACT; const volatile LAS unsigned* tstart;
    __device__ __forceinline__ void operator()(const f32x4 (&acc)[2][2][4][2], const Unit& u, int wr, int wc, int fr, int fq) const {
        const int e = u.pn >> 1, lrow0 = (u.pm - (int)tstart[e]) * 256 + wr * 64 + fr, row0 = u.pm * 256 + wr * 64 + fr, col = (u.pn & 1) * 128 + wc * 32 + 8 * fq;
        const float* lw = LW + (size_t)e * M + lrow0; const float* lr = LR + (size_t)e * M + lrow0;
#pragma unroll
        for (int ai = 0; ai < 2; ++ai)
#pragma unroll
            for (int m = 0; m < 4; ++m) { const int ro = ai * 128 + m * 16; const float w = lw[ro], rs = lr[ro];
                f32x4 a, b;
#pragma unroll
                for (int i = 0; i < 4; ++i) { const float g0 = rs * acc[ai][0][m][0][i], g1 = rs * acc[ai][0][m][1][i], sw = rs * w;
                    a[i] = g0 * sigmoidf_(g0) * acc[ai][1][m][0][i] * sw; b[i] = g1 * sigmoidf_(g1) * acc[ai][1][m][1][i] * sw; }
                *(u32x4*)(ACT + (size_t)(row0 + ro) * DF + col) = pack8(a, b); }
    } };
struct EpiDown { static constexpr bool PERM = true, AFTER_DRAIN = false; const int* LIST; const unsigned* cnt; bf16_t* MO0; bf16_t* MO1; const volatile LAS unsigned* tstart;
    __device__ __forceinline__ void operator()(const f32x4 (&acc)[2][2][4][2], const Unit& u, int wr, int wc, int fr, int fq) const {
        const int e = u.pn >> 2, lrow0 = (u.pm - (int)tstart[e]) * 256 + wr * 64 + fr, col0 = (u.pn & 3) * 256 + wc * 32 + 8 * fq;
        const int n_e = (int)__hip_atomic_load(cnt + 64 * e, __ATOMIC_RELAXED, __HIP_MEMORY_SCOPE_AGENT); const int* li = LIST + (size_t)e * M;
#pragma unroll
        for (int ai = 0; ai < 2; ++ai)
#pragma unroll
            for (int m = 0; m < 4; ++m) { const int lr = lrow0 + ai * 128 + m * 16;
                if (lr < n_e) { const int info = li[lr]; bf16_t* dst = ((info & 1) ? MO1 : MO0) + (size_t)(info >> 1) * D + col0;
#pragma unroll
                    for (int bj = 0; bj < 2; ++bj) *(u32x4*)(dst + bj * 128) = pack8(acc[ai][bj][m][0], acc[ai][bj][m][1]); } }
    } };
struct EpiPe { static constexpr bool PERM = true, AFTER_DRAIN = false; bf16_t* O;
    __device__ __forceinline__ void operator()(const f32x4 (&acc)[2][2][4][2], const Unit& u, int wr, int wc, int fr, int fq) const {
        const int row0 = u.pm * 256 + wr * 64 + fr, col0 = u.pn * 256 + wc * 32 + 8 * fq;
#pragma unroll
        for (int ai = 0; ai < 2; ++ai)
#pragma unroll
            for (int m = 0; m < 4; ++m) { bf16_t* rowp = O + (size_t)(row0 + ai * 128 + m * 16) * D + col0;
#pragma unroll
                for (int bj = 0; bj < 2; ++bj) *(u32x4*)(rowp + bj * 128) = pack8(acc[ai][bj][m][0], acc[ai][bj][m][1]); }
    } };
struct EpiGate { static constexpr bool PERM = true, AFTER_DRAIN = false; const float* bias; bf16_t* PE;
    __device__ __forceinline__ void operator()(const f32x4 (&acc)[2][2][4][2], const Unit& u, int wr, int wc, int fr, int fq) const {
        const int row0 = u.pm * 256 + wr * 64 + fr, col0 = u.pn * 256 + wc * 32 + 8 * fq;
        u32x4 pe[2][4][2];
#pragma unroll
        for (int ai = 0; ai < 2; ++ai)
#pragma unroll
            for (int m = 0; m < 4; ++m)
#pragma unroll
                for (int bj = 0; bj < 2; ++bj) pe[ai][m][bj] = *(const u32x4*)(PE + (size_t)(row0 + ai * 128 + m * 16) * D + col0 + bj * 128);
#pragma unroll
        for (int bj = 0; bj < 2; ++bj) { const f32x4 b0 = *(const f32x4*)(bias + col0 + bj * 128), b1 = *(const f32x4*)(bias + col0 + bj * 128 + 4);
#pragma unroll
            for (int ai = 0; ai < 2; ++ai)
#pragma unroll
                for (int m = 0; m < 4; ++m) { const u32x4 z = pe[ai][m][bj]; f32x4 a = acc[ai][bj][m][0] + b0, b = acc[ai][bj][m][1] + b1;
                    a[0] = bflo(z.x) * sigmoidf_(a[0]); a[1] = bfhi(z.x) * sigmoidf_(a[1]); a[2] = bflo(z.y) * sigmoidf_(a[2]); a[3] = bfhi(z.y) * sigmoidf_(a[3]);
                    b[0] = bflo(z.z) * sigmoidf_(b[0]); b[1] = bfhi(z.z) * sigmoidf_(b[1]); b[2] = bflo(z.w) * sigmoidf_(b[2]); b[3] = bfhi(z.w) * sigmoidf_(b[3]);
                    *(u32x4*)(PE + (size_t)(row0 + ai * 128 + m * 16) * D + col0 + bj * 128) = pack8(a, b); } }
    } };

struct GroupOrder { int G, c;
    __device__ __forceinline__ bool next(int i, Unit& u) const { const int L = i * G + c; if (L >= NG * 4) return false; u.pm = L; u.pn = L >> 2; u.nv = 256; return true; }
    __device__ __forceinline__ void a_ready(const Unit&) const {}
    __device__ __forceinline__ void done(const Unit&) const {} };
struct PeOrder { int G, c, n2;
    __device__ __forceinline__ bool next(int i, Unit& u) const { if (c < n2) return false; const int L = i * (G - n2) + (c - n2); if (L >= (M / 256) * (D / 256)) return false; u.pm = L >> 2; u.pn = L & 3; u.nv = 256; return true; }
    __device__ __forceinline__ void a_ready(const Unit&) const {}
    __device__ __forceinline__ void done(const Unit&) const {} };
struct WeffOrder { int G, c;
    __device__ __forceinline__ bool next(int i, Unit& u) const { const int L = (G >= 256) ? ((i == 0) ? c - 128 : -1) : i * G + c; if (L < 0 || L >= 8) return false; u.pm = L; u.pn = L >> 2; u.nv = 256; return true; }
    __device__ __forceinline__ void a_ready(const Unit&) const {}
    __device__ __forceinline__ void done(const Unit&) const {} };
struct EpiWeff { static constexpr bool PERM = true, AFTER_DRAIN = false; bf16_t* O;
    __device__ __forceinline__ void operator()(const f32x4 (&acc)[2][2][4][2], const Unit& u, int wr, int wc, int fr, int fq) const {
        const int row0 = (u.pm & 3) * 256 + wr * 64 + fr, col0 = u.pn * 256 + wc * 32 + 8 * fq;
#pragma unroll
        for (int ai = 0; ai < 2; ++ai)
#pragma unroll
            for (int m = 0; m < 4; ++m) { bf16_t* rowp = O + (size_t)(row0 + ai * 128 + m * 16) * D + col0;
#pragma unroll
                for (int bj = 0; bj < 2; ++bj) *(u32x4*)(rowp + bj * 128) = pack8(acc[ai][bj][m][0], acc[ai][bj][m][1]); }
    } };
template <int NSUB> struct ExpertOrder { int G, c; const volatile LAS unsigned* misc;
    __device__ __forceinline__ bool next(int i, Unit& u) const {
        const int L = i * G + c, tp = L / NSUB, sub = L % NSUB; if (tp >= __builtin_amdgcn_readfirstlane((int)misc[MW_TSTART + NEXP])) return false;
        const unsigned ent = (unsigned)__builtin_amdgcn_readfirstlane((int)misc[MW_TL + tp]); const int e = ent & 31u, rt = (ent >> 5) & 127u;
        u.pm = __builtin_amdgcn_readfirstlane((int)misc[MW_TSTART + e]) + rt; u.pn = e * NSUB + sub; u.nv = (int)(ent >> 12); return true; }
    __device__ __forceinline__ void a_ready(const Unit&) const {}
    __device__ __forceinline__ void done(const Unit&) const {} };

__device__ __forceinline__ void carry_unit(Frame& F, int unit) {
    const int d = unit & 1, g = (unit >> 1) & 31, b = unit >> 6, n = opq(hw_lane()), s = F.wave;
    const float* lt = (const float*)(F.ws + WS_LAMT) + ((g * 2 + d) * 64 + n) * 4;
    const float l16r = lt[0], l16i = lt[1], lkr = lt[2], lki = lt[3];
    const float* SL = (const float*)(F.ws + WS_SLOC) + (size_t)(g * NCH + b * 512) * 256 + d * 128 + n;
    bf16* AS = (bf16*)(F.ws + WS_AS) + (size_t)(g * NCH + b * 512) * 512 + 256 + d * 128 + n;
    LAS float* segE = (LAS float*)(F.lds + RING_OFF);
    float er = 0.f, ei = 0.f;
    for (int i0 = 0; i0 < 64; i0 += 16) {
        float sr[16], si[16];
#pragma unroll
        for (int ii = 0; ii < 16; ++ii) { const int i = s * 64 + i0 + ii, c = d ? (511 - i) : i; sr[ii] = SL[(size_t)c * 256]; si[ii] = SL[(size_t)c * 256 + 64]; }
#pragma unroll
        for (int ii = 0; ii < 16; ++ii) { const float tr = l16r * er - l16i * ei + sr[ii], ti = l16r * ei + l16i * er + si[ii]; er = tr; ei = ti; }
    }
    __syncthreads();
    segE[(s * 64 + n) * 2] = er; segE[(s * 64 + n) * 2 + 1] = ei;
    __syncthreads();
    float xr = 0.f, xi = 0.f;
    for (int sp = 0; sp < s; ++sp) { const float pr = segE[(sp * 64 + n) * 2], pi = segE[(sp * 64 + n) * 2 + 1];
        const float tr = lkr * xr - lki * xi + pr, ti = lkr * xi + lki * xr + pi; xr = tr; xi = ti; }
    for (int i0 = 0; i0 < 64; i0 += 16) {
        float sr[16], si[16];
#pragma unroll
        for (int ii = 0; ii < 16; ++ii) { const int i = s * 64 + i0 + ii, c = d ? (511 - i) : i; sr[ii] = SL[(size_t)c * 256]; si[ii] = SL[(size_t)c * 256 + 64]; }
#pragma unroll
        for (int ii = 0; ii < 16; ++ii) { const int i = s * 64 + i0 + ii, c = d ? (511 - i) : i;
            AS[(size_t)c * 512] = (bf16)f2bf(xr); AS[(size_t)c * 512 + 64] = (bf16)f2bf(xi);
            const float tr = l16r * xr - l16i * xi + sr[ii], ti = l16r * xi + l16i * xr + si[ii]; xr = tr; xi = ti; }
    }
    __syncthreads();
}
__device__ __forceinline__ void diff_row(Frame& F, int m) {
    const int t = m & (SEQ - 1), lane = opq(hw_lane()), h = 1 << (lane >> 4), lo = max(t - h, 0), hi = min(t + h, SEQ);
    const bf16* ZP = (const bf16*)(F.ws + WS_ZP) + (size_t)(m - t) * DP + lane * 8;
    float acc[8];
#pragma unroll
    for (int i = 0; i < 8; ++i) acc[i] = 0.f;
    v4u zt = (v4u){0u, 0u, 0u, 0u};
    v4u zz[16];
#pragma unroll
    for (int k = 0; k < 16; ++k) { const int s = t - 8 + k, sc = (s >= lo && s < hi) ? s : t; zz[k] = *(const GAS v4u*)(ZP + (size_t)sc * DP); }
#pragma unroll
    for (int k = 0; k < 16; ++k) { const int s = t - 8 + k; const float f = (s >= lo && s < hi) ? 1.f : 0.f; const v4u z = zz[k];
        acc[0] += f * bflo(z.x); acc[1] += f * bfhi(z.x); acc[2] += f * bflo(z.y); acc[3] += f * bfhi(z.y); acc[4] += f * bflo(z.z); acc[5] += f * bfhi(z.z); acc[6] += f * bflo(z.w); acc[7] += f * bfhi(z.w);
        if (k == 8) zt = z; }
    const float inv = 1.0f / (float)(hi - lo);
    v4u o; o.x = pk2(acc[0] * inv - bflo(zt.x), acc[1] * inv - bfhi(zt.x)); o.y = pk2(acc[2] * inv - bflo(zt.y), acc[3] * inv - bfhi(zt.y));
    o.z = pk2(acc[4] * inv - bflo(zt.z), acc[5] * inv - bfhi(zt.z)); o.w = pk2(acc[6] * inv - bflo(zt.w), acc[7] * inv - bfhi(zt.w));
    *(GAS v4u*)((bf16*)(F.ws + WS_CAT) + (size_t)m * D + lane * 8) = o;
}
__device__ __forceinline__ void route_phase(Frame& F, const Args& A) {
    typedef short s8v __attribute__((ext_vector_type(8)));
    const int lane = opq(hw_lane()), tok = lane & 15, kq = lane >> 4, w = F.wave, t = w * 64 + lane;
    s8v ah[4][3], al[4][3];
    { const bf16* wh = (const bf16*)(F.ws + WS_WR) + (size_t)tok * D + 128 * w + 8 * kq; const bf16* wl = wh + 48 * D;
#pragma unroll
      for (int sk = 0; sk < 4; ++sk)
#pragma unroll
          for (int q = 0; q < 3; ++q) { ah[sk][q] = *(const GAS s8v*)(wh + (size_t)q * 16 * D + 32 * sk); al[sk][q] = *(const GAS s8v*)(wl + (size_t)q * 16 * D + 32 * sk); } }
    LAS float* P = (LAS float*)(F.lds + RING_OFF);
    LAS float* R = P + 8 * 64 * 52;
    const int cid = (int)blockIdx.x, nit = M / 16;
    for (int b0 = cid; b0 < nit; b0 += 4 * F.G) {
        f32x4 acc[4][3];
        float ssq[4];
        f32x4 hc[4][2], hn[4][2];
        { const float* hrow = F.out + (size_t)(b0 * 16 + tok) * D + 128 * w + 8 * kq;
#pragma unroll
          for (int sk = 0; sk < 4; ++sk) { hc[sk][0] = *(const GAS f32x4*)(hrow + 32 * sk); hc[sk][1] = *(const GAS f32x4*)(hrow + 32 * sk + 4); } }
#pragma unroll
        for (int j = 0; j < 4; ++j) {
            const int itn = b0 + (j + 1) * F.G;
            if (j < 3 && itn < nit) { const float* hrow = F.out + (size_t)(itn * 16 + tok) * D + 128 * w + 8 * kq;
#pragma unroll
                for (int sk = 0; sk < 4; ++sk) { hn[sk][0] = *(const GAS f32x4*)(hrow + 32 * sk); hn[sk][1] = *(const GAS f32x4*)(hrow + 32 * sk + 4); } }
            acc[j][0] = (f32x4){0.f, 0.f, 0.f, 0.f}; acc[j][1] = acc[j][0]; acc[j][2] = acc[j][0]; ssq[j] = 0.f;
            if (b0 + j * F.G < nit) {
#pragma unroll
                for (int sk = 0; sk < 4; ++sk) {
                    const f32x4 h0 = hc[sk][0], h1 = hc[sk][1];
                    ssq[j] += (h0.x * h0.x + h0.y * h0.y) + (h0.z * h0.z + h0.w * h0.w) + (h1.x * h1.x + h1.y * h1.y) + (h1.z * h1.z + h1.w * h1.w);
                    const float hv[8] = {h0.x, h0.y, h0.z, h0.w, h1.x, h1.y, h1.z, h1.w};
                    s8v bh, bl;
#pragma unroll
                    for (int e8 = 0; e8 < 8; ++e8) { const unsigned hb = f2bf(hv[e8]); bh[e8] = (short)hb; bl[e8] = (short)f2bf(hv[e8] - __builtin_bit_cast(float, hb << 16)); }
#pragma unroll
                    for (int q = 0; q < 3; ++q) {
                        acc[j][q] = __builtin_amdgcn_mfma_f32_16x16x32_bf16(ah[sk][q], bh, acc[j][q], 0, 0, 0);
                        acc[j][q] = __builtin_amdgcn_mfma_f32_16x16x32_bf16(ah[sk][q], bl, acc[j][q], 0, 0, 0);
                        acc[j][q] = __builtin_amdgcn_mfma_f32_16x16x32_bf16(al[sk][q], bh, acc[j][q], 0, 0, 0);
                    }
                }
            }
#pragma unroll
            for (int sk = 0; sk < 4; ++sk) { hc[sk][0] = hn[sk][0]; hc[sk][1] = hn[sk][1]; }
        }
#pragma unroll
        for (int j = 0; j < 4; ++j) { LAS float* Pw = P + (w * 64 + j * 16 + tok) * 52;
#pragma unroll
            for (int q = 0; q < 3; ++q)
#pragma unroll
                for (int r = 0; r < 4; ++r) Pw[16 * q + 4 * kq + r] = acc[j][q][r];
            Pw[48 + kq] = ssq[j]; }
        __syncthreads();
        { const int t2 = opq(w * 64 + hw_lane());
#pragma unroll
          for (int i7 = 0; i7 < 7; ++i7) { const int idx = t2 + 512 * i7;
            if (idx < 64 * 52) { float sum = 0.f;
#pragma unroll
                for (int ww = 0; ww < 8; ++ww) sum += P[ww * (64 * 52) + idx];
                R[idx] = sum; } } }
        __syncthreads();
        if (w == 0) {
            const int ln = opq(hw_lane());
            const bool act = b0 + (ln >> 4) * F.G < nit;
            LAS unsigned* HI = (LAS unsigned*)F.MISC + MW_HIST; LAS unsigned* BA = (LAS unsigned*)F.MISC + MW_BASE;
            if (ln < NEXP) HI[ln] = 0u;
            const LAS float* tr = R + ln * 52; const int m = (b0 + (ln >> 4) * F.G) * 16 + (ln & 15);
            const float rstd = 1.f / sqrtf(((tr[48] + tr[49]) + (tr[50] + tr[51])) * (1.f / D) + RMS_EPS);
            float gl[4];
#pragma unroll
            for (int k = 0; k < 4; ++k) gl[k] = rstd * tr[k] + A.in[19][k];
            int gsel = 0; float gmax = gl[0];
#pragma unroll
            for (int k = 1; k < 4; ++k) if (gl[k] > gmax) { gmax = gl[k]; gsel = k; }
            float gden = 0.f;
#pragma unroll
            for (int k = 0; k < 4; ++k) gden += __expf(gl[k] - gmax);
            const float grp_p = 1.0f / gden;
            float el[8];
#pragma unroll
            for (int e = 0; e < 8; ++e) el[e] = rstd * tr[4 + gsel * 8 + e] + A.in[21][gsel * 8 + e];
            int i1 = 0; float m1 = el[0];
#pragma unroll
            for (int e = 1; e < 8; ++e) if (el[e] > m1) { m1 = el[e]; i1 = e; }
            int i2 = -1; float m2 = -3.0e38f;
#pragma unroll
            for (int e = 0; e < 8; ++e) if (e != i1 && el[e] > m2) { m2 = el[e]; i2 = e; }
            const float rr = __expf(m2 - m1), w1 = grp_p / (1.0f + rr), w2 = grp_p * rr / (1.0f + rr);
            const int e1 = gsel * 8 + i1, e2 = gsel * 8 + i2;
            unsigned r1 = 0u, r2 = 0u;
            if (act) { r1 = __hip_atomic_fetch_add(HI + e1, 1u, __ATOMIC_RELAXED, __HIP_MEMORY_SCOPE_WORKGROUP); r2 = __hip_atomic_fetch_add(HI + e2, 1u, __ATOMIC_RELAXED, __HIP_MEMORY_SCOPE_WORKGROUP); }
            LDS_WAIT(); asm volatile("" ::: "memory");
            if (ln < NEXP) { const unsigned hc_ = HI[ln]; BA[ln] = hc_ ? __hip_atomic_fetch_add((unsigned*)(F.ctl + CW_CNT) + 64 * ln, hc_, RLX_AGENT) : 0u; }
            LDS_WAIT(); asm volatile("" ::: "memory");
            if (act) { const unsigned p1 = BA[e1] + r1, p2 = BA[e2] + r2;
                int* LI = (int*)(F.ws + WS_LIST); float* LW = (float*)(F.ws + WS_LISTW); float* LR = (float*)(F.ws + WS_LISTR);
                LI[(size_t)e1 * M + p1] = 2 * m; LW[(size_t)e1 * M + p1] = w1; LR[(size_t)e1 * M + p1] = rstd;
                LI[(size_t)e2 * M + p2] = 2 * m + 1; LW[(size_t)e2 * M + p2] = w2; LR[(size_t)e2 * M + p2] = rstd; }
        }
        __syncthreads();
    }
}
template <class Sched> __device__ __forceinline__ void expert_setup(Frame& F, const Sched& S) {
    const int t = opq(F.wave * 64 + hw_lane());
    if (t < NEXP) F.MISC[MW_CNT + t] = __hip_atomic_load((unsigned*)(F.ctl + CW_CNT) + 64 * t, RLX_AGENT);
    __syncthreads();
    if (t < NEXP) {
        unsigned ts = 0u, nfull_before = 0u, nfull = 0u, rank = 0u; const unsigned n_me = F.MISC[MW_CNT + t], nv_me = n_me & 255u;
        for (int e = 0; e < NEXP; ++e) { const unsigned n = F.MISC[MW_CNT + e], nv = n & 255u;
            if (e < t) { ts += (n + 255u) >> 8; nfull_before += n >> 8; }
            nfull += n >> 8;
            if (nv > nv_me || (nv == nv_me && e < t)) rank += (nv > 0u) ? 1u : 0u; }
        F.MISC[MW_TSTART + t] = ts;
        if (t == NEXP - 1) F.MISC[MW_TSTART + NEXP] = ts + ((n_me + 255u) >> 8);
        for (unsigned rt = 0; rt < (n_me >> 8); ++rt) F.MISC[MW_TL + nfull_before + rt] = (unsigned)t | (rt << 5) | (256u << 12);
        if (nv_me > 0u) F.MISC[MW_TL + nfull + rank] = (unsigned)t | ((n_me >> 8) << 5) | (nv_me << 12);
    }
    __syncthreads();
    LAS unsigned* ro = (LAS unsigned*)(F.lds + ROWOFF_OFF);
    for (int i = 0; i < 4; ++i) { Unit u; if (!S.next(i, u)) break;
        const int e = u.pn >> 1, idx = ((int)u.pm - (int)F.MISC[MW_TSTART + e]) * 256 + (t & 255), n_e = (int)F.MISC[MW_CNT + e];
        if (t < 256) ro[i * 256 + t] = (idx < n_e) ? (unsigned)(((const int*)(F.ws + WS_LIST))[(size_t)e * M + idx] >> 1) * (unsigned)(D * 2) : 0u; }
    __syncthreads();
}
template <int R> __device__ __forceinline__ void moe_combine_rows(Frame& F, const Args& A, int m0, int stride) {
    const int lane = opq(hw_lane());
    const GAS f32x4* gr = (const GAS f32x4*)A.in[25] + lane;
    f32x4 v[R][4]; v2u a[R][4], b[R][4];
#pragma unroll
    for (int r = 0; r < R; ++r) { const size_t m = (size_t)(m0 + r * stride);
#pragma unroll
        for (int j = 0; j < 4; ++j) { v[r][j] = *((const GAS f32x4*)(F.out + m * D) + lane + 64 * j);
            a[r][j] = *((const GAS v2u*)((const bf16*)(F.ws + WS_MO0) + m * D) + lane + 64 * j); b[r][j] = *((const GAS v2u*)((const bf16*)(F.ws + WS_MO1) + m * D) + lane + 64 * j); } }
#pragma unroll
    for (int r = 0; r < R; ++r) { const size_t m = (size_t)(m0 + r * stride); float s = 0.f;
        GAS f32x4* hr = (GAS f32x4*)(F.out + m * D) + lane; GAS unsigned long long* o8 = (GAS unsigned long long*)((bf16*)(F.ws + WS_XN) + m * D) + lane;
#pragma unroll
        for (int j = 0; j < 4; ++j) { f32x4& x = v[r][j];
            x.x += bflo(a[r][j].x) + bflo(b[r][j].x); x.y += bfhi(a[r][j].x) + bfhi(b[r][j].x); x.z += bflo(a[r][j].y) + bflo(b[r][j].y); x.w += bfhi(a[r][j].y) + bfhi(b[r][j].y);
            hr[64 * j] = x; s += (x.x * x.x + x.y * x.y) + (x.z * x.z + x.w * x.w); }
        const float rstd = 1.f / sqrtf(wave_sum(s) * (1.f / D) + RMS_EPS);
#pragma unroll
        for (int j = 0; j < 4; ++j) { const f32x4 gg = gr[64 * j], x = v[r][j];
            o8[64 * j] = (unsigned long long)pk2(x.x * rstd * gg.x, x.y * rstd * gg.y) | ((unsigned long long)pk2(x.z * rstd * gg.z, x.w * rstd * gg.w) << 32); } }
}
template <int R, bool ADDG> __device__ __forceinline__ void final_rows(Frame& F, const Args& A, int m0, int stride) {
    const int lane = opq(hw_lane());
    const GAS f32x4* gr = (const GAS f32x4*)A.in[29] + lane;
    f32x4 v[R][4]; v2u gg[R][4];
#pragma unroll
    for (int r = 0; r < R; ++r) { const size_t m = (size_t)(m0 + r * stride);
#pragma unroll
        for (int j = 0; j < 4; ++j) { v[r][j] = *((const GAS f32x4*)(F.out + m * D) + lane + 64 * j);
            if (ADDG) gg[r][j] = *((const GAS v2u*)((const bf16*)(F.ws + WS_PE) + m * D) + lane + 64 * j); } }
#pragma unroll
    for (int r = 0; r < R; ++r) { const size_t m = (size_t)(m0 + r * stride); float s = 0.f;
        GAS f32x4* hr = (GAS f32x4*)(F.out + m * D) + lane;
#pragma unroll
        for (int j = 0; j < 4; ++j) { f32x4& x = v[r][j];
            if (ADDG) { x.x += bflo(gg[r][j].x); x.y += bfhi(gg[r][j].x); x.z += bflo(gg[r][j].y); x.w += bfhi(gg[r][j].y); }
            s += (x.x * x.x + x.y * x.y) + (x.z * x.z + x.w * x.w); }
        const float rstd = 1.f / sqrtf(wave_sum(s) * (1.f / D) + RMS_EPS);
#pragma unroll
        for (int j = 0; j < 4; ++j) hr[64 * j] = v[r][j] * rstd * gr[64 * j]; }
}

__global__ void __launch_bounds__(NWAVES * 64, 2) mk_fwd(Args args) {
    extern __shared__ __attribute__((aligned(16))) unsigned char lds[];
    Frame F;
    F.lds = (LAS unsigned char*)lds;
    F.MISC = (volatile LAS unsigned*)(F.lds + MISC_OFF);
    F.wave = __builtin_amdgcn_readfirstlane(threadIdx.x >> 6);
    F.G = gridDim.x; F.gw = blockIdx.x * NWAVES + F.wave; F.ngw = F.G * NWAVES;
    F.out = args.out; F.ws = args.ws; F.ctl = (gu32*)(args.ws + WS_CTL);
    for (int u = threadIdx.x; u < (LDS_BYTES - LDSCTL_OFF) / 4; u += NWAVES * 64) ((LAS unsigned*)(F.lds + LDSCTL_OFF))[u] = 0u;
    __syncthreads();
    XcdBarrier bar = xcd_barrier_post((unsigned*)(F.ctl + CW_BAR), F.MISC + 8); bar.wave = F.wave;
#define GRID_BAR() xcd_barrier(bar)
    bf16* const WIN = (bf16*)(F.ws + WS_WIN); bf16* const GLU = (bf16*)(F.ws + WS_GLU); bf16* const WCAT = (bf16*)(F.ws + WS_WCAT); bf16* const WG = (bf16*)(F.ws + WS_WG); bf16* const WPLE = (bf16*)(F.ws + WS_WPLE);
    bf16* const WGU = (bf16*)(F.ws + WS_WGU); bf16* const WD = (bf16*)(F.ws + WS_WD); bf16* const MS = (bf16*)(F.ws + WS_MS); bf16* const WS3 = (bf16*)(F.ws + WS_WS3);
    bf16* const XN = (bf16*)(F.ws + WS_XN); bf16* const ZP = (bf16*)(F.ws + WS_ZP); bf16* const AS = (bf16*)(F.ws + WS_AS); float* const SLOC = (float*)(F.ws + WS_SLOC);
    bf16* const CAT = (bf16*)(F.ws + WS_CAT); bf16* const ZZ = (bf16*)(F.ws + WS_ZZ); bf16* const PB = (bf16*)(F.ws + WS_PB); bf16* const PE = (bf16*)(F.ws + WS_PE);
    bf16* const ACT = (bf16*)(F.ws + WS_ACT); bf16* const MO0 = (bf16*)(F.ws + WS_MO0); bf16* const MO1 = (bf16*)(F.ws + WS_MO1);
    const int cid = (int)blockIdx.x;

    p0_prologue(F, args);
    GRID_BAR();
    { pg8::Gemm g{XN, WIN, D, D, D}; pg8::StaticOrder S; S.init(M, D, F.G, cid); EpiZ E{ZP, AS};
      pg8::gemm_phase<EpiZ, pg8::StaticOrder, true, true>(F.lds + RING_OFF, g, S, E, F.wave); }
    GRID_BAR();
    { pg8::Gemm g{AS, MS, 256, 512, 256}; GroupOrder S{F.G, cid}; EpiSloc E{SLOC};
      pg8::gemm_phase<EpiSloc, GroupOrder, true, true>(F.lds + RING_OFF, g, S, E, F.wave); }
    { pg8::Gemm g{(const bf16*)(F.ws + WS_WOS), (const bf16*)(F.ws + WS_BD), 256, 256, 256}; WeffOrder S{F.G, cid}; EpiWeff E{WCAT};
      pg8::gemm_phase<EpiWeff, WeffOrder, true, true>(F.lds + RING_OFF, g, S, E, F.wave); }
    bg_range(F, args, 1400, 2000, 0, 0);
    GRID_BAR();
    {
        if (F.G >= 256) { if (cid < 128) { carry_unit(F, cid); for (int m = 12288 + cid * NWAVES + F.wave; m < M; m += 128 * NWAVES) diff_row(F, m); }
                          else for (int m = (cid - 128) * NWAVES + F.wave; m < 12288; m += (F.G - 128) * NWAVES) diff_row(F, m); }
        else { for (int u = cid; u < 128; u += F.G) carry_unit(F, u); for (int m = F.gw; m < M; m += F.ngw) diff_row(F, m); }
    }
    GRID_BAR();
    { pg8::Gemm g{AS, WS3, 512, 512, 512}; GroupOrder S{F.G, cid}; EpiY E{ZZ};
      pg8::gemm_phase<EpiY, GroupOrder, true, true>(F.lds + RING_OFF, g, S, E, F.wave); }
    bg_range(F, args, 2000, 5000, 0, M / 2);
    GRID_BAR();
    { pg8::Gemm g{ZZ, GLU, DP, DP, DP}; pg8::StaticOrder S; S.init(M, DP, F.G, cid); EpiGlu E{ZZ, args.in[15], CAT};
      pg8::gemm_phase<EpiGlu, pg8::StaticOrder, true, true>(F.lds + RING_OFF, g, S, E, F.wave); }
    bg_range(F, args, 5000, BG_TOTAL, M / 2, M);
    GRID_BAR();
    { pg8::Gemm g{CAT, WCAT, D, D, D}; pg8::StaticOrder S; S.init(M, D, F.G, cid); EpiRes E{args.in[0], F.out, args.in[17], XN};
      pg8::gemm_phase<EpiRes, pg8::StaticOrder, true, true>(F.lds + RING_OFF, g, S, E, F.wave); }
    GRID_BAR();
    route_phase(F, args);
    bg_range(F, args, 0, 1400, 0, 0, true);
    GRID_BAR();
    { pg8::Gemm g{XN, WGU, D, D, D}; ExpertOrder<2> S{F.G, cid, F.MISC}; expert_setup(F, S);
      EpiAct E{(const float*)(F.ws + WS_LISTW), (const float*)(F.ws + WS_LISTR), ACT, F.MISC + 16};
      pg8::gemm_phase<EpiAct, ExpertOrder<2>, true, true, true, true>(F.lds + RING_OFF, g, S, E, F.wave, (const LAS unsigned*)(F.lds + ROWOFF_OFF)); }
    { const int nun = 2 * __builtin_amdgcn_readfirstlane((int)F.MISC[MW_TSTART + NEXP]), n2 = (nun > F.G && nun < 2 * F.G) ? nun - F.G : 0;
      pg8::Gemm g{PB, WPLE, DPLE, DPLE, DPLE}; PeOrder S{F.G, cid, n2}; EpiPe E{PE};
      pg8::gemm_phase<EpiPe, PeOrder, true, true>(F.lds + RING_OFF, g, S, E, F.wave); }
    GRID_BAR();
    { pg8::Gemm g{ACT, WD, DF, DF, DF}; ExpertOrder<4> S{F.G, cid, F.MISC}; EpiDown E{(const int*)(F.ws + WS_LIST), (const unsigned*)(F.ctl + CW_CNT), MO0, MO1, F.MISC + 16};
      pg8::gemm_phase<EpiDown, ExpertOrder<4>, true, true, false, true>(F.lds + RING_OFF, g, S, E, F.wave); }
    GRID_BAR();
    for (int m = F.gw; m + F.ngw < M; m += 2 * F.ngw) moe_combine_rows<2>(F, args, m, F.ngw);
    GRID_BAR();
    { pg8::Gemm g{XN, WG, D, D, D}; pg8::StaticOrder S; S.init(M, D, F.G, cid); EpiGate E{args.in[27], PE};
      pg8::gemm_phase<EpiGate, pg8::StaticOrder, true, true>(F.lds + RING_OFF, g, S, E, F.wave); }
    GRID_BAR();
    for (int m = F.gw; m + 3 * F.ngw < M; m += 4 * F.ngw) final_rows<4, true>(F, args, m, F.ngw);
}

extern "C" void kernel_launch(void* const* d_in, const int* in_sizes, int n_in, void* d_out, int out_size, void* d_ws, size_t ws_size, hipStream_t stream) {
    static int grid = 0;
    if (grid == 0) {
        if (n_in != 30 || in_sizes[0] != M * D || out_size != M * D || ws_size < WS_END) { fprintf(stderr, "kernel_launch: unexpected shapes (n_in %d, in0 %d, out %d, ws %zu)\n", n_in, n_in > 0 ? in_sizes[0] : -1, out_size, ws_size); grid = -1; return; }
        int dev = 0, cus = 0, per_cu = 0;
        if (hipGetDevice(&dev) != hipSuccess || hipDeviceGetAttribute(&cus, hipDeviceAttributeMultiprocessorCount, dev) != hipSuccess) { grid = -1; return; }
        if (hipFuncSetAttribute((const void*)mk_fwd, hipFuncAttributeMaxDynamicSharedMemorySize, LDS_BYTES) != hipSuccess) { fprintf(stderr, "kernel_launch: hipFuncSetAttribute failed\n"); grid = -1; return; }
        if (hipOccupancyMaxActiveBlocksPerMultiprocessor(&per_cu, (const void*)mk_fwd, NWAVES * 64, LDS_BYTES) != hipSuccess || per_cu < 1) { fprintf(stderr, "kernel_launch: occupancy query reports %d blocks per CU\n", per_cu); }
        (void)hipGetLastError();
        grid = cus;
    }
    if (grid < 0) return;
    (void)hipMemsetAsync((char*)d_ws + WS_CTL, 0, CTL_ZERO_BYTES, stream);
    Args a{};
    for (int i = 0; i < 30; ++i) a.in[i] = (const float*)d_in[i];
    a.out = (float*)d_out; a.ws = (unsigned char*)d_ws;
    hipLaunchKernelGGL(mk_fwd, dim3(grid), dim3(NWAVES * 64), LDS_BYTES, stream, a);
}
```

```cpp
#include <hip/hip_runtime.h>
#include <cstdio>
#include <cstdint>
__device__ __forceinline__ int hw_lane() { int l; asm volatile("v_mbcnt_lo_u32_b32 %0, -1, 0\n\tv_mbcnt_hi_u32_b32 %0, -1, %0" : "=v"(l)); return l; }
namespace pg8 {
#define PG8_LAS __attribute__((address_space(3)))
typedef unsigned short bf16_t;
typedef short bf16x8 __attribute__((ext_vector_type(8)));
typedef float f32x4 __attribute__((ext_vector_type(4)));
typedef unsigned u32x4 __attribute__((ext_vector_type(4)));
constexpr int BM = 256, BK = 64, HALF = 128, HTB = HALF * BK * 2  , STAGE_BYTES = 8 * HTB, NXCD = 8, WGM = 8;

__host__ __device__ __forceinline__ int lds_byte(int r, int c) { const int st = (r >> 4) * 2 + (c >> 5), rr = r & 15, cc = c & 31, ob = rr * 64 + cc * 2; return st * 1024 + (ob ^ (((ob >> 9) & 1) << 5)); }
__host__ __device__ __forceinline__ void stage_rc(int b, int& R, int& C) { const int st = b / 1024, sb = b % 1024, swz = sb ^ (((sb >> 9) & 1) << 5); R = (st >> 1) * 16 + swz / 64; C = (st & 1) * 32 + (swz % 64) / 2; }
__host__ __device__ __forceinline__ int perm32(int rho) { const int n = rho >> 4, i = rho & 15; return 8 * (i >> 2) + 4 * n + (i & 3); }

struct Unit { int pm, pn, nv; };
struct Gemm { const bf16_t* A; const bf16_t* Bt; int K, lda, ldb; };

struct StaticOrder {
    int nM, nN, nwg, G, c;
    __host__ __device__ void init(int M, int N, int G_, int c_) { nM = M / BM; nN = N / BM; nwg = nM * nN; G = G_; c = c_; }
    __host__ __device__ bool next(int i, Unit& u) const {
        const long L = (long)i * G + c; if (L >= nwg) return false;
        int wgid = (int)L; { const int q = nwg / NXCD, r = nwg % NXCD, xcd = wgid % NXCD, off = wgid / NXCD; wgid = (xcd < r ? xcd * (q + 1) : r * (q + 1) + (xcd - r) * q) + off; }
        const int nig = WGM * nN, gid = wgid / nig, fm = gid * WGM, gsz = (nM - fm) < WGM ? (nM - fm) : WGM;
        u.pm = fm + ((wgid % nig) % gsz); u.pn = (wgid % nig) / gsz; u.nv = 256; return true;
    }
    __device__ __forceinline__ void a_ready(const Unit&) const {}
    __device__ __forceinline__ void done(const Unit&) const {}
};

template <class Epi, class Sched, bool ALIGN_EPI = false, bool SP2 = false, bool GATHER = false, bool SKIP = false>
__device__ __forceinline__ void gemm_phase(PG8_LAS unsigned char* lds, const Gemm g, const Sched& S, const Epi& E, const int wid  , const PG8_LAS unsigned* rowoff = nullptr) {
    static_assert(!GATHER || SP2, "GATHER is written for the SP2 loop");
    int lane_ = hw_lane(); asm volatile("" : "+v"(lane_));
    const int lane = lane_, tid = wid * 64 + lane, wr = wid >> 2, wc = wid & 3, fr = lane & 15, fq = lane >> 4;
    const int K = g.K, nt = K / BK;
    unsigned voffA[2], voffB[2];
#pragma unroll
    for (int i = 0; i < 2; ++i) { int R, C; stage_rc(tid * 16 + i * 8192, R, C); const int Rb = Epi::PERM ? ((R & ~31) + perm32(R & 31)) : R;
        voffA[i] = (unsigned)(R * g.lda + C) * 2u; voffB[i] = (unsigned)(Rb * g.ldb + C) * 2u; }
    const size_t kstep = (size_t)(BK * 2);
    const size_t hstepA = GATHER ? (size_t)0 : (size_t)HALF * g.lda * 2, hstepB = (size_t)HALF * g.ldb * 2;
    const size_t tstepA = 2 * hstepA, tstepB = 2 * hstepB;
    const unsigned ldsw = (unsigned)wid * 1024u;
    const int aoff = lds_byte(wr * 64 + fr, fq * 8), boff = lds_byte(wc * 32 + fr, fq * 8);
    unsigned cvo[2][2];
#define PG8_LOADVO(dst, u_) do { _Pragma("unroll") for (int _h = 0; _h < 2; ++_h) _Pragma("unroll") for (int _i = 0; _i < 2; ++_i) { int R_, C_; stage_rc(tid * 16 + _i * 8192, R_, C_); \
        dst[_h][_i] = rowoff[(u_) * 256 + _h * 128 + R_] + (unsigned)C_ * 2u; } } while (0)
#define PG8_VA(h) (GATHER ? cvo[h] : voffA)
#define PG8_SA(b, h) (((b) * 2 + (h)) * HTB)
#define PG8_SB(b, h) ((4 + (b) * 2 + (h)) * HTB)
#define PG8_STAGE(bufoff, gbase, voff) do { _Pragma("unroll") for (int _i = 0; _i < 2; ++_i) \
        __builtin_amdgcn_global_load_lds((const unsigned*)((const char*)(gbase) + (voff)[_i]), (PG8_LAS unsigned*)(lds + (bufoff) + ldsw + _i * 8192), 16, 0, 0); } while (0)
#define PG8_LDA(dst, b, h) do { _Pragma("unroll") for (int m = 0; m < 4; ++m) _Pragma("unroll") for (int k = 0; k < 2; ++k) dst[m][k] = *(const PG8_LAS bf16x8*)(lds + PG8_SA(b, h) + aoff + m * 2048 + k * 1024); } while (0)
#define PG8_LDB(dst, b, h) do { _Pragma("unroll") for (int n = 0; n < 2; ++n) _Pragma("unroll") for (int k = 0; k < 2; ++k) dst[n][k] = *(const PG8_LAS bf16x8*)(lds + PG8_SB(b, h) + boff + n * 2048 + k * 1024); } while (0)
#define PG8_MMA(ai, bj, At, Bt) do { if (SKIP && (ai) * HALF + wr * 64 >= cur.nv) break; __builtin_amdgcn_s_setprio(1); _Pragma("unroll") for (int m = 0; m < 4; ++m) _Pragma("unroll") for (int n = 0; n < 2; ++n) _Pragma("unroll") for (int k = 0; k < 2; ++k) \
        acc[ai][bj][m][n] = __builtin_amdgcn_mfma_f32_16x16x32_bf16(Bt[n][k], At[m][k], acc[ai][bj][m][n], 0, 0, 0); __builtin_amdgcn_s_setprio(0); } while (0)
#define PG8_WAIT_V(n) asm volatile("s_waitcnt vmcnt(" #n ")" ::: "memory")
#define PG8_WAIT_L(n) asm volatile("s_waitcnt lgkmcnt(" #n ")" ::: "memory")
#define PG8_BAR __builtin_amdgcn_s_barrier()
#define PG8_SCHED __builtin_amdgcn_sched_barrier(0)
    Unit cur, nxt; int ui = 0;
    if (!S.next(0, cur)) return;
    f32x4 acc[2][2][4][2];
#pragma unroll
    for (int a = 0; a < 2; ++a)
#pragma unroll
        for (int b = 0; b < 2; ++b)
#pragma unroll
            for (int m = 0; m < 4; ++m)
#pragma unroll
                for (int n = 0; n < 2; ++n) acc[a][b][m][n] = (f32x4){0.f, 0.f, 0.f, 0.f};
    bf16x8 At[4][2], B0[2][2], B1[2][2];
    const char* cA = (const char*)g.A + (size_t)cur.pm * tstepA; const char* cB = (const char*)g.Bt + (size_t)cur.pn * tstepB;
    S.a_ready(cur);
    if constexpr (GATHER) PG8_LOADVO(cvo, 0);
    if constexpr (SP2) {
        PG8_STAGE(PG8_SB(0, 0), cB, voffB); PG8_STAGE(PG8_SB(0, 1), cB + hstepB, voffB); PG8_STAGE(PG8_SA(0, 0), cA, PG8_VA(0)); PG8_STAGE(PG8_SA(0, 1), cA + hstepA, PG8_VA(1));
        if (wr == 1) PG8_BAR;
        PG8_WAIT_V(2); PG8_BAR;
        PG8_STAGE(PG8_SB(1, 0), cB + kstep, voffB); PG8_STAGE(PG8_SA(1, 0), cA + kstep, PG8_VA(0)); PG8_STAGE(PG8_SB(1, 1), cB + hstepB + kstep, voffB);
        PG8_WAIT_V(6); PG8_BAR;
    } else {
        PG8_STAGE(PG8_SB(0, 0), cB, voffB); PG8_STAGE(PG8_SA(0, 0), cA, voffA); PG8_STAGE(PG8_SB(0, 1), cB + hstepB, voffB); PG8_STAGE(PG8_SA(0, 1), cA + hstepA, voffA);
        if (wr == 1) PG8_BAR;
        PG8_WAIT_V(4); PG8_BAR;
        PG8_STAGE(PG8_SB(1, 0), cB + kstep, voffB); PG8_STAGE(PG8_SA(1, 0), cA + kstep, voffA); PG8_STAGE(PG8_SB(1, 1), cB + hstepB + kstep, voffB);
        PG8_WAIT_V(6); PG8_BAR;
    }
    for (;;) {
        const bool has_next = S.next(ui + 1, nxt);
        const char* nA = has_next ? (const char*)g.A + (size_t)nxt.pm * tstepA : cA; const char* nB = has_next ? (const char*)g.Bt + (size_t)nxt.pn * tstepB : cB;
        for (int t = 0; t < nt; t += 2) {
            const bool last = (t == nt - 2);
            const char* a1 = cA + (size_t)(t + 1) * kstep;
            const char* a2 = last ? nA : cA + (size_t)(t + 2) * kstep; const char* b2 = last ? nB : cB + (size_t)(t + 2) * kstep;
            const char* a3 = a2 + kstep; const char* b3 = b2 + kstep;
            if (last && has_next) S.a_ready(nxt);
            if constexpr (SP2) {
            PG8_LDB(B0, 0, 0); PG8_LDB(B1, 0, 1); PG8_SCHED; PG8_LDA(At, 0, 0); PG8_STAGE(PG8_SA(1, 1), a1 + hstepA, PG8_VA(1));
            if constexpr (GATHER) { if (last && has_next) PG8_LOADVO(cvo, ui + 1); }
            PG8_WAIT_V(8); PG8_WAIT_L(0); PG8_BAR; PG8_MMA(0, 0, At, B0); PG8_MMA(0, 1, At, B1); PG8_BAR; PG8_SCHED;
            PG8_LDA(At, 0, 1); PG8_STAGE(PG8_SB(0, 0), b2, voffB); PG8_STAGE(PG8_SB(0, 1), b2 + hstepB, voffB); PG8_STAGE(PG8_SA(0, 0), a2, PG8_VA(0));
            PG8_WAIT_V(8); PG8_WAIT_L(0); PG8_BAR; PG8_MMA(1, 0, At, B0); PG8_MMA(1, 1, At, B1); PG8_BAR; PG8_SCHED;
            PG8_LDB(B0, 1, 0); PG8_LDB(B1, 1, 1); PG8_SCHED; PG8_LDA(At, 1, 0); PG8_STAGE(PG8_SA(0, 1), a2 + hstepA, PG8_VA(1));
            PG8_WAIT_V(8); PG8_WAIT_L(0); PG8_BAR; PG8_MMA(0, 0, At, B0); PG8_MMA(0, 1, At, B1); PG8_BAR; PG8_SCHED;
            PG8_LDA(At, 1, 1); PG8_STAGE(PG8_SB(1, 0), b3, voffB); PG8_STAGE(PG8_SB(1, 1), b3 + hstepB, voffB); PG8_STAGE(PG8_SA(1, 0), a3, PG8_VA(0));
            PG8_WAIT_V(8); PG8_WAIT_L(0); PG8_BAR; PG8_MMA(1, 0, At, B0); PG8_MMA(1, 1, At, B1); PG8_BAR; PG8_SCHED;
            } else {
            PG8_LDB(B0, 0, 0); PG8_SCHED; PG8_LDA(At, 0, 0); PG8_STAGE(PG8_SA(1, 1), a1 + hstepA, voffA);
            PG8_WAIT_L(8); PG8_BAR; PG8_WAIT_L(0); PG8_MMA(0, 0, At, B0); PG8_BAR; PG8_SCHED;
            PG8_LDB(B1, 0, 1); PG8_STAGE(PG8_SB(0, 0), b2, voffB);
            PG8_BAR; PG8_WAIT_L(0); PG8_MMA(0, 1, At, B1); PG8_BAR;
            PG8_LDA(At, 0, 1); PG8_STAGE(PG8_SA(0, 0), a2, voffA);
            PG8_BAR; PG8_WAIT_L(0); PG8_MMA(1, 0, At, B0); PG8_BAR; PG8_SCHED;
            PG8_STAGE(PG8_SB(0, 1), b2 + hstepB, voffB);
            PG8_WAIT_V(6); PG8_BAR; PG8_MMA(1, 1, At, B1); PG8_BAR;
            PG8_LDB(B0, 1, 0); PG8_SCHED; PG8_LDA(At, 1, 0); PG8_STAGE(PG8_SA(0, 1), a2 + hstepA, voffA);
            PG8_WAIT_L(8); PG8_BAR; PG8_WAIT_L(0); PG8_MMA(0, 0, At, B0); PG8_BAR; PG8_SCHED;
            PG8_LDB(B1, 1, 1); PG8_STAGE(PG8_SB(1, 0), b3, voffB);
            PG8_BAR; PG8_WAIT_L(0); PG8_MMA(0, 1, At, B1); PG8_BAR;
            PG8_LDA(At, 1, 1); PG8_STAGE(PG8_SA(1, 0), a3, voffA);
            PG8_BAR; PG8_WAIT_L(0); PG8_MMA(1, 0, At, B0); PG8_BAR; PG8_SCHED;
            PG8_STAGE(PG8_SB(1, 1), b3 + hstepB, voffB);
            PG8_WAIT_V(6); PG8_BAR; PG8_MMA(1, 1, At, B1); PG8_BAR;
            }
        }
        if constexpr (ALIGN_EPI) { if (wr == 0) PG8_BAR; }
        if constexpr (!Epi::AFTER_DRAIN) { E(acc, cur, wr, wc, fr, fq); S.done(cur); }
        if (!has_next) break;
#pragma unroll
        for (int a = 0; a < 2; ++a)
#pragma unroll
            for (int b = 0; b < 2; ++b)
#pragma unroll
                for (int m = 0; m < 4; ++m)
#pragma unroll
                    for (int n = 0; n < 2; ++n) acc[a][b][m][n] = (f32x4){0.f, 0.f, 0.f, 0.f};
        cur = nxt; cA = nA; cB = nB; ++ui;
        if constexpr (ALIGN_EPI) { if (wr == 1) PG8_BAR; }
    }
    PG8_WAIT_V(0);
    if constexpr (!ALIGN_EPI) { if (wr == 0) PG8_BAR; }
    PG8_BAR;
    if constexpr (Epi::AFTER_DRAIN) { E.fused(acc, cur, wr, wc, fr, fq, lds, wid, lane); S.done(cur); }
#undef PG8_SA
#undef PG8_LOADVO
#undef PG8_VA
#undef PG8_SB
#undef PG8_STAGE
#undef PG8_LDA
#undef PG8_LDB
#undef PG8_MMA
#undef PG8_WAIT_V
#undef PG8_WAIT_L
#undef PG8_BAR
#undef PG8_SCHED
}
}

constexpr int NWAVES = 8;
constexpr int M = 16384, D = 1024, SEQ = 8192, DP = 512, NG = 32, NST = 64, GC = 16, CL = 16  ;
constexpr int NCH = M / CL;
constexpr int NEXP = 32, DF = 256, DPLE = 256;
constexpr int ACT_ROWS = 2 * M + NEXP * 256;
constexpr float RMS_EPS = 1e-6f;

constexpr size_t MiB = 1u << 20;
constexpr size_t WS_CTL = 0, CTL_ZERO_BYTES = 1 * MiB;
constexpr size_t WS_WR = 1 * MiB;
constexpr size_t WS_LAMT = 1 * MiB + 256 * 1024;
constexpr size_t WS_WIN = 2 * MiB, WS_GLU = 4 * MiB, WS_WCAT = 5 * MiB, WS_WG = 7 * MiB, WS_WPLE = 9 * MiB;
constexpr size_t WS_WGU = 10 * MiB, WS_WD = 42 * MiB;
constexpr size_t WS_MS = 58 * MiB, WS_WS3 = 62 * MiB;
constexpr size_t WS_ZZ = 70 * MiB;
constexpr size_t WS_PE = 58 * MiB;
constexpr size_t WS_XN = 90 * MiB;
constexpr size_t WS_ZP = 122 * MiB, WS_AS = 138 * MiB, WS_SLOC = 170 * MiB, WS_CAT = 202 * MiB, WS_PB = 234 * MiB;
constexpr size_t WS_ACT = 202 * MiB, WS_MO0 = 122 * MiB, WS_MO1 = 154 * MiB;
constexpr size_t WS_LIST = 244 * MiB, WS_LISTW = 246 * MiB, WS_LISTR = 248 * MiB;
constexpr size_t WS_WOS = 242 * MiB, WS_BD = 243 * MiB;
constexpr size_t WS_END = 256 * MiB;
static_assert(WS_MO1 + (size_t)M * D * 2 <= WS_ACT && WS_ACT + (size_t)ACT_ROWS * 512 <= WS_PB && WS_PB + (size_t)M * 512 <= WS_WOS && WS_LISTR + (size_t)NEXP * M * 4 <= WS_END, "ws map");
constexpr int CW_CNT = 8192;
constexpr int CW_BAR = 4096;
constexpr int ROWOFF_OFF = 143360;
constexpr int RING_OFF = 0, RING_BYTES = 131072, P0_SCR = 64 * 65 * 4  , LDSCTL_OFF = 139264, MISC_OFF = LDSCTL_OFF + 320, LDS_BYTES = 147456;
static_assert(NWAVES * P0_SCR <= LDSCTL_OFF && MISC_OFF + 4 * 512 <= ROWOFF_OFF && ROWOFF_OFF + 4 * 1024 <= LDS_BYTES, "LDS map");
constexpr int MW_TSTART = 16, MW_HIST = 64, MW_BASE = 96, MW_CNT = 128, MW_TL = 192;

#define GAS __attribute__((address_space(1)))
#define LAS __attribute__((address_space(3)))
typedef unsigned short bf16;
typedef unsigned v4u __attribute__((ext_vector_type(4)));
typedef unsigned v2u __attribute__((ext_vector_type(2)));
typedef float f32x4 __attribute__((ext_vector_type(4)));
typedef GAS unsigned gu32;
#define RLX_AGENT __ATOMIC_RELAXED, __HIP_MEMORY_SCOPE_AGENT
#define LDS_WAIT() asm volatile("s_waitcnt lgkmcnt(0)" ::: "memory")
#define VM_WAIT() asm volatile("s_waitcnt vmcnt(0)" ::: "memory")
__device__ __forceinline__ unsigned f2bf(float f) { unsigned u = __builtin_bit_cast(unsigned, f); return (u + 0x7fffu + ((u >> 16) & 1u)) >> 16; }
__device__ __forceinline__ unsigned pk2(float lo, float hi) { return f2bf(lo) | (f2bf(hi) << 16); }
__device__ __forceinline__ float bflo(unsigned w) { return __builtin_bit_cast(float, w << 16); }
__device__ __forceinline__ float bfhi(unsigned w) { return __builtin_bit_cast(float, w & 0xffff0000u); }
__device__ __forceinline__ float sigmoidf_(float x) { return __builtin_amdgcn_rcpf(1.0f + __expf(-x)); }
__device__ __forceinline__ float gelu_tanh(float y) { const float t = 1.5957691216f * (y + 0.044715f * y * y * y); return y * __builtin_amdgcn_rcpf(1.0f + __expf(-t)); }

#define XB_TMO      128
#define XB_XCNT(j)  (256  + 64 * (j))
#define XB_XSUB(j)  (1280 + 64 * (j))
#define XB_XGEN(j)  (2304 + 64 * (j))
#define XB_TOP      3328
#define XB_TOPGEN   3392
#define XCD_BAR_WORDS 3456
#define XB_SPIN_CAP (1u << 18)
__device__ __forceinline__ unsigned xb_ld(unsigned* p)              { return __hip_atomic_load(p, __ATOMIC_RELAXED, __HIP_MEMORY_SCOPE_AGENT); }
__device__ __forceinline__ unsigned xb_add(unsigned* p, unsigned v) { return __hip_atomic_fetch_add(p, v, __ATOMIC_RELAXED, __HIP_MEMORY_SCOPE_AGENT); }
__device__ __forceinline__ unsigned xb_xcc_id() { return (unsigned)__builtin_amdgcn_s_getreg((3 << 11) | 20) & 0xFu; }
#define XB_SPIN(cond, bar) do { unsigned _sp = 0; while (cond) { __builtin_amdgcn_s_sleep(1); \
    if ((++_sp & 255u) == 0u) { if (xb_ld(&(bar)[XB_TMO])) break; if (_sp > XB_SPIN_CAP) { atomicAdd(&(bar)[XB_TMO], 1u); break; } } } } while (0)
struct XcdBarrier { unsigned* bar; unsigned x; volatile LAS unsigned* st; int wave; };
__device__ __forceinline__ XcdBarrier xcd_barrier_post(unsigned* bar, volatile LAS unsigned* st) {
    XcdBarrier b; b.bar = bar; b.x = xb_xcc_id(); b.st = st; b.wave = 0;
    if (threadIdx.x == 0) (void)xb_add(&bar[XB_XCNT(b.x)], 1u);
    return b;
}
__device__ __forceinline__ void xcd_barrier_complete(unsigned* bar, unsigned x, unsigned& nloc, unsigned& nx) {
    const unsigned G = gridDim.x * gridDim.y * gridDim.z;
    unsigned sum, cnt, mine, sp = 0u;
    for (;;) {
        sum = 0u; cnt = 0u; mine = 0u;
#pragma unroll
        for (unsigned j = 0; j < 16; ++j) { const unsigned c = xb_ld(&bar[XB_XCNT(j)]); sum += c; cnt += (c > 0u) ? 1u : 0u; mine = (j == x) ? c : mine; }
        if (sum == G) break;
        __builtin_amdgcn_s_sleep(1);
        if ((++sp & 255u) == 0u) { if (xb_ld(&bar[XB_TMO])) break; if (sp > XB_SPIN_CAP) { atomicAdd(&bar[XB_TMO], 1u); break; } }
    }
    nloc = mine > 0u ? mine : 1u; nx = cnt > 0u ? cnt : 1u;
}
__device__ __forceinline__ void xcd_barrier(const XcdBarrier& b) {
    asm volatile("s_waitcnt vmcnt(0)" ::: "memory");
    __syncthreads();
    if (b.wave == 0 && hw_lane() == 0) {
        unsigned* bar = b.bar;
        __builtin_amdgcn_s_waitcnt(0);
        unsigned nloc = b.st[0], nx = b.st[1];
        if (nloc == 0u) { xcd_barrier_complete(bar, b.x, nloc, nx); b.st[0] = nloc; b.st[1] = nx; }
        const unsigned old = xb_add(&bar[XB_XSUB(b.x)], 1u);
        const unsigned gen = old / nloc;
        if (old + 1u == (gen + 1u) * nloc) {
            __builtin_amdgcn_fence(__ATOMIC_RELEASE, "agent");
            asm volatile("s_waitcnt vmcnt(0)" ::: "memory");
            const unsigned og = xb_add(&bar[XB_TOP], 1u);
            const unsigned tg = og / nx;
            if (og + 1u == (tg + 1u) * nx) xb_add(&bar[XB_TOPGEN], 1u);
            else XB_SPIN(xb_ld(&bar[XB_TOPGEN]) == tg, bar);
            __builtin_amdgcn_fence(__ATOMIC_ACQUIRE, "agent");
            xb_add(&bar[XB_XGEN(b.x)], 1u);
            asm volatile("s_waitcnt vmcnt(0)" ::: "memory");
        } else {
            XB_SPIN(xb_ld(&bar[XB_XGEN(b.x)]) == gen, bar);
            __builtin_amdgcn_fence(__ATOMIC_ACQUIRE, "agent");
            asm volatile("s_waitcnt vmcnt(0)" ::: "memory");
        }
    }
    __syncthreads();
}

struct Args { const float* in[30]; float* out; unsigned char* ws; };
struct Frame {
    LAS unsigned char* lds;
    volatile LAS unsigned* MISC;
    gu32* ctl;
    int wave, G, gw, ngw;
    float* out;
    unsigned char* ws;
};
__device__ __forceinline__ int opq(int v) { asm volatile("" : "+v"(v)); return v; }
template <int CTRL> __device__ __forceinline__ float dpp_f(float v) { return __builtin_bit_cast(float, __builtin_amdgcn_update_dpp(0, __builtin_bit_cast(int, v), CTRL, 0xf, 0xf, true)); }
__device__ __forceinline__ float wave_sum(float v) {
    v += dpp_f<0xB1>(v);
    v += dpp_f<0x4E>(v);
    v += dpp_f<0x141>(v);
    v += dpp_f<0x140>(v);
    const float r0 = __builtin_bit_cast(float, __builtin_amdgcn_readlane(__builtin_bit_cast(int, v), 0)), r1 = __builtin_bit_cast(float, __builtin_amdgcn_readlane(__builtin_bit_cast(int, v), 16));
    const float r2 = __builtin_bit_cast(float, __builtin_amdgcn_readlane(__builtin_bit_cast(int, v), 32)), r3 = __builtin_bit_cast(float, __builtin_amdgcn_readlane(__builtin_bit_cast(int, v), 48));
    return (r0 + r1) + (r2 + r3);
}

__device__ __forceinline__ void transpose_item64(const float* src, int ld_src, bf16* dst, int ld_dst, LAS float* scr, int lane, const float* kscale = nullptr) {
    f32x4 v[16];
    const int kq = lane >> 4, n4 = (lane & 15) * 4;
#pragma unroll
    for (int i = 0; i < 16; ++i) v[i] = *(const GAS f32x4*)(src + (size_t)(4 * i + kq) * ld_src + n4);
    if (kscale) {
#pragma unroll
        for (int i = 0; i < 16; ++i) v[i] = v[i] * kscale[4 * i + kq]; }
#pragma unroll
    for (int i = 0; i < 16; ++i) { LAS float* p = scr + (4 * i + kq) * 65 + n4; p[0] = v[i].x; p[1] = v[i].y; p[2] = v[i].z; p[3] = v[i].w; }
    LDS_WAIT(); asm volatile("" ::: "memory");
    const int c = lane & 7;
#pragma unroll
    for (int j = 0; j < 8; ++j) { const int n = (lane >> 3) + 8 * j; const LAS float* q = scr + (8 * c) * 65 + n;
        v4u o; o.x = pk2(q[0 * 65], q[1 * 65]); o.y = pk2(q[2 * 65], q[3 * 65]); o.z = pk2(q[4 * 65], q[5 * 65]); o.w = pk2(q[6 * 65], q[7 * 65]);
        *(GAS v4u*)(dst + (size_t)n * ld_dst + 8 * c) = o; }
    LDS_WAIT(); asm volatile("" ::: "memory");
}
__device__ __forceinline__ void sincos_d(double x, double& sn, double& cs) {
    const double k = __builtin_rint(x * 0.63661977236758134308);
    const double r = (x - k * 1.57079632679489655800e+00) - k * 6.12323399573676603587e-17;
    const double r2 = r * r;
    const double s = r * (1.0 + r2 * (-1.0 / 6.0 + r2 * (1.0 / 120.0 + r2 * (-1.0 / 5040.0 + r2 * (1.0 / 362880.0 + r2 * (-1.0 / 39916800.0 + r2 * (1.0 / 6227020800.0)))))));
    const double c = 1.0 + r2 * (-0.5 + r2 * (1.0 / 24.0 + r2 * (-1.0 / 720.0 + r2 * (1.0 / 40320.0 + r2 * (-1.0 / 3628800.0 + r2 * (1.0 / 479001600.0 + r2 * (-1.0 / 87178291200.0)))))));
    const int q = ((int)k) & 3;
    sn = (q == 0) ? s : (q == 1) ? c : (q == 2) ? -s : -c;
    cs = (q == 0) ? c : (q == 1) ? -s : (q == 2) ? -c : s;
}
__device__ __forceinline__ void ssm_gen(Frame& F, const Args& A, int g, int sl) {
    LAS float* lamP = (LAS float*)(F.lds + RING_OFF);
    LAS float* Bb = lamP + 2 * 17 * 64 * 2;
    LAS float* Cc = Bb + 2 * 64 * 16 * 2;
    LAS float* KT = Cc + 2 * 16 * 64 * 2;
    LAS float* dv = KT + 32 * 260;
    LAS float* bfac = dv + 16;
    const float* a_re = A.in[6]; const float* a_im = A.in[7]; const float* log_dt = A.in[8];
    const float* b_re = A.in[9]; const float* b_im = A.in[10]; const float* c_re = A.in[11]; const float* c_im = A.in[12]; const float* ssm_d = A.in[13];
    const int t = opq(F.wave * 64 + hw_lane());
    float pbr[4], pbi[4], pcr[4], pci[4];
#pragma unroll
    for (int i = 0; i < 4; ++i) { const int idx = t + 512 * i; const size_t si = (size_t)((idx >> 10) * NG + g) * 1024 + (idx & 1023);
        pbr[i] = b_re[si]; pbi[i] = b_im[si]; pcr[i] = c_re[si]; pci[i] = c_im[si]; }
    const int d_a = (t >> 6) & 1, n_a = t & 63;
    const float p_are = a_re[(d_a * NG + g) * NST + n_a], p_aim = a_im[(d_a * NG + g) * NST + n_a], p_ldt = log_dt[d_a * NG + g], p_dv = ssm_d[g * GC + (t & 15)];
    __syncthreads();
    if (t < 128) {
        const int d = d_a, n = n_a;
        const float dtf = expf(p_ldt), mag = expf(p_are * dtf); const double ang = (double)p_aim * (double)dtf;
        double sn, cs; sincos_d(ang, sn, cs);
        const float lr = mag * (float)cs, li = mag * (float)sn;
        const float nr = lr - 1.0f, ni = li, den = p_are * p_are + p_aim * p_aim;
        bfac[(d * 64 + n) * 2] = (nr * p_are + ni * p_aim) / den; bfac[(d * 64 + n) * 2 + 1] = (ni * p_are - nr * p_aim) / den;
        float pr = 1.0f, pi = 0.0f;
        for (int k = 0; k <= 16; ++k) { lamP[((d * 17 + k) * 64 + n) * 2] = pr; lamP[((d * 17 + k) * 64 + n) * 2 + 1] = pi;
            const float tr = pr * lr - pi * li, ti = pr * li + pi * lr; pr = tr; pi = ti; }
        if (sl == 0) {
            float* lt = (float*)(F.ws + WS_LAMT) + ((g * 2 + d) * 64 + n) * 4;
            double s16, c16, s1k, c1k; sincos_d(ang * 16.0, s16, c16); sincos_d(ang * 1024.0, s1k, c1k);
            const float m16 = expf(p_are * dtf * 16.0f), m1k = expf(p_are * dtf * 1024.0f);
            lt[0] = m16 * (float)c16; lt[1] = m16 * (float)s16; lt[2] = m1k * (float)c1k; lt[3] = m1k * (float)s1k; }
    }
    if (t < 16) dv[t] = p_dv;
    __syncthreads();
#pragma unroll
    for (int i = 0; i < 4; ++i) { const int idx = t + 512 * i, d = idx >> 10, n = (idx >> 4) & 63;
        const float fr = bfac[(d * 64 + n) * 2], fi = bfac[(d * 64 + n) * 2 + 1];
        Bb[idx * 2] = fr * pbr[i] - fi * pbi[i]; Bb[idx * 2 + 1] = fr * pbi[i] + fi * pbr[i];
        Cc[idx * 2] = pcr[i]; Cc[idx * 2 + 1] = pci[i]; }
    __syncthreads();
    {
        const int d = t >> 8, co = (t >> 4) & 15, ci = t & 15;
        float acc[16];
#pragma unroll
        for (int k = 0; k < 16; ++k) acc[k] = 0.f;
        for (int n = 0; n < 64; ++n) {
            const float cr = Cc[((d * 16 + co) * 64 + n) * 2], cim = Cc[((d * 16 + co) * 64 + n) * 2 + 1];
            const float br = Bb[((d * 64 + n) * 16 + ci) * 2], bi = Bb[((d * 64 + n) * 16 + ci) * 2 + 1];
            const float lr = lamP[((d * 17 + 1) * 64 + n) * 2], li = lamP[((d * 17 + 1) * 64 + n) * 2 + 1];
            float qr = cr * br - cim * bi, qi = cr * bi + cim * br;
#pragma unroll
            for (int k = 0; k < 16; ++k) { acc[k] += qr; const float tr = qr * lr - qi * li; qi = qr * li + qi * lr; qr = tr; }
        }
#pragma unroll
        for (int k = 0; k < 16; ++k) KT[(d * 16 + k) * 260 + co * 16 + ci] = acc[k];
    }
    __syncthreads();
    bf16* WS3 = (bf16*)(F.ws + WS_WS3) + ((size_t)g * 256 + sl * 64) * 512;
#pragma unroll
    for (int i2 = 0; i2 < 2; ++i2) {
        const int idx = t + 512 * i2, rowl = idx >> 4, sq = idx & 15, row = sl * 64 + rowl, j = row >> 4, co = row & 15;
        float v[16];
        if (j != sq) { const LAS float* src = KT + ((j > sq) ? (j - sq) : (16 + sq - j)) * 260 + co * 16;
#pragma unroll
            for (int i = 0; i < 16; ++i) v[i] = src[i]; }
        else {
#pragma unroll
            for (int i = 0; i < 16; ++i) v[i] = KT[co * 16 + i] + KT[16 * 260 + co * 16 + i] + (co == i ? dv[co] : 0.f); }
        v4u o0, o1; o0.x = pk2(v[0], v[1]); o0.y = pk2(v[2], v[3]); o0.z = pk2(v[4], v[5]); o0.w = pk2(v[6], v[7]); o1.x = pk2(v[8], v[9]); o1.y = pk2(v[10], v[11]); o1.z = pk2(v[12], v[13]); o1.w = pk2(v[14], v[15]);
        GAS v4u* dst = (GAS v4u*)(WS3 + (size_t)rowl * 512 + sq * 16); dst[0] = o0; dst[1] = o1;
    }
#pragma unroll
    for (int i2 = 0; i2 < 4; ++i2) {
        const int idx = t + 512 * i2, rowl = idx >> 5, q = (idx >> 3) & 3, n0 = (idx & 7) * 8, row = sl * 64 + rowl, j = row >> 4, co = row & 15, d = q >> 1, e = (d == 0) ? (j + 1) : (16 - j);
        float v[8];
#pragma unroll
        for (int i = 0; i < 8; ++i) { const int n = n0 + i;
            const float cr = Cc[((d * 16 + co) * 64 + n) * 2], cim = Cc[((d * 16 + co) * 64 + n) * 2 + 1];
            const float pr = lamP[((d * 17 + e) * 64 + n) * 2], pi = lamP[((d * 17 + e) * 64 + n) * 2 + 1];
            v[i] = (q & 1) ? -(cr * pi + cim * pr) : (cr * pr - cim * pi); }
        v4u o; o.x = pk2(v[0], v[1]); o.y = pk2(v[2], v[3]); o.z = pk2(v[4], v[5]); o.w = pk2(v[6], v[7]);
        *(GAS v4u*)(WS3 + (size_t)rowl * 512 + 256 + q * 64 + n0) = o;
    }
    bf16* MS = (bf16*)(F.ws + WS_MS) + ((size_t)g * 256 + sl * 64) * 256;
#pragma unroll
    for (int i2 = 0; i2 < 4; ++i2) {
        const int idx = t + 512 * i2, rowl = idx >> 5, kc = (idx & 31) * 8, row = sl * 64 + rowl, d = row >> 7, n = (row >> 1) & 63, q = row & 1  , j = kc >> 4, ci0 = kc & 15, e = (d == 0) ? (15 - j) : j;
        const float pr = lamP[((d * 17 + e) * 64 + n) * 2], pi = lamP[((d * 17 + e) * 64 + n) * 2 + 1];
        float v[8];
#pragma unroll
        for (int i = 0; i < 8; ++i) { const float br = Bb[((d * 64 + n) * 16 + ci0 + i) * 2], bi = Bb[((d * 64 + n) * 16 + ci0 + i) * 2 + 1];
            v[i] = (q & 1) ? (pr * bi + pi * br) : (pr * br - pi * bi); }
        v4u o; o.x = pk2(v[0], v[1]); o.y = pk2(v[2], v[3]); o.z = pk2(v[4], v[5]); o.w = pk2(v[6], v[7]);
        *(GAS v4u*)(MS + (size_t)rowl * 256 + kc) = o;
    }
    __syncthreads();
}
constexpr int BG_GU = NEXP * 16 * 4, BG_DN = NEXP * 4 * 16, BG_WOB = 8 * 16, BG_WG = 16 * 16, BG_WPLE = 4 * 16;
constexpr int BG_TOTAL = 2 * BG_GU + BG_DN + BG_WOB + BG_WG + BG_WPLE;
struct BgDesc { const float* src; bf16* dst; int ld_src, ld_dst; };
__device__ __forceinline__ BgDesc bg_desc(Frame& F, const Args& A, int r) {
    BgDesc d;
    if (r < 2 * BG_GU) {
        const int up = r >= BG_GU; if (up) r -= BG_GU;
        const int e = r >> 6, kb = (r >> 2) & 15, nb = r & 3, k0 = kb * 64, n0 = nb * 64;
        d.src = A.in[up ? 23 : 22] + ((size_t)e * D + k0) * DF + n0; d.ld_src = DF;
        d.dst = (bf16*)(F.ws + WS_WGU) + ((size_t)e * 512 + (n0 >> 7) * 256 + (up ? 128 : 0) + (n0 & 127)) * D + k0; d.ld_dst = D; return d; }
    r -= 2 * BG_GU;
    if (r < BG_DN) {
        const int e = r >> 6, kb = (r >> 4) & 3, nb = r & 15, k0 = kb * 64, n0 = nb * 64;
        d.src = A.in[24] + ((size_t)e * DF + k0) * D + n0; d.ld_src = D; d.dst = (bf16*)(F.ws + WS_WD) + ((size_t)e * D + n0) * DF + k0; d.ld_dst = DF; return d; }
    r -= BG_DN;
    if (r < BG_WOB) { const int kb = r >> 4, nb = r & 15;
        d.src = A.in[16] + (size_t)(DP + kb * 64) * D + nb * 64; d.ld_src = D; d.dst = (bf16*)(F.ws + WS_WCAT) + (size_t)nb * 64 * D + DP + kb * 64; d.ld_dst = D; return d; }
    r -= BG_WOB;
    if (r < BG_WG) { const int kb = r >> 4, nb = r & 15; d.src = A.in[26] + (size_t)kb * 64 * D + nb * 64; d.ld_src = D; d.dst = (bf16*)(F.ws + WS_WG) + (size_t)nb * 64 * D + kb * 64; d.ld_dst = D; return d; }
    r -= BG_WG;
    { const int kb = r >> 4, nb = r & 15; d.src = A.in[28] + (size_t)kb * 64 * D + nb * 64; d.ld_src = D; d.dst = (bf16*)(F.ws + WS_WPLE) + (size_t)nb * 64 * DPLE + kb * 64; d.ld_dst = DPLE; return d; }
}
__device__ __forceinline__ void tr64_load(f32x4 (&v)[16], const float* src, int ld_src, int lane) {
    const int kq = lane >> 4, n4 = (lane & 15) * 4;
#pragma unroll
    for (int i = 0; i < 16; ++i) v[i] = *(const GAS f32x4*)(src + (size_t)(4 * i + kq) * ld_src + n4);
}
__device__ __forceinline__ void tr64_finish(const f32x4 (&v)[16], bf16* dst, int ld_dst, LAS float* scr, int lane) {
    const int kq = lane >> 4, n4 = (lane & 15) * 4;
#pragma unroll
    for (int i = 0; i < 16; ++i) { LAS float* p = scr + (4 * i + kq) * 65 + n4; p[0] = v[i].x; p[1] = v[i].y; p[2] = v[i].z; p[3] = v[i].w; }
    LDS_WAIT(); asm volatile("" ::: "memory");
    const int c = lane & 7;
#pragma unroll
    for (int j = 0; j < 8; ++j) { const int n = (lane >> 3) + 8 * j; const LAS float* q = scr + (8 * c) * 65 + n;
        v4u o; o.x = pk2(q[0 * 65], q[1 * 65]); o.y = pk2(q[2 * 65], q[3 * 65]); o.z = pk2(q[4 * 65], q[5 * 65]); o.w = pk2(q[6 * 65], q[7 * 65]);
        *(GAS v4u*)(dst + (size_t)n * ld_dst + 8 * c) = o; }
    LDS_WAIT(); asm volatile("" ::: "memory");
}
__device__ __forceinline__ void bg_range(Frame& F, const Args& A, int lo, int hi, int plo, int phi, bool all = false) {
    int widx, nw;
    if (all) { widx = F.gw; nw = F.ngw; }
    else if (F.G >= 256) { if ((int)blockIdx.x < 128) return; widx = ((int)blockIdx.x - 128) * NWAVES + F.wave; nw = (F.G - 128) * NWAVES; } else { widx = F.gw; nw = F.ngw; }
    LAS float* scr = (LAS float*)(F.lds + RING_OFF + F.wave * P0_SCR);
    const int lane = opq(hw_lane());
    int it = lo + widx;
    for (; it + nw < hi; it += 2 * nw) {
        f32x4 va[16], vb[16]; const BgDesc da = bg_desc(F, A, it), db = bg_desc(F, A, it + nw);
        tr64_load(va, da.src, da.ld_src, lane); tr64_load(vb, db.src, db.ld_src, lane);
        tr64_finish(va, da.dst, da.ld_dst, scr, lane); tr64_finish(vb, db.dst, db.ld_dst, scr, lane); }
    if (it < hi) { f32x4 va[16]; const BgDesc dc = bg_desc(F, A, it); tr64_load(va, dc.src, dc.ld_src, lane); tr64_finish(va, dc.dst, dc.ld_dst, scr, lane); }
    for (int m = plo + 4 * widx; m < phi; m += 4 * nw) {
        f32x4 pv[4];
#pragma unroll
        for (int r = 0; r < 4; ++r) pv[r] = *((const GAS f32x4*)(A.in[1] + (size_t)(m + r) * DPLE) + lane);
#pragma unroll
        for (int r = 0; r < 4; ++r) { v2u o; o.x = pk2(pv[r].x, pv[r].y); o.y = pk2(pv[r].z, pv[r].w); *((GAS v2u*)((bf16*)(F.ws + WS_PB) + (size_t)(m + r) * DPLE) + lane) = o; }
    }
}
template <int R> __device__ __forceinline__ void xn_rows(Frame& F, const Args& A, int m0, int stride, int lane) {
    const GAS f32x4* gr = (const GAS f32x4*)A.in[2] + lane;
    f32x4 v[R][4];
#pragma unroll
    for (int r = 0; r < R; ++r) { const size_t m = (size_t)(m0 + r * stride);
#pragma unroll
        for (int j = 0; j < 4; ++j) v[r][j] = *((const GAS f32x4*)(A.in[0] + m * D) + lane + 64 * j); }
#pragma unroll
    for (int r = 0; r < R; ++r) { const size_t m = (size_t)(m0 + r * stride); float s = 0.f;
#pragma unroll
        for (int j = 0; j < 4; ++j) s += (v[r][j].x * v[r][j].x + v[r][j].y * v[r][j].y) + (v[r][j].z * v[r][j].z + v[r][j].w * v[r][j].w);
        const float rstd = 1.f / sqrtf(wave_sum(s) * (1.f / D) + RMS_EPS);
        GAS unsigned long long* o8 = (GAS unsigned long long*)((bf16*)(F.ws + WS_XN) + m * D) + lane;
#pragma unroll
        for (int j = 0; j < 4; ++j) { const f32x4 gg = gr[64 * j], x = v[r][j];
            o8[64 * j] = (unsigned long long)pk2(x.x * rstd * gg.x, x.y * rstd * gg.y) | ((unsigned long long)pk2(x.z * rstd * gg.z, x.w * rstd * gg.w) << 32); }
    }
}
__device__ __forceinline__ void p0_prologue(Frame& F, const Args& A) {
    int widx = F.gw, nw = F.ngw;
    if (F.G >= 256) { if ((int)blockIdx.x < 128) { ssm_gen(F, A, (int)blockIdx.x >> 2, (int)blockIdx.x & 3); return; }
                      widx = ((int)blockIdx.x - 128) * NWAVES + F.wave; nw = (F.G - 128) * NWAVES; }
    else { for (int u = blockIdx.x; u < NG * 4; u += F.G) ssm_gen(F, A, u >> 2, u & 3); __syncthreads(); }
    LAS float* scr = (LAS float*)(F.lds + RING_OFF + F.wave * P0_SCR);
    constexpr int I_WIN = 16 * 16, I_GLU = 8 * 8, I_WOS = 8 * 16, I_BD = 256, I_WR = 48, I_ROWS = M / 8;
    constexpr int NITEMS = I_WIN + I_GLU + I_WOS + I_BD + I_WR + I_ROWS;
    for (int it = widx; it < NITEMS; it += nw) {
        int r = it; const int lane = opq(hw_lane());
        if (r < I_WIN) { const int kb = r >> 4, nb = r & 15; transpose_item64(A.in[3] + (size_t)kb * 64 * D + nb * 64, D, (bf16*)(F.ws + WS_WIN) + (size_t)nb * 64 * D + kb * 64, D, scr, lane); continue; }
        r -= I_WIN;
        if (r < I_GLU) { const int kb = r >> 3, nb = r & 7; transpose_item64(A.in[14] + (size_t)kb * 64 * DP + nb * 64, DP, (bf16*)(F.ws + WS_GLU) + (size_t)nb * 64 * DP + kb * 64, DP, scr, lane); continue; }
        r -= I_GLU;
        if (r < I_WOS) {
            const int kb = r >> 4, nb = r & 15, k0 = kb * 64;
            transpose_item64(A.in[16] + (size_t)k0 * D + nb * 64, D, (bf16*)(F.ws + WS_WOS) + ((size_t)(k0 >> 8) * D + nb * 64) * 256 + (k0 & 255), 256, scr, lane, A.in[5] + k0); continue; }
        r -= I_WOS;
        if (r < I_BD) {
            const int row = r * 2 + (lane >> 5), c0 = (lane & 31) * 8, gi = row >> 7;
            v4u o = (v4u){0u, 0u, 0u, 0u};
            if ((c0 >> 7) == (gi & 1)) { const f32x4 a = *(const GAS f32x4*)(A.in[4] + (size_t)row * 128 + (c0 & 127)), b = *(const GAS f32x4*)(A.in[4] + (size_t)row * 128 + (c0 & 127) + 4);
                o.x = pk2(a.x, a.y); o.y = pk2(a.z, a.w); o.z = pk2(b.x, b.y); o.w = pk2(b.z, b.w); }
            *(GAS v4u*)((bf16*)(F.ws + WS_BD) + (size_t)row * 256 + c0) = o; continue; }
        r -= I_BD;
        if (r < I_WR) {
            bf16* dh = (bf16*)(F.ws + WS_WR) + (size_t)r * D; bf16* dl = dh + 48 * D;
            for (int dd = lane; dd < D; dd += 64) { float w = 0.f;
                if (r < 4) w = A.in[18][dd * 4 + r]; else if (r < 36) w = A.in[20][((size_t)((r - 4) >> 3) * D + dd) * 8 + ((r - 4) & 7)];
                w *= A.in[17][dd]; const unsigned h = f2bf(w); dh[dd] = (bf16)h; dl[dd] = (bf16)f2bf(w - __builtin_bit_cast(float, h << 16)); }
            continue; }
        r -= I_WR;
        xn_rows<8>(F, A, r, I_ROWS, lane);
    }
}

using pg8::Unit; using pg8::bf16_t; typedef unsigned u32x4 __attribute__((ext_vector_type(4)));
__device__ __forceinline__ u32x4 pack8(const f32x4& a, const f32x4& b) { u32x4 w; w.x = pk2(a[0], a[1]); w.y = pk2(a[2], a[3]); w.z = pk2(b[0], b[1]); w.w = pk2(b[2], b[3]); return w; }
struct EpiZ { static constexpr bool PERM = true, AFTER_DRAIN = false; bf16_t* ZP; bf16_t* AS;
    __device__ __forceinline__ void operator()(const f32x4 (&acc)[2][2][4][2], const Unit& u, int wr, int wc, int fr, int fq) const {
        const int row0 = u.pm * 256 + wr * 64 + fr;
#pragma unroll
        for (int ai = 0; ai < 2; ++ai)
#pragma unroll
            for (int m = 0; m < 4; ++m) { const int r = row0 + ai * 128 + m * 16;
#pragma unroll
                for (int bj = 0; bj < 2; ++bj) { const int col = u.pn * 256 + bj * 128 + wc * 32 + 8 * fq; const u32x4 w = pack8(acc[ai][bj][m][0], acc[ai][bj][m][1]);
                    if (u.pn < 2) *(u32x4*)(ZP + (size_t)r * DP + col) = w;
                    else { const int sc = col - DP, g = sc >> 4, ch0 = sc & 15; *(u32x4*)(AS + ((size_t)(g * NCH + (r >> 4)) * 512 + (r & 15) * 16 + ch0)) = w; } } }
    } };
struct EpiSloc { static constexpr bool PERM = false, AFTER_DRAIN = false; bf16_t* C;
    __device__ __forceinline__ void operator()(const f32x4 (&acc)[2][2][4][2], const Unit& u, int wr, int wc, int fr, int fq) const {
        const int row0 = u.pm * 256 + wr * 64 + fr, col0 = wc * 32 + 4 * fq;
#pragma unroll
        for (int ai = 0; ai < 2; ++ai)
#pragma unroll
            for (int m = 0; m < 4; ++m) { bf16_t* rowp = C + (size_t)(row0 + ai * 128 + m * 16) * 256 + col0;
#pragma unroll
                for (int bj = 0; bj < 2; ++bj)
#pragma unroll
                    for (int n = 0; n < 2; ++n) { const f32x4 a = acc[ai][bj][m][n]; v2u w; w.x = pk2(a[0], a[1]); w.y = pk2(a[2], a[3]); *(v2u*)(rowp + bj * 128 + n * 16) = w; } }
    } };
struct EpiY { static constexpr bool PERM = true, AFTER_DRAIN = false; bf16_t* ZZ;
    __device__ __forceinline__ void operator()(const f32x4 (&acc)[2][2][4][2], const Unit& u, int wr, int wc, int fr, int fq) const {
        const int g = u.pn, row0 = (u.pm & 3) * 256 + wr * 64 + fr;
#pragma unroll
        for (int ai = 0; ai < 2; ++ai)
#pragma unroll
            for (int m = 0; m < 4; ++m) { const int c = row0 + ai * 128 + m * 16;
#pragma unroll
                for (int bj = 0; bj < 2; ++bj) { const int col = bj * 128 + wc * 32 + 8 * fq, j = col >> 4, co0 = col & 15;
                    f32x4 a = acc[ai][bj][m][0], b = acc[ai][bj][m][1];
#pragma unroll
                    for (int i = 0; i < 4; ++i) { a[i] = gelu_tanh(a[i]); b[i] = gelu_tanh(b[i]); }
                    *(u32x4*)(ZZ + (size_t)(c * CL + j) * DP + g * GC + co0) = pack8(a, b); asm volatile("" ::: "memory"); } }
    } };
struct EpiGlu { static constexpr bool PERM = true, AFTER_DRAIN = false; const bf16_t* ZZ; const float* bias; bf16_t* CAT;
    __device__ __forceinline__ void operator()(const f32x4 (&acc)[2][2][4][2], const Unit& u, int wr, int wc, int fr, int fq) const {
        const int row0 = u.pm * 256 + wr * 64 + fr;
#pragma unroll
        for (int bj = 0; bj < 2; ++bj) { const int col = u.pn * 256 + bj * 128 + wc * 32 + 8 * fq;
            const f32x4 b0 = *(const f32x4*)(bias + col), b1 = *(const f32x4*)(bias + col + 4);
#pragma unroll
            for (int ai = 0; ai < 2; ++ai)
#pragma unroll
                for (int m = 0; m < 4; ++m) { const int r = row0 + ai * 128 + m * 16;
                    const u32x4 z = *(const u32x4*)(ZZ + (size_t)r * DP + col);
                    f32x4 a = acc[ai][bj][m][0] + b0, b = acc[ai][bj][m][1] + b1;
                    a[0] = bflo(z.x) * sigmoidf_(a[0]); a[1] = bfhi(z.x) * sigmoidf_(a[1]); a[2] = bflo(z.y) * sigmoidf_(a[2]); a[3] = bfhi(z.y) * sigmoidf_(a[3]);
                    b[0] = bflo(z.z) * sigmoidf_(b[0]); b[1] = bfhi(z.z) * sigmoidf_(b[1]); b[2] = bflo(z.w) * sigmoidf_(b[2]); b[3] = bfhi(z.w) * sigmoidf_(b[3]);
                    *(u32x4*)(CAT + (size_t)r * D + DP + col) = pack8(a, b); asm volatile("" ::: "memory"); } }
    } };
struct EpiRes { static constexpr bool PERM = true, AFTER_DRAIN = false; const float* X; float* H; const float* G; bf16_t* V;
    __device__ __forceinline__ void operator()(const f32x4 (&acc)[2][2][4][2], const Unit& u, int wr, int wc, int fr, int fq) const {
        const int row0 = u.pm * 256 + wr * 64 + fr, col0 = u.pn * 256 + wc * 32 + 8 * fq;
        f32x4 gv[2][2];
#pragma unroll
        for (int bj = 0; bj < 2; ++bj)
#pragma unroll
            for (int n = 0; n < 2; ++n) gv[bj][n] = *(const f32x4*)(G + col0 + bj * 128 + 4 * n);
#pragma unroll
        for (int ai = 0; ai < 2; ++ai)
#pragma unroll
            for (int m = 0; m < 4; ++m) { const size_t off = (size_t)(row0 + ai * 128 + m * 16) * D + col0;
#pragma unroll
                for (int bj = 0; bj < 2; ++bj) { const f32x4 h0 = *(const f32x4*)(X + off + bj * 128) + acc[ai][bj][m][0], h1 = *(const f32x4*)(X + off + bj * 128 + 4) + acc[ai][bj][m][1];
                    *(f32x4*)(H + off + bj * 128) = h0; *(f32x4*)(H + off + bj * 128 + 4) = h1;
                    *(u32x4*)(V + off + bj * 128) = pack8(h0 * gv[bj][0], h1 * gv[bj][1]); } }
    } };
struct EpiAct { static constexpr bool PERM = true, AFTER_DRAIN = false; const float* LW; const float* LR; bf16_t* ACT; const volatile LAS unsigned* tstart;
    __device__ __forceinline__ void operator()(const f32x4 (&acc)[2][2][4][2], const Unit& u, int wr, int wc, int fr, int fq) const {
        const int e = u.pn >> 1, lrow0 = (u.pm - (int)tstart[e]) * 256 + wr * 64 + fr, row0 = u.pm * 256 + wr * 64 + fr, col = (u.pn & 1) * 128 + wc * 32 + 8 * fq;
        const float* lw = LW + (size_t)e * M + lrow0; const float* lr = LR + (size_t)e * M + lrow0;
#pragma unroll
        for (int ai = 0; ai < 2; ++ai)
#pragma unroll
            for (int m = 0; m < 4; ++m) { const int ro = ai * 128 + m * 16; const float w = lw[ro], rs = lr[ro];
                f32x4 a, b;
#pragma unroll
                for (int i = 0; i < 4; ++i) { const float g0 = rs * acc[ai][0][m][0][i], g1 = rs * acc[ai][0][m][1][i], sw = rs * w;
                    a[i] = g0 * sigmoidf_(g0) * acc[ai][1][m][0][i] * sw; b[i] = g1 * sigmoidf_(g1) * acc[ai][1][m][1][i] * sw; }
                *(u32x4*)(ACT + (size_t)(row0 + ro) * DF + col) = pack8(a, b); }
    } };
struct EpiDown { static constexpr bool PERM = true, AFTER_DRAIN = false; const int* LIST; const unsigned* cnt; bf16_t* MO0; bf16_t* MO1; const volatile LAS unsigned* tstart;
    __device__ __forceinline__ void operator()(const f32x4 (&acc)[2][2][4][2], const Unit& u, int wr, int wc, int fr, int fq) const {
        const int e = u.pn >> 2, lrow0 = (u.pm - (int)tstart[e]) * 256 + wr * 64 + fr, col0 = (u.pn & 3) * 256 + wc * 32 + 8 * fq;
        const int n_e = (int)__hip_atomic_load(cnt + 64 * e, __ATOMIC_RELAXED, __HIP_MEMORY_SCOPE_AGENT); const int* li = LIST + (size_t)e * M;
#pragma unroll
        for (int ai = 0; ai < 2; ++ai)
#pragma unroll
            for (int m = 0; m < 4; ++m) { const int lr = lrow0 + ai * 128 + m * 16;
                if (lr < n_e) { const int info = li[lr]; bf16_t* dst = ((info & 1) ? MO1 : MO0) + (size_t)(info >> 1) * D + col0;
#pragma unroll
                    for (int bj = 0; bj < 2; ++bj) *(u32x4*)(dst + bj * 128) = pack8(acc[ai][bj][m][0], acc[ai][bj][m][1]); } }
    } };
struct EpiPe { static constexpr bool PERM = true, AFTER_DRAIN = false; bf16_t* O;
    __device__ __forceinline__ void operator()(const f32x4 (&acc)[2][2][4][2], const Unit& u, int wr, int wc, int fr, int fq) const {
        const int row0 = u.pm * 256 + wr * 64 + fr, col0 = u.pn * 256 + wc * 32 + 8 * fq;
#pragma unroll
        for (int ai = 0; ai < 2; ++ai)
#pragma unroll
            for (int m = 0; m < 4; ++m) { bf16_t* rowp = O + (size_t)(row0 + ai * 128 + m * 16) * D + col0;
#pragma unroll
                for (int bj = 0; bj < 2; ++bj) *(u32x4*)(rowp + bj * 128) = pack8(acc[ai][bj][m][0], acc[ai][bj][m][1]); }
    } };
struct EpiGate { static constexpr bool PERM = true, AFTER_DRAIN = false; const float* bias; bf16_t* PE;
    __device__ __forceinline__ void operator()(const f32x4 (&acc)[2][2][4][2], const Unit& u, int wr, int wc, int fr, int fq) const {
        const int row0 = u.pm * 256 + wr * 64 + fr, col0 = u.pn * 256 + wc * 32 + 8 * fq;
        u32x4 pe[2][4][2];
#pragma unroll
        for (int ai = 0; ai < 2; ++ai)
#pragma unroll
            for (int m = 0; m < 4; ++m)
#pragma unroll
                for (int bj = 0; bj < 2; ++bj) pe[ai][m][bj] = *(const u32x4*)(PE + (size_t)(row0 + ai * 128 + m * 16) * D + col0 + bj * 128);
#pragma unroll
        for (int bj = 0; bj < 2; ++bj) { const f32x4 b0 = *(const f32x4*)(bias + col0 + bj * 128), b1 = *(const f32x4*)(bias + col0 + bj * 128 + 4);
#pragma unroll
            for (int ai = 0; ai < 2; ++ai)
#pragma unroll
                for (int m = 0; m < 4; ++m) { const u32x4 z = pe[ai][m][bj]; f32x4 a = acc[ai][bj][m][0] + b0, b = acc[ai][bj][m][1] + b1;
                    a[0] = bflo(z.x) * sigmoidf_(a[0]); a[1] = bfhi(z.x) * sigmoidf_(a[1]); a[2] = bflo(z.y) * sigmoidf_(a[2]); a[3] = bfhi(z.y) * sigmoidf_(a[3]);
                    b[0] = bflo(z.z) * sigmoidf_(b[0]); b[1] = bfhi(z.z) * sigmoidf_(b[1]); b[2] = bflo(z.w) * sigmoidf_(b[2]); b[3] = bfhi(z.w) * sigmoidf_(b[3]);
                    *(u32x4*)(PE + (size_t)(row0 + ai * 128 + m * 16) * D + col0 + bj * 128) = pack8(a, b); } }
    } };

struct GroupOrder { int G, c;
    __device__ __forceinline__ bool next(int i, Unit& u) const { const int L = i * G + c; if (L >= NG * 4) return false; u.pm = L; u.pn = L >> 2; u.nv = 256; return true; }
    __device__ __forceinline__ void a_ready(const Unit&) const {}
    __device__ __forceinline__ void done(const Unit&) const {} };
struct PeOrder { int G, c, n2;
    __device__ __forceinline__ bool next(int i, Unit& u) const { if (c < n2) return false; const int L = i * (G - n2) + (c - n2); if (L >= (M / 256) * (D / 256)) return false; u.pm = L >> 2; u.pn = L & 3; u.nv = 256; return true; }
    __device__ __forceinline__ void a_ready(const Unit&) const {}
    __device__ __forceinline__ void done(const Unit&) const {} };
struct WeffOrder { int G, c;
    __device__ __forceinline__ bool next(int i, Unit& u) const { const int L = (G >= 256) ? ((i == 0) ? c - 128 : -1) : i * G + c; if (L < 0 || L >= 8) return false; u.pm = L; u.pn = L >> 2; u.nv = 256; return true; }
    __device__ __forceinline__ void a_ready(const Unit&) const {}
    __device__ __forceinline__ void done(const Unit&) const {} };
struct EpiWeff { static constexpr bool PERM = true, AFTER_DRAIN = false; bf16_t* O;
    __device__ __forceinline__ void operator()(const f32x4 (&acc)[2][2][4][2], const Unit& u, int wr, int wc, int fr, int fq) const {
        const int row0 = (u.pm & 3) * 256 + wr * 64 + fr, col0 = u.pn * 256 + wc * 32 + 8 * fq;
#pragma unroll
        for (int ai = 0; ai < 2; ++ai)
#pragma unroll
            for (int m = 0; m < 4; ++m) { bf16_t* rowp = O + (size_t)(row0 + ai * 128 + m * 16) * D + col0;
#pragma unroll
                for (int bj = 0; bj < 2; ++bj) *(u32x4*)(rowp + bj * 128) = pack8(acc[ai][bj][m][0], acc[ai][bj][m][1]); }
    } };
template <int NSUB> struct ExpertOrder { int G, c; const volatile LAS unsigned* misc;
    __device__ __forceinline__ bool next(int i, Unit& u) const {
        const int L = i * G + c, tp = L / NSUB, sub = L % NSUB; if (tp >= __builtin_amdgcn_readfirstlane((int)misc[MW_TSTART + NEXP])) return false;
        const unsigned ent = (unsigned)__builtin_amdgcn_readfirstlane((int)misc[MW_TL + tp]); const int e = ent & 31u, rt = (ent >> 5) & 127u;
        u.pm = __builtin_amdgcn_readfirstlane((int)misc[MW_TSTART + e]) + rt; u.pn = e * NSUB + sub; u.nv = (int)(ent >> 12); return true; }
    __device__ __forceinline__ void a_ready(const Unit&) const {}
    __device__ __forceinline__ void done(const Unit&) const {} };

__device__ __forceinline__ void carry_unit(Frame& F, int unit) {
    const int d = unit & 1, g = (unit >> 1) & 31, b = unit >> 6, n = opq(hw_lane()), s = F.wave;
    const float* lt = (const float*)(F.ws + WS_LAMT) + ((g * 2 + d) * 64 + n) * 4;
    const float l16r = lt[0], l16i = lt[1], lkr = lt[2], lki = lt[3];
    const GAS unsigned* SL = (const GAS unsigned*)((const bf16*)(F.ws + WS_SLOC) + (size_t)(g * NCH + b * 512) * 256 + d * 128) + n;
    bf16* AS = (bf16*)(F.ws + WS_AS) + (size_t)(g * NCH + b * 512) * 512 + 256 + d * 128 + n;
    LAS float* segE = (LAS float*)(F.lds + RING_OFF);
    float er = 0.f, ei = 0.f;
    for (int i0 = 0; i0 < 64; i0 += 16) {
        unsigned sv[16];
#pragma unroll
        for (int ii = 0; ii < 16; ++ii) { const int i = s * 64 + i0 + ii, c = d ? (511 - i) : i; sv[ii] = SL[(size_t)c * 128]; }
#pragma unroll
        for (int ii = 0; ii < 16; ++ii) { const float tr = l16r * er - l16i * ei + bflo(sv[ii]), ti = l16r * ei + l16i * er + bfhi(sv[ii]); er = tr; ei = ti; }
    }
    __syncthreads();
    segE[(s * 64 + n) * 2] = er; segE[(s * 64 + n) * 2 + 1] = ei;
    __syncthreads();
    float xr = 0.f, xi = 0.f;
    for (int sp = 0; sp < s; ++sp) { const float pr = segE[(sp * 64 + n) * 2], pi = segE[(sp * 64 + n) * 2 + 1];
        const float tr = lkr * xr - lki * xi + pr, ti = lkr * xi + lki * xr + pi; xr = tr; xi = ti; }
    for (int i0 = 0; i0 < 64; i0 += 16) {
        unsigned sv[16];
#pragma unroll
        for (int ii = 0; ii < 16; ++ii) { const int i = s * 64 + i0 + ii, c = d ? (511 - i) : i; sv[ii] = SL[(size_t)c * 128]; }
#pragma unroll
        for (int ii = 0; ii < 16; ++ii) { const int i = s * 64 + i0 + ii, c = d ? (511 - i) : i;
            AS[(size_t)c * 512] = (bf16)f2bf(xr); AS[(size_t)c * 512 + 64] = (bf16)f2bf(xi);
            const float tr = l16r * xr - l16i * xi + bflo(sv[ii]), ti = l16r * xi + l16i * xr + bfhi(sv[ii]); xr = tr; xi = ti; }
    }
    __syncthreads();
}
__device__ __forceinline__ void diff_row(Frame& F, int m) {
    const int t = m & (SEQ - 1), lane = opq(hw_lane()), h = 1 << (lane >> 4), lo = max(t - h, 0), hi = min(t + h, SEQ);
    const bf16* ZP = (const bf16*)(F.ws + WS_ZP) + (size_t)(m - t) * DP + lane * 8;
    float acc[8];
#pragma unroll
    for (int i = 0; i < 8; ++i) acc[i] = 0.f;
    v4u zt = (v4u){0u, 0u, 0u, 0u};
    v4u zz[16];
#pragma unroll
    for (int k = 0; k < 16; ++k) { const int s = t - 8 + k, sc = (s >= lo && s < hi) ? s : t; zz[k] = *(const GAS v4u*)(ZP + (size_t)sc * DP); }
#pragma unroll
    for (int k = 0; k < 16; ++k) { const int s = t - 8 + k; const float f = (s >= lo && s < hi) ? 1.f : 0.f; const v4u z = zz[k];
        acc[0] += f * bflo(z.x); acc[1] += f * bfhi(z.x); acc[2] += f * bflo(z.y); acc[3] += f * bfhi(z.y); acc[4] += f * bflo(z.z); acc[5] += f * bfhi(z.z); acc[6] += f * bflo(z.w); acc[7] += f * bfhi(z.w);
        if (k == 8) zt = z; }
    const float inv = 1.0f / (float)(hi - lo);
    v4u o; o.x = pk2(acc[0] * inv - bflo(zt.x), acc[1] * inv - bfhi(zt.x)); o.y = pk2(acc[2] * inv - bflo(zt.y), acc[3] * inv - bfhi(zt.y));
    o.z = pk2(acc[4] * inv - bflo(zt.z), acc[5] * inv - bfhi(zt.z)); o.w = pk2(acc[6] * inv - bflo(zt.w), acc[7] * inv - bfhi(zt.w));
    *(GAS v4u*)((bf16*)(F.ws + WS_CAT) + (size_t)m * D + lane * 8) = o;
}
__device__ __forceinline__ void route_phase(Frame& F, const Args& A) {
    typedef short s8v __attribute__((ext_vector_type(8)));
    const int lane = opq(hw_lane()), tok = lane & 15, kq = lane >> 4, w = F.wave, t = w * 64 + lane;
    s8v ah[4][3], al[4][3];
    { const bf16* wh = (const bf16*)(F.ws + WS_WR) + (size_t)tok * D + 128 * w + 8 * kq; const bf16* wl = wh + 48 * D;
#pragma unroll
      for (int sk = 0; sk < 4; ++sk)
#pragma unroll
          for (int q = 0; q < 3; ++q) { ah[sk][q] = *(const GAS s8v*)(wh + (size_t)q * 16 * D + 32 * sk); al[sk][q] = *(const GAS s8v*)(wl + (size_t)q * 16 * D + 32 * sk); } }
    LAS float* P = (LAS float*)(F.lds + RING_OFF);
    LAS float* R = P + 8 * 64 * 52;
    const int cid = (int)blockIdx.x, nit = M / 16;
    for (int b0 = cid; b0 < nit; b0 += 4 * F.G) {
        f32x4 acc[4][3];
        float ssq[4];
        f32x4 hc[4][2], hn[4][2];
        { const float* hrow = F.out + (size_t)(b0 * 16 + tok) * D + 128 * w + 8 * kq;
#pragma unroll
          for (int sk = 0; sk < 4; ++sk) { hc[sk][0] = *(const GAS f32x4*)(hrow + 32 * sk); hc[sk][1] = *(const GAS f32x4*)(hrow + 32 * sk + 4); } }
#pragma unroll
        for (int j = 0; j < 4; ++j) {
            const int itn = b0 + (j + 1) * F.G;
            if (j < 3 && itn < nit) { const float* hrow = F.out + (size_t)(itn * 16 + tok) * D + 128 * w + 8 * kq;
#pragma unroll
                for (int sk = 0; sk < 4; ++sk) { hn[sk][0] = *(const GAS f32x4*)(hrow + 32 * sk); hn[sk][1] = *(const GAS f32x4*)(hrow + 32 * sk + 4); } }
            acc[j][0] = (f32x4){0.f, 0.f, 0.f, 0.f}; acc[j][1] = acc[j][0]; acc[j][2] = acc[j][0]; ssq[j] = 0.f;
            if (b0 + j * F.G < nit) {
#pragma unroll
                for (int sk = 0; sk < 4; ++sk) {
                    const f32x4 h0 = hc[sk][0], h1 = hc[sk][1];
                    ssq[j] += (h0.x * h0.x + h0.y * h0.y) + (h0.z * h0.z + h0.w * h0.w) + (h1.x * h1.x + h1.y * h1.y) + (h1.z * h1.z + h1.w * h1.w);
                    const float hv[8] = {h0.x, h0.y, h0.z, h0.w, h1.x, h1.y, h1.z, h1.w};
                    s8v bh, bl;
#pragma unroll
                    for (int e8 = 0; e8 < 8; ++e8) { const unsigned hb = f2bf(hv[e8]); bh[e8] = (short)hb; bl[e8] = (short)f2bf(hv[e8] - __builtin_bit_cast(float, hb << 16)); }
#pragma unroll
                    for (int q = 0; q < 3; ++q) {
                        acc[j][q] = __builtin_amdgcn_mfma_f32_16x16x32_bf16(ah[sk][q], bh, acc[j][q], 0, 0, 0);
                        acc[j][q] = __builtin_amdgcn_mfma_f32_16x16x32_bf16(ah[sk][q], bl, acc[j][q], 0, 0, 0);
                        acc[j][q] = __builtin_amdgcn_mfma_f32_16x16x32_bf16(al[sk][q], bh, acc[j][q], 0, 0, 0);
                    }
                }
            }
#pragma unroll
            for (int sk = 0; sk < 4; ++sk) { hc[sk][0] = hn[sk][0]; hc[sk][1] = hn[sk][1]; }
        }
#pragma unroll
        for (int j = 0; j < 4; ++j) { LAS float* Pw = P + (w * 64 + j * 16 + tok) * 52;
#pragma unroll
            for (int q = 0; q < 3; ++q)
#pragma unroll
                for (int r = 0; r < 4; ++r) Pw[16 * q + 4 * kq + r] = acc[j][q][r];
            Pw[48 + kq] = ssq[j]; }
        __syncthreads();
        { const int t2 = opq(w * 64 + hw_lane());
#pragma unroll
          for (int i7 = 0; i7 < 7; ++i7) { const int idx = t2 + 512 * i7;
            if (idx < 64 * 52) { float sum = 0.f;
#pragma unroll
                for (int ww = 0; ww < 8; ++ww) sum += P[ww * (64 * 52) + idx];
                R[idx] = sum; } } }
        __syncthreads();
        if (w == 0) {
            const int ln = opq(hw_lane());
            const bool act = b0 + (ln >> 4) * F.G < nit;
            LAS unsigned* HI = (LAS unsigned*)F.MISC + MW_HIST; LAS unsigned* BA = (LAS unsigned*)F.MISC + MW_BASE;
            if (ln < NEXP) HI[ln] = 0u;
            const LAS float* tr = R + ln * 52; const int m = (b0 + (ln >> 4) * F.G) * 16 + (ln & 15);
            const float rstd = 1.f / sqrtf(((tr[48] + tr[49]) + (tr[50] + tr[51])) * (1.f / D) + RMS_EPS);
            float gl[4];
#pragma unroll
            for (int k = 0; k < 4; ++k) gl[k] = rstd * tr[k] + A.in[19][k];
            int gsel = 0; float gmax = gl[0];
#pragma unroll
            for (int k = 1; k < 4; ++k) if (gl[k] > gmax) { gmax = gl[k]; gsel = k; }
            float gden = 0.f;
#pragma unroll
            for (int k = 0; k < 4; ++k) gden += __expf(gl[k] - gmax);
            const float grp_p = 1.0f / gden;
            float el[8];
#pragma unroll
            for (int e = 0; e < 8; ++e) el[e] = rstd * tr[4 + gsel * 8 + e] + A.in[21][gsel * 8 + e];
            int i1 = 0; float m1 = el[0];
#pragma unroll
            for (int e = 1; e < 8; ++e) if (el[e] > m1) { m1 = el[e]; i1 = e; }
            int i2 = -1; float m2 = -3.0e38f;
#pragma unroll
            for (int e = 0; e < 8; ++e) if (e != i1 && el[e] > m2) { m2 = el[e]; i2 = e; }
            const float rr = __expf(m2 - m1), w1 = grp_p / (1.0f + rr), w2 = grp_p * rr / (1.0f + rr);
            const int e1 = gsel * 8 + i1, e2 = gsel * 8 + i2;
            unsigned r1 = 0u, r2 = 0u;
            if (act) { r1 = __hip_atomic_fetch_add(HI + e1, 1u, __ATOMIC_RELAXED, __HIP_MEMORY_SCOPE_WORKGROUP); r2 = __hip_atomic_fetch_add(HI + e2, 1u, __ATOMIC_RELAXED, __HIP_MEMORY_SCOPE_WORKGROUP); }
            LDS_WAIT(); asm volatile("" ::: "memory");
            if (ln < NEXP) { const unsigned hc_ = HI[ln]; BA[ln] = hc_ ? __hip_atomic_fetch_add((unsigned*)(F.ctl + CW_CNT) + 64 * ln, hc_, RLX_AGENT) : 0u; }
            LDS_WAIT(); asm volatile("" ::: "memory");
            if (act) { const unsigned p1 = BA[e1] + r1, p2 = BA[e2] + r2;
                int* LI = (int*)(F.ws + WS_LIST); float* LW = (float*)(F.ws + WS_LISTW); float* LR = (float*)(F.ws + WS_LISTR);
                LI[(size_t)e1 * M + p1] = 2 * m; LW[(size_t)e1 * M + p1] = w1; LR[(size_t)e1 * M + p1] = rstd;
                LI[(size_t)e2 * M + p2] = 2 * m + 1; LW[(size_t)e2 * M + p2] = w2; LR[(size_t)e2 * M + p2] = rstd; }
        }
        __syncthreads();
    }
}
template <class Sched> __device__ __forceinline__ void expert_setup(Frame& F, const Sched& S) {
    const int t = opq(F.wave * 64 + hw_lane());
    if (t < NEXP) F.MISC[MW_CNT + t] = __hip_atomic_load((unsigned*)(F.ctl + CW_CNT) + 64 * t, RLX_AGENT);
    __syncthreads();
    if (t < NEXP) {
        unsigned ts = 0u, nfull_before = 0u, nfull = 0u, rank = 0u; const unsigned n_me = F.MISC[MW_CNT + t], nv_me = n_me & 255u;
        for (int e = 0; e < NEXP; ++e) { const unsigned n = F.MISC[MW_CNT + e], nv = n & 255u;
            if (e < t) { ts += (n + 255u) >> 8; nfull_before += n >> 8; }
            nfull += n >> 8;
            if (nv > nv_me || (nv == nv_me && e < t)) rank += (nv > 0u) ? 1u : 0u; }
        F.MISC[MW_TSTART + t] = ts;
        if (t == NEXP - 1) F.MISC[MW_TSTART + NEXP] = ts + ((n_me + 255u) >> 8);
        for (unsigned rt = 0; rt < (n_me >> 8); ++rt) F.MISC[MW_TL + nfull_before + rt] = (unsigned)t | (rt << 5) | (256u << 12);
        if (nv_me > 0u) F.MISC[MW_TL + nfull + rank] = (unsigned)t | ((n_me >> 8) << 5) | (nv_me << 12);
    }
    __syncthreads();
    LAS unsigned* ro = (LAS unsigned*)(F.lds + ROWOFF_OFF);
    for (int i = 0; i < 4; ++i) { Unit u; if (!S.next(i, u)) break;
        const int e = u.pn >> 1, idx = ((int)u.pm - (int)F.MISC[MW_TSTART + e]) * 256 + (t & 255), n_e = (int)F.MISC[MW_CNT + e];
        if (t < 256) ro[i * 256 + t] = (idx < n_e) ? (unsigned)(((const int*)(F.ws + WS_LIST))[(size_t)e * M + idx] >> 1) * (unsigned)(D * 2) : 0u; }
    __syncthreads();
}
template <int R> __device__ __forceinline__ void moe_combine_rows(Frame& F, const Args& A, int m0, int stride) {
    const int lane = opq(hw_lane());
    const GAS f32x4* gr = (const GAS f32x4*)A.in[25] + lane;
    f32x4 v[R][4]; v2u a[R][4], b[R][4];
#pragma unroll
    for (int r = 0; r < R; ++r) { const size_t m = (size_t)(m0 + r * stride);
#pragma unroll
        for (int j = 0; j < 4; ++j) { v[r][j] = *((const GAS f32x4*)(F.out + m * D) + lane + 64 * j);
            a[r][j] = *((const GAS v2u*)((const bf16*)(F.ws + WS_MO0) + m * D) + lane + 64 * j); b[r][j] = *((const GAS v2u*)((const bf16*)(F.ws + WS_MO1) + m * D) + lane + 64 * j); } }
#pragma unroll
    for (int r = 0; r < R; ++r) { const size_t m = (size_t)(m0 + r * stride); float s = 0.f;
        GAS f32x4* hr = (GAS f32x4*)(F.out + m * D) + lane; GAS unsigned long long* o8 = (GAS unsigned long long*)((bf16*)(F.ws + WS_XN) + m * D) + lane;
#pragma unroll
        for (int j = 0; j < 4; ++j) { f32x4& x = v[r][j];
            x.x += bflo(a[r][j].x) + bflo(b[r][j].x); x.y += bfhi(a[r][j].x) + bfhi(b[r][j].x); x.z += bflo(a[r][j].y) + bflo(b[r][j].y); x.w += bfhi(a[r][j].y) + bfhi(b[r][j].y);
            hr[64 * j] = x; s += (x.x * x.x + x.y * x.y) + (x.z * x.z + x.w * x.w); }
        const float rstd = 1.f / sqrtf(wave_sum(s) * (1.f / D) + RMS_EPS);
#pragma unroll
        for (int j = 0; j < 4; ++j) { const f32x4 gg = gr[64 * j], x = v[r][j];
            o8[64 * j] = (unsigned long long)pk2(x.x * rstd * gg.x, x.y * rstd * gg.y) | ((unsigned long long)pk2(x.z * rstd * gg.z, x.w * rstd * gg.w) << 32); } }
}
template <int R, bool ADDG> __device__ __forceinline__ void final_rows(Frame& F, const Args& A, int m0, int stride) {
    const int lane = opq(hw_lane());
    const GAS f32x4* gr = (const GAS f32x4*)A.in[29] + lane;
    f32x4 v[R][4]; v2u gg[R][4];
#pragma unroll
    for (int r = 0; r < R; ++r) { const size_t m = (size_t)(m0 + r * stride);
#pragma unroll
        for (int j = 0; j < 4; ++j) { v[r][j] = *((const GAS f32x4*)(F.out + m * D) + lane + 64 * j);
            if (ADDG) gg[r][j] = *((const GAS v2u*)((const bf16*)(F.ws + WS_PE) + m * D) + lane + 64 * j); } }
#pragma unroll
    for (int r = 0; r < R; ++r) { const size_t m = (size_t)(m0 + r * stride); float s = 0.f;
        GAS f32x4* hr = (GAS f32x4*)(F.out + m * D) + lane;
#pragma unroll
        for (int j = 0; j < 4; ++j) { f32x4& x = v[r][j];
            if (ADDG) { x.x += bflo(gg[r][j].x); x.y += bfhi(gg[r][j].x); x.z += bflo(gg[r][j].y); x.w += bfhi(gg[r][j].y); }
            s += (x.x * x.x + x.y * x.y) + (x.z * x.z + x.w * x.w); }
        const float rstd = 1.f / sqrtf(wave_sum(s) * (1.f / D) + RMS_EPS);
#pragma unroll
        for (int j = 0; j < 4; ++j) hr[64 * j] = v[r][j] * rstd * gr[64 * j]; }
}

__global__ void __launch_bounds__(NWAVES * 64, 2) mk_fwd(Args args) {
    extern __shared__ __attribute__((aligned(16))) unsigned char lds[];
    Frame F;
    F.lds = (LAS unsigned char*)lds;
    F.MISC = (volatile LAS unsigned*)(F.lds + MISC_OFF);
    F.wave = __builtin_amdgcn_readfirstlane(threadIdx.x >> 6);
    F.G = gridDim.x; F.gw = blockIdx.x * NWAVES + F.wave; F.ngw = F.G * NWAVES;
    F.out = args.out; F.ws = args.ws; F.ctl = (gu32*)(args.ws + WS_CTL);
    for (int u = threadIdx.x; u < (LDS_BYTES - LDSCTL_OFF) / 4; u += NWAVES * 64) ((LAS unsigned*)(F.lds + LDSCTL_OFF))[u] = 0u;
    __syncthreads();
    XcdBarrier bar = xcd_barrier_post((unsigned*)(F.ctl + CW_BAR), F.MISC + 8); bar.wave = F.wave;
#define GRID_BAR() xcd_barrier(bar)
    bf16* const WIN = (bf16*)(F.ws + WS_WIN); bf16* const GLU = (bf16*)(F.ws + WS_GLU); bf16* const WCAT = (bf16*)(F.ws + WS_WCAT); bf16* const WG = (bf16*)(F.ws + WS_WG); bf16* const WPLE = (bf16*)(F.ws + WS_WPLE);
    bf16* const WGU = (bf16*)(F.ws + WS_WGU); bf16* const WD = (bf16*)(F.ws + WS_WD); bf16* const MS = (bf16*)(F.ws + WS_MS); bf16* const WS3 = (bf16*)(F.ws + WS_WS3);
    bf16* const XN = (bf16*)(F.ws + WS_XN); bf16* const ZP = (bf16*)(F.ws + WS_ZP); bf16* const AS = (bf16*)(F.ws + WS_AS); bf16* const SLOC = (bf16*)(F.ws + WS_SLOC);
    bf16* const CAT = (bf16*)(F.ws + WS_CAT); bf16* const ZZ = (bf16*)(F.ws + WS_ZZ); bf16* const PB = (bf16*)(F.ws + WS_PB); bf16* const PE = (bf16*)(F.ws + WS_PE);
    bf16* const ACT = (bf16*)(F.ws + WS_ACT); bf16* const MO0 = (bf16*)(F.ws + WS_MO0); bf16* const MO1 = (bf16*)(F.ws + WS_MO1);
    const int cid = (int)blockIdx.x;

    p0_prologue(F, args);
    GRID_BAR();
    { pg8::Gemm g{XN, WIN, D, D, D}; pg8::StaticOrder S; S.init(M, D, F.G, cid); EpiZ E{ZP, AS};
      pg8::gemm_phase<EpiZ, pg8::StaticOrder, true, true>(F.lds + RING_OFF, g, S, E, F.wave); }
    GRID_BAR();
    { pg8::Gemm g{AS, MS, 256, 512, 256}; GroupOrder S{F.G, cid}; EpiSloc E{SLOC};
      pg8::gemm_phase<EpiSloc, GroupOrder, true, true>(F.lds + RING_OFF, g, S, E, F.wave); }
    { pg8::Gemm g{(const bf16*)(F.ws + WS_WOS), (const bf16*)(F.ws + WS_BD), 256, 256, 256}; WeffOrder S{F.G, cid}; EpiWeff E{WCAT};
      pg8::gemm_phase<EpiWeff, WeffOrder, true, true>(F.lds + RING_OFF, g, S, E, F.wave); }
    bg_range(F, args, 1400, 2000, 0, 0);
    GRID_BAR();
    {
        if (F.G >= 256) { if (cid < 128) { carry_unit(F, cid); for (int m = 10240 + cid * NWAVES + F.wave; m < M; m += 128 * NWAVES) diff_row(F, m); }
                          else for (int m = (cid - 128) * NWAVES + F.wave; m < 10240; m += (F.G - 128) * NWAVES) diff_row(F, m); }
        else { for (int u = cid; u < 128; u += F.G) carry_unit(F, u); for (int m = F.gw; m < M; m += F.ngw) diff_row(F, m); }
    }
    GRID_BAR();
    { pg8::Gemm g{AS, WS3, 512, 512, 512}; GroupOrder S{F.G, cid}; EpiY E{ZZ};
      pg8::gemm_phase<EpiY, GroupOrder, true, true>(F.lds + RING_OFF, g, S, E, F.wave); }
    bg_range(F, args, 2000, 5000, 0, M / 2);
    GRID_BAR();
    { pg8::Gemm g{ZZ, GLU, DP, DP, DP}; pg8::StaticOrder S; S.init(M, DP, F.G, cid); EpiGlu E{ZZ, args.in[15], CAT};
      pg8::gemm_phase<EpiGlu, pg8::StaticOrder, true, true>(F.lds + RING_OFF, g, S, E, F.wave); }
    bg_range(F, args, 5000, BG_TOTAL, M / 2, M);
    GRID_BAR();
    { pg8::Gemm g{CAT, WCAT, D, D, D}; pg8::StaticOrder S; S.init(M, D, F.G, cid); EpiRes E{args.in[0], F.out, args.in[17], XN};
      pg8::gemm_phase<EpiRes, pg8::StaticOrder, true, true>(F.lds + RING_OFF, g, S, E, F.wave); }
    GRID_BAR();
    route_phase(F, args);
    bg_range(F, args, 0, 1400, 0, 0, true);
    GRID_BAR();
    { pg8::Gemm g{XN, WGU, D, D, D}; ExpertOrder<2> S{F.G, cid, F.MISC}; expert_setup(F, S);
      EpiAct E{(const float*)(F.ws + WS_LISTW), (const float*)(F.ws + WS_LISTR), ACT, F.MISC + 16};
      pg8::gemm_phase<EpiAct, ExpertOrder<2>, true, true, true, true>(F.lds + RING_OFF, g, S, E, F.wave, (const LAS unsigned*)(F.lds + ROWOFF_OFF)); }
    { const int nun = 2 * __builtin_amdgcn_readfirstlane((int)F.MISC[MW_TSTART + NEXP]), n2 = (nun > F.G && nun < 2 * F.G) ? nun - F.G : 0;
      pg8::Gemm g{PB, WPLE, DPLE, DPLE, DPLE}; PeOrder S{F.G, cid, n2}; EpiPe E{PE};
      pg8::gemm_phase<EpiPe, PeOrder, true, true>(F.lds + RING_OFF, g, S, E, F.wave); }
    GRID_BAR();
    { pg8::Gemm g{ACT, WD, DF, DF, DF}; ExpertOrder<4> S{F.G, cid, F.MISC}; EpiDown E{(const int*)(F.ws + WS_LIST), (const unsigned*)(F.ctl + CW_CNT), MO0, MO1, F.MISC + 16};
      pg8::gemm_phase<EpiDown, ExpertOrder<4>, true, true, false, true>(F.lds + RING_OFF, g, S, E, F.wave); }
    GRID_BAR();
    for (int m = F.gw; m + F.ngw < M; m += 2 * F.ngw) moe_combine_rows<2>(F, args, m, F.ngw);
    GRID_BAR();
    { pg8::Gemm g{XN, WG, D, D, D}; pg8::StaticOrder S; S.init(M, D, F.G, cid); EpiGate E{args.in[27], PE};
      pg8::gemm_phase<EpiGate, pg8::StaticOrder, true, true>(F.lds + RING_OFF, g, S, E, F.wave); }
    GRID_BAR();
    for (int m = F.gw; m + 3 * F.ngw < M; m += 4 * F.ngw) final_rows<4, true>(F, args, m, F.ngw);
}

extern "C" void kernel_launch(void* const* d_in, const int* in_sizes, int n_in, void* d_out, int out_size, void* d_ws, size_t ws_size, hipStream_t stream) {
    static int grid = 0;
    if (grid == 0) {
        if (n_in != 30 || in_sizes[0] != M * D || out_size != M * D || ws_size < WS_END) { fprintf(stderr, "kernel_launch: unexpected shapes (n_in %d, in0 %d, out %d, ws %zu)\n", n_in, n_in > 0 ? in_sizes[0] : -1, out_size, ws_size); grid = -1; return; }
        int dev = 0, cus = 0, per_cu = 0;
        if (hipGetDevice(&dev) != hipSuccess || hipDeviceGetAttribute(&cus, hipDeviceAttributeMultiprocessorCount, dev) != hipSuccess) { grid = -1; return; }
        if (hipFuncSetAttribute((const void*)mk_fwd, hipFuncAttributeMaxDynamicSharedMemorySize, LDS_BYTES) != hipSuccess) { fprintf(stderr, "kernel_launch: hipFuncSetAttribute failed\n"); grid = -1; return; }
        if (hipOccupancyMaxActiveBlocksPerMultiprocessor(&per_cu, (const void*)mk_fwd, NWAVES * 64, LDS_BYTES) != hipSuccess || per_cu < 1) { fprintf(stderr, "kernel_launch: occupancy query reports %d blocks per CU\n", per_cu); }
        (void)hipGetLastError();
        grid = cus;
    }
    if (grid < 0) return;
    (void)hipMemsetAsync((char*)d_ws + WS_CTL, 0, CTL_ZERO_BYTES, stream);
    Args a{};
    for (int i = 0; i < 30; ++i) a.in[i] = (const float*)d_in[i];
    a.out = (float*)d_out; a.ws = (unsigned char*)d_ws;
    hipLaunchKernelGGL(mk_fwd, dim3(grid), dim3(NWAVES * 64), LDS_BYTES, stream, a);
}
```
